# Optimizing an MI355X kernel written in HIP

```python
import jax
import jax.numpy as jnp
from jax import lax
import numpy as np

D_MODEL = 1024
BATCH = 16
SEQ = 2048
DEPTH = 1

CTX_LEN = 256
GRID_W = 64
N_HEADS = 16
N_KV_HEADS = 4
GROUP = N_HEADS // N_KV_HEADS
HEAD_DIM = D_MODEL // N_HEADS
ATTN_WIDTH = N_HEADS * HEAD_DIM
KV_WIDTH = N_KV_HEADS * HEAD_DIM
WINDOW = 128
Q_BLOCK = 128
ROPE_BASE = 10000.0
CONV_WIDTH = D_MODEL
CONV_SIZE = 3
N_EXPERTS = 16
EXPERT_FF = D_MODEL
CAPACITY_FACTOR = 2
N_MOD = 6
IN_WIDTH = ATTN_WIDTH + 2 * KV_WIDTH + 3 * CONV_WIDTH + 2 * D_MODEL
EPS = 1e-6
NEG_INF = -1e30

kernel_name = "hybrid_gated_swa_shortconv_ecmoe_dit"


def rmsnorm(x, g):
    x32 = x.astype(jnp.float32)
    y = x32 * lax.rsqrt(jnp.mean(x32 * x32, axis=-1, keepdims=True) + EPS)
    return (y * g.astype(jnp.float32)).astype(x.dtype)


def modulate(h, shift, scale):
    return h * (1 + scale) + shift


def split_projection(p):
    sizes = (ATTN_WIDTH, KV_WIDTH, KV_WIDTH, CONV_WIDTH, CONV_WIDTH, CONV_WIDTH, D_MODEL, D_MODEL)
    parts = []
    off = 0
    for s in sizes:
        parts.append(p[..., off:off + s])
        off += s
    return parts


def axial_rope_tables(n_tokens, dtype):
    rows = n_tokens // GRID_W
    row = jnp.repeat(jnp.arange(rows, dtype=jnp.float32), GRID_W)
    col = jnp.tile(jnp.arange(GRID_W, dtype=jnp.float32), rows)
    n_freq = HEAD_DIM // 4
    inv_freq = ROPE_BASE ** (-jnp.arange(n_freq, dtype=jnp.float32) / n_freq)
    ang_r = row[:, None] * inv_freq[None, :]
    ang_c = col[:, None] * inv_freq[None, :]
    ang = jnp.concatenate([ang_r, ang_r, ang_c, ang_c], axis=-1)[:, None, :]
    return jnp.cos(ang).astype(dtype), jnp.sin(ang).astype(dtype)


def rotate_half(z):
    z1, z2 = jnp.split(z, 2, axis=-1)
    return jnp.concatenate([-z2, z1], axis=-1)


def apply_axial_rope(x, cos, sin):
    xr, xc = jnp.split(x, 2, axis=-1)
    rot = jnp.concatenate([rotate_half(xr), rotate_half(xc)], axis=-1)
    return x * cos + rot * sin


def sink_column(sink, shape_prefix):
    return jnp.broadcast_to(sink.astype(jnp.float32)[None, :, :, None, None], shape_prefix + (1,))


def latent_window_attention(q, k, v, k_ctx, v_ctx, sink):
    B, T = q.shape[0], q.shape[1]
    L = k_ctx.shape[1]
    n_blocks = T // Q_BLOCK
    span = Q_BLOCK + 2 * WINDOW
    scale = HEAD_DIM ** -0.5
    pad = ((0, 0), (WINDOW, WINDOW), (0, 0), (0, 0))
    kp = jnp.pad(k, pad)
    vp = jnp.pad(v, pad)
    key_offset = jnp.arange(span) - WINDOW

    def block(i):
        start = i * Q_BLOCK
        qb = lax.dynamic_slice_in_dim(q, start, Q_BLOCK, axis=1)
        kb = lax.dynamic_slice_in_dim(kp, start, span, axis=1)
        vb = lax.dynamic_slice_in_dim(vp, start, span, axis=1)
        s_lat = jnp.einsum('bqhgd,bshd->bhgqs', qb, kb).astype(jnp.float32) * scale
        s_ctx = jnp.einsum('bqhgd,bshd->bhgqs', qb, k_ctx).astype(jnp.float32) * scale
        qpos = start + jnp.arange(Q_BLOCK)
        kpos = start + key_offset
        valid = (jnp.abs(qpos[:, None] - kpos[None, :]) <= WINDOW) & (kpos >= 0)[None, :] & (kpos < T)[None, :]
        s_lat = jnp.where(valid, s_lat, NEG_INF)
        logits = jnp.concatenate([s_lat, s_ctx, sink_column(sink, s_lat.shape[:-1])], axis=-1)
        p = jax.nn.softmax(logits, axis=-1)
        p_lat = p[..., :span].astype(v.dtype)
        p_ctx = p[..., span:span + L].astype(v.dtype)
        return (jnp.einsum('bhgqs,bshd->bqhgd', p_lat, vb)
                + jnp.einsum('bhgqs,bshd->bqhgd', p_ctx, v_ctx))

    o = lax.map(block, jnp.arange(n_blocks))
    return jnp.transpose(o, (1, 0, 2, 3, 4, 5)).reshape(B, T, ATTN_WIDTH)


def context_attention(q, k, v, sink):
    B, L = q.shape[0], q.shape[1]
    scale = HEAD_DIM ** -0.5
    s = jnp.einsum('bqhgd,bshd->bhgqs', q, k).astype(jnp.float32) * scale
    p = jax.nn.softmax(jnp.concatenate([s, sink_column(sink, s.shape[:-1])], axis=-1), axis=-1)
    o = jnp.einsum('bhgqs,bshd->bqhgd', p[..., :L].astype(v.dtype), v)
    return o.reshape(B, L, ATTN_WIDTH)


def short_conv_mixer(u, gate_b, gate_c, conv_w):
    z = gate_c * u
    zp = jnp.pad(z, ((0, 0), (1, 1), (0, 0)))
    y = conv_w[0] * zp[:, :-2] + conv_w[1] * zp[:, 1:-1] + conv_w[2] * zp[:, 2:]
    return gate_b * y


def gated_merge(o_attn, y_conv, g_attn, g_conv, w_proj_attn, w_proj_conv, w_out):
    a = jnp.einsum('btf,fd->btd', o_attn, w_proj_attn)
    s = jnp.einsum('btf,fd->btd', y_conv, w_proj_conv)
    merged = jax.nn.sigmoid(g_attn) * a + jax.nn.sigmoid(g_conv) * s
    return jnp.einsum('btd,de->bte', merged, w_out)


def expert_choice_moe(h, w_router, w_gate, w_up, w_down):
    B, T, D = h.shape
    cap = CAPACITY_FACTOR * T // N_EXPERTS
    logits = jnp.einsum('btd,de->bte', h, w_router).astype(jnp.float32)
    affinity = jax.nn.softmax(logits, axis=-1)
    gate, idx = lax.top_k(jnp.swapaxes(affinity, 1, 2), cap)
    xe = jax.vmap(lambda hb, ib: hb[ib])(h, idx)
    a = jnp.einsum('becd,edf->becf', xe, w_gate)
    u = jnp.einsum('becd,edf->becf', xe, w_up)
    ye = jnp.einsum('becf,efd->becd', jax.nn.silu(a) * u, w_down) * gate.astype(h.dtype)[..., None]

    def combine(yb, ib):
        return jnp.zeros((T, D), yb.dtype).at[ib.reshape(-1)].add(yb.reshape(-1, D))

    return jax.vmap(combine)(ye, idx)


def setup_inputs(seed: int = 0) -> dict:
    key = jax.random.key(seed)
    ks = jax.random.split(key, 20)
    f32 = jnp.float32

    def nrm(k, shape, scale):
        return jax.random.normal(k, shape, f32) * scale

    return {
        'x': nrm(ks[0], (BATCH, SEQ, D_MODEL), 1.0),
        'c': nrm(ks[1], (BATCH, D_MODEL), 1.0),
        'ctx': nrm(ks[2], (BATCH, CTX_LEN, D_MODEL), 1.0),
        'c_ctx': nrm(ks[3], (D_MODEL,), 1.0),
        'w_mod': nrm(ks[4], (DEPTH, D_MODEL, N_MOD * D_MODEL), 0.5 * D_MODEL ** -0.5),
        'b_mod': nrm(ks[5], (DEPTH, N_MOD * D_MODEL), 0.02),
        'norm1_g': 1.0 + nrm(ks[6], (DEPTH, D_MODEL), 0.02),
        'w_in': nrm(ks[7], (DEPTH, D_MODEL, IN_WIDTH), D_MODEL ** -0.5),
        'attn_sink': nrm(ks[8], (DEPTH, N_KV_HEADS, GROUP), 0.5),
        'conv_w': nrm(ks[9], (DEPTH, CONV_SIZE, CONV_WIDTH), CONV_SIZE ** -0.5),
        'w_proj_attn': nrm(ks[10], (DEPTH, ATTN_WIDTH, D_MODEL), ATTN_WIDTH ** -0.5),
        'w_proj_conv': nrm(ks[11], (DEPTH, CONV_WIDTH, D_MODEL), CONV_WIDTH ** -0.5),
        'w_out': nrm(ks[12], (DEPTH, D_MODEL, D_MODEL), D_MODEL ** -0.5),
        'norm2_g': 1.0 + nrm(ks[13], (DEPTH, D_MODEL), 0.02),
        'w_router': nrm(ks[14], (DEPTH, D_MODEL, N_EXPERTS), D_MODEL ** -0.5),
        'w_exp_gate': nrm(ks[15], (DEPTH, N_EXPERTS, D_MODEL, EXPERT_FF), D_MODEL ** -0.5),
        'w_exp_up': nrm(ks[16], (DEPTH, N_EXPERTS, D_MODEL, EXPERT_FF), D_MODEL ** -0.5),
        'w_exp_down': nrm(ks[17], (DEPTH, N_EXPERTS, EXPERT_FF, D_MODEL), EXPERT_FF ** -0.5),
        'final_norm_g': 1.0 + nrm(ks[18], (D_MODEL,), 0.02),
    }


def reference(x, c, ctx, c_ctx, w_mod, b_mod, norm1_g, w_in, attn_sink, conv_w,
              w_proj_attn, w_proj_conv, w_out, norm2_g, w_router, w_exp_gate, w_exp_up,
              w_exp_down, final_norm_g):
    B, T = x.shape[0], x.shape[1]
    L = ctx.shape[1]
    cos, sin = axial_rope_tables(T, x.dtype)
    h_ctx_stream = ctx
    for layer in range(DEPTH):
        last = layer == DEPTH - 1
        mod = jnp.einsum('bd,de->be', jax.nn.silu(c), w_mod[layer]) + b_mod[layer]
        sh1, sc1, g1, sh2, sc2, g2 = jnp.split(mod[:, None, :], N_MOD, axis=-1)
        mod_c = jnp.einsum('d,de->e', jax.nn.silu(c_ctx), w_mod[layer]) + b_mod[layer]
        csh1, csc1, cg1, csh2, csc2, cg2 = jnp.split(mod_c, N_MOD, axis=-1)

        hc = modulate(rmsnorm(h_ctx_stream, norm1_g[layer]), csh1, csc1)
        if last:
            kv_c = jnp.einsum('btd,df->btf', hc, w_in[layer][:, ATTN_WIDTH:ATTN_WIDTH + 2 * KV_WIDTH])
            k_c, v_c = jnp.split(kv_c, 2, axis=-1)
        else:
            pc = split_projection(jnp.einsum('btd,df->btf', hc, w_in[layer]))
            q_c, k_c, v_c, u_c, b_c, c_c, ga_c, gc_c = pc
        k_ctx = k_c.reshape(B, L, N_KV_HEADS, HEAD_DIM)
        v_ctx = v_c.reshape(B, L, N_KV_HEADS, HEAD_DIM)

        hx = modulate(rmsnorm(x, norm1_g[layer]), sh1, sc1)
        q_x, k_x, v_x, u_x, b_x, c_x, ga_x, gc_x = split_projection(
            jnp.einsum('btd,df->btf', hx, w_in[layer]))
        q = apply_axial_rope(q_x.reshape(B, T, N_HEADS, HEAD_DIM), cos, sin)
        q = q.reshape(B, T, N_KV_HEADS, GROUP, HEAD_DIM)
        k = apply_axial_rope(k_x.reshape(B, T, N_KV_HEADS, HEAD_DIM), cos, sin)
        v = v_x.reshape(B, T, N_KV_HEADS, HEAD_DIM)
        o_attn = latent_window_attention(q, k, v, k_ctx, v_ctx, attn_sink[layer])
        y_conv = short_conv_mixer(u_x, b_x, c_x, conv_w[layer])
        x = x + g1 * gated_merge(o_attn, y_conv, ga_x, gc_x,
                                 w_proj_attn[layer], w_proj_conv[layer], w_out[layer])

        hx2 = modulate(rmsnorm(x, norm2_g[layer]), sh2, sc2)
        x = x + g2 * expert_choice_moe(hx2, w_router[layer], w_exp_gate[layer],
                                       w_exp_up[layer], w_exp_down[layer])

        if not last:
            o_c = context_attention(q_c.reshape(B, L, N_KV_HEADS, GROUP, HEAD_DIM),
                                    k_ctx, v_ctx, attn_sink[layer])
            y_c = short_conv_mixer(u_c, b_c, c_c, conv_w[layer])
            h_ctx_stream = h_ctx_stream + cg1 * gated_merge(
                o_c, y_c, ga_c, gc_c, w_proj_attn[layer], w_proj_conv[layer], w_out[layer])
            hc2 = modulate(rmsnorm(h_ctx_stream, norm2_g[layer]), csh2, csc2)
            h_ctx_stream = h_ctx_stream + cg2 * expert_choice_moe(
                hc2, w_router[layer], w_exp_gate[layer], w_exp_up[layer], w_exp_down[layer])

    return rmsnorm(x, final_norm_g)
```

```cpp
#include <hip/hip_runtime.h>
#include <hip/hip_cooperative_groups.h>
#include <cstdio>
#include <cstdint>
#ifndef HYB
#define HYB -1
#endif
#if HYB >= 0
#define FK_NBF 8
#endif
namespace g8 {
#define G8_LAS __attribute__((address_space(3)))
typedef unsigned short bf16_t;
typedef short bf16x8 __attribute__((ext_vector_type(8)));
typedef float f32x4 __attribute__((ext_vector_type(4)));
typedef float f32x2 __attribute__((ext_vector_type(2)));
typedef unsigned u32x4 __attribute__((ext_vector_type(4)));
typedef unsigned u32x2 __attribute__((ext_vector_type(2)));
constexpr int BM = 256, BK = 64, HALF = 128, HTB = HALF * BK * 2, STAGE_BYTES = 8 * HTB;

__host__ __device__ __forceinline__ int lds_byte(int r, int c) { const int st = (r >> 4) * 2 + (c >> 5), rr = r & 15, cc = c & 31, ob = rr * 64 + cc * 2; return st * 1024 + (ob ^ (((ob >> 9) & 1) << 5)); }
__host__ __device__ __forceinline__ void stage_rc(int b, int& R, int& C) { const int st = b / 1024, sb = b % 1024, swz = sb ^ (((sb >> 9) & 1) << 5); R = (st >> 1) * 16 + swz / 64; C = (st & 1) * 32 + (swz % 64) / 2; }
__host__ __device__ __forceinline__ int perm32(int rho) { const int n = rho >> 4, i = rho & 15; return 8 * (i >> 2) + 4 * n + (i & 3); }
__host__ __device__ __forceinline__ int pinv32(int x) { return 16 * ((x >> 2) & 1) + 4 * (x >> 3) + (x & 3); }

struct Unit { const char* a; const char* b; const int* rows; int kind; int pm; int pn; int aux; };

__device__ __forceinline__ unsigned cvt_pk_bf16(float lo, float hi) { unsigned r; asm volatile("v_cvt_pk_bf16_f32 %0, %1, %2" : "=v"(r) : "v"(lo), "v"(hi)); return r; }
__device__ __forceinline__ float bf_lo(unsigned w) { return __uint_as_float(w << 16); }
__device__ __forceinline__ float bf_hi(unsigned w) { return __uint_as_float(w & 0xffff0000u); }

template <class Epi, class Sched, bool HAS_MID, bool GATHER = false>
__device__ __forceinline__ void gemm_phase(G8_LAS unsigned char* lds, const int K, const Sched& S, const Epi& E) {
    const int tid = threadIdx.x, wid = __builtin_amdgcn_readfirstlane(tid >> 6), lane = tid & 63, wr = wid >> 2, wc = wid & 3, fr = lane & 15, fq = lane >> 4;
    const int nt = K / BK;
    unsigned voff[2];
#pragma unroll
    for (int i = 0; i < 2; ++i) { int R, C; stage_rc(tid * 16 + i * 8192, R, C); voff[i] = (unsigned)(R * K + C) * 2u; }
    const size_t kstep = (size_t)(BK * 2);
    const size_t hstep = (size_t)HALF * K * 2;
    const unsigned ldsw = (unsigned)wid * 1024u;
    const int aoff = lds_byte(wr * 64 + fr, fq * 8), boff = lds_byte(wc * 32 + fr, fq * 8);
#define G8_SA(b, h) (((b) * 2 + (h)) * HTB)
#define G8_SB(b, h) ((4 + (b) * 2 + (h)) * HTB)
#define G8_STAGE(bufoff, gbase) do { _Pragma("unroll") for (int _i = 0; _i < 2; ++_i) \
        __builtin_amdgcn_global_load_lds((const unsigned*)((const char*)(gbase) + voff[_i]), (G8_LAS unsigned*)(lds + (bufoff) + ldsw + _i * 8192), 16, 0, 0); } while (0)
#define G8_STAGE_V(bufoff, gbase, vv) do { _Pragma("unroll") for (int _i = 0; _i < 2; ++_i) \
        __builtin_amdgcn_global_load_lds((const unsigned*)((const char*)(gbase) + (vv)[_i]), (G8_LAS unsigned*)(lds + (bufoff) + ldsw + _i * 8192), 16, 0, 0); } while (0)
#define G8_STAGE_A(bufoff, gbase, h) do { if constexpr (GATHER) G8_STAGE_V(bufoff, gbase, va[h]); else G8_STAGE(bufoff, (gbase) + (h) * hstep); } while (0)
#define G8_LDA(dst, b, h) do { _Pragma("unroll") for (int m = 0; m < 4; ++m) _Pragma("unroll") for (int k = 0; k < 2; ++k) dst[m][k] = *(const G8_LAS bf16x8*)(lds + G8_SA(b, h) + aoff + m * 2048 + k * 1024); } while (0)
#define G8_LDB(dst, b, h) do { _Pragma("unroll") for (int n = 0; n < 2; ++n) _Pragma("unroll") for (int k = 0; k < 2; ++k) dst[n][k] = *(const G8_LAS bf16x8*)(lds + G8_SB(b, h) + boff + n * 2048 + k * 1024); } while (0)
#define G8_MMA(ai, bj, At, Bt) do { __builtin_amdgcn_s_setprio(1); _Pragma("unroll") for (int m = 0; m < 4; ++m) _Pragma("unroll") for (int n = 0; n < 2; ++n) _Pragma("unroll") for (int k = 0; k < 2; ++k) \
        acc[ai][bj][m][n] = __builtin_amdgcn_mfma_f32_16x16x32_bf16(Bt[n][k], At[m][k], acc[ai][bj][m][n], 0, 0, 0); __builtin_amdgcn_s_setprio(0); } while (0)
#define G8_WAIT_V(n) asm volatile("s_waitcnt vmcnt(" #n ")" ::: "memory")
#define G8_WAIT_L(n) asm volatile("s_waitcnt lgkmcnt(" #n ")" ::: "memory")
#define G8_BAR __builtin_amdgcn_s_barrier()
#define G8_SCHED __builtin_amdgcn_sched_barrier(0)
    Unit cur, nxt; int ui = 0;
    if (!S.next(0, cur)) return;
    f32x4 acc[2][2][4][2];
#pragma unroll
    for (int a = 0; a < 2; ++a)
#pragma unroll
        for (int b = 0; b < 2; ++b)
#pragma unroll
            for (int m = 0; m < 4; ++m)
#pragma unroll
                for (int n = 0; n < 2; ++n) acc[a][b][m][n] = (f32x4){0.f, 0.f, 0.f, 0.f};
    bf16x8 At[4][2], B0[2][2], B1[2][2];
    const char* cA = cur.a; const char* cB = cur.b;
    unsigned va[2][2], vn[2][2];
    int gR[2], gC[2];
#pragma unroll
    for (int i = 0; i < 2; ++i) stage_rc(tid * 16 + i * 8192, gR[i], gC[i]);
    if constexpr (GATHER) {
#pragma unroll
        for (int h = 0; h < 2; ++h)
#pragma unroll
            for (int i = 0; i < 2; ++i) { va[h][i] = (unsigned)(cur.rows[128 * h + gR[i]] * K + gC[i]) * 2u; vn[h][i] = va[h][i]; }
    }
    G8_STAGE(G8_SB(0, 0), cB); G8_STAGE(G8_SB(0, 1), cB + hstep); G8_STAGE_A(G8_SA(0, 0), cA, 0); G8_STAGE_A(G8_SA(0, 1), cA, 1);
    if (wr == 1) G8_BAR;
    G8_WAIT_V(2); G8_BAR;
    G8_STAGE(G8_SB(1, 0), cB + kstep); G8_STAGE_A(G8_SA(1, 0), cA + kstep, 0); G8_STAGE(G8_SB(1, 1), cB + hstep + kstep);
    G8_WAIT_V(6); G8_BAR;
    for (;;) {
        const bool has_next = S.next(ui + 1, nxt);
        const char* nA = has_next ? nxt.a : cA; const char* nB = has_next ? nxt.b : cB;
        if constexpr (GATHER) { if (has_next) {
#pragma unroll
            for (int h = 0; h < 2; ++h)
#pragma unroll
                for (int i = 0; i < 2; ++i) vn[h][i] = (unsigned)(nxt.rows[128 * h + gR[i]] * K + gC[i]) * 2u; } }
        for (int t = 0; t < nt; t += 2) {
            const bool last = (t == nt - 2);
            const char* a1 = cA + (size_t)(t + 1) * kstep;
            const char* a2 = last ? nA : cA + (size_t)(t + 2) * kstep; const char* b2 = last ? nB : cB + (size_t)(t + 2) * kstep;
            const char* a3 = a2 + kstep; const char* b3 = b2 + kstep;
            if constexpr (HAS_MID) { if (t == (nt >> 1)) E.mid(acc, cur, wr, wc, fr, fq); }
            G8_LDB(B0, 0, 0); G8_LDB(B1, 0, 1); G8_SCHED; G8_LDA(At, 0, 0); G8_STAGE_A(G8_SA(1, 1), a1, 1);
            if constexpr (GATHER) { if (last) { va[0][0] = vn[0][0]; va[0][1] = vn[0][1]; va[1][0] = vn[1][0]; va[1][1] = vn[1][1]; } }
            G8_WAIT_V(8); G8_WAIT_L(0); G8_BAR; G8_MMA(0, 0, At, B0); G8_MMA(0, 1, At, B1); G8_BAR; G8_SCHED;
            G8_LDA(At, 0, 1); G8_STAGE(G8_SB(0, 0), b2); G8_STAGE(G8_SB(0, 1), b2 + hstep); G8_STAGE_A(G8_SA(0, 0), a2, 0);
            G8_WAIT_V(8); G8_WAIT_L(0); G8_BAR; G8_MMA(1, 0, At, B0); G8_MMA(1, 1, At, B1); G8_BAR; G8_SCHED;
            G8_LDB(B0, 1, 0); G8_LDB(B1, 1, 1); G8_SCHED; G8_LDA(At, 1, 0); G8_STAGE_A(G8_SA(0, 1), a2, 1);
            G8_WAIT_V(8); G8_WAIT_L(0); G8_BAR; G8_MMA(0, 0, At, B0); G8_MMA(0, 1, At, B1); G8_BAR; G8_SCHED;
            G8_LDA(At, 1, 1); G8_STAGE(G8_SB(1, 0), b3); G8_STAGE(G8_SB(1, 1), b3 + hstep); G8_STAGE_A(G8_SA(1, 0), a3, 0);
            G8_WAIT_V(8); G8_WAIT_L(0); G8_BAR; G8_MMA(1, 0, At, B0); G8_MMA(1, 1, At, B1); G8_BAR; G8_SCHED;
        }
        if (wr == 0) G8_BAR;
        E(acc, cur, wr, wc, fr, fq);
        if (!has_next) break;
#pragma unroll
        for (int a = 0; a < 2; ++a)
#pragma unroll
            for (int b = 0; b < 2; ++b)
#pragma unroll
                for (int m = 0; m < 4; ++m)
#pragma unroll
                    for (int n = 0; n < 2; ++n) acc[a][b][m][n] = (f32x4){0.f, 0.f, 0.f, 0.f};
        cur = nxt; cA = nA; cB = nB; ++ui;
        if (wr == 1) G8_BAR;
    }
    G8_WAIT_V(0);
    G8_BAR;
#undef G8_SA
#undef G8_SB
#undef G8_STAGE
#undef G8_LDA
#undef G8_STAGE_V
#undef G8_STAGE_A
#undef G8_LDB
#undef G8_MMA
#undef G8_WAIT_V
#undef G8_WAIT_L
#undef G8_BAR
#undef G8_SCHED
}
}
namespace fk {
using namespace g8;
namespace cg = cooperative_groups;
#define LAS G8_LAS
#ifndef FK_NBF
#define FK_NBF 16
#endif
#ifndef FK_DBL
#define FK_DBL 0
#endif
constexpr int NBF = FK_NBF;
constexpr int D = 1024, T = 2048, LC = 256, NE = 16, CAP = 256;
constexpr int M = NBF * T, MC = NBF * LC, MA = M + MC;
constexpr int NT_IN = 25;
constexpr float LOG2E = 1.4426950408889634f;
constexpr float C2 = 0.125f * LOG2E;
typedef float f32x16 __attribute__((ext_vector_type(16)));

constexpr size_t MiB = (size_t)1 << 20;
constexpr size_t SC = (size_t)NBF << 16;
constexpr size_t WS_CTL = 0, WS_MOD = 1 * MiB, WS_ROPE = 1 * MiB + 512 * 1024, WS_IDX = 2 * MiB, WS_GATE = 2 * MiB + 256 * 1024,
                 WS_AFF = 2 * MiB + 512 * 1024, WS_SEL = 5 * MiB;
constexpr size_t WS_WIN = 8 * MiB, WS_WV = WS_WIN + (size_t)6400 * 2048, WS_WP = 21 * MiB, WS_WO = 25 * MiB, WS_WGU = 27 * MiB, WS_WD = 91 * MiB;
constexpr size_t R0 = 124 * MiB;
constexpr size_t WS_Q = R0, WS_KB = R0 + 64 * SC, WS_KCB = R0 + 80 * SC, WS_VB = R0 + 82 * SC, WS_VCB = R0 + 98 * SC, WS_Z = R0 + 100 * SC, WS_BB = R0 + 164 * SC,
                 WS_AO = R0 + 228 * SC, WS_HX = R0 + 284 * SC, WS_MB = R0, WS_DL = R0 + 64 * SC, WS_HX2 = R0, WS_XE = R0 + 192 * SC, WS_YE = R0 + 192 * SC;
constexpr size_t R_END = R0 + 356 * SC;
constexpr size_t OB_RB = 0, OB_SGC = 64 * SC, OB_HB = 0, OB_BYTES = 128 * SC;

constexpr int LDS_BYTES = 147456;
constexpr int LDS_MISC = 140 * 1024;
constexpr int LDS_MISC_Q = 140 * 1024 + 64;

struct Params {
    const float *x, *c, *ctx, *c_ctx, *w_mod, *b_mod, *norm1_g, *w_in, *sink, *conv_w, *wpa, *wpc, *wo, *norm2_g, *w_router, *wg, *wu, *wd, *fg;
    float* out; unsigned char* ws; unsigned char* ob;
    int ph_lo, ph_hi;
};

__device__ __forceinline__ float wave_sum(float v) {
#pragma unroll
    for (int o = 1; o < 64; o <<= 1) v += __shfl_xor(v, o);
    return v;
}
__device__ __forceinline__ unsigned f2bf(float f) { unsigned u = __builtin_bit_cast(unsigned, f); return (u + 0x7fffu + ((u >> 16) & 1u)) >> 16; }
__device__ __forceinline__ unsigned pk2(float lo, float hi) { return f2bf(lo) | (f2bf(hi) << 16); }
__device__ __forceinline__ void bf8_to_f32(const u32x4 w, f32x4& lo, f32x4& hi4) { lo = (f32x4){bf_lo(w.x), bf_hi(w.x), bf_lo(w.y), bf_hi(w.y)}; hi4 = (f32x4){bf_lo(w.z), bf_hi(w.z), bf_lo(w.w), bf_hi(w.w)}; }
__device__ __forceinline__ u32x4 f32_to_bf8(const f32x4 a, const f32x4 b) { u32x4 w; w.x = pk2(a.x, a.y); w.y = pk2(a.z, a.w); w.z = pk2(b.x, b.y); w.w = pk2(b.z, b.w); return w; }
__device__ __forceinline__ float sq4(const f32x4 v) { return (v.x * v.x + v.y * v.y) + (v.z * v.z + v.w * v.w); }
__device__ __forceinline__ float dot4(const f32x4 a, const f32x4 b) { return (a.x * b.x + a.y * b.y) + (a.z * b.z + a.w * b.w); }
__device__ __forceinline__ float sigmoidf_(float v) { return 1.f / (1.f + __expf(-v)); }

__device__ __forceinline__ void transpose_item64(const float* __restrict__ W, int N, int k0, int n0, bf16_t* __restrict__ dst, int pitch, bool perm, int lane) {
    const float* src = W + (size_t)k0 * N + n0 + lane;
    const int dr = perm ? ((lane & 32) + pinv32(lane & 31)) : lane;
    bf16_t* drow = dst + (size_t)dr * pitch + k0;
#pragma unroll
    for (int h = 0; h < 2; ++h) {
        float v[32];
#pragma unroll
        for (int j = 0; j < 32; ++j) v[j] = src[(size_t)(32 * h + j) * N];
#pragma unroll
        for (int c = 0; c < 4; ++c) { u32x4 o; o.x = pk2(v[8 * c], v[8 * c + 1]); o.y = pk2(v[8 * c + 2], v[8 * c + 3]); o.z = pk2(v[8 * c + 4], v[8 * c + 5]); o.w = pk2(v[8 * c + 6], v[8 * c + 7]);
            *(u32x4*)(drow + 32 * h + 8 * c) = o; }
    }
}

constexpr int CV_IN = 16 * 104, CV_SQ = 256, CV_TOTAL = CV_IN + 3 * CV_SQ + 48 * CV_SQ;
__device__ __forceinline__ void conv_item(const Params& P, int it, int lane) {
    bf16_t* WIN = (bf16_t*)(P.ws + WS_WIN); bf16_t* WV = (bf16_t*)(P.ws + WS_WV); bf16_t* WP = (bf16_t*)(P.ws + WS_WP); bf16_t* WO = (bf16_t*)(P.ws + WS_WO);
    bf16_t* WGU = (bf16_t*)(P.ws + WS_WGU); bf16_t* WD = (bf16_t*)(P.ws + WS_WD);
    int r = it;
    if (r < CV_IN) {
        const int kb = r / 104, nb = r % 104, k0 = 64 * kb, n0 = 64 * nb;
        bf16_t* dst; bool perm = true;
        if (n0 < 1280) { dst = WIN + (size_t)n0 * 1024; perm = false; }
        else if (n0 < 1536) { dst = WV + (size_t)(n0 - 1280) * 1024; perm = false; }
        else if (n0 < 2560) { const int ch = n0 - 1536; dst = WIN + (size_t)(1280 + (ch >> 7) * 256 + (ch & 127)) * 1024; }
        else if (n0 < 3584) { dst = WIN + (size_t)(3328 + (n0 - 2560)) * 1024; }
        else if (n0 < 4608) { const int ch = n0 - 3584; dst = WIN + (size_t)(1280 + (ch >> 7) * 256 + 128 + (ch & 127)) * 1024; }
        else if (n0 < 5632) { const int ch = n0 - 4608; dst = WIN + (size_t)(4352 + (ch >> 7) * 256 + (ch & 127)) * 1024; }
        else { const int ch = n0 - 5632; dst = WIN + (size_t)(4352 + (ch >> 7) * 256 + 128 + (ch & 127)) * 1024; }
        transpose_item64(P.w_in, 6656, k0, n0, dst, 1024, perm, lane);
        return;
    }
    r -= CV_IN;
    const int mat = r / CV_SQ, q = r % CV_SQ, kb = q / 16, nb = q % 16, k0 = 64 * kb, n0 = 64 * nb;
    if (mat == 0) transpose_item64(P.wpa, 1024, k0, n0, WP + (size_t)n0 * 2048, 2048, true, lane);
    else if (mat == 1) transpose_item64(P.wpc, 1024, k0, n0, WP + (size_t)n0 * 2048 + 1024, 2048, true, lane);
    else if (mat == 2) transpose_item64(P.wo, 1024, k0, n0, WO + (size_t)n0 * 1024, 1024, true, lane);
    else {
        const int m2 = mat - 3, kind = m2 >> 4, e = m2 & 15;
        if (kind == 0) transpose_item64(P.wg + (size_t)e * 1048576, 1024, k0, n0, WGU + ((size_t)e * 2048 + (n0 >> 7) * 256 + (n0 & 127)) * 1024, 1024, true, lane);
        else if (kind == 1) transpose_item64(P.wu + (size_t)e * 1048576, 1024, k0, n0, WGU + ((size_t)e * 2048 + (n0 >> 7) * 256 + 128 + (n0 & 127)) * 1024, 1024, true, lane);
        else transpose_item64(P.wd + (size_t)e * 1048576, 1024, k0, n0, WD + ((size_t)e * 1024 + n0) * 1024, 1024, true, lane);
    }
}

__device__ __forceinline__ void ph_prep(const Params& P, LAS unsigned char* lds) {
    const int tid = threadIdx.x, lane = tid & 63, wave = __builtin_amdgcn_readfirstlane(tid >> 6);
    const int G = gridDim.x, wg = blockIdx.x;
    float* mod = (float*)(P.ws + WS_MOD);
    if (wg < 96) {
        LAS float* sl = (LAS float*)lds;
        LAS float* red = (LAS float*)(lds + 17 * 1024 * 4);
        for (int i = tid; i < 17 * 1024; i += 512) { const int r = i >> 10, k = i & 1023; const float v = r < 16 ? P.c[r * 1024 + k] : P.c_ctx[k]; sl[i] = v / (1.f + __expf(-v)); }
        __syncthreads();
        const int col = tid & 63, kg = wave, n = wg * 64 + col;
        float acc[17];
#pragma unroll
        for (int r = 0; r < 17; ++r) acc[r] = 0.f;
        for (int kb = kg * 128; kb < kg * 128 + 128; kb += 16) {
            float w[16];
#pragma unroll
            for (int j = 0; j < 16; ++j) w[j] = P.w_mod[(size_t)(kb + j) * 6144 + n];
#pragma unroll
            for (int j = 0; j < 16; ++j)
#pragma unroll
                for (int r = 0; r < 17; ++r) acc[r] += sl[r * 1024 + kb + j] * w[j]; }
#pragma unroll
        for (int r = 0; r < 17; ++r) red[(kg * 17 + r) * 64 + col] = acc[r];
        __syncthreads();
        for (int i = tid; i < 17 * 64; i += 512) { const int r = i >> 6, cc = i & 63; float s = 0.f;
#pragma unroll
            for (int g = 0; g < 8; ++g) s += red[(g * 17 + r) * 64 + cc];
            mod[r * 6144 + wg * 64 + cc] = s + P.b_mod[wg * 64 + cc]; }
        __syncthreads();
    } else if (wg == 96) {
        float2* rope = (float2*)(P.ws + WS_ROPE);
        for (int i = tid; i < 64 * 16; i += 512) { const int pos = i >> 4, f = i & 15; const float ang = (float)pos * powf(10000.f, -(float)f / 16.f); rope[i] = make_float2(cosf(ang), sinf(ang)); }
    }
    constexpr int I_IN = 16 * 104;
    if (wg >= 96) { for (int it = (wg - 96) * 8 + wave; it < 1280; it += (G - 96) * 8) conv_item(P, it, lane); }
    else { for (int it = 1280 + wg * 8 + wave; it < I_IN; it += 96 * 8) conv_item(P, it, lane); }
}

template <int NR>
__device__ __forceinline__ void norm1_rows(const Params& P, int row0, int lane) {
    const float* mod = (const float*)(P.ws + WS_MOD);
    bf16_t* HX = (bf16_t*)(P.ws + WS_HX);
    const float* xr; const float* mv;
    if (row0 < M) { xr = P.x + (size_t)row0 * D; mv = mod + (row0 >> 11) * 6144; } else { xr = P.ctx + (size_t)(row0 - M) * D; mv = mod + 16 * 6144; }
    f32x4 v[NR][4];
#pragma unroll
    for (int r = 0; r < NR; ++r)
#pragma unroll
        for (int j = 0; j < 2; ++j) { v[r][2 * j] = *(const f32x4*)(xr + (size_t)r * D + 8 * lane + 512 * j); v[r][2 * j + 1] = *(const f32x4*)(xr + (size_t)r * D + 8 * lane + 512 * j + 4); }
    float rs[NR];
#pragma unroll
    for (int r = 0; r < NR; ++r) { const float ss = (sq4(v[r][0]) + sq4(v[r][1])) + (sq4(v[r][2]) + sq4(v[r][3])); rs[r] = 1.0f / sqrtf(wave_sum(ss) * (1.f / D) + 1e-6f); }
#pragma unroll
    for (int j = 0; j < 2; ++j) { const int c0 = 8 * lane + 512 * j;
        const f32x4 g0 = *(const f32x4*)(P.norm1_g + c0) * (*(const f32x4*)(mv + 1024 + c0) + 1.0f), g1 = *(const f32x4*)(P.norm1_g + c0 + 4) * (*(const f32x4*)(mv + 1024 + c0 + 4) + 1.0f);
        const f32x4 sh0 = *(const f32x4*)(mv + c0), sh1 = *(const f32x4*)(mv + c0 + 4);
#pragma unroll
        for (int r = 0; r < NR; ++r) *(u32x4*)(HX + (size_t)(row0 + r) * D + c0) = f32_to_bf8(v[r][2 * j] * rs[r] * g0 + sh0, v[r][2 * j + 1] * rs[r] * g1 + sh1); }
}
enum { KD_Q = 0, KD_K = 1, KD_KC = 2, KD_VT = 3, KD_VTC = 4, KD_UC = 5, KD_BC = 6, KD_GG = 7 };
struct InprojSched {
    int G, c; const char *hx, *win, *wv;
    static constexpr int NMAIN = (M / 256) * NT_IN, NVT = M / 256, NC = MC / 256, NTOT = NMAIN + NVT;
    __device__ __forceinline__ bool next(int i, Unit& u) const {
        const int Lx = i * G + c; if (Lx >= NTOT) return false;
        constexpr size_t TS = (size_t)256 * 1024 * 2;
        if (Lx < NMAIN) {
            const int wgid = (Lx % 8) * (NMAIN / 8) + Lx / 8;
            constexpr int nig = 8 * NT_IN; const int gid = wgid / nig, w = wgid % nig;
            u.pm = gid * 8 + (w % 8); u.pn = w / 8;
            u.a = hx + (size_t)u.pm * TS; u.b = win + (size_t)u.pn * TS;
            u.kind = u.pn < 4 ? KD_Q : u.pn == 4 ? KD_K : u.pn < 13 ? KD_UC : u.pn < 17 ? KD_BC : KD_GG; u.aux = 0; u.rows = nullptr;
        } else {
            const int xq = Lx - NMAIN;
            u.kind = KD_VT; u.pm = 0; u.pn = xq; u.a = wv; u.b = hx + (size_t)xq * TS;
            u.aux = 0; u.rows = nullptr;
        }
        return true;
    }
};
struct CtxSched {
    int c; const char *hx, *win, *wv;
    __device__ __forceinline__ bool next(int i, Unit& u) const {
        if (i != 0) return false;
        constexpr size_t TS = (size_t)256 * 1024 * 2; constexpr int NC = MC / 256;
        if (c < NC) { u.kind = KD_KC; u.pm = M / 256 + c; u.pn = 4; u.a = hx + (size_t)u.pm * TS; u.b = win + (size_t)4 * TS; }
        else { u.kind = KD_VTC; u.pm = 0; u.pn = c - NC; u.a = wv; u.b = hx + (size_t)(M / 256 + u.pn) * TS; }
        u.aux = 0; u.rows = nullptr; return true;
    }
};
struct EpiInproj {
    bf16_t *q, *z, *bb, *rb, *sgc; unsigned char *kb, *kcb, *vb, *vcb; const float* rope;
    __device__ __forceinline__ void operator()(const f32x4 (&acc)[2][2][4][2], const Unit& u, int wr, int wc, int fr, int fq) const {
        const int kind = u.kind;
        if (kind == KD_Q || kind == KD_K) {
#pragma unroll
            for (int ai = 0; ai < 2; ++ai)
#pragma unroll
                for (int m = 0; m < 4; ++m) {
                    const int r = u.pm * 256 + 128 * ai + 64 * wr + 16 * m + fr, t = r & 2047, b = r >> 11;
                    const int pos = (wc & 1) ? (t & 63) : (t >> 6);
                    const float* tb = rope + (pos * 16 + 4 * fq) * 2;
                    const f32x4 t0 = *(const f32x4*)tb, t1 = *(const f32x4*)(tb + 4);
                    const f32x4 cs = {t0.x, t0.z, t1.x, t1.z}, sn = {t0.y, t0.w, t1.y, t1.w};
#pragma unroll
                    for (int bj = 0; bj < 2; ++bj) {
                        const f32x4 x0 = acc[ai][bj][m][0], x1 = acc[ai][bj][m][1];
                        f32x4 o0 = x0 * cs - x1 * sn, o1 = x1 * cs + x0 * sn;
                        if (kind == KD_Q) {
                            o0 = o0 * C2; o1 = o1 * C2;
                            bf16_t* dst = q + (size_t)r * 1024 + u.pn * 256 + 128 * bj + 32 * wc + 4 * fq;
                            u32x2 w0, w1; w0.x = cvt_pk_bf16(o0.x, o0.y); w0.y = cvt_pk_bf16(o0.z, o0.w); w1.x = cvt_pk_bf16(o1.x, o1.y); w1.y = cvt_pk_bf16(o1.z, o1.w);
                            *(u32x2*)dst = w0; *(u32x2*)(dst + 16) = w1;
                        } else {
                            const int hkv = 2 * bj + (wc >> 1), ch0 = 4 * (wc & 1) + (fq >> 1);
                            unsigned char* dst = kb + ((size_t)((b * 4 + hkv) * 32 + (t >> 6))) * 8192 + ch0 * 1024 + (t & 63) * 16 + 8 * (fq & 1);
                            u32x2 w0, w1; w0.x = cvt_pk_bf16(o0.x, o0.y); w0.y = cvt_pk_bf16(o0.z, o0.w); w1.x = cvt_pk_bf16(o1.x, o1.y); w1.y = cvt_pk_bf16(o1.z, o1.w);
                            *(u32x2*)dst = w0; *(u32x2*)(dst + 2048) = w1;
                        }
                    }
                }
        } else if (kind == KD_KC) {
#pragma unroll
            for (int ai = 0; ai < 2; ++ai)
#pragma unroll
                for (int m = 0; m < 4; ++m) {
                    const int r = (u.pm - M / 256) * 256 + 128 * ai + 64 * wr + 16 * m + fr, l = r & 255, b = r >> 8;
#pragma unroll
                    for (int bj = 0; bj < 2; ++bj) {
                        const int hkv = 2 * bj + (wc >> 1), ch0 = 4 * (wc & 1) + (fq >> 1);
                        unsigned char* dst = kcb + ((size_t)((b * 4 + hkv) * 4 + (l >> 6))) * 8192 + ch0 * 1024 + (l & 63) * 16 + 8 * (fq & 1);
#pragma unroll
                        for (int n = 0; n < 2; ++n) { const f32x4 v = acc[ai][bj][m][n]; u32x2 w; w.x = cvt_pk_bf16(v.x, v.y); w.y = cvt_pk_bf16(v.z, v.w); *(u32x2*)(dst + n * 2048) = w; }
                    }
                }
        } else if (kind == KD_VT || kind == KD_VTC) {
#pragma unroll
            for (int ai = 0; ai < 2; ++ai)
#pragma unroll
                for (int m = 0; m < 4; ++m) {
                    const int hkv = 2 * ai + wr, d = 16 * m + fr;
#pragma unroll
                    for (int bj = 0; bj < 2; ++bj) {
                        size_t blk;
                        if (kind == KD_VT) blk = (size_t)(((u.pn >> 3) * 4 + hkv) * 32 + 4 * (u.pn & 7) + 2 * bj + (wc >> 1));
                        else blk = (size_t)((u.pn * 4 + hkv) * 4 + 2 * bj + (wc >> 1));
                        unsigned char* base = (kind == KD_VT ? vb : vcb) + blk * 8192 + d * 16 + 8 * (fq >> 1);
#pragma unroll
                        for (int n = 0; n < 2; ++n) { const f32x4 v = acc[ai][bj][m][n]; u32x2 w; w.x = cvt_pk_bf16(v.x, v.y); w.y = cvt_pk_bf16(v.z, v.w);
                            *(u32x2*)(base + (2 * (2 * (wc & 1) + n) + (fq & 1)) * 1024) = w; }
                    }
                }
        } else if (kind == KD_UC) {
#pragma unroll
            for (int ai = 0; ai < 2; ++ai)
#pragma unroll
                for (int m = 0; m < 4; ++m) {
                    const int r = u.pm * 256 + 128 * ai + 64 * wr + 16 * m + fr;
                    const f32x4 v0 = acc[ai][0][m][0] * acc[ai][1][m][0], v1 = acc[ai][0][m][1] * acc[ai][1][m][1];
                    u32x4 w; w.x = cvt_pk_bf16(v0.x, v0.y); w.y = cvt_pk_bf16(v0.z, v0.w); w.z = cvt_pk_bf16(v1.x, v1.y); w.w = cvt_pk_bf16(v1.z, v1.w);
                    *(u32x4*)(z + (size_t)r * 1024 + (u.pn - 5) * 128 + 32 * wc + 8 * fq) = w;
                }
        } else if (kind == KD_BC) {
#pragma unroll
            for (int ai = 0; ai < 2; ++ai)
#pragma unroll
                for (int m = 0; m < 4; ++m) {
                    const int r = u.pm * 256 + 128 * ai + 64 * wr + 16 * m + fr;
#pragma unroll
                    for (int bj = 0; bj < 2; ++bj) { const f32x4 v0 = acc[ai][bj][m][0], v1 = acc[ai][bj][m][1];
                        u32x4 w; w.x = cvt_pk_bf16(v0.x, v0.y); w.y = cvt_pk_bf16(v0.z, v0.w); w.z = cvt_pk_bf16(v1.x, v1.y); w.w = cvt_pk_bf16(v1.z, v1.w);
                        *(u32x4*)(bb + (size_t)r * 1024 + (u.pn - 13) * 256 + 128 * bj + 32 * wc + 8 * fq) = w; }
                }
        } else {
#pragma unroll
            for (int ai = 0; ai < 2; ++ai)
#pragma unroll
                for (int m = 0; m < 4; ++m) {
                    const int r = u.pm * 256 + 128 * ai + 64 * wr + 16 * m + fr;
                    f32x4 rr[2], sg[2];
#pragma unroll
                    for (int n = 0; n < 2; ++n)
#pragma unroll
                        for (int j = 0; j < 4; ++j) { const float ea = __expf(-acc[ai][0][m][n][j]), ec = __expf(-acc[ai][1][m][n][j]);
                            rr[n][j] = (1.f + ec) / (1.f + ea); sg[n][j] = 1.f / (1.f + ec); }
                    const size_t off = (size_t)r * 1024 + (u.pn - 17) * 128 + 32 * wc + 8 * fq;
                    u32x4 w; w.x = cvt_pk_bf16(rr[0].x, rr[0].y); w.y = cvt_pk_bf16(rr[0].z, rr[0].w); w.z = cvt_pk_bf16(rr[1].x, rr[1].y); w.w = cvt_pk_bf16(rr[1].z, rr[1].w);
                    *(u32x4*)(rb + off) = w;
                    w.x = cvt_pk_bf16(sg[0].x, sg[0].y); w.y = cvt_pk_bf16(sg[0].z, sg[0].w); w.z = cvt_pk_bf16(sg[1].x, sg[1].y); w.w = cvt_pk_bf16(sg[1].z, sg[1].w);
                    *(u32x4*)(sgc + off) = w;
                }
        }
    }
};
__device__ __forceinline__ void ph_inproj(const Params& P, LAS unsigned char* lds) {
    InprojSched S; S.G = gridDim.x; S.c = blockIdx.x; S.hx = (const char*)(P.ws + WS_HX); S.win = (const char*)(P.ws + WS_WIN); S.wv = (const char*)(P.ws + WS_WV);
    EpiInproj E; E.q = (bf16_t*)(P.ws + WS_Q); E.z = (bf16_t*)(P.ws + WS_Z); E.bb = (bf16_t*)(P.ws + WS_BB); E.rb = (bf16_t*)(P.ob + OB_RB); E.sgc = (bf16_t*)(P.ob + OB_SGC);
    E.kb = P.ws + WS_KB; E.kcb = P.ws + WS_KCB; E.vb = P.ws + WS_VB; E.vcb = P.ws + WS_VCB; E.rope = (const float*)(P.ws + WS_ROPE);
    gemm_phase<EpiInproj, InprojSched, false>(lds, 1024, S, E);
}

constexpr int CW_QUEUE = 3584;
__device__ __forceinline__ void ph_norm1(const Params& P, LAS unsigned char* lds) {
    const int tid = threadIdx.x, lane = tid & 63, wave = __builtin_amdgcn_readfirstlane(tid >> 6), wg = blockIdx.x, G = gridDim.x;
    constexpr int NC = MC / 256;
    if (wg < 2 * NC && G > 2 * NC) {
        const int tile = wg < NC ? wg : wg - NC;
        for (int r = wave * 4; r < 256; r += 32) norm1_rows<4>(P, M + tile * 256 + r, lane);
        asm volatile("s_waitcnt vmcnt(0)" ::: "memory");
        __syncthreads();
        CtxSched S; S.c = wg; S.hx = (const char*)(P.ws + WS_HX); S.win = (const char*)(P.ws + WS_WIN); S.wv = (const char*)(P.ws + WS_WV);
        EpiInproj E; E.q = nullptr; E.z = nullptr; E.bb = nullptr; E.rb = nullptr; E.sgc = nullptr;
        E.kb = P.ws + WS_KB; E.kcb = P.ws + WS_KCB; E.vb = P.ws + WS_VB; E.vcb = P.ws + WS_VCB; E.rope = (const float*)(P.ws + WS_ROPE);
        gemm_phase<EpiInproj, CtxSched, false>(lds, 1024, S, E);
    } else {
        const int nw = (G - 2 * NC) * 8, gw = (wg - 2 * NC) * 8 + wave;
        for (int row = gw * 4; row < M; row += nw * 4) norm1_rows<4>(P, row, lane);
    }
    unsigned* head = (unsigned*)(P.ws + WS_CTL) + CW_QUEUE;
    LAS unsigned* slot = (LAS unsigned*)(lds + LDS_MISC_Q);
    for (;;) {
        __syncthreads();
        if (tid == 0) slot[0] = __hip_atomic_fetch_add(head, 32u, __ATOMIC_RELAXED, __HIP_MEMORY_SCOPE_AGENT);
        __syncthreads();
        const int base = CV_IN + (int)slot[0];
        if (base >= CV_TOTAL) break;
#pragma unroll 1
        for (int k = 0; k < 4; ++k) { const int it = base + wave * 4 + k; if (it < CV_TOTAL) conv_item(P, it, lane); }
    }
}

__device__ __forceinline__ int crow(int r, int hi) { return (r & 3) + 8 * (r >> 2) + 4 * hi; }
constexpr float ATT_THR = 24.0f;
constexpr int ATT_NS = 5;
struct AttnUnitInfo { int b, hkv, qb, w_lo, nwin, ntile; };
__device__ __forceinline__ AttnUnitInfo attn_decode(int uidx) {
    AttnUnitInfo u; u.b = uidx >> 7; u.hkv = (uidx >> 5) & 3; u.qb = uidx & 31;
    u.w_lo = u.qb - 2 < 0 ? 0 : u.qb - 2; const int w_hi = u.qb + 2 > 31 ? 31 : u.qb + 2; u.nwin = w_hi - u.w_lo + 1; u.ntile = u.nwin + 4; return u;
}
__device__ __forceinline__ float max3f(float a, float b, float c) { float r; asm("v_max3_f32 %0, %1, %2, %3" : "=v"(r) : "v"(a), "v"(b), "v"(c)); return r; }
__device__ __forceinline__ void attn_finish(const Params& P, const f32x16& o0, const f32x16& o1, float lrun, int b, int hkv, int qb, int g, int wsub, int r32, int hi) {
    const float ltot = lrun + __shfl_xor(lrun, 32), inv = 1.f / ltot;
    bf16_t* AO = (bf16_t*)(P.ws + WS_AO) + (size_t)(b * T + qb * 64 + 32 * wsub + r32) * 2048 + (hkv * 4 + g) * 64 + 4 * hi;
#pragma unroll
    for (int g4 = 0; g4 < 4; ++g4) {
        u32x2 w; w.x = cvt_pk_bf16(o0[4 * g4] * inv, o0[4 * g4 + 1] * inv); w.y = cvt_pk_bf16(o0[4 * g4 + 2] * inv, o0[4 * g4 + 3] * inv); *(u32x2*)(AO + 8 * g4) = w;
        w.x = cvt_pk_bf16(o1[4 * g4] * inv, o1[4 * g4 + 1] * inv); w.y = cvt_pk_bf16(o1[4 * g4 + 2] * inv, o1[4 * g4 + 3] * inv); *(u32x2*)(AO + 32 + 8 * g4) = w;
    }
}
__device__ __forceinline__ void attn_drain(const Params& P, LAS unsigned char* lds, const f32x16& Pa, const f32x16& Pb, f32x16& o0, f32x16& o1, float lrun, int vslot,
                                           int cu, int nun, int ubase, int GY, int g, int wsub, int r32, int hi) {
    float sacc = 0.f;
#pragma unroll
    for (int r = 0; r < 16; ++r) sacc += Pa[r] + Pb[r];
    lrun += sacc;
    const LAS unsigned char* Vp = lds + vslot * 16384 + 8192 + hi * 1024 + r32 * 16;
#pragma unroll
    for (int ks = 0; ks < 4; ++ks) {
        const f32x16& S = ks < 2 ? Pa : Pb; const int o = 8 * (ks & 1);
        const u32x4 pw = (u32x4){cvt_pk_bf16(S[o], S[o + 1]), cvt_pk_bf16(S[o + 2], S[o + 3]), cvt_pk_bf16(S[o + 4], S[o + 5]), cvt_pk_bf16(S[o + 6], S[o + 7])};
        const bf16x8 v0 = *(const LAS bf16x8*)(Vp + (2 * ks) * 1024), v1 = *(const LAS bf16x8*)(Vp + (2 * ks) * 1024 + 512);
        const bf16x8 pb = __builtin_bit_cast(bf16x8, pw);
        o0 = __builtin_amdgcn_mfma_f32_32x32x16_bf16(v0, pb, o0, 0, 0, 0); o1 = __builtin_amdgcn_mfma_f32_32x32x16_bf16(v1, pb, o1, 0, 0, 0);
    }
    const AttnUnitInfo li = attn_decode(ubase + GY * (nun - 1));
    attn_finish(P, o0, o1, lrun, li.b, li.hkv, li.qb, g, wsub, r32, hi);
}
__device__ __forceinline__ void attn_phase(const Params& P, LAS unsigned char* lds) {
    const int tid = threadIdx.x, lane = tid & 63, wid = __builtin_amdgcn_readfirstlane(tid >> 6), r32 = lane & 31, hi = lane >> 5;
    constexpr int NU = NBF * 4 * 32;
    const int G = gridDim.x, xg = blockIdx.x & 7, yg = blockIdx.x >> 3, GY = G >> 3;
    const int nun = (NU / 8 - yg + GY - 1) / GY;
    if (nun <= 0) return;
    const int ubase = xg * (NU / 8) + yg;
    const bf16_t* Q = (const bf16_t*)(P.ws + WS_Q);
    const unsigned char* KB = P.ws + WS_KB; const unsigned char* VB = P.ws + WS_VB; const unsigned char* KCB = P.ws + WS_KCB; const unsigned char* VCB = P.ws + WS_VCB;
    const int g = wid >> 1, wsub = wid & 1;
#define AT_WAIT(n) asm volatile("s_waitcnt vmcnt(" #n ")" ::: "memory")
#define AT_SB() __builtin_amdgcn_sched_barrier(0)
    int pu = 0, pit = 0, pstep = 0, pslot = 0; AttnUnitInfo pinfo = attn_decode(ubase);
    auto issue = [&]() {
        const size_t bh = (size_t)(pinfo.b * 4 + pinfo.hkv);
        const unsigned char* ks = pit < pinfo.nwin ? KB + (bh * 32 + pinfo.w_lo + pit) * 8192 : KCB + (bh * 4 + (pit - pinfo.nwin)) * 8192;
        const unsigned char* vs = pit < pinfo.nwin ? VB + (bh * 32 + pinfo.w_lo + pit) * 8192 : VCB + (bh * 4 + (pit - pinfo.nwin)) * 8192;
        LAS unsigned char* dst = lds + pslot * 16384 + wid * 1024;
        __builtin_amdgcn_global_load_lds((const unsigned*)(ks + wid * 1024 + lane * 16), (LAS unsigned*)dst, 16, 0, 0);
        __builtin_amdgcn_global_load_lds((const unsigned*)(vs + wid * 1024 + lane * 16), (LAS unsigned*)(dst + 8192), 16, 0, 0);
        ++pstep; pslot = pslot == ATT_NS - 1 ? 0 : pslot + 1; ++pit;
        if (pit == pinfo.ntile) { pit = 0; ++pu; if (pu < nun) pinfo = attn_decode(ubase + GY * pu); }
    };
    int total = 0;
    for (int k = 0; k < nun; ++k) total += attn_decode(ubase + GY * k).ntile;
    *(LAS u32x4*)(lds + (ATT_NS - 1) * 16384 + 8192 + tid * 16) = (u32x4){0u, 0u, 0u, 0u};
    __syncthreads();
    int cu = 0, it = 0, step = 0, cslot = 0, vslot = ATT_NS - 1; AttnUnitInfo ci = attn_decode(ubase);
    int fb = 0, fhkv = 0, fqb = 0;
    constexpr int ATT_QOFF = ATT_NS * 16384;
    auto issueQ = [&](const AttnUnitInfo& ui) {
        const bf16_t* qp = Q + (size_t)(ui.b * T + ui.qb * 64 + 32 * wsub + r32) * 1024 + (ui.hkv * 4 + g) * 64 + hi * 8;
#pragma unroll
        for (int j = 0; j < 4; ++j)
            __builtin_amdgcn_global_load_lds((const unsigned*)(qp + 16 * j), (LAS unsigned*)(lds + ATT_QOFF + wid * 4096 + j * 1024), 16, 0, 0);
    };
    float sk0 = P.sink[0 * 4 + g] * LOG2E, sk1 = P.sink[1 * 4 + g] * LOG2E, sk2 = P.sink[2 * 4 + g] * LOG2E, sk3 = P.sink[3 * 4 + g] * LOG2E;
    asm volatile("s_waitcnt vmcnt(0)" : "+v"(sk0), "+v"(sk1), "+v"(sk2), "+v"(sk3) :: "memory");
    bf16x8 qf[4];
    float sink_c = 0.f;
    const f32x16 zero16 = {0.f, 0.f, 0.f, 0.f, 0.f, 0.f, 0.f, 0.f, 0.f, 0.f, 0.f, 0.f, 0.f, 0.f, 0.f, 0.f};
    f32x16 o0, o1, pA0, pA1, pB0, pB1;
    float mrun = 0.f, lrun = 0.f; bool slow = false;
#pragma unroll
    for (int r = 0; r < 16; ++r) { o0[r] = 0.f; o1[r] = 0.f; pA0[r] = 0.f; pA1[r] = 0.f; pB0[r] = 0.f; pB1[r] = 0.f; }
    bf16x8 fr[4]; u32x4 pw[4];
    issueQ(ci);
    issue(); if (total > 1) issue(); if (total > 2) issue();
    if (total > 2) AT_WAIT(2); else AT_WAIT(0);
    __builtin_amdgcn_s_barrier(); asm volatile("" ::: "memory");
    if (pstep < total) issue();
#define AT_FA(base, i) (*(const LAS bf16x8*)((base) + (((i) >> 1) * 2) * 1024 + ((i) & 1) * 512))
    { const LAS unsigned char* K0 = lds + hi * 1024 + r32 * 16; fr[0] = AT_FA(K0, 0); fr[1] = AT_FA(K0, 1); fr[2] = AT_FA(K0, 2); }

#define AT_PK(Pa, Pb, w) cvt_pk_bf16((w) < 8 ? Pa[2 * (w)] : Pb[2 * (w) - 16], (w) < 8 ? Pa[2 * (w) + 1] : Pb[2 * (w) - 15])
#define AT_PV(Pa, Pb, i) ((i) < 16 ? Pa[(i)] : Pb[(i) - 16])
#define AT_GAPA(gi, Cn, Pa, Pb) do { \
        Cn = __builtin_amdgcn_mfma_f32_32x32x16_bf16(fr[(gi) & 3], qf[(gi) >> 1], (gi) < 2 ? zero16 : Cn, 0, 0, 0); \
        if ((gi) + 3 < 8) fr[((gi) + 3) & 3] = AT_FA(Kc, (gi) + 3); else fr[((gi) + 3) & 3] = AT_FA(Vp, (gi) + 3 - 8); \
        sacc += AT_PV(Pa, Pb, 4 * (gi)) + AT_PV(Pa, Pb, 4 * (gi) + 1); sacc2 += AT_PV(Pa, Pb, 4 * (gi) + 2) + AT_PV(Pa, Pb, 4 * (gi) + 3); \
        pw[(gi) >> 1][2 * ((gi) & 1)] = AT_PK(Pa, Pb, 2 * (gi)); pw[(gi) >> 1][2 * ((gi) & 1) + 1] = AT_PK(Pa, Pb, 2 * (gi) + 1); AT_SB(); } while (0)
#define AT_GAPB(gi, Cx, cb) do { \
        if ((gi) & 1) o1 = __builtin_amdgcn_mfma_f32_32x32x16_bf16(fr[(gi) & 3], __builtin_bit_cast(bf16x8, pw[(gi) >> 1]), o1, 0, 0, 0); \
        else o0 = __builtin_amdgcn_mfma_f32_32x32x16_bf16(fr[(gi) & 3], __builtin_bit_cast(bf16x8, pw[(gi) >> 1]), o0, 0, 0, 0); \
        if ((gi) + 3 < 8) fr[((gi) + 3) & 3] = AT_FA(Vp, (gi) + 3); else fr[((gi) + 3) & 3] = AT_FA(Kn, (gi) + 3 - 8); \
        Cx[cb] = __builtin_amdgcn_exp2f(Cx[cb]); Cx[cb + 1] = __builtin_amdgcn_exp2f(Cx[cb + 1]); Cx[cb + 2] = __builtin_amdgcn_exp2f(Cx[cb + 2]); Cx[cb + 3] = __builtin_amdgcn_exp2f(Cx[cb + 3]); \
        AT_SB(); } while (0)
#define AT_STEP(C0, C1, Pa, Pb) do { \
        const bool first = (it == 0); \
        if (first) { fb = ci.b; fhkv = ci.hkv; fqb = ci.qb; if (step > 0) { const AttnUnitInfo pi = attn_decode(ubase + GY * (cu - 1)); fb = pi.b; fhkv = pi.hkv; fqb = pi.qb; } \
            sink_c = ci.hkv == 0 ? sk0 : ci.hkv == 1 ? sk1 : ci.hkv == 2 ? sk2 : sk3; mrun = 0.f; slow = false; \
            _Pragma("unroll") for (int ks = 0; ks < 4; ++ks) qf[ks] = *(const LAS bf16x8*)(lds + ATT_QOFF + wid * 4096 + (2 * ks + hi) * 512 + r32 * 16); \
            asm volatile("s_waitcnt lgkmcnt(0)" ::: "memory"); \
            if (cu + 1 < nun) issueQ(attn_decode(ubase + GY * (cu + 1))); } \
        const LAS unsigned char* Kc = lds + cslot * 16384 + hi * 1024 + r32 * 16; \
        const LAS unsigned char* Vp = lds + vslot * 16384 + 8192 + hi * 1024 + r32 * 16; \
        const int nslot = cslot == ATT_NS - 1 ? 0 : cslot + 1; \
        const LAS unsigned char* Kn = lds + nslot * 16384 + hi * 1024 + r32 * 16; \
        float sacc = 0.f, sacc2 = 0.f; AT_SB(); \
        AT_GAPA(0, C0, Pa, Pb); AT_GAPA(1, C1, Pa, Pb); AT_GAPA(2, C0, Pa, Pb); AT_GAPA(3, C1, Pa, Pb); AT_GAPA(4, C0, Pa, Pb); AT_GAPA(5, C1, Pa, Pb); AT_GAPA(6, C0, Pa, Pb); AT_GAPA(7, C1, Pa, Pb); \
        lrun += sacc + sacc2; \
        if (slow) { _Pragma("unroll") for (int r = 0; r < 16; ++r) { C0[r] -= mrun; C1[r] -= mrun; } } \
        if (it < ci.nwin) { const int wt = ci.w_lo + it, dq = wt - ci.qb; \
            if (dq == 2 || dq == -2) { const int base = ci.qb * 64 + 32 * wsub + r32 - 64 * wt; \
                _Pragma("unroll") for (int r = 0; r < 16; ++r) { const int d0 = base - crow(r, hi), d1 = d0 - 32; \
                    if (d0 > 128 || d0 < -128) C0[r] = -1e30f; if (d1 > 128 || d1 < -128) C1[r] = -1e30f; } } } \
        float mx; { float ma = max3f(C0[0], C0[1], C1[0]), mb = max3f(C0[2], C0[3], C1[1]); ma = max3f(ma, C1[2], C1[3]); \
            _Pragma("unroll") for (int r = 4; r < 16; r += 4) { ma = max3f(ma, C0[r], C0[r + 1]); mb = max3f(mb, C0[r + 2], C0[r + 3]); ma = max3f(ma, C1[r], C1[r + 1]); mb = max3f(mb, C1[r + 2], C1[r + 3]); } \
            mx = fmaxf(ma, mb); mx = fmaxf(mx, __shfl_xor(mx, 32)); } \
        float fres = 1.f; bool resc = false; \
        if (__any(mx > ATT_THR)) { const float dl = fmaxf(mx, 0.f); fres = __builtin_amdgcn_exp2f(-dl); mrun += dl; resc = true; slow = true; \
            _Pragma("unroll") for (int r = 0; r < 16; ++r) { C0[r] -= dl; C1[r] -= dl; } } \
        AT_SB(); \
        AT_GAPB(0, C0, 0); AT_GAPB(1, C0, 4); AT_GAPB(2, C0, 8); AT_GAPB(3, C0, 12); AT_GAPB(4, C1, 0); AT_GAPB(5, C1, 4); AT_GAPB(6, C1, 8); AT_GAPB(7, C1, 12); \
        if (first && step > 0) { attn_finish(P, o0, o1, lrun, fb, fhkv, fqb, g, wsub, r32, hi); \
            _Pragma("unroll") for (int r = 0; r < 16; ++r) { o0[r] = 0.f; o1[r] = 0.f; } lrun = (hi == 0 ? __builtin_amdgcn_exp2f(sink_c) : 0.f) * fres; } \
        else if (first) { lrun = (hi == 0 ? __builtin_amdgcn_exp2f(sink_c) : 0.f) * fres; } \
        else if (resc) { lrun *= fres; _Pragma("unroll") for (int r = 0; r < 16; ++r) { o0[r] *= fres; o1[r] *= fres; } } \
        ++it; ++step; vslot = cslot; cslot = nslot; \
        if (it == ci.ntile) { it = 0; ++cu; if (cu < nun) ci = attn_decode(ubase + GY * cu); } \
        if (step < total) { \
            const int ahead = pstep - step;        \
            if (ahead >= 3) AT_WAIT(2); else AT_WAIT(0); \
            __builtin_amdgcn_s_barrier(); asm volatile("" ::: "memory"); \
            if (pstep < total) issue(); \
        } } while (0)

    while (step < total) {
        AT_STEP(pB0, pB1, pA0, pA1);
        if (step >= total) {
            attn_drain(P, lds, pB0, pB1, o0, o1, lrun, vslot, cu, nun, ubase, GY, g, wsub, r32, hi);
            break; }
        AT_STEP(pA0, pA1, pB0, pB1);
        if (step >= total) { attn_drain(P, lds, pA0, pA1, o0, o1, lrun, vslot, cu, nun, ubase, GY, g, wsub, r32, hi); break; }
    }
    AT_WAIT(0);
    __syncthreads();
#undef AT_STEP
#undef AT_GAPA
#undef AT_GAPB
#undef AT_PK
#undef AT_PV
#undef AT_FA
#undef AT_WAIT
#undef AT_SB
}
__device__ __forceinline__ void ph_mix(const Params& P, LAS unsigned char* lds) {
    const int G = gridDim.x;
    attn_phase(P, lds);
#if (FK_DBL >> 11) & 1
    attn_phase(P, lds);
#endif
#if (FK_DBL >> 12) & 1
    for (int rep = 0; rep < 2; ++rep)
#endif
    const bf16_t* Z = (const bf16_t*)(P.ws + WS_Z); const bf16_t* BB = (const bf16_t*)(P.ws + WS_BB); bf16_t* AO = (bf16_t*)(P.ws + WS_AO);
    for (int it = blockIdx.x * 512 + threadIdx.x; it < (M / 16) * 128; it += G * 512) {
        const int cch = it & 127, tr = it >> 7, row0 = tr * 16, tl = row0 & 2047;
        const f32x4 wa = *(const f32x4*)(P.conv_w + cch * 8), wb = *(const f32x4*)(P.conv_w + cch * 8 + 4);
        const f32x4 wc0 = *(const f32x4*)(P.conv_w + 1024 + cch * 8), wc1 = *(const f32x4*)(P.conv_w + 1024 + cch * 8 + 4);
        const f32x4 we0 = *(const f32x4*)(P.conv_w + 2048 + cch * 8), we1 = *(const f32x4*)(P.conv_w + 2048 + cch * 8 + 4);
        const bf16_t* zp = Z + (size_t)row0 * 1024 + cch * 8;
        u32x4 zm = tl > 0 ? *(const u32x4*)(zp - 1024) : (u32x4){0u, 0u, 0u, 0u};
        u32x4 zc = *(const u32x4*)zp;
#pragma unroll 4
        for (int i = 0; i < 16; ++i) {
            const u32x4 zn = (tl + i + 1 < 2048) ? *(const u32x4*)(zp + (size_t)(i + 1) * 1024) : (u32x4){0u, 0u, 0u, 0u};
            const u32x4 bv = *(const u32x4*)(BB + (size_t)(row0 + i) * 1024 + cch * 8);
            float y[8];
#pragma unroll
            for (int k = 0; k < 4; ++k) {
                const float w0l = k < 2 ? wa[2 * k] : wb[2 * k - 4], w0h = k < 2 ? wa[2 * k + 1] : wb[2 * k - 3];
                const float w1l = k < 2 ? wc0[2 * k] : wc1[2 * k - 4], w1h = k < 2 ? wc0[2 * k + 1] : wc1[2 * k - 3];
                const float w2l = k < 2 ? we0[2 * k] : we1[2 * k - 4], w2h = k < 2 ? we0[2 * k + 1] : we1[2 * k - 3];
                y[2 * k] = bf_lo(bv[k]) * (w0l * bf_lo(zm[k]) + w1l * bf_lo(zc[k]) + w2l * bf_lo(zn[k]));
                y[2 * k + 1] = bf_hi(bv[k]) * (w0h * bf_hi(zm[k]) + w1h * bf_hi(zc[k]) + w2h * bf_hi(zn[k]));
            }
            u32x4 o; o.x = cvt_pk_bf16(y[0], y[1]); o.y = cvt_pk_bf16(y[2], y[3]); o.z = cvt_pk_bf16(y[4], y[5]); o.w = cvt_pk_bf16(y[6], y[7]);
            *(u32x4*)(AO + (size_t)(row0 + i) * 2048 + 1024 + cch * 8) = o;
            zm = zc; zc = zn;
        }
    }
}

struct RowColSched {
    int G, c, nM, nN; const char *A, *B; size_t ts;
    __device__ __forceinline__ bool next(int i, Unit& u) const {
        const int nwg = nM * nN, Lx = i * G + c; if (Lx >= nwg) return false;
        const int wgid = (Lx % 8) * (nwg / 8) + Lx / 8;
        const int nig = 8 * nN, gid = wgid / nig, w = wgid % nig;
        u.pm = gid * 8 + (w % 8); u.pn = w / 8; u.a = A + (size_t)u.pm * ts; u.b = B + (size_t)u.pn * ts; u.kind = 0; u.aux = 0; u.rows = nullptr; return true;
    }
};
struct EpiProj {
    const bf16_t *rb, *sgc; bf16_t* mb;
    __device__ __forceinline__ void mid(f32x4 (&acc)[2][2][4][2], const Unit& u, int wr, int wc, int fr, int fq) const {
#pragma unroll
        for (int ai = 0; ai < 2; ++ai)
#pragma unroll
            for (int m = 0; m < 4; ++m) { const int r = u.pm * 256 + 128 * ai + 64 * wr + 16 * m + fr;
#pragma unroll
                for (int bj = 0; bj < 2; ++bj) { const u32x4 w = *(const u32x4*)(rb + (size_t)r * 1024 + u.pn * 256 + 128 * bj + 32 * wc + 8 * fq);
                    acc[ai][bj][m][0] *= (f32x4){bf_lo(w.x), bf_hi(w.x), bf_lo(w.y), bf_hi(w.y)}; acc[ai][bj][m][1] *= (f32x4){bf_lo(w.z), bf_hi(w.z), bf_lo(w.w), bf_hi(w.w)}; } }
    }
    __device__ __forceinline__ void operator()(const f32x4 (&acc)[2][2][4][2], const Unit& u, int wr, int wc, int fr, int fq) const {
#pragma unroll
        for (int ai = 0; ai < 2; ++ai)
#pragma unroll
            for (int m = 0; m < 4; ++m) { const int r = u.pm * 256 + 128 * ai + 64 * wr + 16 * m + fr;
#pragma unroll
                for (int bj = 0; bj < 2; ++bj) { const size_t off = (size_t)r * 1024 + u.pn * 256 + 128 * bj + 32 * wc + 8 * fq; const u32x4 w = *(const u32x4*)(sgc + off);
                    const f32x4 v0 = acc[ai][bj][m][0] * (f32x4){bf_lo(w.x), bf_hi(w.x), bf_lo(w.y), bf_hi(w.y)}, v1 = acc[ai][bj][m][1] * (f32x4){bf_lo(w.z), bf_hi(w.z), bf_lo(w.w), bf_hi(w.w)};
                    u32x4 o; o.x = cvt_pk_bf16(v0.x, v0.y); o.y = cvt_pk_bf16(v0.z, v0.w); o.z = cvt_pk_bf16(v1.x, v1.y); o.w = cvt_pk_bf16(v1.z, v1.w);
                    *(u32x4*)(mb + off) = o; } }
    }
};
__device__ __forceinline__ void ph_proj(const Params& P, LAS unsigned char* lds) {
    RowColSched S; S.G = gridDim.x; S.c = blockIdx.x; S.nM = M / 256; S.nN = 4; S.A = (const char*)(P.ws + WS_AO); S.B = (const char*)(P.ws + WS_WP); S.ts = (size_t)256 * 2048 * 2;
    EpiProj E; E.rb = (const bf16_t*)(P.ob + OB_RB); E.sgc = (const bf16_t*)(P.ob + OB_SGC); E.mb = (bf16_t*)(P.ws + WS_MB);
    gemm_phase<EpiProj, RowColSched, true>(lds, 2048, S, E);
}
struct EpiOut {
    const float* mod; bf16_t* dl;
    __device__ __forceinline__ void operator()(const f32x4 (&acc)[2][2][4][2], const Unit& u, int wr, int wc, int fr, int fq) const {
        const int b = (u.pm * 256) >> 11;
#pragma unroll
        for (int bj = 0; bj < 2; ++bj) { const int col = u.pn * 256 + 128 * bj + 32 * wc + 8 * fq;
            const f32x4 g0 = *(const f32x4*)(mod + b * 6144 + 2048 + col), g1 = *(const f32x4*)(mod + b * 6144 + 2048 + col + 4);
#pragma unroll
            for (int ai = 0; ai < 2; ++ai)
#pragma unroll
                for (int m = 0; m < 4; ++m) { const size_t off = (size_t)(u.pm * 256 + 128 * ai + 64 * wr + 16 * m + fr) * 1024 + col;
                    const f32x4 v0 = g0 * acc[ai][bj][m][0], v1 = g1 * acc[ai][bj][m][1];
                    u32x4 w; w.x = cvt_pk_bf16(v0.x, v0.y); w.y = cvt_pk_bf16(v0.z, v0.w); w.z = cvt_pk_bf16(v1.x, v1.y); w.w = cvt_pk_bf16(v1.z, v1.w);
                    *(u32x4*)(dl + off) = w; } }
    }
};
__device__ __forceinline__ void ph_out(const Params& P, LAS unsigned char* lds) {
    RowColSched S; S.G = gridDim.x; S.c = blockIdx.x; S.nM = M / 256; S.nN = 4; S.A = (const char*)(P.ws + WS_MB); S.B = (const char*)(P.ws + WS_WO); S.ts = (size_t)256 * 1024 * 2;
    EpiOut E; E.mod = (const float*)(P.ws + WS_MOD); E.dl = (bf16_t*)(P.ws + WS_DL);
    gemm_phase<EpiOut, RowColSched, false>(lds, 1024, S, E);
}

__device__ __forceinline__ void ph_router(const Params& P, LAS unsigned char* lds) {
    const int tid = threadIdx.x, lane = tid & 63, wave = tid >> 6;
    LAS float* wt = (LAS float*)lds;
    for (int i = tid; i < 16384; i += 512) { const int k = i >> 4, e = i & 15; wt[e * 1024 + k] = P.w_router[i]; }
    __syncthreads();
    const bf16_t* DL = (const bf16_t*)(P.ws + WS_DL); const float* mod = (const float*)(P.ws + WS_MOD);
    bf16_t* HX2 = (bf16_t*)(P.ws + WS_HX2); float* AFF = (float*)(P.ws + WS_AFF);
    f32x4 nx0[4], nx1[4]; u32x4 nd0[2], nd1[2];
    const int rp0 = blockIdx.x * 8 + wave, rstep = gridDim.x * 8;
#define RT_LOAD(rpv) do { _Pragma("unroll") for (int j = 0; j < 2; ++j) { const size_t o0 = (size_t)((rpv) * 2) * D + 8 * lane + 512 * j; \
        nx0[2 * j] = *(const f32x4*)(P.x + o0); nx0[2 * j + 1] = *(const f32x4*)(P.x + o0 + 4); nx1[2 * j] = *(const f32x4*)(P.x + o0 + D); nx1[2 * j + 1] = *(const f32x4*)(P.x + o0 + D + 4); \
        nd0[j] = *(const u32x4*)(DL + o0); nd1[j] = *(const u32x4*)(DL + o0 + D); } } while (0)
    if (rp0 < M / 2) RT_LOAD(rp0);
    for (int rp = rp0; rp < M / 2; rp += rstep) {
        const int row = rp * 2, b = row >> 11; const float* mv = mod + b * 6144;
        f32x4 v0[4], v1[4]; float s0 = 0.f, s1 = 0.f;
#pragma unroll
        for (int j = 0; j < 2; ++j) { f32x4 a, c; bf8_to_f32(nd0[j], a, c); v0[2 * j] = nx0[2 * j] + a; v0[2 * j + 1] = nx0[2 * j + 1] + c; bf8_to_f32(nd1[j], a, c); v1[2 * j] = nx1[2 * j] + a; v1[2 * j + 1] = nx1[2 * j + 1] + c;
            s0 += sq4(v0[2 * j]) + sq4(v0[2 * j + 1]); s1 += sq4(v1[2 * j]) + sq4(v1[2 * j + 1]); }
        if (rp + rstep < M / 2) RT_LOAD(rp + rstep);
        const float r0 = 1.0f / sqrtf(wave_sum(s0) * (1.f / D) + 1e-6f), r1 = 1.0f / sqrtf(wave_sum(s1) * (1.f / D) + 1e-6f);
#pragma unroll
        for (int j = 0; j < 2; ++j) { const int c0 = 8 * lane + 512 * j;
            const f32x4 g0 = *(const f32x4*)(P.norm2_g + c0) * (*(const f32x4*)(mv + 4096 + c0) + 1.0f), g1 = *(const f32x4*)(P.norm2_g + c0 + 4) * (*(const f32x4*)(mv + 4096 + c0 + 4) + 1.0f);
            const f32x4 sh0 = *(const f32x4*)(mv + 3072 + c0), sh1 = *(const f32x4*)(mv + 3072 + c0 + 4);
            v0[2 * j] = v0[2 * j] * r0 * g0 + sh0; v0[2 * j + 1] = v0[2 * j + 1] * r0 * g1 + sh1; v1[2 * j] = v1[2 * j] * r1 * g0 + sh0; v1[2 * j + 1] = v1[2 * j + 1] * r1 * g1 + sh1;
            *(u32x4*)(HX2 + (size_t)row * D + c0) = f32_to_bf8(v0[2 * j], v0[2 * j + 1]); *(u32x4*)(HX2 + (size_t)(row + 1) * D + c0) = f32_to_bf8(v1[2 * j], v1[2 * j + 1]); }
        float mine0 = 0.f, mine1 = 0.f;
#pragma unroll 2
        for (int e = 0; e < 16; ++e) { float a = 0.f, c = 0.f;
#pragma unroll
            for (int j = 0; j < 4; ++j) { const f32x4 w = *(const LAS f32x4*)(wt + e * 1024 + 8 * lane + 512 * (j >> 1) + 4 * (j & 1));
                a += dot4(v0[j], w); c += dot4(v1[j], w); }
            a = wave_sum(a); c = wave_sum(c);
            if (lane == e) { mine0 = a; mine1 = c; } }
        float m0 = mine0, m1 = mine1;
#pragma unroll
        for (int o = 1; o < 16; o <<= 1) { m0 = fmaxf(m0, __shfl_xor(m0, o)); m1 = fmaxf(m1, __shfl_xor(m1, o)); }
        mine0 = expf(mine0 - m0); mine1 = expf(mine1 - m1);
        float z0 = mine0, z1 = mine1;
#pragma unroll
        for (int o = 1; o < 16; o <<= 1) { z0 += __shfl_xor(z0, o); z1 += __shfl_xor(z1, o); }
        if (lane < 16) { const int t = row & 2047; AFF[(size_t)(b * 16 + lane) * T + t] = mine0 / z0; AFF[(size_t)(b * 16 + lane) * T + t + 1] = mine1 / z1; }
    }
}

__device__ __forceinline__ int block_count(int v, LAS int* red, int wave, int lane) {
#pragma unroll
    for (int o = 1; o < 64; o <<= 1) v += __shfl_xor(v, o);
    __syncthreads();
    if (lane == 0) red[wave] = v;
    __syncthreads();
    return red[0] + red[1] + red[2] + red[3] + red[4] + red[5] + red[6] + red[7];
}
__device__ __forceinline__ int block_excl_prefix(int v, LAS int* red, int wave, int lane, int& total) {
    int inc = v;
#pragma unroll
    for (int o = 1; o < 64; o <<= 1) { const int n = __shfl_up(inc, o); if (lane >= o) inc += n; }
    __syncthreads();
    if (lane == 63) red[wave] = inc;
    __syncthreads();
    int base = 0, tot = 0;
#pragma unroll
    for (int w = 0; w < 8; ++w) { const int s = red[w]; if (w < wave) base += s; tot += s; }
    total = tot; return base + inc - v;
}
__device__ __forceinline__ void ph_topk(const Params& P, LAS unsigned char* lds) {
    const int tid = threadIdx.x, lane = tid & 63, wave = tid >> 6;
    LAS int* red = (LAS int*)lds;
    const float* AFF = (const float*)(P.ws + WS_AFF); int* IDX = (int*)(P.ws + WS_IDX); float* GATE = (float*)(P.ws + WS_GATE); int* SEL = (int*)(P.ws + WS_SEL);
    for (int be = blockIdx.x; be < NBF * 16; be += gridDim.x) {
        const int b = be >> 4, e = be & 15;
        const u32x4 kv = *(const u32x4*)(AFF + (size_t)be * T + tid * 4);
        unsigned thr = 0u;
        for (int bit = 31; bit >= 0; --bit) { const unsigned cand = thr | (1u << bit);
            const int cnt = block_count((kv.x >= cand) + (kv.y >= cand) + (kv.z >= cand) + (kv.w >= cand), red, wave, lane);
            if (cnt >= CAP) thr = cand; }
        const int ngt = block_count((kv.x > thr) + (kv.y > thr) + (kv.z > thr) + (kv.w > thr), red, wave, lane);
        const int need = CAP - ngt;
        int tot;
        const int e0 = kv.x == thr, e1 = kv.y == thr, e2 = kv.z == thr, e3 = kv.w == thr;
        const int eqb = block_excl_prefix(e0 + e1 + e2 + e3, red, wave, lane, tot);
        const int s0 = (kv.x > thr) || (e0 && eqb < need), s1 = (kv.y > thr) || (e1 && eqb + e0 < need), s2 = (kv.z > thr) || (e2 && eqb + e0 + e1 < need),
                  s3 = (kv.w > thr) || (e3 && eqb + e0 + e1 + e2 < need);
        const int sb = block_excl_prefix(s0 + s1 + s2 + s3, red, wave, lane, tot);
        const int p0 = sb, p1 = sb + s0, p2 = p1 + s1, p3 = p2 + s2;
        const int t0 = 4 * tid;
        if (s0) { IDX[be * CAP + p0] = t0; GATE[be * CAP + p0] = __uint_as_float(kv.x); }
        if (s1) { IDX[be * CAP + p1] = t0 + 1; GATE[be * CAP + p1] = __uint_as_float(kv.y); }
        if (s2) { IDX[be * CAP + p2] = t0 + 2; GATE[be * CAP + p2] = __uint_as_float(kv.z); }
        if (s3) { IDX[be * CAP + p3] = t0 + 3; GATE[be * CAP + p3] = __uint_as_float(kv.w); }
        SEL[(size_t)(b * T + t0) * 16 + e] = s0 ? p0 : -1; SEL[(size_t)(b * T + t0 + 1) * 16 + e] = s1 ? p1 : -1;
        SEL[(size_t)(b * T + t0 + 2) * 16 + e] = s2 ? p2 : -1; SEL[(size_t)(b * T + t0 + 3) * 16 + e] = s3 ? p3 : -1;
        __syncthreads();
    }
}

struct MoeUpSched {
    int G, c; const char *hx2, *wgu; const int* idx;
    __device__ __forceinline__ bool next(int i, Unit& u) const {
        const int Lx = i * G + c; if (Lx >= NBF * 128) return false;
        const int x = Lx & 7, j = Lx >> 3, e = 2 * x + j / (NBF * 8), jj = j % (NBF * 8), rg = jj >> 5, w = jj & 31;
        const int smp = 8 * (rg >> 1) + (w & 7), pn = 4 * (rg & 1) + (w >> 3), be = smp * 16 + e;
        u.pm = be; u.pn = pn; u.kind = 0; u.aux = e; u.a = hx2 + (size_t)smp * ((size_t)T * 1024 * 2); u.rows = idx + be * CAP; u.b = wgu + ((size_t)e * 2048 + pn * 256) * 2048; return true;
    }
};
struct EpiUp {
    bf16_t* hb;
    __device__ __forceinline__ void operator()(const f32x4 (&acc)[2][2][4][2], const Unit& u, int wr, int wc, int fr, int fq) const {
#pragma unroll
        for (int ai = 0; ai < 2; ++ai)
#pragma unroll
            for (int m = 0; m < 4; ++m) { const int r = u.pm * 256 + 128 * ai + 64 * wr + 16 * m + fr;
                f32x4 h[2];
#pragma unroll
                for (int n = 0; n < 2; ++n)
#pragma unroll
                    for (int j = 0; j < 4; ++j) { const float a = acc[ai][0][m][n][j]; h[n][j] = a / (1.f + __expf(-a)) * acc[ai][1][m][n][j]; }
                u32x4 w; w.x = cvt_pk_bf16(h[0].x, h[0].y); w.y = cvt_pk_bf16(h[0].z, h[0].w); w.z = cvt_pk_bf16(h[1].x, h[1].y); w.w = cvt_pk_bf16(h[1].z, h[1].w);
                *(u32x4*)(hb + (size_t)r * 1024 + u.pn * 128 + 32 * wc + 8 * fq) = w; }
    }
};
__device__ __forceinline__ void ph_moe_up(const Params& P, LAS unsigned char* lds) {
    MoeUpSched S; S.G = gridDim.x; S.c = blockIdx.x; S.hx2 = (const char*)(P.ws + WS_HX2); S.idx = (const int*)(P.ws + WS_IDX); S.wgu = (const char*)(P.ws + WS_WGU);
    EpiUp E; E.hb = (bf16_t*)(P.ob + OB_HB);
    gemm_phase<EpiUp, MoeUpSched, false, true>(lds, 1024, S, E);
}
struct MoeDownSched {
    int G, c; const char *hb, *wd;
    __device__ __forceinline__ bool next(int i, Unit& u) const {
        const int Lx = i * G + c; if (Lx >= NBF * 64) return false;
        const int x = Lx & 7, j = Lx >> 3, e = 2 * x + j / (NBF * 4), jj = j % (NBF * 4), rg = jj >> 5, w = jj & 31;
        const int smp = 8 * rg + (w & 7), pn = w >> 3, be = smp * 16 + e;
        u.pm = be; u.pn = pn; u.kind = 0; u.aux = e; u.rows = nullptr; u.a = hb + (size_t)be * (256 * 1024 * 2); u.b = wd + ((size_t)e * 1024 + pn * 256) * 2048; return true;
    }
};
struct EpiDown {
    const float* gate; bf16_t* ye;
    __device__ __forceinline__ void operator()(const f32x4 (&acc)[2][2][4][2], const Unit& u, int wr, int wc, int fr, int fq) const {
#pragma unroll
        for (int ai = 0; ai < 2; ++ai)
#pragma unroll
            for (int m = 0; m < 4; ++m) { const int r = u.pm * 256 + 128 * ai + 64 * wr + 16 * m + fr; const float gt = gate[r];
#pragma unroll
                for (int bj = 0; bj < 2; ++bj) { const f32x4 v0 = acc[ai][bj][m][0] * gt, v1 = acc[ai][bj][m][1] * gt;
                    u32x4 w; w.x = cvt_pk_bf16(v0.x, v0.y); w.y = cvt_pk_bf16(v0.z, v0.w); w.z = cvt_pk_bf16(v1.x, v1.y); w.w = cvt_pk_bf16(v1.z, v1.w);
                    *(u32x4*)(ye + (size_t)r * 1024 + u.pn * 256 + 128 * bj + 32 * wc + 8 * fq) = w; } }
    }
};
__device__ __forceinline__ void ph_moe_down(const Params& P, LAS unsigned char* lds) {
    MoeDownSched S; S.G = gridDim.x; S.c = blockIdx.x; S.hb = (const char*)(P.ob + OB_HB); S.wd = (const char*)(P.ws + WS_WD);
    EpiDown E; E.gate = (const float*)(P.ws + WS_GATE); E.ye = (bf16_t*)(P.ws + WS_YE);
    gemm_phase<EpiDown, MoeDownSched, false>(lds, 1024, S, E);
}

__device__ __forceinline__ void ph_final(const Params& P) {
    const int lane = threadIdx.x & 63, wave = threadIdx.x >> 6;
    const bf16_t* DL = (const bf16_t*)(P.ws + WS_DL); const float* mod = (const float*)(P.ws + WS_MOD); const int* SEL = (const int*)(P.ws + WS_SEL); const bf16_t* YE = (const bf16_t*)(P.ws + WS_YE);
    constexpr int NR = 2;
    for (int row0 = (blockIdx.x * 8 + wave) * NR; row0 < M; row0 += gridDim.x * 8 * NR) {
        const int b = row0 >> 11;
        int sv[NR]; f32x4 xv[NR][4]; u32x4 dv[NR][2];
#pragma unroll
        for (int r = 0; r < NR; ++r) { sv[r] = SEL[(size_t)(row0 + r) * 16 + (lane & 15)];
#pragma unroll
            for (int j = 0; j < 2; ++j) { const size_t o = (size_t)(row0 + r) * D + 8 * lane + 512 * j; xv[r][2 * j] = *(const f32x4*)(P.x + o); xv[r][2 * j + 1] = *(const f32x4*)(P.x + o + 4); dv[r][j] = *(const u32x4*)(DL + o); } }
        f32x4 mo[NR][4];
#pragma unroll
        for (int r = 0; r < NR; ++r)
#pragma unroll
            for (int j = 0; j < 4; ++j) mo[r][j] = (f32x4){0.f, 0.f, 0.f, 0.f};
#pragma unroll
        for (int e = 0; e < 16; ++e) {
#pragma unroll
            for (int r = 0; r < NR; ++r) { const int sl = __builtin_amdgcn_readlane(sv[r], e);
                if (sl >= 0) { const bf16_t* yr = YE + ((size_t)(b * 16 + e) * CAP + sl) * D + 8 * lane;
#pragma unroll
                    for (int j = 0; j < 2; ++j) { f32x4 a, c; bf8_to_f32(*(const u32x4*)(yr + 512 * j), a, c); mo[r][2 * j] += a; mo[r][2 * j + 1] += c; } } } }
#pragma unroll
        for (int r = 0; r < NR; ++r) { float ss = 0.f; f32x4 v[4];
#pragma unroll
            for (int j = 0; j < 2; ++j) { const int c0 = 8 * lane + 512 * j; f32x4 a, c; bf8_to_f32(dv[r][j], a, c);
                v[2 * j] = xv[r][2 * j] + a + *(const f32x4*)(mod + b * 6144 + 5120 + c0) * mo[r][2 * j]; v[2 * j + 1] = xv[r][2 * j + 1] + c + *(const f32x4*)(mod + b * 6144 + 5120 + c0 + 4) * mo[r][2 * j + 1];
                ss += sq4(v[2 * j]) + sq4(v[2 * j + 1]); }
            const float rs = 1.0f / sqrtf(wave_sum(ss) * (1.f / D) + 1e-6f);
#pragma unroll
            for (int j = 0; j < 2; ++j) { const int c0 = 8 * lane + 512 * j;
                *(f32x4*)(P.out + (size_t)(row0 + r) * D + c0) = v[2 * j] * rs * *(const f32x4*)(P.fg + c0); *(f32x4*)(P.out + (size_t)(row0 + r) * D + c0 + 4) = v[2 * j + 1] * rs * *(const f32x4*)(P.fg + c0 + 4); } }
    }
}

#define XB_TMO      128
#define XB_XCNT(j)  (256  + 64 * (j))
#define XB_XSUB(j)  (1280 + 64 * (j))
#define XB_XGEN(j)  (2304 + 64 * (j))
#define XB_TOP      3328
#define XB_TOPGEN   3392
#define XCD_BAR_WORDS 3456
#define XB_SPIN_CAP (1u << 20)
__device__ __forceinline__ unsigned xb_ld(unsigned* p)              { return __hip_atomic_load(p, __ATOMIC_RELAXED, __HIP_MEMORY_SCOPE_AGENT); }
__device__ __forceinline__ unsigned xb_add(unsigned* p, unsigned v) { return __hip_atomic_fetch_add(p, v, __ATOMIC_RELAXED, __HIP_MEMORY_SCOPE_AGENT); }
__device__ __forceinline__ unsigned xb_xcc_id() { return (unsigned)__builtin_amdgcn_s_getreg((3 << 11) | 20) & 0xFu; }
#define XB_SPIN(cond, bar) do { unsigned _sp = 0; while (cond) { __builtin_amdgcn_s_sleep(1); \
    if ((++_sp & 255u) == 0u) { if (xb_ld(&(bar)[XB_TMO])) break; if (_sp > XB_SPIN_CAP) { atomicAdd(&(bar)[XB_TMO], 1u); break; } } } } while (0)
struct XcdBarrier { unsigned* bar; unsigned x; volatile LAS unsigned* st; };
__device__ __forceinline__ XcdBarrier xcd_barrier_post(unsigned* bar, volatile LAS unsigned* st) {
    XcdBarrier b; b.bar = bar; b.x = xb_xcc_id(); b.st = st;
    if (threadIdx.x == 0) (void)xb_add(&bar[XB_XCNT(b.x)], 1u);
    return b;
}
__device__ __forceinline__ void xcd_barrier_complete(unsigned* bar, unsigned x, unsigned& nloc, unsigned& nx) {
    const unsigned G = gridDim.x * gridDim.y * gridDim.z;
    unsigned sum, cnt, mine, sp = 0u;
    for (;;) {
        sum = 0u; cnt = 0u; mine = 0u;
#pragma unroll
        for (unsigned j = 0; j < 16; ++j) { const unsigned c = xb_ld(&bar[XB_XCNT(j)]); sum += c; cnt += (c > 0u) ? 1u : 0u; mine = (j == x) ? c : mine; }
        if (sum == G) break;
        __builtin_amdgcn_s_sleep(1);
        if ((++sp & 255u) == 0u) { if (xb_ld(&bar[XB_TMO])) break; if (sp > XB_SPIN_CAP) { atomicAdd(&bar[XB_TMO], 1u); break; } }
    }
    nloc = mine > 0u ? mine : 1u; nx = cnt > 0u ? cnt : 1u;
}
__device__ __forceinline__ void xcd_barrier(const XcdBarrier& b) {
    asm volatile("s_waitcnt vmcnt(0)" ::: "memory");
    __syncthreads();
    if (threadIdx.x == 0) {
        unsigned* bar = b.bar;
        __builtin_amdgcn_s_waitcnt(0);
        unsigned nloc = b.st[0], nx = b.st[1];
        if (nloc == 0u) { xcd_barrier_complete(bar, b.x, nloc, nx); b.st[0] = nloc; b.st[1] = nx; }
        const unsigned old = xb_add(&bar[XB_XSUB(b.x)], 1u);
        const unsigned gen = old / nloc;
        if (old + 1u == (gen + 1u) * nloc) {
            __builtin_amdgcn_fence(__ATOMIC_RELEASE, "agent");
            asm volatile("s_waitcnt vmcnt(0)" ::: "memory");
            const unsigned og = xb_add(&bar[XB_TOP], 1u);
            const unsigned tg = og / nx;
            if (og + 1u == (tg + 1u) * nx) xb_add(&bar[XB_TOPGEN], 1u);
            else XB_SPIN(xb_ld(&bar[XB_TOPGEN]) == tg, bar);
            __builtin_amdgcn_fence(__ATOMIC_ACQUIRE, "agent");
            xb_add(&bar[XB_XGEN(b.x)], 1u);
            asm volatile("s_waitcnt vmcnt(0)" ::: "memory");
        } else {
            XB_SPIN(xb_ld(&bar[XB_XGEN(b.x)]) == gen, bar);
            __builtin_amdgcn_fence(__ATOMIC_ACQUIRE, "agent");
            asm volatile("s_waitcnt vmcnt(0)" ::: "memory");
        }
    }
    __syncthreads();
}


#ifdef FK_COPYPROBE
__device__ __forceinline__ void ph_copyprobe(const Params& P) {
    const int lane = threadIdx.x & 63, wave = threadIdx.x >> 6;
    const u32x4* src = (const u32x4*)P.x; u32x4* dst = (u32x4*)(P.ws + WS_AO);
    const size_t nchunk = (size_t)M * D * 4 / 4096;
    for (size_t c0 = (size_t)(blockIdx.x * 8 + wave) * 4; c0 < nchunk; c0 += (size_t)gridDim.x * 8 * 4) {
        u32x4 v[4][4];
#pragma unroll
        for (int r = 0; r < 4; ++r)
#pragma unroll
            for (int j = 0; j < 4; ++j) v[r][j] = src[(c0 + r) * 256 + lane + 64 * j];
#pragma unroll
        for (int r = 0; r < 4; ++r)
#pragma unroll
            for (int j = 0; j < 4; ++j) dst[(c0 + r) * 256 + lane + 64 * j] = v[r][j];
    }
}
#endif
constexpr int NPHASE = 11;
constexpr size_t CTL_ZERO_BYTES = 16384;
#ifndef FK_MASK
#define FK_MASK 0x7ff
#endif
#ifndef FK_CGSYNC
#define FK_CGSYNC 0
#endif
__global__ void __launch_bounds__(512, 2) mega(Params P) {
    extern __shared__ __attribute__((aligned(16))) unsigned char lds_raw[];
    LAS unsigned char* lds = (LAS unsigned char*)lds_raw;
    cg::grid_group grid = cg::this_grid();
    volatile LAS unsigned* misc = (volatile LAS unsigned*)(lds + LDS_MISC);
    if (threadIdx.x < 2) misc[threadIdx.x] = 0u;
    __syncthreads();
    const XcdBarrier bar = xcd_barrier_post((unsigned*)(P.ws + WS_CTL), misc);
    const int lo = P.ph_lo, hi = P.ph_hi;
    if (lo < 0) grid.sync();
#define FK_SYNC(k) do { if ((k) < FK_CGSYNC) grid.sync(); else xcd_barrier(bar); } while (0)
#define FK_PH(k, call) if (((FK_MASK >> (k)) & 1) && lo <= (k) && (k) < hi) { call; if ((FK_DBL >> (k)) & 1) { FK_SYNC(k); call; } if ((k) + 1 < hi) FK_SYNC(k); }
#ifdef FK_COPYPROBE
    for (int rep = 0; rep < FK_COPYPROBE; ++rep) { ph_copyprobe(P); xcd_barrier(bar); }
#endif
    FK_PH(0, ph_prep(P, lds))
    FK_PH(1, ph_norm1(P, lds))
    FK_PH(2, ph_inproj(P, lds))
    FK_PH(3, ph_mix(P, lds))
    FK_PH(4, ph_proj(P, lds))
    FK_PH(5, ph_out(P, lds))
    FK_PH(6, ph_router(P, lds))
    FK_PH(7, ph_topk(P, lds))
    FK_PH(8, ph_moe_up(P, lds))
    FK_PH(9, ph_moe_down(P, lds))
    FK_PH(10, ph_final(P))
#undef FK_PH
#undef FK_SYNC
}
}
static void fk_launch(fk::Params p, int lo, int hi, hipStream_t stream);
#if HYB >= 0
#include <hip/hip_runtime.h>

namespace nv {
constexpr int D = 1024, T = 2048, L = 256, NB = 16, INW = 6656, NE = 16, CAP = 256;

__global__ void k_mod(const float* __restrict__ c, const float* __restrict__ c_ctx, const float* __restrict__ w_mod,
                      const float* __restrict__ b_mod, float* __restrict__ mod) {
    const int n = blockIdx.x * 256 + threadIdx.x, r = blockIdx.y;
    const float* cv = r < 16 ? c + r * 1024 : c_ctx;
    float acc = 0.f;
    for (int k = 0; k < 1024; ++k) { const float v = cv[k]; const float s = v / (1.f + expf(-v)); acc += s * w_mod[(size_t)k * 6144 + n]; }
    mod[r * 6144 + n] = acc + b_mod[n];
}

__device__ __forceinline__ float block_sum256(float v, float* red) {
#pragma unroll
    for (int o = 32; o > 0; o >>= 1) v += __shfl_xor(v, o);
    __syncthreads();
    if ((threadIdx.x & 63) == 0) red[threadIdx.x >> 6] = v;
    __syncthreads();
    return red[0] + red[1] + red[2] + red[3];
}

__global__ void k_norm_mod(const float* __restrict__ x, const float* __restrict__ g, const float* __restrict__ shift,
                           const float* __restrict__ scale, float* __restrict__ out) {
    __shared__ float red[4];
    const int row = blockIdx.x, t = threadIdx.x;
    const float* xr = x + (size_t)row * D;
    float v[4]; float ss = 0.f;
#pragma unroll
    for (int j = 0; j < 4; ++j) { v[j] = xr[t + 256 * j]; ss += v[j] * v[j]; }
    const float tot = block_sum256(ss, red);
    const float rs = 1.0f / sqrtf(tot * (1.f / D) + 1e-6f);
#pragma unroll
    for (int j = 0; j < 4; ++j) { const int cidx = t + 256 * j; out[(size_t)row * D + cidx] = v[j] * rs * g[cidx] * (1.f + scale[cidx]) + shift[cidx]; }
}

__global__ __launch_bounds__(256) void k_sgemm(const float* __restrict__ A, int lda, const int* __restrict__ rows, long sA, long sRows,
                                               const float* __restrict__ B, int ldb, long sB, float* __restrict__ C, int ldc, long sC, int K) {
    __shared__ float As[16][65];
    __shared__ float Bs[16][64];
    const int z = blockIdx.z;
    A += (size_t)z * sA; B += (size_t)z * sB; C += (size_t)z * sC; if (rows) rows += (size_t)z * sRows;
    const int tx = threadIdx.x & 15, ty = threadIdx.x >> 4;
    const int m0 = blockIdx.y * 64, n0 = blockIdx.x * 64;
    float acc[4][4];
#pragma unroll
    for (int i = 0; i < 4; ++i)
#pragma unroll
        for (int j = 0; j < 4; ++j) acc[i][j] = 0.f;
    for (int k0 = 0; k0 < K; k0 += 16) {
#pragma unroll
        for (int ii = 0; ii < 4; ++ii) { const int i = threadIdx.x + 256 * ii; const int r = i >> 4, kk = i & 15; const int row = m0 + r; const int src = rows ? rows[row] : row;
            As[kk][r] = A[(size_t)src * lda + k0 + kk]; }
#pragma unroll
        for (int ii = 0; ii < 4; ++ii) { const int i = threadIdx.x + 256 * ii; const int kk = i >> 6, cc = i & 63; Bs[kk][cc] = B[(size_t)(k0 + kk) * ldb + n0 + cc]; }
        __syncthreads();
#pragma unroll
        for (int kk = 0; kk < 16; ++kk) {
            float a[4], b[4];
#pragma unroll
            for (int i = 0; i < 4; ++i) a[i] = As[kk][ty * 4 + i];
#pragma unroll
            for (int j = 0; j < 4; ++j) b[j] = Bs[kk][tx * 4 + j];
#pragma unroll
            for (int i = 0; i < 4; ++i)
#pragma unroll
                for (int j = 0; j < 4; ++j) acc[i][j] += a[i] * b[j];
        }
        __syncthreads();
    }
#pragma unroll
    for (int i = 0; i < 4; ++i)
#pragma unroll
        for (int j = 0; j < 4; ++j) C[(size_t)(m0 + ty * 4 + i) * ldc + n0 + tx * 4 + j] = acc[i][j];
}

__global__ void k_rope(float* __restrict__ P) {
    const int gid = blockIdx.x * 256 + threadIdx.x;
    const int pr = gid & 31, hs = (gid >> 5) % 20, t = gid / (32 * 20);
    if (t >= T) return;
    const int half = pr >> 4, i = pr & 15;
    const float pos = half == 0 ? (float)(t / 64) : (float)(t % 64);
    const float inv_freq = powf(10000.f, -(float)i / 16.f);
    const float ang = pos * inv_freq;
    const float cs = cosf(ang), sn = sinf(ang);
    float* p = P + (size_t)t * INW + hs * 64 + half * 32 + i;
    const float x1 = p[0], x2 = p[16];
    p[0] = x1 * cs - x2 * sn;
    p[16] = x2 * cs + x1 * sn;
}

__global__ __launch_bounds__(64) void k_attn(const float* __restrict__ P, const float* __restrict__ kvc, const float* __restrict__ sink, float* __restrict__ o) {
    __shared__ float qs[64];
    __shared__ float sc[257 + 256];
    const int t = blockIdx.x, h = blockIdx.y, hkv = h >> 2, d = threadIdx.x;
    qs[d] = P[(size_t)t * INW + h * 64 + d];
    __syncthreads();
    const int lo = t - 128 < 0 ? 0 : t - 128, hi = t + 128 > T - 1 ? T - 1 : t + 128, nw = hi - lo + 1, ntot = nw + L;
    for (int j = d; j < ntot; j += 64) {
        const float* kp = j < nw ? P + (size_t)(lo + j) * INW + 1024 + hkv * 64 : kvc + (size_t)(j - nw) * 512 + hkv * 64;
        float s = 0.f;
        for (int dd = 0; dd < 64; ++dd) s += qs[dd] * kp[dd];
        sc[j] = s * 0.125f;
    }
    __syncthreads();
    const float sk = sink[h];
    float m = sk;
    for (int j = d; j < ntot; j += 64) m = fmaxf(m, sc[j]);
#pragma unroll
    for (int off = 32; off > 0; off >>= 1) m = fmaxf(m, __shfl_xor(m, off));
    float l = 0.f;
    for (int j = d; j < ntot; j += 64) { const float p = expf(sc[j] - m); sc[j] = p; l += p; }
#pragma unroll
    for (int off = 32; off > 0; off >>= 1) l += __shfl_xor(l, off);
    l += expf(sk - m);
    __syncthreads();
    float acc = 0.f;
    for (int j = 0; j < ntot; ++j) {
        const float* vp = j < nw ? P + (size_t)(lo + j) * INW + 1280 + hkv * 64 : kvc + (size_t)(j - nw) * 512 + 256 + hkv * 64;
        acc += sc[j] * vp[d];
    }
    o[(size_t)t * D + h * 64 + d] = acc / l;
}

__global__ void k_conv(const float* __restrict__ P, const float* __restrict__ cw, float* __restrict__ y) {
    const int gid = blockIdx.x * 256 + threadIdx.x; const int ch = gid & 1023, t = gid >> 10;
    const float* pr = P + (size_t)t * INW;
    const float z1 = pr[3584 + ch] * pr[1536 + ch];
    const float z0 = t > 0 ? pr[3584 + ch - INW] * pr[1536 + ch - INW] : 0.f;
    const float z2 = t < T - 1 ? pr[3584 + ch + INW] * pr[1536 + ch + INW] : 0.f;
    y[gid] = pr[2560 + ch] * (cw[ch] * z0 + cw[1024 + ch] * z1 + cw[2048 + ch] * z2);
}

__global__ void k_merge(const float* __restrict__ P, float* __restrict__ a, const float* __restrict__ s) {
    const int gid = blockIdx.x * 256 + threadIdx.x; const int ch = gid & 1023, t = gid >> 10;
    const float ga = P[(size_t)t * INW + 4608 + ch], gc = P[(size_t)t * INW + 5632 + ch];
    a[gid] = a[gid] / (1.f + expf(-ga)) + s[gid] / (1.f + expf(-gc));
}

__global__ void k_resid(const float* __restrict__ x, const float* __restrict__ g, const float* __restrict__ o, float* __restrict__ x1) {
    const int gid = blockIdx.x * 256 + threadIdx.x; const int ch = gid & 1023;
    x1[gid] = x[gid] + g[ch] * o[gid];
}

__global__ void k_router(const float* __restrict__ x1, const float* __restrict__ g, const float* __restrict__ shift, const float* __restrict__ scale,
                         const float* __restrict__ w_router, float* __restrict__ hx2, float* __restrict__ aff) {
    __shared__ float red[4];
    __shared__ float lg[16];
    const int row = blockIdx.x, t = threadIdx.x;
    const float* xr = x1 + (size_t)row * D;
    float v[4]; float ss = 0.f;
#pragma unroll
    for (int j = 0; j < 4; ++j) { v[j] = xr[t + 256 * j]; ss += v[j] * v[j]; }
    const float tot = block_sum256(ss, red);
    const float rs = 1.0f / sqrtf(tot * (1.f / D) + 1e-6f);
#pragma unroll
    for (int j = 0; j < 4; ++j) { const int cidx = t + 256 * j; v[j] = v[j] * rs * g[cidx] * (1.f + scale[cidx]) + shift[cidx]; hx2[(size_t)row * D + cidx] = v[j]; }
    for (int e = 0; e < 16; ++e) {
        float p = 0.f;
#pragma unroll
        for (int j = 0; j < 4; ++j) p += v[j] * w_router[(size_t)(t + 256 * j) * 16 + e];
        const float s = block_sum256(p, red);
        if (t == 0) lg[e] = s;
    }
    __syncthreads();
    if (t < 16) {
        float m = lg[0];
        for (int e = 1; e < 16; ++e) m = fmaxf(m, lg[e]);
        float sum = 0.f;
        for (int e = 0; e < 16; ++e) sum += expf(lg[e] - m);
        aff[(size_t)t * T + row] = expf(lg[t] - m) / sum;
    }
}

__global__ void k_topk(const float* __restrict__ aff, int* __restrict__ idx, float* __restrict__ gate, int* __restrict__ sel) {
    __shared__ float a[T];
    const int e = blockIdx.x;
    for (int i = threadIdx.x; i < T; i += 256) a[i] = aff[(size_t)e * T + i];
    __syncthreads();
    for (int i = threadIdx.x; i < T; i += 256) {
        const float v = a[i]; int rank = 0;
        for (int j = 0; j < T; ++j) { const float w = a[j]; rank += (w > v || (w == v && j < i)) ? 1 : 0; }
        if (rank < CAP) { idx[e * CAP + rank] = i; gate[e * CAP + rank] = v; sel[i * 16 + e] = rank; }
        else sel[i * 16 + e] = -1;
    }
}

__global__ void k_silu_mul(float* __restrict__ a, const float* __restrict__ u) {
    const size_t gid = (size_t)blockIdx.x * 256 + threadIdx.x;
    const float v = a[gid];
    a[gid] = v / (1.f + expf(-v)) * u[gid];
}

__global__ void k_combine(const float* __restrict__ x1, const float* __restrict__ g2, const float* __restrict__ ye, const float* __restrict__ gate,
                          const int* __restrict__ sel, const float* __restrict__ fg, float* __restrict__ out) {
    __shared__ float red[4];
    const int row = blockIdx.x, t = threadIdx.x;
    float m[4] = {0.f, 0.f, 0.f, 0.f};
    for (int e = 0; e < 16; ++e) {
        const int s = sel[row * 16 + e];
        if (s >= 0) { const float gt = gate[e * CAP + s]; const float* yr = ye + ((size_t)e * CAP + s) * D;
#pragma unroll
            for (int j = 0; j < 4; ++j) m[j] += gt * yr[t + 256 * j]; }
    }
    float v[4]; float ss = 0.f;
#pragma unroll
    for (int j = 0; j < 4; ++j) { const int cidx = t + 256 * j; v[j] = x1[(size_t)row * D + cidx] + g2[cidx] * m[j]; ss += v[j] * v[j]; }
    const float tot = block_sum256(ss, red);
    const float rs = 1.0f / sqrtf(tot * (1.f / D) + 1e-6f);
#pragma unroll
    for (int j = 0; j < 4; ++j) { const int cidx = t + 256 * j; out[(size_t)row * D + cidx] = v[j] * rs * fg[cidx]; }
}

struct Inputs {
    const float *x, *c, *ctx, *c_ctx, *w_mod, *b_mod, *norm1_g, *w_in, *sink, *conv_w, *wpa, *wpc, *wo, *norm2_g, *w_router, *wg, *wu, *wd, *fg;
};
struct Scratch {
    float *mod, *hx, *hc, *P, *kvc, *oat, *yc, *a, *s, *o1, *x1, *hx2, *aff, *gate, *ea, *eu, *ye; int *idx, *sel;
};
inline size_t carve(Scratch& S, char* base) {
    size_t off = 0;
    auto take = [&](size_t bytes) { char* p = base + off; off += (bytes + 255) & ~(size_t)255; return p; };
    S.mod = (float*)take(17 * 6144 * 4);
    S.hx = (float*)take((size_t)T * D * 4); S.hc = (float*)take((size_t)L * D * 4);
    S.P = (float*)take((size_t)T * INW * 4); S.kvc = (float*)take((size_t)L * 512 * 4);
    S.oat = (float*)take((size_t)T * D * 4); S.yc = (float*)take((size_t)T * D * 4);
    S.a = (float*)take((size_t)T * D * 4); S.s = (float*)take((size_t)T * D * 4); S.o1 = (float*)take((size_t)T * D * 4);
    S.x1 = (float*)take((size_t)T * D * 4); S.hx2 = (float*)take((size_t)T * D * 4);
    S.aff = (float*)take((size_t)NE * T * 4); S.gate = (float*)take(NE * CAP * 4); S.idx = (int*)take(NE * CAP * 4); S.sel = (int*)take((size_t)T * 16 * 4);
    S.ea = S.P; S.eu = S.P + (size_t)NE * CAP * D; S.ye = S.P + (size_t)2 * NE * CAP * D;
    return off;
}

inline void run_mod(const Inputs& I, const Scratch& S, hipStream_t st) { k_mod<<<dim3(24, 17), 256, 0, st>>>(I.c, I.c_ctx, I.w_mod, I.b_mod, S.mod); }
inline void s1a_norm(const Inputs& I, const Scratch& S, int b, hipStream_t st) {
    const float* mb = S.mod + b * 6144; const float* mc = S.mod + 16 * 6144;
    k_norm_mod<<<T, 256, 0, st>>>(I.x + (size_t)b * T * D, I.norm1_g, mb, mb + 1024, S.hx);
    k_norm_mod<<<L, 256, 0, st>>>(I.ctx + (size_t)b * L * D, I.norm1_g, mc, mc + 1024, S.hc);
}
inline void s1b_gemm(const Inputs& I, const Scratch& S, int b, hipStream_t st) {
    k_sgemm<<<dim3(INW / 64, T / 64, 1), 256, 0, st>>>(S.hx, D, nullptr, 0, 0, I.w_in, INW, 0, S.P, INW, 0, D);
    k_sgemm<<<dim3(512 / 64, L / 64, 1), 256, 0, st>>>(S.hc, D, nullptr, 0, 0, I.w_in + 1024, INW, 0, S.kvc, 512, 0, D);
    k_rope<<<T * 20 * 32 / 256, 256, 0, st>>>(S.P);
}
inline void s2_mix(const Inputs& I, const Scratch& S, int b, hipStream_t st) {
    k_attn<<<dim3(T, 16), 64, 0, st>>>(S.P, S.kvc, I.sink, S.oat);
    k_conv<<<T * D / 256, 256, 0, st>>>(S.P, I.conv_w, S.yc);
}
inline void s3_merge(const Inputs& I, const Scratch& S, int b, hipStream_t st) {
    k_sgemm<<<dim3(D / 64, T / 64, 1), 256, 0, st>>>(S.oat, D, nullptr, 0, 0, I.wpa, D, 0, S.a, D, 0, D);
    k_sgemm<<<dim3(D / 64, T / 64, 1), 256, 0, st>>>(S.yc, D, nullptr, 0, 0, I.wpc, D, 0, S.s, D, 0, D);
    k_merge<<<T * D / 256, 256, 0, st>>>(S.P, S.a, S.s);
}
inline void s4_out(const Inputs& I, const Scratch& S, int b, hipStream_t st) {
    k_sgemm<<<dim3(D / 64, T / 64, 1), 256, 0, st>>>(S.a, D, nullptr, 0, 0, I.wo, D, 0, S.o1, D, 0, D);
    k_resid<<<T * D / 256, 256, 0, st>>>(I.x + (size_t)b * T * D, S.mod + b * 6144 + 2048, S.o1, S.x1);
}
inline void s5_router(const Inputs& I, const Scratch& S, int b, hipStream_t st) {
    const float* mb = S.mod + b * 6144;
    k_router<<<T, 256, 0, st>>>(S.x1, I.norm2_g, mb + 3072, mb + 4096, I.w_router, S.hx2, S.aff);
}
inline void s6_topk(const Inputs& I, const Scratch& S, int b, hipStream_t st) { k_topk<<<NE, 256, 0, st>>>(S.aff, S.idx, S.gate, S.sel); }
inline void s7_up(const Inputs& I, const Scratch& S, int b, hipStream_t st) {
    k_sgemm<<<dim3(D / 64, CAP / 64, NE), 256, 0, st>>>(S.hx2, D, S.idx, 0, CAP, I.wg, D, (long)D * D, S.ea, D, (long)CAP * D, D);
    k_sgemm<<<dim3(D / 64, CAP / 64, NE), 256, 0, st>>>(S.hx2, D, S.idx, 0, CAP, I.wu, D, (long)D * D, S.eu, D, (long)CAP * D, D);
    k_silu_mul<<<NE * CAP * D / 256, 256, 0, st>>>(S.ea, S.eu);
}
inline void s8_down(const Inputs& I, const Scratch& S, int b, hipStream_t st) {
    k_sgemm<<<dim3(D / 64, CAP / 64, NE), 256, 0, st>>>(S.ea, D, nullptr, (long)CAP * D, 0, I.wd, D, (long)D * D, S.ye, D, (long)CAP * D, D);
}
inline void s9_final(const Inputs& I, const Scratch& S, int b, float* out, hipStream_t st) {
    k_combine<<<T, 256, 0, st>>>(S.x1, S.mod + b * 6144 + 5120, S.ye, S.gate, S.sel, I.fg, out + (size_t)b * T * D);
}
}
namespace hyb {
using fk::bf16_t;
__device__ __forceinline__ float bf2f(bf16_t v) { return __uint_as_float((unsigned)v << 16); }
__global__ void k_cv_bf16(const bf16_t* __restrict__ src, size_t spitch, float* __restrict__ dst, int cols, size_t n) {
    const size_t gid = (size_t)blockIdx.x * 256 + threadIdx.x; if (gid >= n) return;
    const size_t r = gid / cols; const int c = (int)(gid % cols);
    dst[gid] = bf2f(src[r * spitch + c]);
}
__global__ void k_copy_f32(const float* __restrict__ src, float* __restrict__ dst, size_t n) { const size_t gid = (size_t)blockIdx.x * 256 + threadIdx.x; if (gid < n) dst[gid] = src[gid]; }
__global__ void k_copy_i32(const int* __restrict__ src, int* __restrict__ dst, size_t n) { const size_t gid = (size_t)blockIdx.x * 256 + threadIdx.x; if (gid < n) dst[gid] = src[gid]; }
__global__ void k_fill_f32(float* __restrict__ dst, float v, size_t n) { const size_t gid = (size_t)blockIdx.x * 256 + threadIdx.x; if (gid < n) dst[gid] = v; }
__device__ __forceinline__ float logit_(float p) { return p >= 1.f ? 30.f : (p <= 0.f ? -30.f : logf(p / (1.f - p))); }
__global__ void k_cv_P(const unsigned char* __restrict__ ws, const unsigned char* __restrict__ ob, int b, float* __restrict__ Pn) {
    const size_t gid = (size_t)blockIdx.x * 256 + threadIdx.x; if (gid >= (size_t)2048 * 6656) return;
    const int t = (int)(gid / 6656), col = (int)(gid % 6656); const size_t row = (size_t)b * 2048 + t;
    float v;
    if (col < 1024) v = bf2f(((const bf16_t*)(ws + fk::WS_Q))[row * 1024 + col]) / fk::C2;
    else if (col < 1280) { const int hkv = (col - 1024) >> 6, d = col & 63; const size_t blk = (size_t)((b * 4 + hkv) * 32 + (t >> 6));
        v = bf2f(*(const bf16_t*)(ws + fk::WS_KB + blk * 8192 + (d >> 3) * 1024 + (t & 63) * 16 + (d & 7) * 2)); }
    else if (col < 1536) { const int hkv = (col - 1280) >> 6, d = col & 63; const size_t blk = (size_t)((b * 4 + hkv) * 32 + (t >> 6));
        const int kk = t & 63, s = kk >> 4, w = kk & 15, h = (w >> 2) & 1, e = w >> 3, jj = w & 3;
        v = bf2f(*(const bf16_t*)(ws + fk::WS_VB + blk * 8192 + (2 * s + h) * 1024 + d * 16 + 8 * e + 2 * jj)); }
    else if (col < 2560) v = bf2f(((const bf16_t*)(ws + fk::WS_Z))[row * 1024 + col - 1536]);
    else if (col < 3584) v = bf2f(((const bf16_t*)(ws + fk::WS_BB))[row * 1024 + col - 2560]);
    else if (col < 4608) v = 1.f;
    else { const int ch = col < 5632 ? col - 4608 : col - 5632;
        const float r = bf2f(((const bf16_t*)(ob + fk::OB_RB))[row * 1024 + ch]), sg = bf2f(((const bf16_t*)(ob + fk::OB_SGC))[row * 1024 + ch]);
        v = col < 5632 ? logit_(r * sg) : logit_(sg); }
    Pn[gid] = v;
}
__global__ void k_cv_kvc(const unsigned char* __restrict__ ws, int b, float* __restrict__ kvc) {
    const int gid = blockIdx.x * 256 + threadIdx.x; if (gid >= 256 * 512) return;
    const int l = gid >> 9, col = gid & 511;
    if (col < 256) { const int hkv = col >> 6, d = col & 63; const size_t blk = (size_t)((b * 4 + hkv) * 4 + (l >> 6));
        kvc[gid] = bf2f(*(const bf16_t*)(ws + fk::WS_KCB + blk * 8192 + (d >> 3) * 1024 + (l & 63) * 16 + (d & 7) * 2)); }
    else { const int hkv = (col - 256) >> 6, d = col & 63; const size_t blk = (size_t)((b * 4 + hkv) * 4 + (l >> 6));
        const int kk = l & 63, s = kk >> 4, w = kk & 15, h = (w >> 2) & 1, e = w >> 3, jj = w & 3;
        kvc[gid] = bf2f(*(const bf16_t*)(ws + fk::WS_VCB + blk * 8192 + (2 * s + h) * 1024 + d * 16 + 8 * e + 2 * jj)); }
}
inline unsigned nblk(size_t n) { return (unsigned)((n + 255) / 256); }

inline void run(fk::Params p, void* const* d_in, float* out, char* nbase, size_t nbytes, hipStream_t st) {
    nv::Inputs I; const float** ip = (const float**)&I; for (int i = 0; i < 19; ++i) ip[i] = (const float*)d_in[i];
    nv::Scratch S; const size_t need = nv::carve(S, nbase);
    if (need > nbytes) { fprintf(stderr, "hybrid: scratch too small %zu > %zu\n", need, nbytes); return; }
    constexpr int X = HYB;
    if (X >= 10) { fk_launch(p, 0, fk::NPHASE, st); }
    else { fk_launch(p, 0, X + 1, st); }
    nv::run_mod(I, S, st);
    const unsigned char* ws = p.ws; const unsigned char* ob = p.ob;
    constexpr size_t TD = (size_t)2048 * 1024;
    for (int b = 0; b < 16; ++b) {
        const bool fast = b < fk::NBF;
        if (b == fk::NBF && X == 0) nv::run_mod(I, S, st);
        int from = 0;
        if (fast) {
            const size_t r0 = (size_t)b * 2048;
            if (X == 0) { k_copy_f32<<<nblk(17 * 6144), 256, 0, st>>>((const float*)(ws + fk::WS_MOD), S.mod, 17 * 6144); from = 0; }
            else if (X == 1) { k_cv_bf16<<<nblk(TD), 256, 0, st>>>((const bf16_t*)(ws + fk::WS_HX) + r0 * 1024, 1024, S.hx, 1024, TD);
                k_cv_bf16<<<nblk(256 * 1024), 256, 0, st>>>((const bf16_t*)(ws + fk::WS_HX) + ((size_t)fk::M + (size_t)b * 256) * 1024, 1024, S.hc, 1024, (size_t)256 * 1024); from = 1; }
            else if (X == 2 || X == 3) { k_cv_P<<<nblk((size_t)2048 * 6656), 256, 0, st>>>(ws, ob, b, S.P); k_cv_kvc<<<512, 256, 0, st>>>(ws, b, S.kvc); from = 2;
                if (X == 3) { k_cv_bf16<<<nblk(TD), 256, 0, st>>>((const bf16_t*)(ws + fk::WS_AO) + r0 * 2048, 2048, S.oat, 1024, TD);
                    k_cv_bf16<<<nblk(TD), 256, 0, st>>>((const bf16_t*)(ws + fk::WS_AO) + r0 * 2048 + 1024, 2048, S.yc, 1024, TD); from = 3; } }
            else if (X == 4) { k_cv_bf16<<<nblk(TD), 256, 0, st>>>((const bf16_t*)(ws + fk::WS_MB) + r0 * 1024, 1024, S.a, 1024, TD); from = 4; }
            else {
                k_cv_bf16<<<nblk(TD), 256, 0, st>>>((const bf16_t*)(ws + fk::WS_DL) + r0 * 1024, 1024, S.o1, 1024, TD); nv::k_resid<<<nblk(TD), 256, 0, st>>>(I.x + r0 * 1024, S.one, S.o1, S.x1); from = 5;
                if (X >= 6) { k_cv_bf16<<<nblk(TD), 256, 0, st>>>((const bf16_t*)(ws + fk::WS_HX2) + r0 * 1024, 1024, S.hx2, 1024, TD);
                    k_copy_f32<<<nblk(16 * 2048), 256, 0, st>>>((const float*)(ws + fk::WS_AFF) + (size_t)b * 16 * 2048, S.aff, 16 * 2048); from = 6; }
                if (X >= 7) { k_copy_i32<<<nblk(16 * 256), 256, 0, st>>>((const int*)(ws + fk::WS_IDX) + b * 16 * 256, S.idx, 16 * 256);
                    k_copy_f32<<<nblk(16 * 256), 256, 0, st>>>((const float*)(ws + fk::WS_GATE) + b * 16 * 256, S.gate, 16 * 256);
                    k_copy_i32<<<nblk(2048 * 16), 256, 0, st>>>((const int*)(ws + fk::WS_SEL) + r0 * 16, S.sel, 2048 * 16); from = 7; }
                if (X >= 8) { k_cv_bf16<<<nblk((size_t)4096 * 1024), 256, 0, st>>>((const bf16_t*)(ob + fk::OB_HB) + (size_t)b * 4096 * 1024, 1024, S.ea, 1024, (size_t)4096 * 1024); from = 8; }
                if (X >= 9) { k_cv_bf16<<<nblk((size_t)4096 * 1024), 256, 0, st>>>((const bf16_t*)(ws + fk::WS_YE) + (size_t)b * 4096 * 1024, 1024, S.ye, 1024, (size_t)4096 * 1024);
                    k_fill_f32<<<nblk(16 * 256), 256, 0, st>>>(S.gate, 1.f, 16 * 256); from = 9; }
                if (X >= 10) from = 10;
            }
        }
        if (from <= 0) nv::s1a_norm(I, S, b, st);
        if (from <= 1) nv::s1b_gemm(I, S, b, st);
        if (from <= 2) nv::s2_mix(I, S, b, st);
        if (from <= 3) nv::s3_merge(I, S, b, st);
        if (from <= 4) nv::s4_out(I, S, b, st);
        if (from <= 5) nv::s5_router(I, S, b, st);
        if (from <= 6) nv::s6_topk(I, S, b, st);
        if (from <= 7) nv::s7_up(I, S, b, st);
        if (from <= 8) nv::s8_down(I, S, b, st);
        if (from <= 9) nv::s9_final(I, S, b, out, st);
    }
}
}
#endif

static int fk_grid = 0;
static bool fk_setup() {
    if (fk_grid) return fk_grid > 0;
    int dev = 0, cus = 0, per_cu = 0;
    if (hipGetDevice(&dev) != hipSuccess || hipDeviceGetAttribute(&cus, hipDeviceAttributeMultiprocessorCount, dev) != hipSuccess) { fk_grid = -1; return false; }
    if (hipFuncSetAttribute((const void*)fk::mega, hipFuncAttributeMaxDynamicSharedMemorySize, fk::LDS_BYTES) != hipSuccess) { fprintf(stderr, "kernel_launch: hipFuncSetAttribute failed\n"); fk_grid = -1; return false; }
    if (hipOccupancyMaxActiveBlocksPerMultiprocessor(&per_cu, (const void*)fk::mega, 512, fk::LDS_BYTES) != hipSuccess || per_cu < 1) { fprintf(stderr, "kernel_launch: occupancy query says %d\n", per_cu); fk_grid = -1; return false; }
    fk_grid = cus * per_cu;
    return true;
}
static void fk_launch(fk::Params p, int lo, int hi, hipStream_t stream) {
    p.ph_lo = lo; p.ph_hi = hi;
    if (hipMemsetAsync(p.ws + fk::WS_CTL, 0, fk::CTL_ZERO_BYTES, stream) != hipSuccess) { fprintf(stderr, "kernel_launch: memset failed\n"); return; }
    void* args[] = {&p};
    hipError_t e = hipLaunchCooperativeKernel((const void*)fk::mega, dim3(fk_grid), dim3(512), args, fk::LDS_BYTES, stream);
    if (e != hipSuccess) fprintf(stderr, "kernel_launch: cooperative launch failed: %s (grid %d)\n", hipGetErrorString(e), fk_grid);
}

extern "C" void kernel_launch(void* const* d_in, const int* in_sizes, int n_in, void* d_out, int out_size, void* d_ws, size_t ws_size, hipStream_t stream) {
    if (n_in != 19 || !fk_setup()) { fprintf(stderr, "kernel_launch: bad setup (n_in %d)\n", n_in); return; }
    fk::Params p{};
    const float** ip = (const float**)&p;
    for (int i = 0; i < 19; ++i) ip[i] = (const float*)d_in[i];
    p.out = (float*)d_out; p.ws = (unsigned char*)d_ws;
#if HYB < 0
    if (ws_size < fk::R_END) { fprintf(stderr, "kernel_launch: workspace too small: %zu < %zu\n", ws_size, (size_t)fk::R_END); return; }
    p.ob = (unsigned char*)d_out;
    fk_launch(p, 0, fk::NPHASE, stream);
#else
    p.ob = (unsigned char*)d_ws + fk::R_END;
    hyb::run(p, d_in, (float*)d_out, (char*)d_ws + fk::R_END + fk::OB_BYTES, ws_size - fk::R_END - fk::OB_BYTES, stream);
#endif
}
```

```cpp
#include <hip/hip_runtime.h>
#include <hip/hip_cooperative_groups.h>
#include <cstdio>
#include <cstdint>
#ifndef HYB
#define HYB -1
#endif
#if HYB >= 0
#define FK_NBF 8
#endif
namespace g8 {
#define G8_LAS __attribute__((address_space(3)))
typedef unsigned short bf16_t;
typedef short bf16x8 __attribute__((ext_vector_type(8)));
typedef float f32x4 __attribute__((ext_vector_type(4)));
typedef float f32x2 __attribute__((ext_vector_type(2)));
typedef unsigned u32x4 __attribute__((ext_vector_type(4)));
typedef unsigned u32x2 __attribute__((ext_vector_type(2)));
constexpr int BM = 256, BK = 64, HALF = 128, HTB = HALF * BK * 2, STAGE_BYTES = 8 * HTB;

__host__ __device__ __forceinline__ int lds_byte(int r, int c) { const int st = (r >> 4) * 2 + (c >> 5), rr = r & 15, cc = c & 31, ob = rr * 64 + cc * 2; return st * 1024 + (ob ^ (((ob >> 9) & 1) << 5)); }
__host__ __device__ __forceinline__ void stage_rc(int b, int& R, int& C) { const int st = b / 1024, sb = b % 1024, swz = sb ^ (((sb >> 9) & 1) << 5); R = (st >> 1) * 16 + swz / 64; C = (st & 1) * 32 + (swz % 64) / 2; }
__host__ __device__ __forceinline__ int perm32(int rho) { const int n = rho >> 4, i = rho & 15; return 8 * (i >> 2) + 4 * n + (i & 3); }
__host__ __device__ __forceinline__ int pinv32(int x) { return 16 * ((x >> 2) & 1) + 4 * (x >> 3) + (x & 3); }

struct Unit { const char* a; const char* b; const int* rows; int kind; int pm; int pn; int aux; };

__device__ __forceinline__ unsigned cvt_pk_bf16(float lo, float hi) { unsigned r; asm volatile("v_cvt_pk_bf16_f32 %0, %1, %2" : "=v"(r) : "v"(lo), "v"(hi)); return r; }
__device__ __forceinline__ float bf_lo(unsigned w) { return __uint_as_float(w << 16); }
__device__ __forceinline__ float bf_hi(unsigned w) { return __uint_as_float(w & 0xffff0000u); }

template <class Epi, class Sched, bool HAS_MID, bool GATHER = false, int KREP = 1>
__device__ __forceinline__ void gemm_phase(G8_LAS unsigned char* lds, const int K, const Sched& S, const Epi& E) {
    const int tid = threadIdx.x, wid = __builtin_amdgcn_readfirstlane(tid >> 6), lane = tid & 63, wr = wid >> 2, wc = wid & 3, fr = lane & 15, fq = lane >> 4;
    const int nt = K / BK;
    unsigned voff[2];
#pragma unroll
    for (int i = 0; i < 2; ++i) { int R, C; stage_rc(tid * 16 + i * 8192, R, C); voff[i] = (unsigned)(R * K + C) * 2u; }
    const size_t kstep = (size_t)(BK * 2);
    const size_t hstep = (size_t)HALF * K * 2;
    const unsigned ldsw = (unsigned)wid * 1024u;
    const int aoff = lds_byte(wr * 64 + fr, fq * 8), boff = lds_byte(wc * 32 + fr, fq * 8);
#define G8_SA(b, h) (((b) * 2 + (h)) * HTB)
#define G8_SB(b, h) ((4 + (b) * 2 + (h)) * HTB)
#define G8_STAGE(bufoff, gbase) do { _Pragma("unroll") for (int _i = 0; _i < 2; ++_i) \
        __builtin_amdgcn_global_load_lds((const unsigned*)((const char*)(gbase) + voff[_i]), (G8_LAS unsigned*)(lds + (bufoff) + ldsw + _i * 8192), 16, 0, 0); } while (0)
#define G8_STAGE_V(bufoff, gbase, vv) do { _Pragma("unroll") for (int _i = 0; _i < 2; ++_i) \
        __builtin_amdgcn_global_load_lds((const unsigned*)((const char*)(gbase) + (vv)[_i]), (G8_LAS unsigned*)(lds + (bufoff) + ldsw + _i * 8192), 16, 0, 0); } while (0)
#define G8_STAGE_A(bufoff, gbase, h) do { if constexpr (GATHER) G8_STAGE_V(bufoff, gbase, va[h]); else G8_STAGE(bufoff, (gbase) + (h) * hstep); } while (0)
#define G8_LDA(dst, b, h) do { _Pragma("unroll") for (int m = 0; m < 4; ++m) _Pragma("unroll") for (int k = 0; k < 2; ++k) dst[m][k] = *(const G8_LAS bf16x8*)(lds + G8_SA(b, h) + aoff + m * 2048 + k * 1024); } while (0)
#define G8_LDB(dst, b, h) do { _Pragma("unroll") for (int n = 0; n < 2; ++n) _Pragma("unroll") for (int k = 0; k < 2; ++k) dst[n][k] = *(const G8_LAS bf16x8*)(lds + G8_SB(b, h) + boff + n * 2048 + k * 1024); } while (0)
#define G8_MMA(ai, bj, At, Bt) do { __builtin_amdgcn_s_setprio(1); _Pragma("unroll") for (int m = 0; m < 4; ++m) _Pragma("unroll") for (int n = 0; n < 2; ++n) _Pragma("unroll") for (int k = 0; k < 2; ++k) \
        acc[ai][bj][m][n] = __builtin_amdgcn_mfma_f32_16x16x32_bf16(Bt[n][k], At[m][k], acc[ai][bj][m][n], 0, 0, 0); __builtin_amdgcn_s_setprio(0); } while (0)
#define G8_WAIT_V(n) asm volatile("s_waitcnt vmcnt(" #n ")" ::: "memory")
#define G8_WAIT_L(n) asm volatile("s_waitcnt lgkmcnt(" #n ")" ::: "memory")
#define G8_BAR __builtin_amdgcn_s_barrier()
#define G8_SCHED __builtin_amdgcn_sched_barrier(0)
    Unit cur, nxt; int ui = 0;
    if (!S.next(0, cur)) return;
    f32x4 acc[2][2][4][2];
#pragma unroll
    for (int a = 0; a < 2; ++a)
#pragma unroll
        for (int b = 0; b < 2; ++b)
#pragma unroll
            for (int m = 0; m < 4; ++m)
#pragma unroll
                for (int n = 0; n < 2; ++n) acc[a][b][m][n] = (f32x4){0.f, 0.f, 0.f, 0.f};
    bf16x8 At[4][2], B0[2][2], B1[2][2];
    const char* cA = cur.a; const char* cB = cur.b;
    unsigned va[2][2], vn[2][2];
    int gR[2], gC[2];
#pragma unroll
    for (int i = 0; i < 2; ++i) stage_rc(tid * 16 + i * 8192, gR[i], gC[i]);
    if constexpr (GATHER) {
#pragma unroll
        for (int h = 0; h < 2; ++h)
#pragma unroll
            for (int i = 0; i < 2; ++i) { va[h][i] = (unsigned)(cur.rows[128 * h + gR[i]] * K + gC[i]) * 2u; vn[h][i] = va[h][i]; }
    }
    G8_STAGE(G8_SB(0, 0), cB); G8_STAGE(G8_SB(0, 1), cB + hstep); G8_STAGE_A(G8_SA(0, 0), cA, 0); G8_STAGE_A(G8_SA(0, 1), cA, 1);
    if (wr == 1) G8_BAR;
    G8_WAIT_V(2); G8_BAR;
    G8_STAGE(G8_SB(1, 0), cB + kstep); G8_STAGE_A(G8_SA(1, 0), cA + kstep, 0); G8_STAGE(G8_SB(1, 1), cB + hstep + kstep);
    G8_WAIT_V(6); G8_BAR;
    for (;;) {
        const bool has_next = S.next(ui + 1, nxt);
        const char* nA = has_next ? nxt.a : cA; const char* nB = has_next ? nxt.b : cB;
        if constexpr (GATHER) { if (has_next) {
#pragma unroll
            for (int h = 0; h < 2; ++h)
#pragma unroll
                for (int i = 0; i < 2; ++i) vn[h][i] = (unsigned)(nxt.rows[128 * h + gR[i]] * K + gC[i]) * 2u; } }
        constexpr int KR = (KREP == 3) ? 1 : KREP;
        for (int tt = 0; tt < KR * nt; tt += 2) {
            const bool last = (tt == KR * nt - 2);
            const int t = (KREP == 1 || KREP == 3) ? tt : (tt >= nt ? tt - nt : tt);
            const char* a1 = cA + (size_t)(t + 1) * kstep;
            const int t2 = (KR > 1 && t + 2 >= nt) ? 0 : t + 2;
            const char* a2 = last ? nA : cA + (size_t)t2 * kstep; const char* b2 = last ? nB : cB + (size_t)t2 * kstep;
            const char* a3 = a2 + kstep; const char* b3 = b2 + kstep;
            if constexpr (HAS_MID) { if (t == (nt >> 1)) E.mid(acc, cur, wr, wc, fr, fq); }
            G8_LDB(B0, 0, 0); G8_LDB(B1, 0, 1); G8_SCHED; G8_LDA(At, 0, 0); G8_STAGE_A(G8_SA(1, 1), a1, 1);
            if constexpr (GATHER) { if (last) { va[0][0] = vn[0][0]; va[0][1] = vn[0][1]; va[1][0] = vn[1][0]; va[1][1] = vn[1][1]; } }
            G8_WAIT_V(8); G8_WAIT_L(0); G8_BAR; G8_MMA(0, 0, At, B0); G8_MMA(0, 1, At, B1); G8_BAR; G8_SCHED;
            G8_LDA(At, 0, 1); G8_STAGE(G8_SB(0, 0), b2); G8_STAGE(G8_SB(0, 1), b2 + hstep); G8_STAGE_A(G8_SA(0, 0), a2, 0);
            G8_WAIT_V(8); G8_WAIT_L(0); G8_BAR; G8_MMA(1, 0, At, B0); G8_MMA(1, 1, At, B1); G8_BAR; G8_SCHED;
            G8_LDB(B0, 1, 0); G8_LDB(B1, 1, 1); G8_SCHED; G8_LDA(At, 1, 0); G8_STAGE_A(G8_SA(0, 1), a2, 1);
            G8_WAIT_V(8); G8_WAIT_L(0); G8_BAR; G8_MMA(0, 0, At, B0); G8_MMA(0, 1, At, B1); G8_BAR; G8_SCHED;
            G8_LDA(At, 1, 1); G8_STAGE(G8_SB(1, 0), b3); G8_STAGE(G8_SB(1, 1), b3 + hstep); G8_STAGE_A(G8_SA(1, 0), a3, 0);
            G8_WAIT_V(8); G8_WAIT_L(0); G8_BAR; G8_MMA(1, 0, At, B0); G8_MMA(1, 1, At, B1); G8_BAR; G8_SCHED;
        }
        if (wr == 0) G8_BAR;
        if constexpr (KR > 1) {
#pragma unroll
            for (int a = 0; a < 2; ++a)
#pragma unroll
                for (int b = 0; b < 2; ++b)
#pragma unroll
                    for (int m = 0; m < 4; ++m)
#pragma unroll
                        for (int n = 0; n < 2; ++n) acc[a][b][m][n] *= (1.0f / KR);
        }
        E(acc, cur, wr, wc, fr, fq);
#ifdef FK_EPI2_PROBE
        if constexpr (KREP == 3) { asm volatile("" ::: "memory"); E(acc, cur, wr, wc, fr, fq); }
#endif
        if (!has_next) break;
#pragma unroll
        for (int a = 0; a < 2; ++a)
#pragma unroll
            for (int b = 0; b < 2; ++b)
#pragma unroll
                for (int m = 0; m < 4; ++m)
#pragma unroll
                    for (int n = 0; n < 2; ++n) acc[a][b][m][n] = (f32x4){0.f, 0.f, 0.f, 0.f};
        cur = nxt; cA = nA; cB = nB; ++ui;
        if (wr == 1) G8_BAR;
    }
    G8_WAIT_V(0);
    G8_BAR;
#undef G8_SA
#undef G8_SB
#undef G8_STAGE
#undef G8_LDA
#undef G8_STAGE_V
#undef G8_STAGE_A
#undef G8_LDB
#undef G8_MMA
#undef G8_WAIT_V
#undef G8_WAIT_L
#undef G8_BAR
#undef G8_SCHED
}
}
namespace fk {
using namespace g8;
namespace cg = cooperative_groups;
#define LAS G8_LAS
#ifndef FK_NBF
#define FK_NBF 16
#endif
#ifndef FK_DBL
#define FK_DBL 0
#endif
constexpr int NBF = FK_NBF;
constexpr int D = 1024, T = 2048, LC = 256, NE = 16, CAP = 256;
constexpr int M = NBF * T, MC = NBF * LC, MA = M + MC;
constexpr int NT_IN = 25;
constexpr float LOG2E = 1.4426950408889634f;
constexpr float C2 = 0.125f * LOG2E;
typedef float f32x16 __attribute__((ext_vector_type(16)));

constexpr size_t MiB = (size_t)1 << 20;
constexpr size_t SC = (size_t)NBF << 16;
constexpr size_t WS_CTL = 0, WS_MOD = 1 * MiB, WS_ROPE = 1 * MiB + 512 * 1024, WS_IDX = 2 * MiB, WS_GATE = 2 * MiB + 256 * 1024,
                 WS_AFF = 2 * MiB + 512 * 1024, WS_SEL = 5 * MiB;
constexpr size_t WS_WIN = 8 * MiB, WS_WV = WS_WIN + (size_t)6400 * 2048, WS_WP = 21 * MiB, WS_WO = 25 * MiB, WS_WGU = 27 * MiB, WS_WD = 91 * MiB;
constexpr size_t R0 = 124 * MiB;
constexpr size_t WS_Q = R0, WS_KB = R0 + 64 * SC, WS_KCB = R0 + 80 * SC, WS_VB = R0 + 82 * SC, WS_VCB = R0 + 98 * SC, WS_Z = R0 + 100 * SC, WS_BB = R0 + 164 * SC,
                 WS_AO = R0 + 228 * SC, WS_HX = R0 + 284 * SC, WS_MB = R0, WS_DL = R0 + 64 * SC, WS_HX2 = R0, WS_XE = R0 + 192 * SC, WS_YE = R0 + 192 * SC;
constexpr size_t R_END = R0 + 356 * SC;
constexpr size_t OB_RB = 0, OB_SGC = 64 * SC, OB_HB = 0, OB_BYTES = 128 * SC;

constexpr int LDS_BYTES = 147456;
constexpr int LDS_MISC = 140 * 1024;
constexpr int LDS_MISC_Q = 140 * 1024 + 64;

struct Params {
    const float *x, *c, *ctx, *c_ctx, *w_mod, *b_mod, *norm1_g, *w_in, *sink, *conv_w, *wpa, *wpc, *wo, *norm2_g, *w_router, *wg, *wu, *wd, *fg;
    float* out; unsigned char* ws; unsigned char* ob;
    int ph_lo, ph_hi;
};

__device__ __forceinline__ float wave_sum(float v) {
#pragma unroll
    for (int o = 1; o < 64; o <<= 1) v += __shfl_xor(v, o);
    return v;
}
__device__ __forceinline__ unsigned f2bf(float f) { unsigned u = __builtin_bit_cast(unsigned, f); return (u + 0x7fffu + ((u >> 16) & 1u)) >> 16; }
__device__ __forceinline__ unsigned pk2(float lo, float hi) { return f2bf(lo) | (f2bf(hi) << 16); }
__device__ __forceinline__ void bf8_to_f32(const u32x4 w, f32x4& lo, f32x4& hi4) { lo = (f32x4){bf_lo(w.x), bf_hi(w.x), bf_lo(w.y), bf_hi(w.y)}; hi4 = (f32x4){bf_lo(w.z), bf_hi(w.z), bf_lo(w.w), bf_hi(w.w)}; }
__device__ __forceinline__ u32x4 f32_to_bf8(const f32x4 a, const f32x4 b) { u32x4 w; w.x = pk2(a.x, a.y); w.y = pk2(a.z, a.w); w.z = pk2(b.x, b.y); w.w = pk2(b.z, b.w); return w; }
__device__ __forceinline__ float sq4(const f32x4 v) { return (v.x * v.x + v.y * v.y) + (v.z * v.z + v.w * v.w); }
__device__ __forceinline__ float dot4(const f32x4 a, const f32x4 b) { return (a.x * b.x + a.y * b.y) + (a.z * b.z + a.w * b.w); }
__device__ __forceinline__ float sigmoidf_(float v) { return 1.f / (1.f + __expf(-v)); }

__device__ __forceinline__ void transpose_item64(const float* __restrict__ W, int N, int k0, int n0, bf16_t* __restrict__ dst, int pitch, bool perm, int lane) {
    const float* src = W + (size_t)k0 * N + n0 + lane;
    const int dr = perm ? ((lane & 32) + pinv32(lane & 31)) : lane;
    bf16_t* drow = dst + (size_t)dr * pitch + k0;
#pragma unroll
    for (int h = 0; h < 2; ++h) {
        float v[32];
#pragma unroll
        for (int j = 0; j < 32; ++j) v[j] = src[(size_t)(32 * h + j) * N];
#pragma unroll
        for (int c = 0; c < 4; ++c) { u32x4 o; o.x = pk2(v[8 * c], v[8 * c + 1]); o.y = pk2(v[8 * c + 2], v[8 * c + 3]); o.z = pk2(v[8 * c + 4], v[8 * c + 5]); o.w = pk2(v[8 * c + 6], v[8 * c + 7]);
            *(u32x4*)(drow + 32 * h + 8 * c) = o; }
    }
}

constexpr int CV_IN = 16 * 104, CV_SQ = 256, CV_TOTAL = CV_IN + 3 * CV_SQ + 48 * CV_SQ;
__device__ __forceinline__ void conv_item(const Params& P, int it, int lane) {
    bf16_t* WIN = (bf16_t*)(P.ws + WS_WIN); bf16_t* WV = (bf16_t*)(P.ws + WS_WV); bf16_t* WP = (bf16_t*)(P.ws + WS_WP); bf16_t* WO = (bf16_t*)(P.ws + WS_WO);
    bf16_t* WGU = (bf16_t*)(P.ws + WS_WGU); bf16_t* WD = (bf16_t*)(P.ws + WS_WD);
    int r = it;
    if (r < CV_IN) {
        const int kb = r / 104, nb = r % 104, k0 = 64 * kb, n0 = 64 * nb;
        bf16_t* dst; bool perm = true;
        if (n0 < 1280) { dst = WIN + (size_t)n0 * 1024; perm = false; }
        else if (n0 < 1536) { dst = WV + (size_t)(n0 - 1280) * 1024; perm = false; }
        else if (n0 < 2560) { const int ch = n0 - 1536; dst = WIN + (size_t)(1280 + (ch >> 7) * 256 + (ch & 127)) * 1024; }
        else if (n0 < 3584) { dst = WIN + (size_t)(3328 + (n0 - 2560)) * 1024; }
        else if (n0 < 4608) { const int ch = n0 - 3584; dst = WIN + (size_t)(1280 + (ch >> 7) * 256 + 128 + (ch & 127)) * 1024; }
        else if (n0 < 5632) { const int ch = n0 - 4608; dst = WIN + (size_t)(4352 + (ch >> 7) * 256 + (ch & 127)) * 1024; }
        else { const int ch = n0 - 5632; dst = WIN + (size_t)(4352 + (ch >> 7) * 256 + 128 + (ch & 127)) * 1024; }
        transpose_item64(P.w_in, 6656, k0, n0, dst, 1024, perm, lane);
        return;
    }
    r -= CV_IN;
    const int mat = r / CV_SQ, q = r % CV_SQ, kb = q / 16, nb = q % 16, k0 = 64 * kb, n0 = 64 * nb;
    if (mat == 0) transpose_item64(P.wpa, 1024, k0, n0, WP + (size_t)n0 * 2048, 2048, true, lane);
    else if (mat == 1) transpose_item64(P.wpc, 1024, k0, n0, WP + (size_t)n0 * 2048 + 1024, 2048, true, lane);
    else if (mat == 2) transpose_item64(P.wo, 1024, k0, n0, WO + (size_t)n0 * 1024, 1024, true, lane);
    else {
        const int m2 = mat - 3, kind = m2 >> 4, e = m2 & 15;
        if (kind == 0) transpose_item64(P.wg + (size_t)e * 1048576, 1024, k0, n0, WGU + ((size_t)e * 2048 + (n0 >> 7) * 256 + (n0 & 127)) * 1024, 1024, true, lane);
        else if (kind == 1) transpose_item64(P.wu + (size_t)e * 1048576, 1024, k0, n0, WGU + ((size_t)e * 2048 + (n0 >> 7) * 256 + 128 + (n0 & 127)) * 1024, 1024, true, lane);
        else transpose_item64(P.wd + (size_t)e * 1048576, 1024, k0, n0, WD + ((size_t)e * 1024 + n0) * 1024, 1024, true, lane);
    }
}

__device__ __forceinline__ void ph_prep(const Params& P, LAS unsigned char* lds) {
    const int tid = threadIdx.x, lane = tid & 63, wave = __builtin_amdgcn_readfirstlane(tid >> 6);
    const int G = gridDim.x, wg = blockIdx.x;
    float* mod = (float*)(P.ws + WS_MOD);
    if (wg < 96) {
        LAS float* sl = (LAS float*)lds;
        LAS float* red = (LAS float*)(lds + 17 * 1024 * 4);
        for (int i = tid; i < 17 * 1024; i += 512) { const int r = i >> 10, k = i & 1023; const float v = r < 16 ? P.c[r * 1024 + k] : P.c_ctx[k]; sl[i] = v / (1.f + __expf(-v)); }
        __syncthreads();
        const int col = tid & 63, kg = wave, n = wg * 64 + col;
        float acc[17];
#pragma unroll
        for (int r = 0; r < 17; ++r) acc[r] = 0.f;
        for (int kb = kg * 128; kb < kg * 128 + 128; kb += 16) {
            float w[16];
#pragma unroll
            for (int j = 0; j < 16; ++j) w[j] = P.w_mod[(size_t)(kb + j) * 6144 + n];
#pragma unroll
            for (int j = 0; j < 16; ++j)
#pragma unroll
                for (int r = 0; r < 17; ++r) acc[r] += sl[r * 1024 + kb + j] * w[j]; }
#pragma unroll
        for (int r = 0; r < 17; ++r) red[(kg * 17 + r) * 64 + col] = acc[r];
        __syncthreads();
        for (int i = tid; i < 17 * 64; i += 512) { const int r = i >> 6, cc = i & 63; float s = 0.f;
#pragma unroll
            for (int g = 0; g < 8; ++g) s += red[(g * 17 + r) * 64 + cc];
            mod[r * 6144 + wg * 64 + cc] = s + P.b_mod[wg * 64 + cc]; }
        __syncthreads();
    } else if (wg == 96) {
        float2* rope = (float2*)(P.ws + WS_ROPE);
        for (int i = tid; i < 64 * 16; i += 512) { const int pos = i >> 4, f = i & 15; const float ang = (float)pos * powf(10000.f, -(float)f / 16.f); rope[i] = make_float2(cosf(ang), sinf(ang)); }
    }
    constexpr int I_IN = 16 * 104;
    if (wg >= 96) { for (int it = (wg - 96) * 8 + wave; it < 1280; it += (G - 96) * 8) conv_item(P, it, lane); }
    else { for (int it = 1280 + wg * 8 + wave; it < I_IN; it += 96 * 8) conv_item(P, it, lane); }
}

template <int NR>
__device__ __forceinline__ void norm1_rows(const Params& P, int row0, int lane) {
    const float* mod = (const float*)(P.ws + WS_MOD);
    bf16_t* HX = (bf16_t*)(P.ws + WS_HX);
    const float* xr; const float* mv;
    if (row0 < M) { xr = P.x + (size_t)row0 * D; mv = mod + (row0 >> 11) * 6144; } else { xr = P.ctx + (size_t)(row0 - M) * D; mv = mod + 16 * 6144; }
    f32x4 v[NR][4];
#pragma unroll
    for (int r = 0; r < NR; ++r)
#pragma unroll
        for (int j = 0; j < 2; ++j) { v[r][2 * j] = *(const f32x4*)(xr + (size_t)r * D + 8 * lane + 512 * j); v[r][2 * j + 1] = *(const f32x4*)(xr + (size_t)r * D + 8 * lane + 512 * j + 4); }
    float rs[NR];
#pragma unroll
    for (int r = 0; r < NR; ++r) { const float ss = (sq4(v[r][0]) + sq4(v[r][1])) + (sq4(v[r][2]) + sq4(v[r][3])); rs[r] = 1.0f / sqrtf(wave_sum(ss) * (1.f / D) + 1e-6f); }
#pragma unroll
    for (int j = 0; j < 2; ++j) { const int c0 = 8 * lane + 512 * j;
        const f32x4 g0 = *(const f32x4*)(P.norm1_g + c0) * (*(const f32x4*)(mv + 1024 + c0) + 1.0f), g1 = *(const f32x4*)(P.norm1_g + c0 + 4) * (*(const f32x4*)(mv + 1024 + c0 + 4) + 1.0f);
        const f32x4 sh0 = *(const f32x4*)(mv + c0), sh1 = *(const f32x4*)(mv + c0 + 4);
#pragma unroll
        for (int r = 0; r < NR; ++r) *(u32x4*)(HX + (size_t)(row0 + r) * D + c0) = f32_to_bf8(v[r][2 * j] * rs[r] * g0 + sh0, v[r][2 * j + 1] * rs[r] * g1 + sh1); }
}
enum { KD_Q = 0, KD_K = 1, KD_KC = 2, KD_VT = 3, KD_VTC = 4, KD_UC = 5, KD_BC = 6, KD_GG = 7 };
struct InprojSched {
    int G, c; const char *hx, *win, *wv;
    static constexpr int NMAIN = (M / 256) * NT_IN, NVT = M / 256, NC = MC / 256, NTOT = NMAIN + NVT;
    __device__ __forceinline__ bool next(int i, Unit& u) const {
        const int Lx = i * G + c; if (Lx >= NTOT) return false;
        constexpr size_t TS = (size_t)256 * 1024 * 2;
        if (Lx < NMAIN) {
            const int wgid = (Lx % 8) * (NMAIN / 8) + Lx / 8;
            constexpr int nig = 8 * NT_IN; const int gid = wgid / nig, w = wgid % nig;
            u.pm = gid * 8 + (w % 8); u.pn = w / 8;
            u.a = hx + (size_t)u.pm * TS; u.b = win + (size_t)u.pn * TS;
            u.kind = u.pn < 4 ? KD_Q : u.pn == 4 ? KD_K : u.pn < 13 ? KD_UC : u.pn < 17 ? KD_BC : KD_GG; u.aux = 0; u.rows = nullptr;
        } else {
            const int xq = Lx - NMAIN;
            u.kind = KD_VT; u.pm = 0; u.pn = xq; u.a = wv; u.b = hx + (size_t)xq * TS;
            u.aux = 0; u.rows = nullptr;
        }
        return true;
    }
};
struct CtxSched {
    int c; const char *hx, *win, *wv;
    __device__ __forceinline__ bool next(int i, Unit& u) const {
        if (i != 0) return false;
        constexpr size_t TS = (size_t)256 * 1024 * 2; constexpr int NC = MC / 256;
        if (c < NC) { u.kind = KD_KC; u.pm = M / 256 + c; u.pn = 4; u.a = hx + (size_t)u.pm * TS; u.b = win + (size_t)4 * TS; }
        else { u.kind = KD_VTC; u.pm = 0; u.pn = c - NC; u.a = wv; u.b = hx + (size_t)(M / 256 + u.pn) * TS; }
        u.aux = 0; u.rows = nullptr; return true;
    }
};
struct EpiInproj {
    bf16_t *q, *z, *bb, *rb, *sgc; unsigned char *kb, *kcb, *vb, *vcb; const float* rope;
    __device__ __forceinline__ void operator()(const f32x4 (&acc)[2][2][4][2], const Unit& u, int wr, int wc, int fr, int fq) const {
        const int kind = u.kind;
        if (kind == KD_Q || kind == KD_K) {
#pragma unroll
            for (int ai = 0; ai < 2; ++ai)
#pragma unroll
                for (int m = 0; m < 4; ++m) {
                    const int r = u.pm * 256 + 128 * ai + 64 * wr + 16 * m + fr, t = r & 2047, b = r >> 11;
                    const int pos = (wc & 1) ? (t & 63) : (t >> 6);
                    const float* tb = rope + (pos * 16 + 4 * fq) * 2;
                    const f32x4 t0 = *(const f32x4*)tb, t1 = *(const f32x4*)(tb + 4);
                    const f32x4 cs = {t0.x, t0.z, t1.x, t1.z}, sn = {t0.y, t0.w, t1.y, t1.w};
#pragma unroll
                    for (int bj = 0; bj < 2; ++bj) {
                        const f32x4 x0 = acc[ai][bj][m][0], x1 = acc[ai][bj][m][1];
                        f32x4 o0 = x0 * cs - x1 * sn, o1 = x1 * cs + x0 * sn;
                        if (kind == KD_Q) {
                            o0 = o0 * C2; o1 = o1 * C2;
                            bf16_t* dst = q + (size_t)r * 1024 + u.pn * 256 + 128 * bj + 32 * wc + 4 * fq;
                            u32x2 w0, w1; w0.x = cvt_pk_bf16(o0.x, o0.y); w0.y = cvt_pk_bf16(o0.z, o0.w); w1.x = cvt_pk_bf16(o1.x, o1.y); w1.y = cvt_pk_bf16(o1.z, o1.w);
                            *(u32x2*)dst = w0; *(u32x2*)(dst + 16) = w1;
                        } else {
                            const int hkv = 2 * bj + (wc >> 1), ch0 = 4 * (wc & 1) + (fq >> 1);
                            unsigned char* dst = kb + ((size_t)((b * 4 + hkv) * 32 + (t >> 6))) * 8192 + ch0 * 1024 + (t & 63) * 16 + 8 * (fq & 1);
                            u32x2 w0, w1; w0.x = cvt_pk_bf16(o0.x, o0.y); w0.y = cvt_pk_bf16(o0.z, o0.w); w1.x = cvt_pk_bf16(o1.x, o1.y); w1.y = cvt_pk_bf16(o1.z, o1.w);
                            *(u32x2*)dst = w0; *(u32x2*)(dst + 2048) = w1;
                        }
                    }
                }
        } else if (kind == KD_KC) {
#pragma unroll
            for (int ai = 0; ai < 2; ++ai)
#pragma unroll
                for (int m = 0; m < 4; ++m) {
                    const int r = (u.pm - M / 256) * 256 + 128 * ai + 64 * wr + 16 * m + fr, l = r & 255, b = r >> 8;
#pragma unroll
                    for (int bj = 0; bj < 2; ++bj) {
                        const int hkv = 2 * bj + (wc >> 1), ch0 = 4 * (wc & 1) + (fq >> 1);
                        unsigned char* dst = kcb + ((size_t)((b * 4 + hkv) * 4 + (l >> 6))) * 8192 + ch0 * 1024 + (l & 63) * 16 + 8 * (fq & 1);
#pragma unroll
                        for (int n = 0; n < 2; ++n) { const f32x4 v = acc[ai][bj][m][n]; u32x2 w; w.x = cvt_pk_bf16(v.x, v.y); w.y = cvt_pk_bf16(v.z, v.w); *(u32x2*)(dst + n * 2048) = w; }
                    }
                }
        } else if (kind == KD_VT || kind == KD_VTC) {
#pragma unroll
            for (int ai = 0; ai < 2; ++ai)
#pragma unroll
                for (int m = 0; m < 4; ++m) {
                    const int hkv = 2 * ai + wr, d = 16 * m + fr;
#pragma unroll
                    for (int bj = 0; bj < 2; ++bj) {
                        size_t blk;
                        if (kind == KD_VT) blk = (size_t)(((u.pn >> 3) * 4 + hkv) * 32 + 4 * (u.pn & 7) + 2 * bj + (wc >> 1));
                        else blk = (size_t)((u.pn * 4 + hkv) * 4 + 2 * bj + (wc >> 1));
                        unsigned char* base = (kind == KD_VT ? vb : vcb) + blk * 8192 + d * 16 + 8 * (fq >> 1);
#pragma unroll
                        for (int n = 0; n < 2; ++n) { const f32x4 v = acc[ai][bj][m][n]; u32x2 w; w.x = cvt_pk_bf16(v.x, v.y); w.y = cvt_pk_bf16(v.z, v.w);
                            *(u32x2*)(base + (2 * (2 * (wc & 1) + n) + (fq & 1)) * 1024) = w; }
                    }
                }
        } else if (kind == KD_UC) {
#pragma unroll
            for (int ai = 0; ai < 2; ++ai)
#pragma unroll
                for (int m = 0; m < 4; ++m) {
                    const int r = u.pm * 256 + 128 * ai + 64 * wr + 16 * m + fr;
                    const f32x4 v0 = acc[ai][0][m][0] * acc[ai][1][m][0], v1 = acc[ai][0][m][1] * acc[ai][1][m][1];
                    u32x4 w; w.x = cvt_pk_bf16(v0.x, v0.y); w.y = cvt_pk_bf16(v0.z, v0.w); w.z = cvt_pk_bf16(v1.x, v1.y); w.w = cvt_pk_bf16(v1.z, v1.w);
                    *(u32x4*)(z + (size_t)r * 1024 + (u.pn - 5) * 128 + 32 * wc + 8 * fq) = w;
                }
        } else if (kind == KD_BC) {
#pragma unroll
            for (int ai = 0; ai < 2; ++ai)
#pragma unroll
                for (int m = 0; m < 4; ++m) {
                    const int r = u.pm * 256 + 128 * ai + 64 * wr + 16 * m + fr;
#pragma unroll
                    for (int bj = 0; bj < 2; ++bj) { const f32x4 v0 = acc[ai][bj][m][0], v1 = acc[ai][bj][m][1];
                        u32x4 w; w.x = cvt_pk_bf16(v0.x, v0.y); w.y = cvt_pk_bf16(v0.z, v0.w); w.z = cvt_pk_bf16(v1.x, v1.y); w.w = cvt_pk_bf16(v1.z, v1.w);
                        *(u32x4*)(bb + (size_t)r * 1024 + (u.pn - 13) * 256 + 128 * bj + 32 * wc + 8 * fq) = w; }
                }
        } else {
#pragma unroll
            for (int ai = 0; ai < 2; ++ai)
#pragma unroll
                for (int m = 0; m < 4; ++m) {
                    const int r = u.pm * 256 + 128 * ai + 64 * wr + 16 * m + fr;
                    f32x4 rr[2], sg[2];
#pragma unroll
                    for (int n = 0; n < 2; ++n)
#pragma unroll
                        for (int j = 0; j < 4; ++j) { const float ea = __expf(-acc[ai][0][m][n][j]), ec = __expf(-acc[ai][1][m][n][j]);
                            rr[n][j] = (1.f + ec) * __builtin_amdgcn_rcpf(1.f + ea); sg[n][j] = __builtin_amdgcn_rcpf(1.f + ec); }
                    const size_t off = (size_t)r * 1024 + (u.pn - 17) * 128 + 32 * wc + 8 * fq;
                    u32x4 w; w.x = cvt_pk_bf16(rr[0].x, rr[0].y); w.y = cvt_pk_bf16(rr[0].z, rr[0].w); w.z = cvt_pk_bf16(rr[1].x, rr[1].y); w.w = cvt_pk_bf16(rr[1].z, rr[1].w);
                    *(u32x4*)(rb + off) = w;
                    w.x = cvt_pk_bf16(sg[0].x, sg[0].y); w.y = cvt_pk_bf16(sg[0].z, sg[0].w); w.z = cvt_pk_bf16(sg[1].x, sg[1].y); w.w = cvt_pk_bf16(sg[1].z, sg[1].w);
                    *(u32x4*)(sgc + off) = w;
                }
        }
    }
};
__device__ __forceinline__ void ph_inproj(const Params& P, LAS unsigned char* lds) {
    InprojSched S; S.G = gridDim.x; S.c = blockIdx.x; S.hx = (const char*)(P.ws + WS_HX); S.win = (const char*)(P.ws + WS_WIN); S.wv = (const char*)(P.ws + WS_WV);
    EpiInproj E; E.q = (bf16_t*)(P.ws + WS_Q); E.z = (bf16_t*)(P.ws + WS_Z); E.bb = (bf16_t*)(P.ws + WS_BB); E.rb = (bf16_t*)(P.ob + OB_RB); E.sgc = (bf16_t*)(P.ob + OB_SGC);
    E.kb = P.ws + WS_KB; E.kcb = P.ws + WS_KCB; E.vb = P.ws + WS_VB; E.vcb = P.ws + WS_VCB; E.rope = (const float*)(P.ws + WS_ROPE);
#ifdef FK_STAGGER_PROBE
    { const unsigned long long t0 = __builtin_amdgcn_s_memrealtime(); const unsigned long long dt = (unsigned long long)((blockIdx.x >> 3) & 31) * FK_STAGGER_PROBE;
      while (__builtin_amdgcn_s_memrealtime() - t0 < dt) __builtin_amdgcn_s_sleep(4); }
#endif
#if defined(FK_EPI2_PROBE)
    gemm_phase<EpiInproj, InprojSched, false, false, 3>(lds, 1024, S, E);
#elif defined(FK_KREP_INPROJ)
    gemm_phase<EpiInproj, InprojSched, false, false, 2>(lds, 1024, S, E);
#else
    gemm_phase<EpiInproj, InprojSched, false>(lds, 1024, S, E);
#endif
}

constexpr int CW_QUEUE = 3584;
__device__ __forceinline__ void ph_norm1(const Params& P, LAS unsigned char* lds) {
    const int tid = threadIdx.x, lane = tid & 63, wave = __builtin_amdgcn_readfirstlane(tid >> 6), wg = blockIdx.x, G = gridDim.x;
    constexpr int NC = MC / 256;
    if (wg < 2 * NC && G > 2 * NC) {
        const int tile = wg < NC ? wg : wg - NC;
        for (int r = wave * 4; r < 256; r += 32) norm1_rows<4>(P, M + tile * 256 + r, lane);
        asm volatile("s_waitcnt vmcnt(0)" ::: "memory");
        __syncthreads();
        CtxSched S; S.c = wg; S.hx = (const char*)(P.ws + WS_HX); S.win = (const char*)(P.ws + WS_WIN); S.wv = (const char*)(P.ws + WS_WV);
        EpiInproj E; E.q = nullptr; E.z = nullptr; E.bb = nullptr; E.rb = nullptr; E.sgc = nullptr;
        E.kb = P.ws + WS_KB; E.kcb = P.ws + WS_KCB; E.vb = P.ws + WS_VB; E.vcb = P.ws + WS_VCB; E.rope = (const float*)(P.ws + WS_ROPE);
        gemm_phase<EpiInproj, CtxSched, false>(lds, 1024, S, E);
    } else {
        const int nw = (G - 2 * NC) * 8, gw = (wg - 2 * NC) * 8 + wave;
        for (int row = gw * 4; row < M; row += nw * 4) norm1_rows<4>(P, row, lane);
    }
    unsigned* head = (unsigned*)(P.ws + WS_CTL) + CW_QUEUE;
    LAS unsigned* slot = (LAS unsigned*)(lds + LDS_MISC_Q);
    for (;;) {
        __syncthreads();
        if (tid == 0) slot[0] = __hip_atomic_fetch_add(head, 32u, __ATOMIC_RELAXED, __HIP_MEMORY_SCOPE_AGENT);
        __syncthreads();
        const int base = CV_IN + (int)slot[0];
        if (base >= CV_TOTAL) break;
#pragma unroll 1
        for (int k = 0; k < 4; ++k) { const int it = base + wave * 4 + k; if (it < CV_TOTAL) conv_item(P, it, lane); }
    }
}

__device__ __forceinline__ int crow(int r, int hi) { return (r & 3) + 8 * (r >> 2) + 4 * hi; }
#ifndef FK_ATT_THR
#define FK_ATT_THR 24.0f
#endif
constexpr float ATT_THR = FK_ATT_THR;
constexpr int ATT_NS = 5;
struct AttnUnitInfo { int b, hkv, qb, w_lo, nwin, ntile; };
__device__ __forceinline__ AttnUnitInfo attn_decode(int uidx) {
    AttnUnitInfo u; u.b = uidx >> 7; u.hkv = (uidx >> 5) & 3; u.qb = uidx & 31;
    u.w_lo = u.qb - 2 < 0 ? 0 : u.qb - 2; const int w_hi = u.qb + 2 > 31 ? 31 : u.qb + 2; u.nwin = w_hi - u.w_lo + 1; u.ntile = u.nwin + 4; return u;
}
__device__ __forceinline__ float max3f(float a, float b, float c) { float r; asm("v_max3_f32 %0, %1, %2, %3" : "=v"(r) : "v"(a), "v"(b), "v"(c)); return r; }
__device__ __forceinline__ void attn_finish(const Params& P, const f32x16& o0, const f32x16& o1, float lrun, int b, int hkv, int qb, int g, int wsub, int r32, int hi) {
    const float ltot = lrun + __shfl_xor(lrun, 32), inv = 1.f / ltot;
    bf16_t* AO = (bf16_t*)(P.ws + WS_AO) + (size_t)(b * T + qb * 64 + 32 * wsub + r32) * 2048 + (hkv * 4 + g) * 64 + 4 * hi;
#pragma unroll
    for (int g4 = 0; g4 < 4; ++g4) {
        u32x2 w; w.x = cvt_pk_bf16(o0[4 * g4] * inv, o0[4 * g4 + 1] * inv); w.y = cvt_pk_bf16(o0[4 * g4 + 2] * inv, o0[4 * g4 + 3] * inv); *(u32x2*)(AO + 8 * g4) = w;
        w.x = cvt_pk_bf16(o1[4 * g4] * inv, o1[4 * g4 + 1] * inv); w.y = cvt_pk_bf16(o1[4 * g4 + 2] * inv, o1[4 * g4 + 3] * inv); *(u32x2*)(AO + 32 + 8 * g4) = w;
    }
}
__device__ __forceinline__ void attn_drain(const Params& P, LAS unsigned char* lds, const f32x16& Pa, const f32x16& Pb, f32x16& o0, f32x16& o1, float lrun, int vslot,
                                           int cu, int nun, int ubase, int GY, int g, int wsub, int r32, int hi) {
    float sacc = 0.f;
#pragma unroll
    for (int r = 0; r < 16; ++r) sacc += Pa[r] + Pb[r];
    lrun += sacc;
    const LAS unsigned char* Vp = lds + vslot * 16384 + 8192 + hi * 1024 + r32 * 16;
#pragma unroll
    for (int ks = 0; ks < 4; ++ks) {
        const f32x16& S = ks < 2 ? Pa : Pb; const int o = 8 * (ks & 1);
        const u32x4 pw = (u32x4){cvt_pk_bf16(S[o], S[o + 1]), cvt_pk_bf16(S[o + 2], S[o + 3]), cvt_pk_bf16(S[o + 4], S[o + 5]), cvt_pk_bf16(S[o + 6], S[o + 7])};
        const bf16x8 v0 = *(const LAS bf16x8*)(Vp + (2 * ks) * 1024), v1 = *(const LAS bf16x8*)(Vp + (2 * ks) * 1024 + 512);
        const bf16x8 pb = __builtin_bit_cast(bf16x8, pw);
        o0 = __builtin_amdgcn_mfma_f32_32x32x16_bf16(v0, pb, o0, 0, 0, 0); o1 = __builtin_amdgcn_mfma_f32_32x32x16_bf16(v1, pb, o1, 0, 0, 0);
    }
    const AttnUnitInfo li = attn_decode(ubase + GY * (nun - 1));
    attn_finish(P, o0, o1, lrun, li.b, li.hkv, li.qb, g, wsub, r32, hi);
}
__device__ __forceinline__ void attn_phase(const Params& P, LAS unsigned char* lds) {
    const int tid = threadIdx.x, lane = tid & 63, wid = __builtin_amdgcn_readfirstlane(tid >> 6), r32 = lane & 31, hi = lane >> 5;
    constexpr int NU = NBF * 4 * 32;
    const int G = gridDim.x, xg = blockIdx.x & 7, yg = blockIdx.x >> 3, GY = G >> 3;
    const int nun = (NU / 8 - yg + GY - 1) / GY;
    if (nun <= 0) return;
    const int ubase = xg * (NU / 8) + yg;
    const bf16_t* Q = (const bf16_t*)(P.ws + WS_Q);
    const unsigned char* KB = P.ws + WS_KB; const unsigned char* VB = P.ws + WS_VB; const unsigned char* KCB = P.ws + WS_KCB; const unsigned char* VCB = P.ws + WS_VCB;
    const int g = wid >> 1, wsub = wid & 1;
#define AT_WAIT(n) asm volatile("s_waitcnt vmcnt(" #n ")" ::: "memory")
#define AT_SB() __builtin_amdgcn_sched_barrier(0)
    int pu = 0, pit = 0, pstep = 0, pslot = 0; AttnUnitInfo pinfo = attn_decode(ubase);
    auto issue = [&]() {
        const size_t bh = (size_t)(pinfo.b * 4 + pinfo.hkv);
        const unsigned char* ks = pit < pinfo.nwin ? KB + (bh * 32 + pinfo.w_lo + pit) * 8192 : KCB + (bh * 4 + (pit - pinfo.nwin)) * 8192;
        const unsigned char* vs = pit < pinfo.nwin ? VB + (bh * 32 + pinfo.w_lo + pit) * 8192 : VCB + (bh * 4 + (pit - pinfo.nwin)) * 8192;
        LAS unsigned char* dst = lds + pslot * 16384 + wid * 1024;
        __builtin_amdgcn_global_load_lds((const unsigned*)(ks + wid * 1024 + lane * 16), (LAS unsigned*)dst, 16, 0, 0);
        __builtin_amdgcn_global_load_lds((const unsigned*)(vs + wid * 1024 + lane * 16), (LAS unsigned*)(dst + 8192), 16, 0, 0);
        ++pstep; pslot = pslot == ATT_NS - 1 ? 0 : pslot + 1; ++pit;
        if (pit == pinfo.ntile) { pit = 0; ++pu; if (pu < nun) pinfo = attn_decode(ubase + GY * pu); }
    };
    int total = 0;
    for (int k = 0; k < nun; ++k) total += attn_decode(ubase + GY * k).ntile;
    *(LAS u32x4*)(lds + (ATT_NS - 1) * 16384 + 8192 + tid * 16) = (u32x4){0u, 0u, 0u, 0u};
    __syncthreads();
    int cu = 0, it = 0, step = 0, cslot = 0, vslot = ATT_NS - 1; AttnUnitInfo ci = attn_decode(ubase);
    int fb = 0, fhkv = 0, fqb = 0;
    constexpr int ATT_QOFF = ATT_NS * 16384;
    auto issueQ = [&](const AttnUnitInfo& ui) {
        const bf16_t* qp = Q + (size_t)(ui.b * T + ui.qb * 64 + 32 * wsub + r32) * 1024 + (ui.hkv * 4 + g) * 64 + hi * 8;
#pragma unroll
        for (int j = 0; j < 4; ++j)
            __builtin_amdgcn_global_load_lds((const unsigned*)(qp + 16 * j), (LAS unsigned*)(lds + ATT_QOFF + wid * 4096 + j * 1024), 16, 0, 0);
    };
    float sk0 = P.sink[0 * 4 + g] * LOG2E, sk1 = P.sink[1 * 4 + g] * LOG2E, sk2 = P.sink[2 * 4 + g] * LOG2E, sk3 = P.sink[3 * 4 + g] * LOG2E;
    asm volatile("s_waitcnt vmcnt(0)" : "+v"(sk0), "+v"(sk1), "+v"(sk2), "+v"(sk3) :: "memory");
    bf16x8 qf[4];
    float sink_c = 0.f;
    const f32x16 zero16 = {0.f, 0.f, 0.f, 0.f, 0.f, 0.f, 0.f, 0.f, 0.f, 0.f, 0.f, 0.f, 0.f, 0.f, 0.f, 0.f};
    f32x16 o0, o1, pA0, pA1, pB0, pB1;
    float mrun = 0.f, lrun = 0.f; bool slow = false;
#pragma unroll
    for (int r = 0; r < 16; ++r) { o0[r] = 0.f; o1[r] = 0.f; pA0[r] = 0.f; pA1[r] = 0.f; pB0[r] = 0.f; pB1[r] = 0.f; }
    bf16x8 fr[4]; u32x4 pw[4];
    issueQ(ci);
    issue(); if (total > 1) issue(); if (total > 2) issue();
    if (total > 2) AT_WAIT(2); else AT_WAIT(0);
    __builtin_amdgcn_s_barrier(); asm volatile("" ::: "memory");
    if (pstep < total) issue();
#define AT_FA(base, i) (*(const LAS bf16x8*)((base) + (((i) >> 1) * 2) * 1024 + ((i) & 1) * 512))
    { const LAS unsigned char* K0 = lds + hi * 1024 + r32 * 16; fr[0] = AT_FA(K0, 0); fr[1] = AT_FA(K0, 1); fr[2] = AT_FA(K0, 2); }

#define AT_PK(Pa, Pb, w) cvt_pk_bf16((w) < 8 ? Pa[2 * (w)] : Pb[2 * (w) - 16], (w) < 8 ? Pa[2 * (w) + 1] : Pb[2 * (w) - 15])
#define AT_PV(Pa, Pb, i) ((i) < 16 ? Pa[(i)] : Pb[(i) - 16])
#define AT_GAPA(gi, Cn, Pa, Pb) do { \
        Cn = __builtin_amdgcn_mfma_f32_32x32x16_bf16(fr[(gi) & 3], qf[(gi) >> 1], (gi) < 2 ? zero16 : Cn, 0, 0, 0); \
        if ((gi) + 3 < 8) fr[((gi) + 3) & 3] = AT_FA(Kc, (gi) + 3); else fr[((gi) + 3) & 3] = AT_FA(Vp, (gi) + 3 - 8); \
        sacc += AT_PV(Pa, Pb, 4 * (gi)) + AT_PV(Pa, Pb, 4 * (gi) + 1); sacc2 += AT_PV(Pa, Pb, 4 * (gi) + 2) + AT_PV(Pa, Pb, 4 * (gi) + 3); \
        pw[(gi) >> 1][2 * ((gi) & 1)] = AT_PK(Pa, Pb, 2 * (gi)); pw[(gi) >> 1][2 * ((gi) & 1) + 1] = AT_PK(Pa, Pb, 2 * (gi) + 1); AT_SB(); } while (0)
#define AT_GAPB(gi, Cx, cb) do { \
        if ((gi) & 1) o1 = __builtin_amdgcn_mfma_f32_32x32x16_bf16(fr[(gi) & 3], __builtin_bit_cast(bf16x8, pw[(gi) >> 1]), o1, 0, 0, 0); \
        else o0 = __builtin_amdgcn_mfma_f32_32x32x16_bf16(fr[(gi) & 3], __builtin_bit_cast(bf16x8, pw[(gi) >> 1]), o0, 0, 0, 0); \
        if ((gi) + 3 < 8) fr[((gi) + 3) & 3] = AT_FA(Vp, (gi) + 3); else fr[((gi) + 3) & 3] = AT_FA(Kn, (gi) + 3 - 8); \
        Cx[cb] = __builtin_amdgcn_exp2f(Cx[cb]); Cx[cb + 1] = __builtin_amdgcn_exp2f(Cx[cb + 1]); Cx[cb + 2] = __builtin_amdgcn_exp2f(Cx[cb + 2]); Cx[cb + 3] = __builtin_amdgcn_exp2f(Cx[cb + 3]); \
        AT_SB(); } while (0)
#define AT_STEP(C0, C1, Pa, Pb) do { \
        const bool first = (it == 0); \
        if (first) { fb = ci.b; fhkv = ci.hkv; fqb = ci.qb; if (step > 0) { const AttnUnitInfo pi = attn_decode(ubase + GY * (cu - 1)); fb = pi.b; fhkv = pi.hkv; fqb = pi.qb; } \
            sink_c = ci.hkv == 0 ? sk0 : ci.hkv == 1 ? sk1 : ci.hkv == 2 ? sk2 : sk3; mrun = 0.f; slow = false; \
            _Pragma("unroll") for (int ks = 0; ks < 4; ++ks) qf[ks] = *(const LAS bf16x8*)(lds + ATT_QOFF + wid * 4096 + (2 * ks + hi) * 512 + r32 * 16); \
            asm volatile("s_waitcnt lgkmcnt(0)" ::: "memory"); \
            if (cu + 1 < nun) issueQ(attn_decode(ubase + GY * (cu + 1))); } \
        const LAS unsigned char* Kc = lds + cslot * 16384 + hi * 1024 + r32 * 16; \
        const LAS unsigned char* Vp = lds + vslot * 16384 + 8192 + hi * 1024 + r32 * 16; \
        const int nslot = cslot == ATT_NS - 1 ? 0 : cslot + 1; \
        const LAS unsigned char* Kn = lds + nslot * 16384 + hi * 1024 + r32 * 16; \
        float sacc = 0.f, sacc2 = 0.f; AT_SB(); \
        AT_GAPA(0, C0, Pa, Pb); AT_GAPA(1, C1, Pa, Pb); AT_GAPA(2, C0, Pa, Pb); AT_GAPA(3, C1, Pa, Pb); AT_GAPA(4, C0, Pa, Pb); AT_GAPA(5, C1, Pa, Pb); AT_GAPA(6, C0, Pa, Pb); AT_GAPA(7, C1, Pa, Pb); \
        lrun += sacc + sacc2; \
        if (slow) { _Pragma("unroll") for (int r = 0; r < 16; ++r) { C0[r] -= mrun; C1[r] -= mrun; } } \
        if (it < ci.nwin) { const int wt = ci.w_lo + it, dq = wt - ci.qb; \
            if (dq == 2 || dq == -2) { const int base = ci.qb * 64 + 32 * wsub + r32 - 64 * wt; \
                _Pragma("unroll") for (int r = 0; r < 16; ++r) { const int d0 = base - crow(r, hi), d1 = d0 - 32; \
                    if (d0 > 128 || d0 < -128) C0[r] = -1e30f; if (d1 > 128 || d1 < -128) C1[r] = -1e30f; } } } \
        float mx; { float ma = max3f(C0[0], C0[1], C1[0]), mb = max3f(C0[2], C0[3], C1[1]); ma = max3f(ma, C1[2], C1[3]); \
            _Pragma("unroll") for (int r = 4; r < 16; r += 4) { ma = max3f(ma, C0[r], C0[r + 1]); mb = max3f(mb, C0[r + 2], C0[r + 3]); ma = max3f(ma, C1[r], C1[r + 1]); mb = max3f(mb, C1[r + 2], C1[r + 3]); } \
            mx = fmaxf(ma, mb); mx = fmaxf(mx, __shfl_xor(mx, 32)); } \
        float fres = 1.f; bool resc = false; \
        if (__any(mx > ATT_THR)) { const float dl = fmaxf(mx, 0.f); fres = __builtin_amdgcn_exp2f(-dl); mrun += dl; resc = true; slow = true; \
            _Pragma("unroll") for (int r = 0; r < 16; ++r) { C0[r] -= dl; C1[r] -= dl; } } \
        AT_SB(); \
        AT_GAPB(0, C0, 0); AT_GAPB(1, C0, 4); AT_GAPB(2, C0, 8); AT_GAPB(3, C0, 12); AT_GAPB(4, C1, 0); AT_GAPB(5, C1, 4); AT_GAPB(6, C1, 8); AT_GAPB(7, C1, 12); \
        if (first && step > 0) { attn_finish(P, o0, o1, lrun, fb, fhkv, fqb, g, wsub, r32, hi); \
            _Pragma("unroll") for (int r = 0; r < 16; ++r) { o0[r] = 0.f; o1[r] = 0.f; } lrun = (hi == 0 ? __builtin_amdgcn_exp2f(sink_c) : 0.f) * fres; } \
        else if (first) { lrun = (hi == 0 ? __builtin_amdgcn_exp2f(sink_c) : 0.f) * fres; } \
        else if (resc) { lrun *= fres; _Pragma("unroll") for (int r = 0; r < 16; ++r) { o0[r] *= fres; o1[r] *= fres; } } \
        ++it; ++step; vslot = cslot; cslot = nslot; \
        if (it == ci.ntile) { it = 0; ++cu; if (cu < nun) ci = attn_decode(ubase + GY * cu); } \
        if (step < total) { \
            const int ahead = pstep - step;        \
            if (ahead >= 3) AT_WAIT(2); else AT_WAIT(0); \
            __builtin_amdgcn_s_barrier(); asm volatile("" ::: "memory"); \
            if (pstep < total) issue(); \
        } } while (0)

    while (step < total) {
        AT_STEP(pB0, pB1, pA0, pA1);
        if (step >= total) {
            attn_drain(P, lds, pB0, pB1, o0, o1, lrun, vslot, cu, nun, ubase, GY, g, wsub, r32, hi);
            break; }
        AT_STEP(pA0, pA1, pB0, pB1);
        if (step >= total) { attn_drain(P, lds, pA0, pA1, o0, o1, lrun, vslot, cu, nun, ubase, GY, g, wsub, r32, hi); break; }
    }
    AT_WAIT(0);
    __syncthreads();
#undef AT_STEP
#undef AT_GAPA
#undef AT_GAPB
#undef AT_PK
#undef AT_PV
#undef AT_FA
#undef AT_WAIT
#undef AT_SB
}
__device__ __forceinline__ void ph_mix(const Params& P, LAS unsigned char* lds) {
    const int G = gridDim.x;
    attn_phase(P, lds);
#if (FK_DBL >> 11) & 1
    attn_phase(P, lds);
#endif
#if (FK_DBL >> 12) & 1
    for (int rep = 0; rep < 2; ++rep)
#endif
    const bf16_t* Z = (const bf16_t*)(P.ws + WS_Z); const bf16_t* BB = (const bf16_t*)(P.ws + WS_BB); bf16_t* AO = (bf16_t*)(P.ws + WS_AO);
    for (int it = blockIdx.x * 512 + threadIdx.x; it < (M / 16) * 128; it += G * 512) {
        const int cch = it & 127, tr = it >> 7, row0 = tr * 16, tl = row0 & 2047;
        const f32x4 wa = *(const f32x4*)(P.conv_w + cch * 8), wb = *(const f32x4*)(P.conv_w + cch * 8 + 4);
        const f32x4 wc0 = *(const f32x4*)(P.conv_w + 1024 + cch * 8), wc1 = *(const f32x4*)(P.conv_w + 1024 + cch * 8 + 4);
        const f32x4 we0 = *(const f32x4*)(P.conv_w + 2048 + cch * 8), we1 = *(const f32x4*)(P.conv_w + 2048 + cch * 8 + 4);
        const bf16_t* zp = Z + (size_t)row0 * 1024 + cch * 8;
        u32x4 zm = tl > 0 ? *(const u32x4*)(zp - 1024) : (u32x4){0u, 0u, 0u, 0u};
        u32x4 zc = *(const u32x4*)zp;
#pragma unroll 4
        for (int i = 0; i < 16; ++i) {
            const u32x4 zn = (tl + i + 1 < 2048) ? *(const u32x4*)(zp + (size_t)(i + 1) * 1024) : (u32x4){0u, 0u, 0u, 0u};
            const u32x4 bv = *(const u32x4*)(BB + (size_t)(row0 + i) * 1024 + cch * 8);
            float y[8];
#pragma unroll
            for (int k = 0; k < 4; ++k) {
                const float w0l = k < 2 ? wa[2 * k] : wb[2 * k - 4], w0h = k < 2 ? wa[2 * k + 1] : wb[2 * k - 3];
                const float w1l = k < 2 ? wc0[2 * k] : wc1[2 * k - 4], w1h = k < 2 ? wc0[2 * k + 1] : wc1[2 * k - 3];
                const float w2l = k < 2 ? we0[2 * k] : we1[2 * k - 4], w2h = k < 2 ? we0[2 * k + 1] : we1[2 * k - 3];
                y[2 * k] = bf_lo(bv[k]) * (w0l * bf_lo(zm[k]) + w1l * bf_lo(zc[k]) + w2l * bf_lo(zn[k]));
                y[2 * k + 1] = bf_hi(bv[k]) * (w0h * bf_hi(zm[k]) + w1h * bf_hi(zc[k]) + w2h * bf_hi(zn[k]));
            }
            u32x4 o; o.x = cvt_pk_bf16(y[0], y[1]); o.y = cvt_pk_bf16(y[2], y[3]); o.z = cvt_pk_bf16(y[4], y[5]); o.w = cvt_pk_bf16(y[6], y[7]);
            *(u32x4*)(AO + (size_t)(row0 + i) * 2048 + 1024 + cch * 8) = o;
            zm = zc; zc = zn;
        }
    }
}

struct RowColSched {
    int G, c, nM, nN; const char *A, *B; size_t ts;
    __device__ __forceinline__ bool next(int i, Unit& u) const {
        const int nwg = nM * nN, Lx = i * G + c; if (Lx >= nwg) return false;
        const int wgid = (Lx % 8) * (nwg / 8) + Lx / 8;
        const int nig = 8 * nN, gid = wgid / nig, w = wgid % nig;
        u.pm = gid * 8 + (w % 8); u.pn = w / 8; u.a = A + (size_t)u.pm * ts; u.b = B + (size_t)u.pn * ts; u.kind = 0; u.aux = 0; u.rows = nullptr; return true;
    }
};
struct EpiProj {
    const bf16_t *rb, *sgc; bf16_t* mb;
    __device__ __forceinline__ void mid(f32x4 (&acc)[2][2][4][2], const Unit& u, int wr, int wc, int fr, int fq) const {
#pragma unroll
        for (int ai = 0; ai < 2; ++ai)
#pragma unroll
            for (int m = 0; m < 4; ++m) { const int r = u.pm * 256 + 128 * ai + 64 * wr + 16 * m + fr;
#pragma unroll
                for (int bj = 0; bj < 2; ++bj) { const u32x4 w = *(const u32x4*)(rb + (size_t)r * 1024 + u.pn * 256 + 128 * bj + 32 * wc + 8 * fq);
                    acc[ai][bj][m][0] *= (f32x4){bf_lo(w.x), bf_hi(w.x), bf_lo(w.y), bf_hi(w.y)}; acc[ai][bj][m][1] *= (f32x4){bf_lo(w.z), bf_hi(w.z), bf_lo(w.w), bf_hi(w.w)}; } }
    }
    __device__ __forceinline__ void operator()(const f32x4 (&acc)[2][2][4][2], const Unit& u, int wr, int wc, int fr, int fq) const {
#pragma unroll
        for (int ai = 0; ai < 2; ++ai)
#pragma unroll
            for (int m = 0; m < 4; ++m) { const int r = u.pm * 256 + 128 * ai + 64 * wr + 16 * m + fr;
#pragma unroll
                for (int bj = 0; bj < 2; ++bj) { const size_t off = (size_t)r * 1024 + u.pn * 256 + 128 * bj + 32 * wc + 8 * fq; const u32x4 w = *(const u32x4*)(sgc + off);
                    const f32x4 v0 = acc[ai][bj][m][0] * (f32x4){bf_lo(w.x), bf_hi(w.x), bf_lo(w.y), bf_hi(w.y)}, v1 = acc[ai][bj][m][1] * (f32x4){bf_lo(w.z), bf_hi(w.z), bf_lo(w.w), bf_hi(w.w)};
                    u32x4 o; o.x = cvt_pk_bf16(v0.x, v0.y); o.y = cvt_pk_bf16(v0.z, v0.w); o.z = cvt_pk_bf16(v1.x, v1.y); o.w = cvt_pk_bf16(v1.z, v1.w);
                    *(u32x4*)(mb + off) = o; } }
    }
};
__device__ __forceinline__ void ph_proj(const Params& P, LAS unsigned char* lds) {
    RowColSched S; S.G = gridDim.x; S.c = blockIdx.x; S.nM = M / 256; S.nN = 4; S.A = (const char*)(P.ws + WS_AO); S.B = (const char*)(P.ws + WS_WP); S.ts = (size_t)256 * 2048 * 2;
    EpiProj E; E.rb = (const bf16_t*)(P.ob + OB_RB); E.sgc = (const bf16_t*)(P.ob + OB_SGC); E.mb = (bf16_t*)(P.ws + WS_MB);
    gemm_phase<EpiProj, RowColSched, true>(lds, 2048, S, E);
}
struct EpiOut {
    const float* mod; bf16_t* dl;
    __device__ __forceinline__ void operator()(const f32x4 (&acc)[2][2][4][2], const Unit& u, int wr, int wc, int fr, int fq) const {
        const int b = (u.pm * 256) >> 11;
#pragma unroll
        for (int bj = 0; bj < 2; ++bj) { const int col = u.pn * 256 + 128 * bj + 32 * wc + 8 * fq;
            const f32x4 g0 = *(const f32x4*)(mod + b * 6144 + 2048 + col), g1 = *(const f32x4*)(mod + b * 6144 + 2048 + col + 4);
#pragma unroll
            for (int ai = 0; ai < 2; ++ai)
#pragma unroll
                for (int m = 0; m < 4; ++m) { const size_t off = (size_t)(u.pm * 256 + 128 * ai + 64 * wr + 16 * m + fr) * 1024 + col;
                    const f32x4 v0 = g0 * acc[ai][bj][m][0], v1 = g1 * acc[ai][bj][m][1];
                    u32x4 w; w.x = cvt_pk_bf16(v0.x, v0.y); w.y = cvt_pk_bf16(v0.z, v0.w); w.z = cvt_pk_bf16(v1.x, v1.y); w.w = cvt_pk_bf16(v1.z, v1.w);
                    *(u32x4*)(dl + off) = w; } }
    }
};
__device__ __forceinline__ void ph_out(const Params& P, LAS unsigned char* lds) {
    RowColSched S; S.G = gridDim.x; S.c = blockIdx.x; S.nM = M / 256; S.nN = 4; S.A = (const char*)(P.ws + WS_MB); S.B = (const char*)(P.ws + WS_WO); S.ts = (size_t)256 * 1024 * 2;
    EpiOut E; E.mod = (const float*)(P.ws + WS_MOD); E.dl = (bf16_t*)(P.ws + WS_DL);
    gemm_phase<EpiOut, RowColSched, false>(lds, 1024, S, E);
}

__device__ __forceinline__ void ph_router(const Params& P, LAS unsigned char* lds) {
    const int tid = threadIdx.x, lane = tid & 63, wave = tid >> 6;
    LAS float* wt = (LAS float*)lds;
    for (int i = tid; i < 16384; i += 512) { const int k = i >> 4, e = i & 15; wt[e * 1024 + k] = P.w_router[i]; }
    __syncthreads();
    const bf16_t* DL = (const bf16_t*)(P.ws + WS_DL); const float* mod = (const float*)(P.ws + WS_MOD);
    bf16_t* HX2 = (bf16_t*)(P.ws + WS_HX2); float* AFF = (float*)(P.ws + WS_AFF);
    f32x4 nx0[4], nx1[4]; u32x4 nd0[2], nd1[2];
    const int rp0 = blockIdx.x * 8 + wave, rstep = gridDim.x * 8;
#define RT_LOAD(rpv) do { _Pragma("unroll") for (int j = 0; j < 2; ++j) { const size_t o0 = (size_t)((rpv) * 2) * D + 8 * lane + 512 * j; \
        nx0[2 * j] = *(const f32x4*)(P.x + o0); nx0[2 * j + 1] = *(const f32x4*)(P.x + o0 + 4); nx1[2 * j] = *(const f32x4*)(P.x + o0 + D); nx1[2 * j + 1] = *(const f32x4*)(P.x + o0 + D + 4); \
        nd0[j] = *(const u32x4*)(DL + o0); nd1[j] = *(const u32x4*)(DL + o0 + D); } } while (0)
    if (rp0 < M / 2) RT_LOAD(rp0);
    for (int rp = rp0; rp < M / 2; rp += rstep) {
        const int row = rp * 2, b = row >> 11; const float* mv = mod + b * 6144;
        f32x4 v0[4], v1[4]; float s0 = 0.f, s1 = 0.f;
#pragma unroll
        for (int j = 0; j < 2; ++j) { f32x4 a, c; bf8_to_f32(nd0[j], a, c); v0[2 * j] = nx0[2 * j] + a; v0[2 * j + 1] = nx0[2 * j + 1] + c; bf8_to_f32(nd1[j], a, c); v1[2 * j] = nx1[2 * j] + a; v1[2 * j + 1] = nx1[2 * j + 1] + c;
            s0 += sq4(v0[2 * j]) + sq4(v0[2 * j + 1]); s1 += sq4(v1[2 * j]) + sq4(v1[2 * j + 1]); }
        if (rp + rstep < M / 2) RT_LOAD(rp + rstep);
        const float r0 = 1.0f / sqrtf(wave_sum(s0) * (1.f / D) + 1e-6f), r1 = 1.0f / sqrtf(wave_sum(s1) * (1.f / D) + 1e-6f);
#pragma unroll
        for (int j = 0; j < 2; ++j) { const int c0 = 8 * lane + 512 * j;
            const f32x4 g0 = *(const f32x4*)(P.norm2_g + c0) * (*(const f32x4*)(mv + 4096 + c0) + 1.0f), g1 = *(const f32x4*)(P.norm2_g + c0 + 4) * (*(const f32x4*)(mv + 4096 + c0 + 4) + 1.0f);
            const f32x4 sh0 = *(const f32x4*)(mv + 3072 + c0), sh1 = *(const f32x4*)(mv + 3072 + c0 + 4);
            v0[2 * j] = v0[2 * j] * r0 * g0 + sh0; v0[2 * j + 1] = v0[2 * j + 1] * r0 * g1 + sh1; v1[2 * j] = v1[2 * j] * r1 * g0 + sh0; v1[2 * j + 1] = v1[2 * j + 1] * r1 * g1 + sh1;
            *(u32x4*)(HX2 + (size_t)row * D + c0) = f32_to_bf8(v0[2 * j], v0[2 * j + 1]); *(u32x4*)(HX2 + (size_t)(row + 1) * D + c0) = f32_to_bf8(v1[2 * j], v1[2 * j + 1]); }
        float pa[16], pc[16];
#pragma unroll
        for (int e = 0; e < 16; ++e) { float a = 0.f, c = 0.f;
#pragma unroll
            for (int j = 0; j < 4; ++j) { const f32x4 w = *(const LAS f32x4*)(wt + e * 1024 + 8 * lane + 512 * (j >> 1) + 4 * (j & 1));
                a += dot4(v0[j], w); c += dot4(v1[j], w); }
            pa[e] = a; pc[e] = c;
            if ((e & 1) == 1) __builtin_amdgcn_sched_barrier(0); }
#define RT_HALVE(H, DIST) do { const bool up = (lane & (DIST)) != 0; _Pragma("unroll") for (int i = 0; i < (H); ++i) { \
            const float ka = up ? pa[i + (H)] : pa[i], sa = up ? pa[i] : pa[i + (H)], kc = up ? pc[i + (H)] : pc[i], sc = up ? pc[i] : pc[i + (H)]; \
            pa[i] = ka + __shfl_xor(sa, (DIST)); pc[i] = kc + __shfl_xor(sc, (DIST)); } } while (0)
        RT_HALVE(8, 32); RT_HALVE(4, 16); RT_HALVE(2, 8); RT_HALVE(1, 4);
#undef RT_HALVE
        float l0 = pa[0], l1 = pc[0];
        l0 += __shfl_xor(l0, 2); l1 += __shfl_xor(l1, 2); l0 += __shfl_xor(l0, 1); l1 += __shfl_xor(l1, 1);
        float m0 = l0, m1 = l1;
#pragma unroll
        for (int o = 4; o < 64; o <<= 1) { m0 = fmaxf(m0, __shfl_xor(m0, o)); m1 = fmaxf(m1, __shfl_xor(m1, o)); }
        const float e0 = expf(l0 - m0), e1 = expf(l1 - m1);
        float z0 = e0, z1 = e1;
#pragma unroll
        for (int o = 4; o < 64; o <<= 1) { z0 += __shfl_xor(z0, o); z1 += __shfl_xor(z1, o); }
        if ((lane & 3) == 0) { const int ex = ((lane >> 5) & 1) * 8 + ((lane >> 4) & 1) * 4 + ((lane >> 3) & 1) * 2 + ((lane >> 2) & 1); const int t = row & 2047;
            AFF[(size_t)(b * 16 + ex) * T + t] = e0 / z0; AFF[(size_t)(b * 16 + ex) * T + t + 1] = e1 / z1; }
    }
}

__device__ __forceinline__ int block_count4(bool p0, bool p1, bool p2, bool p3, LAS int* red, int par, int wave, int lane) {
    const int c = __builtin_popcountll(__ballot(p0)) + __builtin_popcountll(__ballot(p1)) + __builtin_popcountll(__ballot(p2)) + __builtin_popcountll(__ballot(p3));
    if (lane == 0) red[par * 8 + wave] = c;
    __syncthreads();
    const LAS int* r = red + par * 8;
    return (r[0] + r[1]) + (r[2] + r[3]) + (r[4] + r[5]) + (r[6] + r[7]);
}
__device__ __forceinline__ int block_excl_prefix(int v, LAS int* red, int wave, int lane, int& total) {
    int inc = v;
#pragma unroll
    for (int o = 1; o < 64; o <<= 1) { const int n = __shfl_up(inc, o); if (lane >= o) inc += n; }
    __syncthreads();
    if (lane == 63) red[wave] = inc;
    __syncthreads();
    int base = 0, tot = 0;
#pragma unroll
    for (int w = 0; w < 8; ++w) { const int s = red[w]; if (w < wave) base += s; tot += s; }
    total = tot; return base + inc - v;
}
__device__ __forceinline__ void ph_topk(const Params& P, LAS unsigned char* lds) {
    const int tid = threadIdx.x, lane = tid & 63, wave = tid >> 6;
    LAS int* red = (LAS int*)lds;
    const float* AFF = (const float*)(P.ws + WS_AFF); int* IDX = (int*)(P.ws + WS_IDX); float* GATE = (float*)(P.ws + WS_GATE); int* SEL = (int*)(P.ws + WS_SEL);
    for (int be = blockIdx.x; be < NBF * 16; be += gridDim.x) {
        const int b = be >> 4, e = be & 15;
        const u32x4 kv = *(const u32x4*)(AFF + (size_t)be * T + tid * 4);
        unsigned thr = 0u;
        for (int bit = 31; bit >= 0; --bit) { const unsigned cand = thr | (1u << bit);
            const int cnt = block_count4(kv.x >= cand, kv.y >= cand, kv.z >= cand, kv.w >= cand, red, bit & 1, wave, lane);
            if (cnt >= CAP) thr = cand; }
        const int ngt = block_count4(kv.x > thr, kv.y > thr, kv.z > thr, kv.w > thr, red, 1, wave, lane);
        const int need = CAP - ngt;
        int tot;
        const int e0 = kv.x == thr, e1 = kv.y == thr, e2 = kv.z == thr, e3 = kv.w == thr;
        const int eqb = block_excl_prefix(e0 + e1 + e2 + e3, red + 32, wave, lane, tot);
        const int s0 = (kv.x > thr) || (e0 && eqb < need), s1 = (kv.y > thr) || (e1 && eqb + e0 < need), s2 = (kv.z > thr) || (e2 && eqb + e0 + e1 < need),
                  s3 = (kv.w > thr) || (e3 && eqb + e0 + e1 + e2 < need);
        const int sb = block_excl_prefix(s0 + s1 + s2 + s3, red + 32, wave, lane, tot);
        const int p0 = sb, p1 = sb + s0, p2 = p1 + s1, p3 = p2 + s2;
        const int t0 = 4 * tid;
        if (s0) { IDX[be * CAP + p0] = t0; GATE[be * CAP + p0] = __uint_as_float(kv.x); }
        if (s1) { IDX[be * CAP + p1] = t0 + 1; GATE[be * CAP + p1] = __uint_as_float(kv.y); }
        if (s2) { IDX[be * CAP + p2] = t0 + 2; GATE[be * CAP + p2] = __uint_as_float(kv.z); }
        if (s3) { IDX[be * CAP + p3] = t0 + 3; GATE[be * CAP + p3] = __uint_as_float(kv.w); }
        SEL[(size_t)(b * T + t0) * 16 + e] = s0 ? p0 : -1; SEL[(size_t)(b * T + t0 + 1) * 16 + e] = s1 ? p1 : -1;
        SEL[(size_t)(b * T + t0 + 2) * 16 + e] = s2 ? p2 : -1; SEL[(size_t)(b * T + t0 + 3) * 16 + e] = s3 ? p3 : -1;
        __syncthreads();
    }
}

struct MoeUpSched {
    int G, c; const char *hx2, *wgu; const int* idx;
    __device__ __forceinline__ bool next(int i, Unit& u) const {
        const int Lx = i * G + c; if (Lx >= NBF * 128) return false;
        const int x = Lx & 7, j = Lx >> 3, e = 2 * x + j / (NBF * 8), jj = j % (NBF * 8), rg = jj >> 5, w = jj & 31;
        const int smp = 8 * (rg >> 1) + (w & 7), pn = 4 * (rg & 1) + (w >> 3), be = smp * 16 + e;
        u.pm = be; u.pn = pn; u.kind = 0; u.aux = e; u.a = hx2 + (size_t)smp * ((size_t)T * 1024 * 2); u.rows = idx + be * CAP; u.b = wgu + ((size_t)e * 2048 + pn * 256) * 2048; return true;
    }
};
struct EpiUp {
    bf16_t* hb;
    __device__ __forceinline__ void operator()(const f32x4 (&acc)[2][2][4][2], const Unit& u, int wr, int wc, int fr, int fq) const {
#pragma unroll
        for (int ai = 0; ai < 2; ++ai)
#pragma unroll
            for (int m = 0; m < 4; ++m) { const int r = u.pm * 256 + 128 * ai + 64 * wr + 16 * m + fr;
                f32x4 h[2];
#pragma unroll
                for (int n = 0; n < 2; ++n)
#pragma unroll
                    for (int j = 0; j < 4; ++j) { const float a = acc[ai][0][m][n][j]; h[n][j] = a * __builtin_amdgcn_rcpf(1.f + __expf(-a)) * acc[ai][1][m][n][j]; }
                u32x4 w; w.x = cvt_pk_bf16(h[0].x, h[0].y); w.y = cvt_pk_bf16(h[0].z, h[0].w); w.z = cvt_pk_bf16(h[1].x, h[1].y); w.w = cvt_pk_bf16(h[1].z, h[1].w);
                *(u32x4*)(hb + (size_t)r * 1024 + u.pn * 128 + 32 * wc + 8 * fq) = w; }
    }
};
__device__ __forceinline__ void ph_moe_up(const Params& P, LAS unsigned char* lds) {
    MoeUpSched S; S.G = gridDim.x; S.c = blockIdx.x; S.hx2 = (const char*)(P.ws + WS_HX2); S.idx = (const int*)(P.ws + WS_IDX); S.wgu = (const char*)(P.ws + WS_WGU);
    EpiUp E; E.hb = (bf16_t*)(P.ob + OB_HB);
    gemm_phase<EpiUp, MoeUpSched, false, true>(lds, 1024, S, E);
}
struct MoeDownSched {
    int G, c; const char *hb, *wd;
    __device__ __forceinline__ bool next(int i, Unit& u) const {
        const int Lx = i * G + c; if (Lx >= NBF * 64) return false;
        const int x = Lx & 7, j = Lx >> 3, e = 2 * x + j / (NBF * 4), jj = j % (NBF * 4), rg = jj >> 5, w = jj & 31;
        const int smp = 8 * rg + (w & 7), pn = w >> 3, be = smp * 16 + e;
        u.pm = be; u.pn = pn; u.kind = 0; u.aux = e; u.rows = nullptr; u.a = hb + (size_t)be * (256 * 1024 * 2); u.b = wd + ((size_t)e * 1024 + pn * 256) * 2048; return true;
    }
};
struct EpiDown {
    const float* gate; bf16_t* ye;
    __device__ __forceinline__ void operator()(const f32x4 (&acc)[2][2][4][2], const Unit& u, int wr, int wc, int fr, int fq) const {
#pragma unroll
        for (int ai = 0; ai < 2; ++ai)
#pragma unroll
            for (int m = 0; m < 4; ++m) { const int r = u.pm * 256 + 128 * ai + 64 * wr + 16 * m + fr; const float gt = gate[r];
#pragma unroll
                for (int bj = 0; bj < 2; ++bj) { const f32x4 v0 = acc[ai][bj][m][0] * gt, v1 = acc[ai][bj][m][1] * gt;
                    u32x4 w; w.x = cvt_pk_bf16(v0.x, v0.y); w.y = cvt_pk_bf16(v0.z, v0.w); w.z = cvt_pk_bf16(v1.x, v1.y); w.w = cvt_pk_bf16(v1.z, v1.w);
                    *(u32x4*)(ye + (size_t)r * 1024 + u.pn * 256 + 128 * bj + 32 * wc + 8 * fq) = w; } }
    }
};
__device__ __forceinline__ void ph_moe_down(const Params& P, LAS unsigned char* lds) {
    MoeDownSched S; S.G = gridDim.x; S.c = blockIdx.x; S.hb = (const char*)(P.ob + OB_HB); S.wd = (const char*)(P.ws + WS_WD);
    EpiDown E; E.gate = (const float*)(P.ws + WS_GATE); E.ye = (bf16_t*)(P.ws + WS_YE);
    gemm_phase<EpiDown, MoeDownSched, false>(lds, 1024, S, E);
}

__device__ __forceinline__ void ph_final(const Params& P) {
    const int lane = threadIdx.x & 63, wave = threadIdx.x >> 6;
    const bf16_t* DL = (const bf16_t*)(P.ws + WS_DL); const float* mod = (const float*)(P.ws + WS_MOD); const int* SEL = (const int*)(P.ws + WS_SEL); const bf16_t* YE = (const bf16_t*)(P.ws + WS_YE);
    constexpr int NR = 2;
    for (int row0 = (blockIdx.x * 8 + wave) * NR; row0 < M; row0 += gridDim.x * 8 * NR) {
        const int b = row0 >> 11;
        int sv[NR]; f32x4 xv[NR][4]; u32x4 dv[NR][2];
#pragma unroll
        for (int r = 0; r < NR; ++r) { sv[r] = SEL[(size_t)(row0 + r) * 16 + (lane & 15)];
#pragma unroll
            for (int j = 0; j < 2; ++j) { const size_t o = (size_t)(row0 + r) * D + 8 * lane + 512 * j; xv[r][2 * j] = *(const f32x4*)(P.x + o); xv[r][2 * j + 1] = *(const f32x4*)(P.x + o + 4); dv[r][j] = *(const u32x4*)(DL + o); } }
        f32x4 mo[NR][4];
#pragma unroll
        for (int r = 0; r < NR; ++r)
#pragma unroll
            for (int j = 0; j < 4; ++j) mo[r][j] = (f32x4){0.f, 0.f, 0.f, 0.f};
#pragma unroll
        for (int e = 0; e < 16; ++e) {
#pragma unroll
            for (int r = 0; r < NR; ++r) { const int sl = __builtin_amdgcn_readlane(sv[r], e);
                if (sl >= 0) { const bf16_t* yr = YE + ((size_t)(b * 16 + e) * CAP + sl) * D + 8 * lane;
#pragma unroll
                    for (int j = 0; j < 2; ++j) { f32x4 a, c; bf8_to_f32(*(const u32x4*)(yr + 512 * j), a, c); mo[r][2 * j] += a; mo[r][2 * j + 1] += c; } } } }
#pragma unroll
        for (int r = 0; r < NR; ++r) { float ss = 0.f; f32x4 v[4];
#pragma unroll
            for (int j = 0; j < 2; ++j) { const int c0 = 8 * lane + 512 * j; f32x4 a, c; bf8_to_f32(dv[r][j], a, c);
                v[2 * j] = xv[r][2 * j] + a + *(const f32x4*)(mod + b * 6144 + 5120 + c0) * mo[r][2 * j]; v[2 * j + 1] = xv[r][2 * j + 1] + c + *(const f32x4*)(mod + b * 6144 + 5120 + c0 + 4) * mo[r][2 * j + 1];
                ss += sq4(v[2 * j]) + sq4(v[2 * j + 1]); }
            const float rs = 1.0f / sqrtf(wave_sum(ss) * (1.f / D) + 1e-6f);
#pragma unroll
            for (int j = 0; j < 2; ++j) { const int c0 = 8 * lane + 512 * j;
                *(f32x4*)(P.out + (size_t)(row0 + r) * D + c0) = v[2 * j] * rs * *(const f32x4*)(P.fg + c0); *(f32x4*)(P.out + (size_t)(row0 + r) * D + c0 + 4) = v[2 * j + 1] * rs * *(const f32x4*)(P.fg + c0 + 4); } }
    }
}

#define XB_TMO      128
#define XB_XCNT(j)  (256  + 64 * (j))
#define XB_XSUB(j)  (1280 + 64 * (j))
#define XB_XGEN(j)  (2304 + 64 * (j))
#define XB_TOP      3328
#define XB_TOPGEN   3392
#define XCD_BAR_WORDS 3456
#define XB_SPIN_CAP (1u << 20)
__device__ __forceinline__ unsigned xb_ld(unsigned* p)              { return __hip_atomic_load(p, __ATOMIC_RELAXED, __HIP_MEMORY_SCOPE_AGENT); }
__device__ __forceinline__ unsigned xb_add(unsigned* p, unsigned v) { return __hip_atomic_fetch_add(p, v, __ATOMIC_RELAXED, __HIP_MEMORY_SCOPE_AGENT); }
__device__ __forceinline__ unsigned xb_xcc_id() { return (unsigned)__builtin_amdgcn_s_getreg((3 << 11) | 20) & 0xFu; }
#define XB_SPIN(cond, bar) do { unsigned _sp = 0; while (cond) { __builtin_amdgcn_s_sleep(1); \
    if ((++_sp & 255u) == 0u) { if (xb_ld(&(bar)[XB_TMO])) break; if (_sp > XB_SPIN_CAP) { atomicAdd(&(bar)[XB_TMO], 1u); break; } } } } while (0)
struct XcdBarrier { unsigned* bar; unsigned x; volatile LAS unsigned* st; };
__device__ __forceinline__ XcdBarrier xcd_barrier_post(unsigned* bar, volatile LAS unsigned* st) {
    XcdBarrier b; b.bar = bar; b.x = xb_xcc_id(); b.st = st;
    if (threadIdx.x == 0) (void)xb_add(&bar[XB_XCNT(b.x)], 1u);
    return b;
}
__device__ __forceinline__ void xcd_barrier_complete(unsigned* bar, unsigned x, unsigned& nloc, unsigned& nx) {
    const unsigned G = gridDim.x * gridDim.y * gridDim.z;
    unsigned sum, cnt, mine, sp = 0u;
    for (;;) {
        sum = 0u; cnt = 0u; mine = 0u;
#pragma unroll
        for (unsigned j = 0; j < 16; ++j) { const unsigned c = xb_ld(&bar[XB_XCNT(j)]); sum += c; cnt += (c > 0u) ? 1u : 0u; mine = (j == x) ? c : mine; }
        if (sum == G) break;
        __builtin_amdgcn_s_sleep(1);
        if ((++sp & 255u) == 0u) { if (xb_ld(&bar[XB_TMO])) break; if (sp > XB_SPIN_CAP) { atomicAdd(&bar[XB_TMO], 1u); break; } }
    }
    nloc = mine > 0u ? mine : 1u; nx = cnt > 0u ? cnt : 1u;
}
__device__ __attribute__((noinline)) void xcd_barrier(const XcdBarrier b) {
    asm volatile("s_waitcnt vmcnt(0)" ::: "memory");
    __syncthreads();
    if (threadIdx.x == 0) {
        unsigned* bar = b.bar;
        __builtin_amdgcn_s_waitcnt(0);
        unsigned nloc = b.st[0], nx = b.st[1];
        if (nloc == 0u) { xcd_barrier_complete(bar, b.x, nloc, nx); b.st[0] = nloc; b.st[1] = nx; }
        const unsigned old = xb_add(&bar[XB_XSUB(b.x)], 1u);
        const unsigned gen = old / nloc;
        if (old + 1u == (gen + 1u) * nloc) {
            __builtin_amdgcn_fence(__ATOMIC_RELEASE, "agent");
            asm volatile("s_waitcnt vmcnt(0)" ::: "memory");
            const unsigned og = xb_add(&bar[XB_TOP], 1u);
            const unsigned tg = og / nx;
            if (og + 1u == (tg + 1u) * nx) xb_add(&bar[XB_TOPGEN], 1u);
            else XB_SPIN(xb_ld(&bar[XB_TOPGEN]) == tg, bar);
            __builtin_amdgcn_fence(__ATOMIC_ACQUIRE, "agent");
            xb_add(&bar[XB_XGEN(b.x)], 1u);
            asm volatile("s_waitcnt vmcnt(0)" ::: "memory");
        } else {
            XB_SPIN(xb_ld(&bar[XB_XGEN(b.x)]) == gen, bar);
            __builtin_amdgcn_fence(__ATOMIC_ACQUIRE, "agent");
            asm volatile("s_waitcnt vmcnt(0)" ::: "memory");
        }
    }
    __syncthreads();
}


#ifdef FK_COPYPROBE
#ifndef FK_COPYMODE
#define FK_COPYMODE 0
#endif
__device__ __forceinline__ void ph_copyprobe(const Params& P) {
    const int lane = threadIdx.x & 63, wave = threadIdx.x >> 6;
    const u32x4* src = (const u32x4*)P.wg; u32x4* dst = (u32x4*)(P.ws + WS_AO);
    const size_t nchunk = (size_t)16 * 1024 * 1024 * 4 / 4096;
    constexpr int CH = FK_COPYMODE == 1 ? 12 : 4;
    constexpr int NJ = (FK_COPYMODE == 2 || FK_COPYMODE == 3) ? 1 : 4;
    constexpr int CSTR = FK_COPYMODE == 3 ? 4 : 1;
#if FK_COPYMODE == 7
    return;
#endif
#if FK_COPYMODE == 5 || FK_COPYMODE == 6
    u32x4 acc4 = {0u, 0u, 0u, 0u};
    for (size_t c0 = (size_t)(blockIdx.x * 8 + wave) * CH; c0 < nchunk; c0 += (size_t)gridDim.x * 8 * CH) {
#pragma unroll
        for (int r = 0; r < CH; ++r)
#pragma unroll
            for (int j = 0; j < NJ; ++j) { const size_t c = c0 + r < nchunk ? c0 + r : nchunk - 1;
                if (FK_COPYMODE == 5) { const u32x4 t = src[c * 256 + lane + 64 * j]; acc4.x ^= t.x; acc4.y ^= t.y; acc4.z ^= t.z; acc4.w ^= t.w; }
                else dst[c * 256 + lane + 64 * j] = (u32x4){(unsigned)c, 1u, 2u, 3u}; }
    }
    if (FK_COPYMODE == 5) dst[(size_t)(blockIdx.x * 8 + wave) * 64 + lane] = acc4;
    return;
#endif
#if FK_COPYMODE == 4
    const size_t per = nchunk / ((size_t)gridDim.x * 8), cbeg = (size_t)(blockIdx.x * 8 + wave) * per;
    for (size_t c0 = cbeg; c0 < cbeg + per; c0 += CH) {
#else
    for (size_t c0 = (size_t)(blockIdx.x * 8 + wave) * CH; c0 < nchunk; c0 += (size_t)gridDim.x * 8 * CH) {
#endif
        u32x4 v[CH][NJ];
#pragma unroll
        for (int r = 0; r < CH; ++r)
#pragma unroll
            for (int j = 0; j < NJ; ++j) { const size_t c = c0 + r < nchunk ? c0 + r : nchunk - 1; v[r][j] = src[(c / CSTR * CSTR) * 256 + lane + 64 * j]; }
#pragma unroll
        for (int r = 0; r < CH; ++r)
#pragma unroll
            for (int j = 0; j < NJ; ++j) { const size_t c = c0 + r < nchunk ? c0 + r : nchunk - 1; dst[(c / CSTR * CSTR) * 256 + lane + 64 * j] = v[r][j]; }
    }
}
#endif
constexpr int NPHASE = 11;
constexpr size_t CTL_ZERO_BYTES = 16384;
#ifndef FK_MASK
#define FK_MASK 0x7ff
#endif
#ifndef FK_CGSYNC
#define FK_CGSYNC 0
#endif
__global__ void __launch_bounds__(512, 2) mega(Params P) {
    extern __shared__ __attribute__((aligned(16))) unsigned char lds_raw[];
    LAS unsigned char* lds = (LAS unsigned char*)lds_raw;
    cg::grid_group grid = cg::this_grid();
    volatile LAS unsigned* misc = (volatile LAS unsigned*)(lds + LDS_MISC);
    if (threadIdx.x < 2) misc[threadIdx.x] = 0u;
    __syncthreads();
    const XcdBarrier bar = xcd_barrier_post((unsigned*)(P.ws + WS_CTL), misc);
    const int lo = P.ph_lo, hi = P.ph_hi;
    if (lo < 0) grid.sync();
#define FK_SYNC(k) do { if ((k) < FK_CGSYNC) grid.sync(); else xcd_barrier(bar); } while (0)
    typedef const __attribute__((address_space(4))) Params* KArgPtr;
#if defined(__HIP_DEVICE_COMPILE__)
#define FK_ARGS(name) KArgPtr kp_##name = (KArgPtr)__builtin_amdgcn_kernarg_segment_ptr(); asm volatile("" : "+s"(kp_##name)); const Params name = *(const Params*)kp_##name
#else
#define FK_ARGS(name) const Params name = P
#endif
#define FK_PH(k, call) if (((FK_MASK >> (k)) & 1) && lo <= (k) && (k) < hi) { { FK_ARGS(L); call; } if ((FK_DBL >> (k)) & 1) { FK_SYNC(k); { FK_ARGS(L); call; } } if ((k) + 1 < hi) FK_SYNC(k); }
    FK_PH(0, ph_prep(L, lds))
#ifdef FK_COPYPROBE
    for (int rep = 0; rep < FK_COPYPROBE; ++rep) { { FK_ARGS(L); ph_copyprobe(L); } xcd_barrier(bar); }
#endif
    FK_PH(1, ph_norm1(L, lds))
    FK_PH(2, ph_inproj(L, lds))
    FK_PH(3, ph_mix(L, lds))
    FK_PH(4, ph_proj(L, lds))
    FK_PH(5, ph_out(L, lds))
    FK_PH(6, ph_router(L, lds))
    FK_PH(7, ph_topk(L, lds))
    FK_PH(8, ph_moe_up(L, lds))
    FK_PH(9, ph_moe_down(L, lds))
    FK_PH(10, ph_final(L))
#undef FK_ARGS
#undef FK_PH
#undef FK_SYNC
}
}
static void fk_launch(fk::Params p, int lo, int hi, hipStream_t stream);
#if HYB >= 0
#include <hip/hip_runtime.h>

namespace nv {
constexpr int D = 1024, T = 2048, L = 256, NB = 16, INW = 6656, NE = 16, CAP = 256;

__global__ void k_mod(const float* __restrict__ c, const float* __restrict__ c_ctx, const float* __restrict__ w_mod,
                      const float* __restrict__ b_mod, float* __restrict__ mod) {
    const int n = blockIdx.x * 256 + threadIdx.x, r = blockIdx.y;
    const float* cv = r < 16 ? c + r * 1024 : c_ctx;
    float acc = 0.f;
    for (int k = 0; k < 1024; ++k) { const float v = cv[k]; const float s = v / (1.f + expf(-v)); acc += s * w_mod[(size_t)k * 6144 + n]; }
    mod[r * 6144 + n] = acc + b_mod[n];
}

__device__ __forceinline__ float block_sum256(float v, float* red) {
#pragma unroll
    for (int o = 32; o > 0; o >>= 1) v += __shfl_xor(v, o);
    __syncthreads();
    if ((threadIdx.x & 63) == 0) red[threadIdx.x >> 6] = v;
    __syncthreads();
    return red[0] + red[1] + red[2] + red[3];
}

__global__ void k_norm_mod(const float* __restrict__ x, const float* __restrict__ g, const float* __restrict__ shift,
                           const float* __restrict__ scale, float* __restrict__ out) {
    __shared__ float red[4];
    const int row = blockIdx.x, t = threadIdx.x;
    const float* xr = x + (size_t)row * D;
    float v[4]; float ss = 0.f;
#pragma unroll
    for (int j = 0; j < 4; ++j) { v[j] = xr[t + 256 * j]; ss += v[j] * v[j]; }
    const float tot = block_sum256(ss, red);
    const float rs = 1.0f / sqrtf(tot * (1.f / D) + 1e-6f);
#pragma unroll
    for (int j = 0; j < 4; ++j) { const int cidx = t + 256 * j; out[(size_t)row * D + cidx] = v[j] * rs * g[cidx] * (1.f + scale[cidx]) + shift[cidx]; }
}

__global__ __launch_bounds__(256) void k_sgemm(const float* __restrict__ A, int lda, const int* __restrict__ rows, long sA, long sRows,
                                               const float* __restrict__ B, int ldb, long sB, float* __restrict__ C, int ldc, long sC, int K) {
    __shared__ float As[16][65];
    __shared__ float Bs[16][64];
    const int z = blockIdx.z;
    A += (size_t)z * sA; B += (size_t)z * sB; C += (size_t)z * sC; if (rows) rows += (size_t)z * sRows;
    const int tx = threadIdx.x & 15, ty = threadIdx.x >> 4;
    const int m0 = blockIdx.y * 64, n0 = blockIdx.x * 64;
    float acc[4][4];
#pragma unroll
    for (int i = 0; i < 4; ++i)
#pragma unroll
        for (int j = 0; j < 4; ++j) acc[i][j] = 0.f;
    for (int k0 = 0; k0 < K; k0 += 16) {
#pragma unroll
        for (int ii = 0; ii < 4; ++ii) { const int i = threadIdx.x + 256 * ii; const int r = i >> 4, kk = i & 15; const int row = m0 + r; const int src = rows ? rows[row] : row;
            As[kk][r] = A[(size_t)src * lda + k0 + kk]; }
#pragma unroll
        for (int ii = 0; ii < 4; ++ii) { const int i = threadIdx.x + 256 * ii; const int kk = i >> 6, cc = i & 63; Bs[kk][cc] = B[(size_t)(k0 + kk) * ldb + n0 + cc]; }
        __syncthreads();
#pragma unroll
        for (int kk = 0; kk < 16; ++kk) {
            float a[4], b[4];
#pragma unroll
            for (int i = 0; i < 4; ++i) a[i] = As[kk][ty * 4 + i];
#pragma unroll
            for (int j = 0; j < 4; ++j) b[j] = Bs[kk][tx * 4 + j];
#pragma unroll
            for (int i = 0; i < 4; ++i)
#pragma unroll
                for (int j = 0; j < 4; ++j) acc[i][j] += a[i] * b[j];
        }
        __syncthreads();
    }
#pragma unroll
    for (int i = 0; i < 4; ++i)
#pragma unroll
        for (int j = 0; j < 4; ++j) C[(size_t)(m0 + ty * 4 + i) * ldc + n0 + tx * 4 + j] = acc[i][j];
}

__global__ void k_rope(float* __restrict__ P) {
    const int gid = blockIdx.x * 256 + threadIdx.x;
    const int pr = gid & 31, hs = (gid >> 5) % 20, t = gid / (32 * 20);
    if (t >= T) return;
    const int half = pr >> 4, i = pr & 15;
    const float pos = half == 0 ? (float)(t / 64) : (float)(t % 64);
    const float inv_freq = powf(10000.f, -(float)i / 16.f);
    const float ang = pos * inv_freq;
    const float cs = cosf(ang), sn = sinf(ang);
    float* p = P + (size_t)t * INW + hs * 64 + half * 32 + i;
    const float x1 = p[0], x2 = p[16];
    p[0] = x1 * cs - x2 * sn;
    p[16] = x2 * cs + x1 * sn;
}

__global__ __launch_bounds__(64) void k_attn(const float* __restrict__ P, const float* __restrict__ kvc, const float* __restrict__ sink, float* __restrict__ o) {
    __shared__ float qs[64];
    __shared__ float sc[257 + 256];
    const int t = blockIdx.x, h = blockIdx.y, hkv = h >> 2, d = threadIdx.x;
    qs[d] = P[(size_t)t * INW + h * 64 + d];
    __syncthreads();
    const int lo = t - 128 < 0 ? 0 : t - 128, hi = t + 128 > T - 1 ? T - 1 : t + 128, nw = hi - lo + 1, ntot = nw + L;
    for (int j = d; j < ntot; j += 64) {
        const float* kp = j < nw ? P + (size_t)(lo + j) * INW + 1024 + hkv * 64 : kvc + (size_t)(j - nw) * 512 + hkv * 64;
        float s = 0.f;
        for (int dd = 0; dd < 64; ++dd) s += qs[dd] * kp[dd];
        sc[j] = s * 0.125f;
    }
    __syncthreads();
    const float sk = sink[h];
    float m = sk;
    for (int j = d; j < ntot; j += 64) m = fmaxf(m, sc[j]);
#pragma unroll
    for (int off = 32; off > 0; off >>= 1) m = fmaxf(m, __shfl_xor(m, off));
    float l = 0.f;
    for (int j = d; j < ntot; j += 64) { const float p = expf(sc[j] - m); sc[j] = p; l += p; }
#pragma unroll
    for (int off = 32; off > 0; off >>= 1) l += __shfl_xor(l, off);
    l += expf(sk - m);
    __syncthreads();
    float acc = 0.f;
    for (int j = 0; j < ntot; ++j) {
        const float* vp = j < nw ? P + (size_t)(lo + j) * INW + 1280 + hkv * 64 : kvc + (size_t)(j - nw) * 512 + 256 + hkv * 64;
        acc += sc[j] * vp[d];
    }
    o[(size_t)t * D + h * 64 + d] = acc / l;
}

__global__ void k_conv(const float* __restrict__ P, const float* __restrict__ cw, float* __restrict__ y) {
    const int gid = blockIdx.x * 256 + threadIdx.x; const int ch = gid & 1023, t = gid >> 10;
    const float* pr = P + (size_t)t * INW;
    const float z1 = pr[3584 + ch] * pr[1536 + ch];
    const float z0 = t > 0 ? pr[3584 + ch - INW] * pr[1536 + ch - INW] : 0.f;
    const float z2 = t < T - 1 ? pr[3584 + ch + INW] * pr[1536 + ch + INW] : 0.f;
    y[gid] = pr[2560 + ch] * (cw[ch] * z0 + cw[1024 + ch] * z1 + cw[2048 + ch] * z2);
}

__global__ void k_merge(const float* __restrict__ P, float* __restrict__ a, const float* __restrict__ s) {
    const int gid = blockIdx.x * 256 + threadIdx.x; const int ch = gid & 1023, t = gid >> 10;
    const float ga = P[(size_t)t * INW + 4608 + ch], gc = P[(size_t)t * INW + 5632 + ch];
    a[gid] = a[gid] / (1.f + expf(-ga)) + s[gid] / (1.f + expf(-gc));
}

__global__ void k_resid(const float* __restrict__ x, const float* __restrict__ g, const float* __restrict__ o, float* __restrict__ x1) {
    const int gid = blockIdx.x * 256 + threadIdx.x; const int ch = gid & 1023;
    x1[gid] = x[gid] + g[ch] * o[gid];
}

__global__ void k_router(const float* __restrict__ x1, const float* __restrict__ g, const float* __restrict__ shift, const float* __restrict__ scale,
                         const float* __restrict__ w_router, float* __restrict__ hx2, float* __restrict__ aff) {
    __shared__ float red[4];
    __shared__ float lg[16];
    const int row = blockIdx.x, t = threadIdx.x;
    const float* xr = x1 + (size_t)row * D;
    float v[4]; float ss = 0.f;
#pragma unroll
    for (int j = 0; j < 4; ++j) { v[j] = xr[t + 256 * j]; ss += v[j] * v[j]; }
    const float tot = block_sum256(ss, red);
    const float rs = 1.0f / sqrtf(tot * (1.f / D) + 1e-6f);
#pragma unroll
    for (int j = 0; j < 4; ++j) { const int cidx = t + 256 * j; v[j] = v[j] * rs * g[cidx] * (1.f + scale[cidx]) + shift[cidx]; hx2[(size_t)row * D + cidx] = v[j]; }
    for (int e = 0; e < 16; ++e) {
        float p = 0.f;
#pragma unroll
        for (int j = 0; j < 4; ++j) p += v[j] * w_router[(size_t)(t + 256 * j) * 16 + e];
        const float s = block_sum256(p, red);
        if (t == 0) lg[e] = s;
    }
    __syncthreads();
    if (t < 16) {
        float m = lg[0];
        for (int e = 1; e < 16; ++e) m = fmaxf(m, lg[e]);
        float sum = 0.f;
        for (int e = 0; e < 16; ++e) sum += expf(lg[e] - m);
        aff[(size_t)t * T + row] = expf(lg[t] - m) / sum;
    }
}

__global__ void k_topk(const float* __restrict__ aff, int* __restrict__ idx, float* __restrict__ gate, int* __restrict__ sel) {
    __shared__ float a[T];
    const int e = blockIdx.x;
    for (int i = threadIdx.x; i < T; i += 256) a[i] = aff[(size_t)e * T + i];
    __syncthreads();
    for (int i = threadIdx.x; i < T; i += 256) {
        const float v = a[i]; int rank = 0;
        for (int j = 0; j < T; ++j) { const float w = a[j]; rank += (w > v || (w == v && j < i)) ? 1 : 0; }
        if (rank < CAP) { idx[e * CAP + rank] = i; gate[e * CAP + rank] = v; sel[i * 16 + e] = rank; }
        else sel[i * 16 + e] = -1;
    }
}

__global__ void k_silu_mul(float* __restrict__ a, const float* __restrict__ u) {
    const size_t gid = (size_t)blockIdx.x * 256 + threadIdx.x;
    const float v = a[gid];
    a[gid] = v / (1.f + expf(-v)) * u[gid];
}

__global__ void k_combine(const float* __restrict__ x1, const float* __restrict__ g2, const float* __restrict__ ye, const float* __restrict__ gate,
                          const int* __restrict__ sel, const float* __restrict__ fg, float* __restrict__ out) {
    __shared__ float red[4];
    const int row = blockIdx.x, t = threadIdx.x;
    float m[4] = {0.f, 0.f, 0.f, 0.f};
    for (int e = 0; e < 16; ++e) {
        const int s = sel[row * 16 + e];
        if (s >= 0) { const float gt = gate[e * CAP + s]; const float* yr = ye + ((size_t)e * CAP + s) * D;
#pragma unroll
            for (int j = 0; j < 4; ++j) m[j] += gt * yr[t + 256 * j]; }
    }
    float v[4]; float ss = 0.f;
#pragma unroll
    for (int j = 0; j < 4; ++j) { const int cidx = t + 256 * j; v[j] = x1[(size_t)row * D + cidx] + g2[cidx] * m[j]; ss += v[j] * v[j]; }
    const float tot = block_sum256(ss, red);
    const float rs = 1.0f / sqrtf(tot * (1.f / D) + 1e-6f);
#pragma unroll
    for (int j = 0; j < 4; ++j) { const int cidx = t + 256 * j; out[(size_t)row * D + cidx] = v[j] * rs * fg[cidx]; }
}

struct Inputs {
    const float *x, *c, *ctx, *c_ctx, *w_mod, *b_mod, *norm1_g, *w_in, *sink, *conv_w, *wpa, *wpc, *wo, *norm2_g, *w_router, *wg, *wu, *wd, *fg;
};
struct Scratch {
    float *mod, *hx, *hc, *P, *kvc, *oat, *yc, *a, *s, *o1, *x1, *hx2, *aff, *gate, *ea, *eu, *ye; int *idx, *sel;
};
inline size_t carve(Scratch& S, char* base) {
    size_t off = 0;
    auto take = [&](size_t bytes) { char* p = base + off; off += (bytes + 255) & ~(size_t)255; return p; };
    S.mod = (float*)take(17 * 6144 * 4);
    S.hx = (float*)take((size_t)T * D * 4); S.hc = (float*)take((size_t)L * D * 4);
    S.P = (float*)take((size_t)T * INW * 4); S.kvc = (float*)take((size_t)L * 512 * 4);
    S.oat = (float*)take((size_t)T * D * 4); S.yc = (float*)take((size_t)T * D * 4);
    S.a = (float*)take((size_t)T * D * 4); S.s = (float*)take((size_t)T * D * 4); S.o1 = (float*)take((size_t)T * D * 4);
    S.x1 = (float*)take((size_t)T * D * 4); S.hx2 = (float*)take((size_t)T * D * 4);
    S.aff = (float*)take((size_t)NE * T * 4); S.gate = (float*)take(NE * CAP * 4); S.idx = (int*)take(NE * CAP * 4); S.sel = (int*)take((size_t)T * 16 * 4);
    S.ea = S.P; S.eu = S.P + (size_t)NE * CAP * D; S.ye = S.P + (size_t)2 * NE * CAP * D;
    return off;
}

inline void run_mod(const Inputs& I, const Scratch& S, hipStream_t st) { k_mod<<<dim3(24, 17), 256, 0, st>>>(I.c, I.c_ctx, I.w_mod, I.b_mod, S.mod); }
inline void s1a_norm(const Inputs& I, const Scratch& S, int b, hipStream_t st) {
    const float* mb = S.mod + b * 6144; const float* mc = S.mod + 16 * 6144;
    k_norm_mod<<<T, 256, 0, st>>>(I.x + (size_t)b * T * D, I.norm1_g, mb, mb + 1024, S.hx);
    k_norm_mod<<<L, 256, 0, st>>>(I.ctx + (size_t)b * L * D, I.norm1_g, mc, mc + 1024, S.hc);
}
inline void s1b_gemm(const Inputs& I, const Scratch& S, int b, hipStream_t st) {
    k_sgemm<<<dim3(INW / 64, T / 64, 1), 256, 0, st>>>(S.hx, D, nullptr, 0, 0, I.w_in, INW, 0, S.P, INW, 0, D);
    k_sgemm<<<dim3(512 / 64, L / 64, 1), 256, 0, st>>>(S.hc, D, nullptr, 0, 0, I.w_in + 1024, INW, 0, S.kvc, 512, 0, D);
    k_rope<<<T * 20 * 32 / 256, 256, 0, st>>>(S.P);
}
inline void s2_mix(const Inputs& I, const Scratch& S, int b, hipStream_t st) {
    k_attn<<<dim3(T, 16), 64, 0, st>>>(S.P, S.kvc, I.sink, S.oat);
    k_conv<<<T * D / 256, 256, 0, st>>>(S.P, I.conv_w, S.yc);
}
inline void s3_merge(const Inputs& I, const Scratch& S, int b, hipStream_t st) {
    k_sgemm<<<dim3(D / 64, T / 64, 1), 256, 0, st>>>(S.oat, D, nullptr, 0, 0, I.wpa, D, 0, S.a, D, 0, D);
    k_sgemm<<<dim3(D / 64, T / 64, 1), 256, 0, st>>>(S.yc, D, nullptr, 0, 0, I.wpc, D, 0, S.s, D, 0, D);
    k_merge<<<T * D / 256, 256, 0, st>>>(S.P, S.a, S.s);
}
inline void s4_out(const Inputs& I, const Scratch& S, int b, hipStream_t st) {
    k_sgemm<<<dim3(D / 64, T / 64, 1), 256, 0, st>>>(S.a, D, nullptr, 0, 0, I.wo, D, 0, S.o1, D, 0, D);
    k_resid<<<T * D / 256, 256, 0, st>>>(I.x + (size_t)b * T * D, S.mod + b * 6144 + 2048, S.o1, S.x1);
}
inline void s5_router(const Inputs& I, const Scratch& S, int b, hipStream_t st) {
    const float* mb = S.mod + b * 6144;
    k_router<<<T, 256, 0, st>>>(S.x1, I.norm2_g, mb + 3072, mb + 4096, I.w_router, S.hx2, S.aff);
}
inline void s6_topk(const Inputs& I, const Scratch& S, int b, hipStream_t st) { k_topk<<<NE, 256, 0, st>>>(S.aff, S.idx, S.gate, S.sel); }
inline void s7_up(const Inputs& I, const Scratch& S, int b, hipStream_t st) {
    k_sgemm<<<dim3(D / 64, CAP / 64, NE), 256, 0, st>>>(S.hx2, D, S.idx, 0, CAP, I.wg, D, (long)D * D, S.ea, D, (long)CAP * D, D);
    k_sgemm<<<dim3(D / 64, CAP / 64, NE), 256, 0, st>>>(S.hx2, D, S.idx, 0, CAP, I.wu, D, (long)D * D, S.eu, D, (long)CAP * D, D);
    k_silu_mul<<<NE * CAP * D / 256, 256, 0, st>>>(S.ea, S.eu);
}
inline void s8_down(const Inputs& I, const Scratch& S, int b, hipStream_t st) {
    k_sgemm<<<dim3(D / 64, CAP / 64, NE), 256, 0, st>>>(S.ea, D, nullptr, (long)CAP * D, 0, I.wd, D, (long)D * D, S.ye, D, (long)CAP * D, D);
}
inline void s9_final(const Inputs& I, const Scratch& S, int b, float* out, hipStream_t st) {
    k_combine<<<T, 256, 0, st>>>(S.x1, S.mod + b * 6144 + 5120, S.ye, S.gate, S.sel, I.fg, out + (size_t)b * T * D);
}
}
namespace hyb {
using fk::bf16_t;
__device__ __forceinline__ float bf2f(bf16_t v) { return __uint_as_float((unsigned)v << 16); }
__global__ void k_cv_bf16(const bf16_t* __restrict__ src, size_t spitch, float* __restrict__ dst, int cols, size_t n) {
    const size_t gid = (size_t)blockIdx.x * 256 + threadIdx.x; if (gid >= n) return;
    const size_t r = gid / cols; const int c = (int)(gid % cols);
    dst[gid] = bf2f(src[r * spitch + c]);
}
__global__ void k_copy_f32(const float* __restrict__ src, float* __restrict__ dst, size_t n) { const size_t gid = (size_t)blockIdx.x * 256 + threadIdx.x; if (gid < n) dst[gid] = src[gid]; }
__global__ void k_copy_i32(const int* __restrict__ src, int* __restrict__ dst, size_t n) { const size_t gid = (size_t)blockIdx.x * 256 + threadIdx.x; if (gid < n) dst[gid] = src[gid]; }
__global__ void k_fill_f32(float* __restrict__ dst, float v, size_t n) { const size_t gid = (size_t)blockIdx.x * 256 + threadIdx.x; if (gid < n) dst[gid] = v; }
__device__ __forceinline__ float logit_(float p) { return p >= 1.f ? 30.f : (p <= 0.f ? -30.f : logf(p / (1.f - p))); }
__global__ void k_cv_P(const unsigned char* __restrict__ ws, const unsigned char* __restrict__ ob, int b, float* __restrict__ Pn) {
    const size_t gid = (size_t)blockIdx.x * 256 + threadIdx.x; if (gid >= (size_t)2048 * 6656) return;
    const int t = (int)(gid / 6656), col = (int)(gid % 6656); const size_t row = (size_t)b * 2048 + t;
    float v;
    if (col < 1024) v = bf2f(((const bf16_t*)(ws + fk::WS_Q))[row * 1024 + col]) / fk::C2;
    else if (col < 1280) { const int hkv = (col - 1024) >> 6, d = col & 63; const size_t blk = (size_t)((b * 4 + hkv) * 32 + (t >> 6));
        v = bf2f(*(const bf16_t*)(ws + fk::WS_KB + blk * 8192 + (d >> 3) * 1024 + (t & 63) * 16 + (d & 7) * 2)); }
    else if (col < 1536) { const int hkv = (col - 1280) >> 6, d = col & 63; const size_t blk = (size_t)((b * 4 + hkv) * 32 + (t >> 6));
        const int kk = t & 63, s = kk >> 4, w = kk & 15, h = (w >> 2) & 1, e = w >> 3, jj = w & 3;
        v = bf2f(*(const bf16_t*)(ws + fk::WS_VB + blk * 8192 + (2 * s + h) * 1024 + d * 16 + 8 * e + 2 * jj)); }
    else if (col < 2560) v = bf2f(((const bf16_t*)(ws + fk::WS_Z))[row * 1024 + col - 1536]);
    else if (col < 3584) v = bf2f(((const bf16_t*)(ws + fk::WS_BB))[row * 1024 + col - 2560]);
    else if (col < 4608) v = 1.f;
    else { const int ch = col < 5632 ? col - 4608 : col - 5632;
        const float r = bf2f(((const bf16_t*)(ob + fk::OB_RB))[row * 1024 + ch]), sg = bf2f(((const bf16_t*)(ob + fk::OB_SGC))[row * 1024 + ch]);
        v = col < 5632 ? logit_(r * sg) : logit_(sg); }
    Pn[gid] = v;
}
__global__ void k_cv_kvc(const unsigned char* __restrict__ ws, int b, float* __restrict__ kvc) {
    const int gid = blockIdx.x * 256 + threadIdx.x; if (gid >= 256 * 512) return;
    const int l = gid >> 9, col = gid & 511;
    if (col < 256) { const int hkv = col >> 6, d = col & 63; const size_t blk = (size_t)((b * 4 + hkv) * 4 + (l >> 6));
        kvc[gid] = bf2f(*(const bf16_t*)(ws + fk::WS_KCB + blk * 8192 + (d >> 3) * 1024 + (l & 63) * 16 + (d & 7) * 2)); }
    else { const int hkv = (col - 256) >> 6, d = col & 63; const size_t blk = (size_t)((b * 4 + hkv) * 4 + (l >> 6));
        const int kk = l & 63, s = kk >> 4, w = kk & 15, h = (w >> 2) & 1, e = w >> 3, jj = w & 3;
        kvc[gid] = bf2f(*(const bf16_t*)(ws + fk::WS_VCB + blk * 8192 + (2 * s + h) * 1024 + d * 16 + 8 * e + 2 * jj)); }
}
inline unsigned nblk(size_t n) { return (unsigned)((n + 255) / 256); }

inline void run(fk::Params p, void* const* d_in, float* out, char* nbase, size_t nbytes, hipStream_t st) {
    nv::Inputs I; const float** ip = (const float**)&I; for (int i = 0; i < 19; ++i) ip[i] = (const float*)d_in[i];
    nv::Scratch S; const size_t need = nv::carve(S, nbase);
    if (need > nbytes) { fprintf(stderr, "hybrid: scratch too small %zu > %zu\n", need, nbytes); return; }
    constexpr int X = HYB;
    if (X >= 10) { fk_launch(p, 0, fk::NPHASE, st); }
    else { fk_launch(p, 0, X + 1, st); }
    nv::run_mod(I, S, st);
    const unsigned char* ws = p.ws; const unsigned char* ob = p.ob;
    constexpr size_t TD = (size_t)2048 * 1024;
    for (int b = 0; b < 16; ++b) {
        const bool fast = b < fk::NBF;
        if (b == fk::NBF && X == 0) nv::run_mod(I, S, st);
        int from = 0;
        if (fast) {
            const size_t r0 = (size_t)b * 2048;
            if (X == 0) { k_copy_f32<<<nblk(17 * 6144), 256, 0, st>>>((const float*)(ws + fk::WS_MOD), S.mod, 17 * 6144); from = 0; }
            else if (X == 1) { k_cv_bf16<<<nblk(TD), 256, 0, st>>>((const bf16_t*)(ws + fk::WS_HX) + r0 * 1024, 1024, S.hx, 1024, TD);
                k_cv_bf16<<<nblk(256 * 1024), 256, 0, st>>>((const bf16_t*)(ws + fk::WS_HX) + ((size_t)fk::M + (size_t)b * 256) * 1024, 1024, S.hc, 1024, (size_t)256 * 1024); from = 1; }
            else if (X == 2 || X == 3) { k_cv_P<<<nblk((size_t)2048 * 6656), 256, 0, st>>>(ws, ob, b, S.P); k_cv_kvc<<<512, 256, 0, st>>>(ws, b, S.kvc); from = 2;
                if (X == 3) { k_cv_bf16<<<nblk(TD), 256, 0, st>>>((const bf16_t*)(ws + fk::WS_AO) + r0 * 2048, 2048, S.oat, 1024, TD);
                    k_cv_bf16<<<nblk(TD), 256, 0, st>>>((const bf16_t*)(ws + fk::WS_AO) + r0 * 2048 + 1024, 2048, S.yc, 1024, TD); from = 3; } }
            else if (X == 4) { k_cv_bf16<<<nblk(TD), 256, 0, st>>>((const bf16_t*)(ws + fk::WS_MB) + r0 * 1024, 1024, S.a, 1024, TD); from = 4; }
            else {
                k_cv_bf16<<<nblk(TD), 256, 0, st>>>((const bf16_t*)(ws + fk::WS_DL) + r0 * 1024, 1024, S.o1, 1024, TD); nv::k_resid<<<nblk(TD), 256, 0, st>>>(I.x + r0 * 1024, S.one, S.o1, S.x1); from = 5;
                if (X >= 6) { k_cv_bf16<<<nblk(TD), 256, 0, st>>>((const bf16_t*)(ws + fk::WS_HX2) + r0 * 1024, 1024, S.hx2, 1024, TD);
                    k_copy_f32<<<nblk(16 * 2048), 256, 0, st>>>((const float*)(ws + fk::WS_AFF) + (size_t)b * 16 * 2048, S.aff, 16 * 2048); from = 6; }
                if (X >= 7) { k_copy_i32<<<nblk(16 * 256), 256, 0, st>>>((const int*)(ws + fk::WS_IDX) + b * 16 * 256, S.idx, 16 * 256);
                    k_copy_f32<<<nblk(16 * 256), 256, 0, st>>>((const float*)(ws + fk::WS_GATE) + b * 16 * 256, S.gate, 16 * 256);
                    k_copy_i32<<<nblk(2048 * 16), 256, 0, st>>>((const int*)(ws + fk::WS_SEL) + r0 * 16, S.sel, 2048 * 16); from = 7; }
                if (X >= 8) { k_cv_bf16<<<nblk((size_t)4096 * 1024), 256, 0, st>>>((const bf16_t*)(ob + fk::OB_HB) + (size_t)b * 4096 * 1024, 1024, S.ea, 1024, (size_t)4096 * 1024); from = 8; }
                if (X >= 9) { k_cv_bf16<<<nblk((size_t)4096 * 1024), 256, 0, st>>>((const bf16_t*)(ws + fk::WS_YE) + (size_t)b * 4096 * 1024, 1024, S.ye, 1024, (size_t)4096 * 1024);
                    k_fill_f32<<<nblk(16 * 256), 256, 0, st>>>(S.gate, 1.f, 16 * 256); from = 9; }
                if (X >= 10) from = 10;
            }
        }
        if (from <= 0) nv::s1a_norm(I, S, b, st);
        if (from <= 1) nv::s1b_gemm(I, S, b, st);
        if (from <= 2) nv::s2_mix(I, S, b, st);
        if (from <= 3) nv::s3_merge(I, S, b, st);
        if (from <= 4) nv::s4_out(I, S, b, st);
        if (from <= 5) nv::s5_router(I, S, b, st);
        if (from <= 6) nv::s6_topk(I, S, b, st);
        if (from <= 7) nv::s7_up(I, S, b, st);
        if (from <= 8) nv::s8_down(I, S, b, st);
        if (from <= 9) nv::s9_final(I, S, b, out, st);
    }
}
}
#endif

static int fk_grid = 0;
static bool fk_setup() {
    if (fk_grid) return fk_grid > 0;
    int dev = 0, cus = 0, per_cu = 0;
    if (hipGetDevice(&dev) != hipSuccess || hipDeviceGetAttribute(&cus, hipDeviceAttributeMultiprocessorCount, dev) != hipSuccess) { fk_grid = -1; return false; }
    if (hipFuncSetAttribute((const void*)fk::mega, hipFuncAttributeMaxDynamicSharedMemorySize, fk::LDS_BYTES) != hipSuccess) { fprintf(stderr, "kernel_launch: hipFuncSetAttribute failed\n"); fk_grid = -1; return false; }
    if (hipOccupancyMaxActiveBlocksPerMultiprocessor(&per_cu, (const void*)fk::mega, 512, fk::LDS_BYTES) != hipSuccess || per_cu < 1) { fprintf(stderr, "kernel_launch: occupancy query says %d\n", per_cu); fk_grid = -1; return false; }
    fk_grid = cus * per_cu;
    return true;
}
static void fk_launch(fk::Params p, int lo, int hi, hipStream_t stream) {
    p.ph_lo = lo; p.ph_hi = hi;
    if (hipMemsetAsync(p.ws + fk::WS_CTL, 0, fk::CTL_ZERO_BYTES, stream) != hipSuccess) { fprintf(stderr, "kernel_launch: memset failed\n"); return; }
    void* args[] = {&p};
    hipError_t e = hipLaunchCooperativeKernel((const void*)fk::mega, dim3(fk_grid), dim3(512), args, fk::LDS_BYTES, stream);
    if (e != hipSuccess) fprintf(stderr, "kernel_launch: cooperative launch failed: %s (grid %d)\n", hipGetErrorString(e), fk_grid);
}

extern "C" void kernel_launch(void* const* d_in, const int* in_sizes, int n_in, void* d_out, int out_size, void* d_ws, size_t ws_size, hipStream_t stream) {
    if (n_in != 19 || !fk_setup()) { fprintf(stderr, "kernel_launch: bad setup (n_in %d)\n", n_in); return; }
    fk::Params p{};
    const float** ip = (const float**)&p;
    for (int i = 0; i < 19; ++i) ip[i] = (const float*)d_in[i];
    p.out = (float*)d_out; p.ws = (unsigned char*)d_ws;
#if HYB < 0
    if (ws_size < fk::R_END) { fprintf(stderr, "kernel_launch: workspace too small: %zu < %zu\n", ws_size, (size_t)fk::R_END); return; }
    p.ob = (unsigned char*)d_out;
    fk_launch(p, 0, fk::NPHASE, stream);
#else
    p.ob = (unsigned char*)d_ws + fk::R_END;
    hyb::run(p, d_in, (float*)d_out, (char*)d_ws + fk::R_END + fk::OB_BYTES, ws_size - fk::R_END - fk::OB_BYTES, stream);
#endif
}
```

```cpp
#include <hip/hip_runtime.h>
#include <hip/hip_cooperative_groups.h>
#include <cstdio>
#include <cstdint>
#ifndef HYB
#define HYB -1
#endif
#if HYB >= 0
#define FK_NBF 8
#endif
namespace g8 {
#define G8_LAS __attribute__((address_space(3)))
typedef unsigned short bf16_t;
typedef short bf16x8 __attribute__((ext_vector_type(8)));
typedef float f32x4 __attribute__((ext_vector_type(4)));
typedef float f32x2 __attribute__((ext_vector_type(2)));
typedef unsigned u32x4 __attribute__((ext_vector_type(4)));
typedef unsigned u32x2 __attribute__((ext_vector_type(2)));
constexpr int BM = 256, BK = 64, HALF = 128, HTB = HALF * BK * 2, STAGE_BYTES = 8 * HTB;

__host__ __device__ __forceinline__ int lds_byte(int r, int c) { const int st = (r >> 4) * 2 + (c >> 5), rr = r & 15, cc = c & 31, ob = rr * 64 + cc * 2; return st * 1024 + (ob ^ (((ob >> 9) & 1) << 5)); }
__host__ __device__ __forceinline__ void stage_rc(int b, int& R, int& C) { const int st = b / 1024, sb = b % 1024, swz = sb ^ (((sb >> 9) & 1) << 5); R = (st >> 1) * 16 + swz / 64; C = (st & 1) * 32 + (swz % 64) / 2; }
__host__ __device__ __forceinline__ int perm32(int rho) { const int n = rho >> 4, i = rho & 15; return 8 * (i >> 2) + 4 * n + (i & 3); }
__host__ __device__ __forceinline__ int pinv32(int x) { return 16 * ((x >> 2) & 1) + 4 * (x >> 3) + (x & 3); }

struct Unit { const char* a; const char* b; const int* rows; int kind; int pm; int pn; int aux; };

__device__ __forceinline__ unsigned cvt_pk_bf16(float lo, float hi) { unsigned r; asm volatile("v_cvt_pk_bf16_f32 %0, %1, %2" : "=v"(r) : "v"(lo), "v"(hi)); return r; }
__device__ __forceinline__ float bf_lo(unsigned w) { return __uint_as_float(w << 16); }
__device__ __forceinline__ float bf_hi(unsigned w) { return __uint_as_float(w & 0xffff0000u); }

template <class Epi, class Sched, bool HAS_MID, bool GATHER = false, int KREP = 1>
__device__ __forceinline__ void gemm_phase(G8_LAS unsigned char* lds, const int K, const Sched& S, const Epi& E) {
    const int tid = threadIdx.x, wid = __builtin_amdgcn_readfirstlane(tid >> 6), lane = tid & 63, wr = wid >> 2, wc = wid & 3, fr = lane & 15, fq = lane >> 4;
    const int nt = K / BK;
    unsigned voff[2];
#pragma unroll
    for (int i = 0; i < 2; ++i) { int R, C; stage_rc(tid * 16 + i * 8192, R, C); voff[i] = (unsigned)(R * K + C) * 2u; }
    const size_t kstep = (size_t)(BK * 2);
    const size_t hstep = (size_t)HALF * K * 2;
    const unsigned ldsw = (unsigned)wid * 1024u;
    const int aoff = lds_byte(wr * 64 + fr, fq * 8), boff = lds_byte(wc * 32 + fr, fq * 8);
#define G8_SA(b, h) (((b) * 2 + (h)) * HTB)
#define G8_SB(b, h) ((4 + (b) * 2 + (h)) * HTB)
#define G8_STAGE(bufoff, gbase) do { _Pragma("unroll") for (int _i = 0; _i < 2; ++_i) \
        __builtin_amdgcn_global_load_lds((const unsigned*)((const char*)(gbase) + voff[_i]), (G8_LAS unsigned*)(lds + (bufoff) + ldsw + _i * 8192), 16, 0, 0); } while (0)
#define G8_STAGE_V(bufoff, gbase, vv) do { _Pragma("unroll") for (int _i = 0; _i < 2; ++_i) \
        __builtin_amdgcn_global_load_lds((const unsigned*)((const char*)(gbase) + (vv)[_i]), (G8_LAS unsigned*)(lds + (bufoff) + ldsw + _i * 8192), 16, 0, 0); } while (0)
#define G8_STAGE_A(bufoff, gbase, h) do { if constexpr (GATHER) G8_STAGE_V(bufoff, gbase, va[h]); else G8_STAGE(bufoff, (gbase) + (h) * hstep); } while (0)
#define G8_LDA(dst, b, h) do { _Pragma("unroll") for (int m = 0; m < 4; ++m) _Pragma("unroll") for (int k = 0; k < 2; ++k) dst[m][k] = *(const G8_LAS bf16x8*)(lds + G8_SA(b, h) + aoff + m * 2048 + k * 1024); } while (0)
#define G8_LDB(dst, b, h) do { _Pragma("unroll") for (int n = 0; n < 2; ++n) _Pragma("unroll") for (int k = 0; k < 2; ++k) dst[n][k] = *(const G8_LAS bf16x8*)(lds + G8_SB(b, h) + boff + n * 2048 + k * 1024); } while (0)
#define G8_MMA(ai, bj, At, Bt) do { __builtin_amdgcn_s_setprio(1); _Pragma("unroll") for (int m = 0; m < 4; ++m) _Pragma("unroll") for (int n = 0; n < 2; ++n) _Pragma("unroll") for (int k = 0; k < 2; ++k) \
        acc[ai][bj][m][n] = __builtin_amdgcn_mfma_f32_16x16x32_bf16(Bt[n][k], At[m][k], acc[ai][bj][m][n], 0, 0, 0); __builtin_amdgcn_s_setprio(0); } while (0)
#define G8_WAIT_V(n) asm volatile("s_waitcnt vmcnt(" #n ")" ::: "memory")
#define G8_WAIT_L(n) asm volatile("s_waitcnt lgkmcnt(" #n ")" ::: "memory")
#define G8_BAR __builtin_amdgcn_s_barrier()
#define G8_SCHED __builtin_amdgcn_sched_barrier(0)
    Unit cur, nxt; int ui = 0;
    if (!S.next(0, cur)) return;
    f32x4 acc[2][2][4][2];
#pragma unroll
    for (int a = 0; a < 2; ++a)
#pragma unroll
        for (int b = 0; b < 2; ++b)
#pragma unroll
            for (int m = 0; m < 4; ++m)
#pragma unroll
                for (int n = 0; n < 2; ++n) acc[a][b][m][n] = (f32x4){0.f, 0.f, 0.f, 0.f};
    bf16x8 At[4][2], B0[2][2], B1[2][2];
    const char* cA = cur.a; const char* cB = cur.b;
    unsigned va[2][2], vn[2][2];
    int gR[2], gC[2];
#pragma unroll
    for (int i = 0; i < 2; ++i) stage_rc(tid * 16 + i * 8192, gR[i], gC[i]);
    if constexpr (GATHER) {
#pragma unroll
        for (int h = 0; h < 2; ++h)
#pragma unroll
            for (int i = 0; i < 2; ++i) { va[h][i] = (unsigned)(cur.rows[128 * h + gR[i]] * K + gC[i]) * 2u; vn[h][i] = va[h][i]; }
    }
    G8_STAGE(G8_SB(0, 0), cB); G8_STAGE(G8_SB(0, 1), cB + hstep); G8_STAGE_A(G8_SA(0, 0), cA, 0); G8_STAGE_A(G8_SA(0, 1), cA, 1);
    if (wr == 1) G8_BAR;
    G8_WAIT_V(2); G8_BAR;
    G8_STAGE(G8_SB(1, 0), cB + kstep); G8_STAGE_A(G8_SA(1, 0), cA + kstep, 0); G8_STAGE(G8_SB(1, 1), cB + hstep + kstep);
    G8_WAIT_V(6); G8_BAR;
    for (;;) {
        const bool has_next = S.next(ui + 1, nxt);
        const char* nA = has_next ? nxt.a : cA; const char* nB = has_next ? nxt.b : cB;
        if constexpr (GATHER) { if (has_next) {
#pragma unroll
            for (int h = 0; h < 2; ++h)
#pragma unroll
                for (int i = 0; i < 2; ++i) vn[h][i] = (unsigned)(nxt.rows[128 * h + gR[i]] * K + gC[i]) * 2u; } }
        constexpr int KR = (KREP == 3) ? 1 : KREP;
        for (int tt = 0; tt < KR * nt; tt += 2) {
            const bool last = (tt == KR * nt - 2);
            const int t = (KREP == 1 || KREP == 3) ? tt : (tt >= nt ? tt - nt : tt);
            const char* a1 = cA + (size_t)(t + 1) * kstep;
            const int t2 = (KR > 1 && t + 2 >= nt) ? 0 : t + 2;
            const char* a2 = last ? nA : cA + (size_t)t2 * kstep; const char* b2 = last ? nB : cB + (size_t)t2 * kstep;
            const char* a3 = a2 + kstep; const char* b3 = b2 + kstep;
            if constexpr (HAS_MID) { if (t == (nt >> 1)) E.mid(acc, cur, wr, wc, fr, fq); }
            G8_LDB(B0, 0, 0); G8_LDB(B1, 0, 1); G8_SCHED; G8_LDA(At, 0, 0); G8_STAGE_A(G8_SA(1, 1), a1, 1);
            if constexpr (GATHER) { if (last) { va[0][0] = vn[0][0]; va[0][1] = vn[0][1]; va[1][0] = vn[1][0]; va[1][1] = vn[1][1]; } }
            G8_WAIT_V(8); G8_WAIT_L(0); G8_BAR; G8_MMA(0, 0, At, B0); G8_MMA(0, 1, At, B1); G8_BAR; G8_SCHED;
            G8_LDA(At, 0, 1); G8_STAGE(G8_SB(0, 0), b2); G8_STAGE(G8_SB(0, 1), b2 + hstep); G8_STAGE_A(G8_SA(0, 0), a2, 0);
            G8_WAIT_V(8); G8_WAIT_L(0); G8_BAR; G8_MMA(1, 0, At, B0); G8_MMA(1, 1, At, B1); G8_BAR; G8_SCHED;
            G8_LDB(B0, 1, 0); G8_LDB(B1, 1, 1); G8_SCHED; G8_LDA(At, 1, 0); G8_STAGE_A(G8_SA(0, 1), a2, 1);
            G8_WAIT_V(8); G8_WAIT_L(0); G8_BAR; G8_MMA(0, 0, At, B0); G8_MMA(0, 1, At, B1); G8_BAR; G8_SCHED;
            G8_LDA(At, 1, 1); G8_STAGE(G8_SB(1, 0), b3); G8_STAGE(G8_SB(1, 1), b3 + hstep); G8_STAGE_A(G8_SA(1, 0), a3, 0);
            G8_WAIT_V(8); G8_WAIT_L(0); G8_BAR; G8_MMA(1, 0, At, B0); G8_MMA(1, 1, At, B1); G8_BAR; G8_SCHED;
        }
        if (wr == 0) G8_BAR;
        if constexpr (KR > 1) {
#pragma unroll
            for (int a = 0; a < 2; ++a)
#pragma unroll
                for (int b = 0; b < 2; ++b)
#pragma unroll
                    for (int m = 0; m < 4; ++m)
#pragma unroll
                        for (int n = 0; n < 2; ++n) acc[a][b][m][n] *= (1.0f / KR);
        }
        E(acc, cur, wr, wc, fr, fq);
#ifdef FK_EPI2_PROBE
        if constexpr (KREP == 3) { asm volatile("" ::: "memory"); E(acc, cur, wr, wc, fr, fq); }
#endif
        if (!has_next) break;
#pragma unroll
        for (int a = 0; a < 2; ++a)
#pragma unroll
            for (int b = 0; b < 2; ++b)
#pragma unroll
                for (int m = 0; m < 4; ++m)
#pragma unroll
                    for (int n = 0; n < 2; ++n) acc[a][b][m][n] = (f32x4){0.f, 0.f, 0.f, 0.f};
        cur = nxt; cA = nA; cB = nB; ++ui;
        if (wr == 1) G8_BAR;
    }
    G8_WAIT_V(0);
    G8_BAR;
#undef G8_SA
#undef G8_SB
#undef G8_STAGE
#undef G8_LDA
#undef G8_STAGE_V
#undef G8_STAGE_A
#undef G8_LDB
#undef G8_MMA
#undef G8_WAIT_V
#undef G8_WAIT_L
#undef G8_BAR
#undef G8_SCHED
}
}
namespace fk {
using namespace g8;
namespace cg = cooperative_groups;
#define LAS G8_LAS
#ifndef FK_NBF
#define FK_NBF 16
#endif
#ifndef FK_DBL
#define FK_DBL 0
#endif
constexpr int NBF = FK_NBF;
constexpr int D = 1024, T = 2048, LC = 256, NE = 16, CAP = 256;
constexpr int M = NBF * T, MC = NBF * LC, MA = M + MC;
constexpr int NT_IN = 25;
constexpr float LOG2E = 1.4426950408889634f;
constexpr float C2 = 0.125f * LOG2E;
typedef float f32x16 __attribute__((ext_vector_type(16)));

constexpr size_t MiB = (size_t)1 << 20;
constexpr size_t SC = (size_t)NBF << 16;
constexpr size_t WS_CTL = 0, WS_MOD = 1 * MiB, WS_ROPE = 1 * MiB + 512 * 1024, WS_IDX = 2 * MiB, WS_GATE = 2 * MiB + 256 * 1024,
                 WS_AFF = 2 * MiB + 512 * 1024, WS_SEL = 5 * MiB;
constexpr size_t WS_WIN = 8 * MiB, WS_WV = WS_WIN + (size_t)6400 * 2048, WS_WP = 21 * MiB, WS_WO = 25 * MiB, WS_WGU = 27 * MiB, WS_WD = 91 * MiB;
constexpr size_t R0 = 124 * MiB;
constexpr size_t WS_Q = R0, WS_KB = R0 + 64 * SC, WS_KCB = R0 + 80 * SC, WS_VB = R0 + 82 * SC, WS_VCB = R0 + 98 * SC, WS_Z = R0 + 100 * SC, WS_BB = R0 + 164 * SC,
                 WS_AO = R0 + 228 * SC, WS_HX = R0 + 284 * SC, WS_MB = R0, WS_DL = R0 + 64 * SC, WS_HX2 = R0, WS_XE = R0 + 192 * SC, WS_YE = R0 + 192 * SC;
constexpr size_t R_END = R0 + 356 * SC;
constexpr size_t OB_RB = 0, OB_SGC = 64 * SC, OB_HB = 0, OB_BYTES = 128 * SC;

constexpr int LDS_BYTES = 147456;
constexpr int LDS_MISC = 140 * 1024;
constexpr int LDS_MISC_Q = 140 * 1024 + 64;

#ifdef FK_TS
#define FK_STAMP_WG(k, wgsel) do { if (blockIdx.x == (wgsel) && threadIdx.x == 0) { const unsigned long long t_ = __builtin_amdgcn_s_memrealtime(); \
        __hip_atomic_store((unsigned long long*)(P.ws + WS_CTL) + 1800 + (k), t_, __ATOMIC_RELAXED, __HIP_MEMORY_SCOPE_AGENT); } } while (0)
#else
#define FK_STAMP_WG(k, wgsel) do { } while (0)
#endif
#define FK_STAMP(k) FK_STAMP_WG(k, 0)

struct Params {
    const float *x, *c, *ctx, *c_ctx, *w_mod, *b_mod, *norm1_g, *w_in, *sink, *conv_w, *wpa, *wpc, *wo, *norm2_g, *w_router, *wg, *wu, *wd, *fg;
    float* out; unsigned char* ws; unsigned char* ob;
    int ph_lo, ph_hi;
};

__device__ __forceinline__ float wave_sum(float v) {
#pragma unroll
    for (int o = 1; o < 64; o <<= 1) v += __shfl_xor(v, o);
    return v;
}
__device__ __forceinline__ unsigned f2bf(float f) { unsigned u = __builtin_bit_cast(unsigned, f); return (u + 0x7fffu + ((u >> 16) & 1u)) >> 16; }
__device__ __forceinline__ unsigned pk2(float lo, float hi) { return f2bf(lo) | (f2bf(hi) << 16); }
__device__ __forceinline__ void bf8_to_f32(const u32x4 w, f32x4& lo, f32x4& hi4) { lo = (f32x4){bf_lo(w.x), bf_hi(w.x), bf_lo(w.y), bf_hi(w.y)}; hi4 = (f32x4){bf_lo(w.z), bf_hi(w.z), bf_lo(w.w), bf_hi(w.w)}; }
__device__ __forceinline__ u32x4 f32_to_bf8(const f32x4 a, const f32x4 b) { u32x4 w; w.x = pk2(a.x, a.y); w.y = pk2(a.z, a.w); w.z = pk2(b.x, b.y); w.w = pk2(b.z, b.w); return w; }
__device__ __forceinline__ float sq4(const f32x4 v) { return (v.x * v.x + v.y * v.y) + (v.z * v.z + v.w * v.w); }
__device__ __forceinline__ float dot4(const f32x4 a, const f32x4 b) { return (a.x * b.x + a.y * b.y) + (a.z * b.z + a.w * b.w); }
__device__ __forceinline__ float sigmoidf_(float v) { return 1.f / (1.f + __expf(-v)); }

__device__ __forceinline__ void transpose_item64(const float* __restrict__ W, int N, int k0, int n0, bf16_t* __restrict__ dst, int pitch, bool perm, int lane) {
    const float* src = W + (size_t)k0 * N + n0 + lane;
    const int dr = perm ? ((lane & 32) + pinv32(lane & 31)) : lane;
    bf16_t* drow = dst + (size_t)dr * pitch + k0;
#pragma unroll
    for (int h = 0; h < 2; ++h) {
        float v[32];
#pragma unroll
        for (int j = 0; j < 32; ++j) v[j] = __builtin_nontemporal_load(src + (size_t)(32 * h + j) * N);
#pragma unroll
        for (int c = 0; c < 4; ++c) { u32x4 o; o.x = pk2(v[8 * c], v[8 * c + 1]); o.y = pk2(v[8 * c + 2], v[8 * c + 3]); o.z = pk2(v[8 * c + 4], v[8 * c + 5]); o.w = pk2(v[8 * c + 6], v[8 * c + 7]);
            *(u32x4*)(drow + 32 * h + 8 * c) = o; }
    }
}

constexpr int CV_IN = 16 * 104, CV_SQ = 256, CV_TOTAL = CV_IN + 3 * CV_SQ + 48 * CV_SQ;
__device__ __forceinline__ void conv_item(const Params& P, int it, int lane) {
    bf16_t* WIN = (bf16_t*)(P.ws + WS_WIN); bf16_t* WV = (bf16_t*)(P.ws + WS_WV); bf16_t* WP = (bf16_t*)(P.ws + WS_WP); bf16_t* WO = (bf16_t*)(P.ws + WS_WO);
    bf16_t* WGU = (bf16_t*)(P.ws + WS_WGU); bf16_t* WD = (bf16_t*)(P.ws + WS_WD);
    int r = it;
    if (r < CV_IN) {
        const int kb = r / 104, nb = r % 104, k0 = 64 * kb, n0 = 64 * nb;
        bf16_t* dst; bool perm = true;
        if (n0 < 1280) { dst = WIN + (size_t)n0 * 1024; perm = false; }
        else if (n0 < 1536) { dst = WV + (size_t)(n0 - 1280) * 1024; perm = false; }
        else if (n0 < 2560) { const int ch = n0 - 1536; dst = WIN + (size_t)(1280 + (ch >> 7) * 256 + (ch & 127)) * 1024; }
        else if (n0 < 3584) { dst = WIN + (size_t)(3328 + (n0 - 2560)) * 1024; }
        else if (n0 < 4608) { const int ch = n0 - 3584; dst = WIN + (size_t)(1280 + (ch >> 7) * 256 + 128 + (ch & 127)) * 1024; }
        else if (n0 < 5632) { const int ch = n0 - 4608; dst = WIN + (size_t)(4352 + (ch >> 7) * 256 + (ch & 127)) * 1024; }
        else { const int ch = n0 - 5632; dst = WIN + (size_t)(4352 + (ch >> 7) * 256 + 128 + (ch & 127)) * 1024; }
        transpose_item64(P.w_in, 6656, k0, n0, dst, 1024, perm, lane);
        return;
    }
    r -= CV_IN;
    const int mat = r / CV_SQ, q = r % CV_SQ, kb = q / 16, nb = q % 16, k0 = 64 * kb, n0 = 64 * nb;
    if (mat == 0) transpose_item64(P.wpa, 1024, k0, n0, WP + (size_t)n0 * 2048, 2048, true, lane);
    else if (mat == 1) transpose_item64(P.wpc, 1024, k0, n0, WP + (size_t)n0 * 2048 + 1024, 2048, true, lane);
    else if (mat == 2) transpose_item64(P.wo, 1024, k0, n0, WO + (size_t)n0 * 1024, 1024, true, lane);
    else {
        const int m2 = mat - 3, kind = m2 >> 4, e = m2 & 15;
        if (kind == 0) transpose_item64(P.wg + (size_t)e * 1048576, 1024, k0, n0, WGU + ((size_t)e * 2048 + (n0 >> 7) * 256 + (n0 & 127)) * 1024, 1024, true, lane);
        else if (kind == 1) transpose_item64(P.wu + (size_t)e * 1048576, 1024, k0, n0, WGU + ((size_t)e * 2048 + (n0 >> 7) * 256 + 128 + (n0 & 127)) * 1024, 1024, true, lane);
        else transpose_item64(P.wd + (size_t)e * 1048576, 1024, k0, n0, WD + ((size_t)e * 1024 + n0) * 1024, 1024, true, lane);
    }
}

__device__ __forceinline__ void ph_prep(const Params& P, LAS unsigned char* lds) {
    const int tid = threadIdx.x, lane = tid & 63, wave = __builtin_amdgcn_readfirstlane(tid >> 6);
    const int G = gridDim.x, wg = blockIdx.x;
    float* mod = (float*)(P.ws + WS_MOD);
    if (wg < 96) {
        LAS float* sl = (LAS float*)lds;
        LAS float* red = (LAS float*)(lds + 17 * 1024 * 4);
        for (int i = tid; i < 17 * 1024; i += 512) { const int r = i >> 10, k = i & 1023; const float v = r < 16 ? P.c[r * 1024 + k] : P.c_ctx[k]; sl[i] = v / (1.f + __expf(-v)); }
        __syncthreads();
        const int col = tid & 63, kg = wave, n = wg * 64 + col;
        float acc[17];
#pragma unroll
        for (int r = 0; r < 17; ++r) acc[r] = 0.f;
        for (int kb = kg * 128; kb < kg * 128 + 128; kb += 16) {
            float w[16];
#pragma unroll
            for (int j = 0; j < 16; ++j) w[j] = P.w_mod[(size_t)(kb + j) * 6144 + n];
#pragma unroll
            for (int j = 0; j < 16; ++j)
#pragma unroll
                for (int r = 0; r < 17; ++r) acc[r] += sl[r * 1024 + kb + j] * w[j]; }
#pragma unroll
        for (int r = 0; r < 17; ++r) red[(kg * 17 + r) * 64 + col] = acc[r];
        __syncthreads();
        for (int i = tid; i < 17 * 64; i += 512) { const int r = i >> 6, cc = i & 63; float s = 0.f;
#pragma unroll
            for (int g = 0; g < 8; ++g) s += red[(g * 17 + r) * 64 + cc];
            mod[r * 6144 + wg * 64 + cc] = s + P.b_mod[wg * 64 + cc]; }
        __syncthreads();
    } else if (wg == 96) {
        float2* rope = (float2*)(P.ws + WS_ROPE);
        for (int i = tid; i < 64 * 16; i += 512) { const int pos = i >> 4, f = i & 15; const float ang = (float)pos * powf(10000.f, -(float)f / 16.f); rope[i] = make_float2(cosf(ang), sinf(ang)); }
    }
    constexpr int I_IN = 16 * 104;
    if (wg >= 96) { for (int it = (wg - 96) * 8 + wave; it < 1280; it += (G - 96) * 8) conv_item(P, it, lane); }
    else { for (int it = 1280 + wg * 8 + wave; it < I_IN; it += 96 * 8) conv_item(P, it, lane); }
}

template <int NR>
__device__ __forceinline__ void norm1_rows(const Params& P, int row0, int lane) {
    const float* mod = (const float*)(P.ws + WS_MOD);
    bf16_t* HX = (bf16_t*)(P.ws + WS_HX);
    const float* xr; const float* mv;
    if (row0 < M) { xr = P.x + (size_t)row0 * D; mv = mod + (row0 >> 11) * 6144; } else { xr = P.ctx + (size_t)(row0 - M) * D; mv = mod + 16 * 6144; }
    f32x4 v[NR][4];
#pragma unroll
    for (int r = 0; r < NR; ++r)
#pragma unroll
        for (int j = 0; j < 2; ++j) { v[r][2 * j] = __builtin_nontemporal_load((const f32x4*)(xr + (size_t)r * D + 8 * lane + 512 * j)); v[r][2 * j + 1] = __builtin_nontemporal_load((const f32x4*)(xr + (size_t)r * D + 8 * lane + 512 * j + 4)); }
    float rs[NR];
#pragma unroll
    for (int r = 0; r < NR; ++r) { const float ss = (sq4(v[r][0]) + sq4(v[r][1])) + (sq4(v[r][2]) + sq4(v[r][3])); rs[r] = 1.0f / sqrtf(wave_sum(ss) * (1.f / D) + 1e-6f); }
#pragma unroll
    for (int j = 0; j < 2; ++j) { const int c0 = 8 * lane + 512 * j;
        const f32x4 g0 = *(const f32x4*)(P.norm1_g + c0) * (*(const f32x4*)(mv + 1024 + c0) + 1.0f), g1 = *(const f32x4*)(P.norm1_g + c0 + 4) * (*(const f32x4*)(mv + 1024 + c0 + 4) + 1.0f);
        const f32x4 sh0 = *(const f32x4*)(mv + c0), sh1 = *(const f32x4*)(mv + c0 + 4);
#pragma unroll
        for (int r = 0; r < NR; ++r) *(u32x4*)(HX + (size_t)(row0 + r) * D + c0) = f32_to_bf8(v[r][2 * j] * rs[r] * g0 + sh0, v[r][2 * j + 1] * rs[r] * g1 + sh1); }
}
enum { KD_Q = 0, KD_K = 1, KD_KC = 2, KD_VT = 3, KD_VTC = 4, KD_UC = 5, KD_BC = 6, KD_GG = 7 };
struct InprojSched {
    int G, c; const char *hx, *win, *wv;
    static constexpr int NMAIN = (M / 256) * NT_IN, NVT = M / 256, NC = MC / 256, NTOT = NMAIN + NVT;
    __device__ __forceinline__ bool next(int i, Unit& u) const {
        const int Lx = i * G + c; if (Lx >= NTOT) return false;
        constexpr size_t TS = (size_t)256 * 1024 * 2;
        if (Lx < NMAIN) {
            const int wgid = (Lx % 8) * (NMAIN / 8) + Lx / 8;
            constexpr int nig = 8 * NT_IN; const int gid = wgid / nig, w = wgid % nig;
            u.pm = gid * 8 + (w % 8); u.pn = w / 8;
            u.a = hx + (size_t)u.pm * TS; u.b = win + (size_t)u.pn * TS;
            u.kind = u.pn < 4 ? KD_Q : u.pn == 4 ? KD_K : u.pn < 13 ? KD_UC : u.pn < 17 ? KD_BC : KD_GG; u.aux = 0; u.rows = nullptr;
        } else {
            const int xq = Lx - NMAIN;
            u.kind = KD_VT; u.pm = 0; u.pn = xq; u.a = wv; u.b = hx + (size_t)xq * TS;
            u.aux = 0; u.rows = nullptr;
        }
        return true;
    }
};
struct CtxSched {
    int c; const char *hx, *win, *wv;
    __device__ __forceinline__ bool next(int i, Unit& u) const {
        if (i != 0) return false;
        constexpr size_t TS = (size_t)256 * 1024 * 2; constexpr int NC = MC / 256;
        if (c < NC) { u.kind = KD_KC; u.pm = M / 256 + c; u.pn = 4; u.a = hx + (size_t)u.pm * TS; u.b = win + (size_t)4 * TS; }
        else { u.kind = KD_VTC; u.pm = 0; u.pn = c - NC; u.a = wv; u.b = hx + (size_t)(M / 256 + u.pn) * TS; }
        u.aux = 0; u.rows = nullptr; return true;
    }
};
struct EpiInproj {
    bf16_t *q, *z, *bb, *rb, *sgc; unsigned char *kb, *kcb, *vb, *vcb; const float* rope;
    __device__ __forceinline__ void operator()(const f32x4 (&acc)[2][2][4][2], const Unit& u, int wr, int wc, int fr, int fq) const {
        const int kind = u.kind;
        if (kind == KD_Q || kind == KD_K) {
#pragma unroll
            for (int ai = 0; ai < 2; ++ai)
#pragma unroll
                for (int m = 0; m < 4; ++m) {
                    const int r = u.pm * 256 + 128 * ai + 64 * wr + 16 * m + fr, t = r & 2047, b = r >> 11;
                    const int pos = (wc & 1) ? (t & 63) : (t >> 6);
                    const float* tb = rope + (pos * 16 + 4 * fq) * 2;
                    const f32x4 t0 = *(const f32x4*)tb, t1 = *(const f32x4*)(tb + 4);
                    const f32x4 cs = {t0.x, t0.z, t1.x, t1.z}, sn = {t0.y, t0.w, t1.y, t1.w};
#pragma unroll
                    for (int bj = 0; bj < 2; ++bj) {
                        const f32x4 x0 = acc[ai][bj][m][0], x1 = acc[ai][bj][m][1];
                        f32x4 o0 = x0 * cs - x1 * sn, o1 = x1 * cs + x0 * sn;
                        if (kind == KD_Q) {
                            o0 = o0 * C2; o1 = o1 * C2;
                            bf16_t* dst = q + (size_t)r * 1024 + u.pn * 256 + 128 * bj + 32 * wc + 4 * fq;
                            u32x2 w0, w1; w0.x = cvt_pk_bf16(o0.x, o0.y); w0.y = cvt_pk_bf16(o0.z, o0.w); w1.x = cvt_pk_bf16(o1.x, o1.y); w1.y = cvt_pk_bf16(o1.z, o1.w);
                            *(u32x2*)dst = w0; *(u32x2*)(dst + 16) = w1;
                        } else {
                            const int hkv = 2 * bj + (wc >> 1), ch0 = 4 * (wc & 1) + (fq >> 1);
                            unsigned char* dst = kb + ((size_t)((b * 4 + hkv) * 32 + (t >> 6))) * 8192 + ch0 * 1024 + (t & 63) * 16 + 8 * (fq & 1);
                            u32x2 w0, w1; w0.x = cvt_pk_bf16(o0.x, o0.y); w0.y = cvt_pk_bf16(o0.z, o0.w); w1.x = cvt_pk_bf16(o1.x, o1.y); w1.y = cvt_pk_bf16(o1.z, o1.w);
                            *(u32x2*)dst = w0; *(u32x2*)(dst + 2048) = w1;
                        }
                    }
                }
        } else if (kind == KD_KC) {
#pragma unroll
            for (int ai = 0; ai < 2; ++ai)
#pragma unroll
                for (int m = 0; m < 4; ++m) {
                    const int r = (u.pm - M / 256) * 256 + 128 * ai + 64 * wr + 16 * m + fr, l = r & 255, b = r >> 8;
#pragma unroll
                    for (int bj = 0; bj < 2; ++bj) {
                        const int hkv = 2 * bj + (wc >> 1), ch0 = 4 * (wc & 1) + (fq >> 1);
                        unsigned char* dst = kcb + ((size_t)((b * 4 + hkv) * 4 + (l >> 6))) * 8192 + ch0 * 1024 + (l & 63) * 16 + 8 * (fq & 1);
#pragma unroll
                        for (int n = 0; n < 2; ++n) { const f32x4 v = acc[ai][bj][m][n]; u32x2 w; w.x = cvt_pk_bf16(v.x, v.y); w.y = cvt_pk_bf16(v.z, v.w); *(u32x2*)(dst + n * 2048) = w; }
                    }
                }
        } else if (kind == KD_VT || kind == KD_VTC) {
#pragma unroll
            for (int ai = 0; ai < 2; ++ai)
#pragma unroll
                for (int m = 0; m < 4; ++m) {
                    const int hkv = 2 * ai + wr, d = 16 * m + fr;
#pragma unroll
                    for (int bj = 0; bj < 2; ++bj) {
                        size_t blk;
                        if (kind == KD_VT) blk = (size_t)(((u.pn >> 3) * 4 + hkv) * 32 + 4 * (u.pn & 7) + 2 * bj + (wc >> 1));
                        else blk = (size_t)((u.pn * 4 + hkv) * 4 + 2 * bj + (wc >> 1));
                        unsigned char* base = (kind == KD_VT ? vb : vcb) + blk * 8192 + d * 16 + 8 * (fq >> 1);
#pragma unroll
                        for (int n = 0; n < 2; ++n) { const f32x4 v = acc[ai][bj][m][n]; u32x2 w; w.x = cvt_pk_bf16(v.x, v.y); w.y = cvt_pk_bf16(v.z, v.w);
                            *(u32x2*)(base + (2 * (2 * (wc & 1) + n) + (fq & 1)) * 1024) = w; }
                    }
                }
        } else if (kind == KD_UC) {
#pragma unroll
            for (int ai = 0; ai < 2; ++ai)
#pragma unroll
                for (int m = 0; m < 4; ++m) {
                    const int r = u.pm * 256 + 128 * ai + 64 * wr + 16 * m + fr;
                    const f32x4 v0 = acc[ai][0][m][0] * acc[ai][1][m][0], v1 = acc[ai][0][m][1] * acc[ai][1][m][1];
                    u32x4 w; w.x = cvt_pk_bf16(v0.x, v0.y); w.y = cvt_pk_bf16(v0.z, v0.w); w.z = cvt_pk_bf16(v1.x, v1.y); w.w = cvt_pk_bf16(v1.z, v1.w);
                    *(u32x4*)(z + (size_t)r * 1024 + (u.pn - 5) * 128 + 32 * wc + 8 * fq) = w;
                }
        } else if (kind == KD_BC) {
#pragma unroll
            for (int ai = 0; ai < 2; ++ai)
#pragma unroll
                for (int m = 0; m < 4; ++m) {
                    const int r = u.pm * 256 + 128 * ai + 64 * wr + 16 * m + fr;
#pragma unroll
                    for (int bj = 0; bj < 2; ++bj) { const f32x4 v0 = acc[ai][bj][m][0], v1 = acc[ai][bj][m][1];
                        u32x4 w; w.x = cvt_pk_bf16(v0.x, v0.y); w.y = cvt_pk_bf16(v0.z, v0.w); w.z = cvt_pk_bf16(v1.x, v1.y); w.w = cvt_pk_bf16(v1.z, v1.w);
                        *(u32x4*)(bb + (size_t)r * 1024 + (u.pn - 13) * 256 + 128 * bj + 32 * wc + 8 * fq) = w; }
                }
        } else {
#pragma unroll
            for (int ai = 0; ai < 2; ++ai)
#pragma unroll
                for (int m = 0; m < 4; ++m) {
                    const int r = u.pm * 256 + 128 * ai + 64 * wr + 16 * m + fr;
                    f32x4 rr[2], sg[2];
#pragma unroll
                    for (int n = 0; n < 2; ++n)
#pragma unroll
                        for (int j = 0; j < 4; ++j) { const float ea = __expf(-acc[ai][0][m][n][j]), ec = __expf(-acc[ai][1][m][n][j]);
                            rr[n][j] = (1.f + ec) * __builtin_amdgcn_rcpf(1.f + ea); sg[n][j] = __builtin_amdgcn_rcpf(1.f + ec); }
                    const size_t off = (size_t)r * 1024 + (u.pn - 17) * 128 + 32 * wc + 8 * fq;
                    u32x4 w; w.x = cvt_pk_bf16(rr[0].x, rr[0].y); w.y = cvt_pk_bf16(rr[0].z, rr[0].w); w.z = cvt_pk_bf16(rr[1].x, rr[1].y); w.w = cvt_pk_bf16(rr[1].z, rr[1].w);
                    *(u32x4*)(rb + off) = w;
                    w.x = cvt_pk_bf16(sg[0].x, sg[0].y); w.y = cvt_pk_bf16(sg[0].z, sg[0].w); w.z = cvt_pk_bf16(sg[1].x, sg[1].y); w.w = cvt_pk_bf16(sg[1].z, sg[1].w);
                    *(u32x4*)(sgc + off) = w;
                }
        }
    }
};
__device__ __forceinline__ void ph_inproj(const Params& P, LAS unsigned char* lds) {
    InprojSched S; S.G = gridDim.x; S.c = blockIdx.x; S.hx = (const char*)(P.ws + WS_HX); S.win = (const char*)(P.ws + WS_WIN); S.wv = (const char*)(P.ws + WS_WV);
    EpiInproj E; E.q = (bf16_t*)(P.ws + WS_Q); E.z = (bf16_t*)(P.ws + WS_Z); E.bb = (bf16_t*)(P.ws + WS_BB); E.rb = (bf16_t*)(P.ob + OB_RB); E.sgc = (bf16_t*)(P.ob + OB_SGC);
    E.kb = P.ws + WS_KB; E.kcb = P.ws + WS_KCB; E.vb = P.ws + WS_VB; E.vcb = P.ws + WS_VCB; E.rope = (const float*)(P.ws + WS_ROPE);
#ifdef FK_STAGGER_PROBE
    { const unsigned long long t0 = __builtin_amdgcn_s_memrealtime(); const unsigned long long dt = (unsigned long long)((blockIdx.x >> 3) & 31) * FK_STAGGER_PROBE;
      while (__builtin_amdgcn_s_memrealtime() - t0 < dt) __builtin_amdgcn_s_sleep(4); }
#endif
#if defined(FK_EPI2_PROBE)
    gemm_phase<EpiInproj, InprojSched, false, false, 3>(lds, 1024, S, E);
#elif defined(FK_KREP_INPROJ)
    gemm_phase<EpiInproj, InprojSched, false, false, 2>(lds, 1024, S, E);
#else
    gemm_phase<EpiInproj, InprojSched, false>(lds, 1024, S, E);
#endif
}

constexpr int CW_QUEUE = 3584;
__device__ __forceinline__ void ph_norm1(const Params& P, LAS unsigned char* lds) {
    const int tid = threadIdx.x, lane = tid & 63, wave = __builtin_amdgcn_readfirstlane(tid >> 6), wg = blockIdx.x, G = gridDim.x;
    constexpr int NC = MC / 256;
    if (wg < 2 * NC && G > 2 * NC) {
        const int tile = wg < NC ? wg : wg - NC;
        for (int r = wave * 4; r < 256; r += 32) norm1_rows<4>(P, M + tile * 256 + r, lane);
        asm volatile("s_waitcnt vmcnt(0)" ::: "memory");
        __syncthreads();
        CtxSched S; S.c = wg; S.hx = (const char*)(P.ws + WS_HX); S.win = (const char*)(P.ws + WS_WIN); S.wv = (const char*)(P.ws + WS_WV);
        EpiInproj E; E.q = nullptr; E.z = nullptr; E.bb = nullptr; E.rb = nullptr; E.sgc = nullptr;
        E.kb = P.ws + WS_KB; E.kcb = P.ws + WS_KCB; E.vb = P.ws + WS_VB; E.vcb = P.ws + WS_VCB; E.rope = (const float*)(P.ws + WS_ROPE);
        gemm_phase<EpiInproj, CtxSched, false>(lds, 1024, S, E);
        FK_STAMP_WG(14, 0);
    } else {
        const int nw = (G - 2 * NC) * 8, gw = (wg - 2 * NC) * 8 + wave;
        for (int row = gw * 4; row < M; row += nw * 4) norm1_rows<4>(P, row, lane);
        __syncthreads(); FK_STAMP_WG(12, 40);
    }
    unsigned* head = (unsigned*)(P.ws + WS_CTL) + CW_QUEUE;
    LAS unsigned* slot = (LAS unsigned*)(lds + LDS_MISC_Q);
    for (;;) {
        __syncthreads();
        if (tid == 0) slot[0] = __hip_atomic_fetch_add(head, 32u, __ATOMIC_RELAXED, __HIP_MEMORY_SCOPE_AGENT);
        __syncthreads();
        const int base = CV_IN + (int)slot[0];
        if (base >= CV_TOTAL) break;
#pragma unroll 1
        for (int k = 0; k < 4; ++k) { const int it = base + wave * 4 + k; if (it < CV_TOTAL) conv_item(P, it, lane); }
    }
    FK_STAMP_WG(13, 40); FK_STAMP_WG(15, 0);
}

__device__ __forceinline__ int crow(int r, int hi) { return (r & 3) + 8 * (r >> 2) + 4 * hi; }
#ifndef FK_ATT_THR
#define FK_ATT_THR 24.0f
#endif
constexpr float ATT_THR = FK_ATT_THR;
constexpr int ATT_NS = 5;
struct AttnUnitInfo { int b, hkv, qb, w_lo, nwin, ntile; };
__device__ __forceinline__ AttnUnitInfo attn_decode(int uidx) {
    AttnUnitInfo u; u.b = uidx >> 7; u.hkv = (uidx >> 5) & 3; u.qb = uidx & 31;
    u.w_lo = u.qb - 2 < 0 ? 0 : u.qb - 2; const int w_hi = u.qb + 2 > 31 ? 31 : u.qb + 2; u.nwin = w_hi - u.w_lo + 1; u.ntile = u.nwin + 4; return u;
}
__device__ __forceinline__ float max3f(float a, float b, float c) { float r; asm("v_max3_f32 %0, %1, %2, %3" : "=v"(r) : "v"(a), "v"(b), "v"(c)); return r; }
__device__ __forceinline__ void attn_finish(const Params& P, const f32x16& o0, const f32x16& o1, float lrun, int b, int hkv, int qb, int g, int wsub, int r32, int hi) {
    const float ltot = lrun + __shfl_xor(lrun, 32), inv = 1.f / ltot;
    bf16_t* AO = (bf16_t*)(P.ws + WS_AO) + (size_t)(b * T + qb * 64 + 32 * wsub + r32) * 2048 + (hkv * 4 + g) * 64 + 4 * hi;
#pragma unroll
    for (int g4 = 0; g4 < 4; ++g4) {
        u32x2 w; w.x = cvt_pk_bf16(o0[4 * g4] * inv, o0[4 * g4 + 1] * inv); w.y = cvt_pk_bf16(o0[4 * g4 + 2] * inv, o0[4 * g4 + 3] * inv); *(u32x2*)(AO + 8 * g4) = w;
        w.x = cvt_pk_bf16(o1[4 * g4] * inv, o1[4 * g4 + 1] * inv); w.y = cvt_pk_bf16(o1[4 * g4 + 2] * inv, o1[4 * g4 + 3] * inv); *(u32x2*)(AO + 32 + 8 * g4) = w;
    }
}
__device__ __forceinline__ void attn_drain(const Params& P, LAS unsigned char* lds, const f32x16& Pa, const f32x16& Pb, f32x16& o0, f32x16& o1, float lrun, int vslot,
                                           int cu, int nun, int ubase, int GY, int g, int wsub, int r32, int hi) {
    float sacc = 0.f;
#pragma unroll
    for (int r = 0; r < 16; ++r) sacc += Pa[r] + Pb[r];
    lrun += sacc;
    const LAS unsigned char* Vp = lds + vslot * 16384 + 8192 + hi * 1024 + r32 * 16;
#pragma unroll
    for (int ks = 0; ks < 4; ++ks) {
        const f32x16& S = ks < 2 ? Pa : Pb; const int o = 8 * (ks & 1);
        const u32x4 pw = (u32x4){cvt_pk_bf16(S[o], S[o + 1]), cvt_pk_bf16(S[o + 2], S[o + 3]), cvt_pk_bf16(S[o + 4], S[o + 5]), cvt_pk_bf16(S[o + 6], S[o + 7])};
        const bf16x8 v0 = *(const LAS bf16x8*)(Vp + (2 * ks) * 1024), v1 = *(const LAS bf16x8*)(Vp + (2 * ks) * 1024 + 512);
        const bf16x8 pb = __builtin_bit_cast(bf16x8, pw);
        o0 = __builtin_amdgcn_mfma_f32_32x32x16_bf16(v0, pb, o0, 0, 0, 0); o1 = __builtin_amdgcn_mfma_f32_32x32x16_bf16(v1, pb, o1, 0, 0, 0);
    }
    const AttnUnitInfo li = attn_decode(ubase + GY * (nun - 1));
    attn_finish(P, o0, o1, lrun, li.b, li.hkv, li.qb, g, wsub, r32, hi);
}
__device__ __forceinline__ void attn_phase(const Params& P, LAS unsigned char* lds) {
    const int tid = threadIdx.x, lane = tid & 63, wid = __builtin_amdgcn_readfirstlane(tid >> 6), r32 = lane & 31, hi = lane >> 5;
    constexpr int NU = NBF * 4 * 32;
    const int G = gridDim.x, xg = blockIdx.x & 7, yg = blockIdx.x >> 3, GY = G >> 3;
    const int nun = (NU / 8 - yg + GY - 1) / GY;
    if (nun <= 0) return;
    const int ubase = xg * (NU / 8) + yg;
    const bf16_t* Q = (const bf16_t*)(P.ws + WS_Q);
    const unsigned char* KB = P.ws + WS_KB; const unsigned char* VB = P.ws + WS_VB; const unsigned char* KCB = P.ws + WS_KCB; const unsigned char* VCB = P.ws + WS_VCB;
    const int g = wid >> 1, wsub = wid & 1;
#define AT_WAIT(n) asm volatile("s_waitcnt vmcnt(" #n ")" ::: "memory")
#define AT_SB() __builtin_amdgcn_sched_barrier(0)
    int pu = 0, pit = 0, pstep = 0, pslot = 0; AttnUnitInfo pinfo = attn_decode(ubase);
    auto issue = [&]() {
        const size_t bh = (size_t)(pinfo.b * 4 + pinfo.hkv);
        const unsigned char* ks = pit < pinfo.nwin ? KB + (bh * 32 + pinfo.w_lo + pit) * 8192 : KCB + (bh * 4 + (pit - pinfo.nwin)) * 8192;
        const unsigned char* vs = pit < pinfo.nwin ? VB + (bh * 32 + pinfo.w_lo + pit) * 8192 : VCB + (bh * 4 + (pit - pinfo.nwin)) * 8192;
        LAS unsigned char* dst = lds + pslot * 16384 + wid * 1024;
        __builtin_amdgcn_global_load_lds((const unsigned*)(ks + wid * 1024 + lane * 16), (LAS unsigned*)dst, 16, 0, 0);
        __builtin_amdgcn_global_load_lds((const unsigned*)(vs + wid * 1024 + lane * 16), (LAS unsigned*)(dst + 8192), 16, 0, 0);
        ++pstep; pslot = pslot == ATT_NS - 1 ? 0 : pslot + 1; ++pit;
        if (pit == pinfo.ntile) { pit = 0; ++pu; if (pu < nun) pinfo = attn_decode(ubase + GY * pu); }
    };
    int total = 0;
    for (int k = 0; k < nun; ++k) total += attn_decode(ubase + GY * k).ntile;
    *(LAS u32x4*)(lds + (ATT_NS - 1) * 16384 + 8192 + tid * 16) = (u32x4){0u, 0u, 0u, 0u};
    __syncthreads();
    int cu = 0, it = 0, step = 0, cslot = 0, vslot = ATT_NS - 1; AttnUnitInfo ci = attn_decode(ubase);
    int fb = 0, fhkv = 0, fqb = 0;
    constexpr int ATT_QOFF = ATT_NS * 16384;
    auto issueQ = [&](const AttnUnitInfo& ui) {
        const bf16_t* qp = Q + (size_t)(ui.b * T + ui.qb * 64 + 32 * wsub + r32) * 1024 + (ui.hkv * 4 + g) * 64 + hi * 8;
#pragma unroll
        for (int j = 0; j < 4; ++j)
            __builtin_amdgcn_global_load_lds((const unsigned*)(qp + 16 * j), (LAS unsigned*)(lds + ATT_QOFF + wid * 4096 + j * 1024), 16, 0, 0);
    };
    float sk0 = P.sink[0 * 4 + g] * LOG2E, sk1 = P.sink[1 * 4 + g] * LOG2E, sk2 = P.sink[2 * 4 + g] * LOG2E, sk3 = P.sink[3 * 4 + g] * LOG2E;
    asm volatile("s_waitcnt vmcnt(0)" : "+v"(sk0), "+v"(sk1), "+v"(sk2), "+v"(sk3) :: "memory");
    bf16x8 qf[4];
    float sink_c = 0.f;
    const f32x16 zero16 = {0.f, 0.f, 0.f, 0.f, 0.f, 0.f, 0.f, 0.f, 0.f, 0.f, 0.f, 0.f, 0.f, 0.f, 0.f, 0.f};
    f32x16 o0, o1, pA0, pA1, pB0, pB1;
    float mrun = 0.f, lrun = 0.f; bool slow = false;
#pragma unroll
    for (int r = 0; r < 16; ++r) { o0[r] = 0.f; o1[r] = 0.f; pA0[r] = 0.f; pA1[r] = 0.f; pB0[r] = 0.f; pB1[r] = 0.f; }
    bf16x8 fr[4]; u32x4 pw[4];
    issueQ(ci);
    issue(); if (total > 1) issue(); if (total > 2) issue();
    if (total > 2) AT_WAIT(2); else AT_WAIT(0);
    __builtin_amdgcn_s_barrier(); asm volatile("" ::: "memory");
    if (pstep < total) issue();
#define AT_FA(base, i) (*(const LAS bf16x8*)((base) + (((i) >> 1) * 2) * 1024 + ((i) & 1) * 512))
    { const LAS unsigned char* K0 = lds + hi * 1024 + r32 * 16; fr[0] = AT_FA(K0, 0); fr[1] = AT_FA(K0, 1); fr[2] = AT_FA(K0, 2); }

#define AT_PK(Pa, Pb, w) cvt_pk_bf16((w) < 8 ? Pa[2 * (w)] : Pb[2 * (w) - 16], (w) < 8 ? Pa[2 * (w) + 1] : Pb[2 * (w) - 15])
#define AT_PV(Pa, Pb, i) ((i) < 16 ? Pa[(i)] : Pb[(i) - 16])
#define AT_GAPA(gi, Cn, Pa, Pb) do { \
        Cn = __builtin_amdgcn_mfma_f32_32x32x16_bf16(fr[(gi) & 3], qf[(gi) >> 1], (gi) < 2 ? zero16 : Cn, 0, 0, 0); \
        if ((gi) + 3 < 8) fr[((gi) + 3) & 3] = AT_FA(Kc, (gi) + 3); else fr[((gi) + 3) & 3] = AT_FA(Vp, (gi) + 3 - 8); \
        sacc += AT_PV(Pa, Pb, 4 * (gi)) + AT_PV(Pa, Pb, 4 * (gi) + 1); sacc2 += AT_PV(Pa, Pb, 4 * (gi) + 2) + AT_PV(Pa, Pb, 4 * (gi) + 3); \
        pw[(gi) >> 1][2 * ((gi) & 1)] = AT_PK(Pa, Pb, 2 * (gi)); pw[(gi) >> 1][2 * ((gi) & 1) + 1] = AT_PK(Pa, Pb, 2 * (gi) + 1); AT_SB(); } while (0)
#define AT_GAPB(gi, Cx, cb) do { \
        if ((gi) & 1) o1 = __builtin_amdgcn_mfma_f32_32x32x16_bf16(fr[(gi) & 3], __builtin_bit_cast(bf16x8, pw[(gi) >> 1]), o1, 0, 0, 0); \
        else o0 = __builtin_amdgcn_mfma_f32_32x32x16_bf16(fr[(gi) & 3], __builtin_bit_cast(bf16x8, pw[(gi) >> 1]), o0, 0, 0, 0); \
        if ((gi) + 3 < 8) fr[((gi) + 3) & 3] = AT_FA(Vp, (gi) + 3); else fr[((gi) + 3) & 3] = AT_FA(Kn, (gi) + 3 - 8); \
        Cx[cb] = __builtin_amdgcn_exp2f(Cx[cb]); Cx[cb + 1] = __builtin_amdgcn_exp2f(Cx[cb + 1]); Cx[cb + 2] = __builtin_amdgcn_exp2f(Cx[cb + 2]); Cx[cb + 3] = __builtin_amdgcn_exp2f(Cx[cb + 3]); \
        AT_SB(); } while (0)
#define AT_STEP(C0, C1, Pa, Pb) do { \
        const bool first = (it == 0); \
        if (first) { fb = ci.b; fhkv = ci.hkv; fqb = ci.qb; if (step > 0) { const AttnUnitInfo pi = attn_decode(ubase + GY * (cu - 1)); fb = pi.b; fhkv = pi.hkv; fqb = pi.qb; } \
            sink_c = ci.hkv == 0 ? sk0 : ci.hkv == 1 ? sk1 : ci.hkv == 2 ? sk2 : sk3; mrun = 0.f; slow = false; \
            _Pragma("unroll") for (int ks = 0; ks < 4; ++ks) qf[ks] = *(const LAS bf16x8*)(lds + ATT_QOFF + wid * 4096 + (2 * ks + hi) * 512 + r32 * 16); \
            asm volatile("s_waitcnt lgkmcnt(0)" ::: "memory"); \
            if (cu + 1 < nun) issueQ(attn_decode(ubase + GY * (cu + 1))); } \
        const LAS unsigned char* Kc = lds + cslot * 16384 + hi * 1024 + r32 * 16; \
        const LAS unsigned char* Vp = lds + vslot * 16384 + 8192 + hi * 1024 + r32 * 16; \
        const int nslot = cslot == ATT_NS - 1 ? 0 : cslot + 1; \
        const LAS unsigned char* Kn = lds + nslot * 16384 + hi * 1024 + r32 * 16; \
        float sacc = 0.f, sacc2 = 0.f; AT_SB(); \
        AT_GAPA(0, C0, Pa, Pb); AT_GAPA(1, C1, Pa, Pb); AT_GAPA(2, C0, Pa, Pb); AT_GAPA(3, C1, Pa, Pb); AT_GAPA(4, C0, Pa, Pb); AT_GAPA(5, C1, Pa, Pb); AT_GAPA(6, C0, Pa, Pb); AT_GAPA(7, C1, Pa, Pb); \
        lrun += sacc + sacc2; \
        if (slow) { _Pragma("unroll") for (int r = 0; r < 16; ++r) { C0[r] -= mrun; C1[r] -= mrun; } } \
        if (it < ci.nwin) { const int wt = ci.w_lo + it, dq = wt - ci.qb; \
            if (dq == 2 || dq == -2) { const int base = ci.qb * 64 + 32 * wsub + r32 - 64 * wt; \
                _Pragma("unroll") for (int r = 0; r < 16; ++r) { const int d0 = base - crow(r, hi), d1 = d0 - 32; \
                    if (d0 > 128 || d0 < -128) C0[r] = -1e30f; if (d1 > 128 || d1 < -128) C1[r] = -1e30f; } } } \
        float mx; { float ma = max3f(C0[0], C0[1], C1[0]), mb = max3f(C0[2], C0[3], C1[1]); ma = max3f(ma, C1[2], C1[3]); \
            _Pragma("unroll") for (int r = 4; r < 16; r += 4) { ma = max3f(ma, C0[r], C0[r + 1]); mb = max3f(mb, C0[r + 2], C0[r + 3]); ma = max3f(ma, C1[r], C1[r + 1]); mb = max3f(mb, C1[r + 2], C1[r + 3]); } \
            mx = fmaxf(ma, mb); mx = fmaxf(mx, __shfl_xor(mx, 32)); } \
        float fres = 1.f; bool resc = false; \
        if (__any(mx > ATT_THR)) { const float dl = fmaxf(mx, 0.f); fres = __builtin_amdgcn_exp2f(-dl); mrun += dl; resc = true; slow = true; \
            _Pragma("unroll") for (int r = 0; r < 16; ++r) { C0[r] -= dl; C1[r] -= dl; } } \
        AT_SB(); \
        AT_GAPB(0, C0, 0); AT_GAPB(1, C0, 4); AT_GAPB(2, C0, 8); AT_GAPB(3, C0, 12); AT_GAPB(4, C1, 0); AT_GAPB(5, C1, 4); AT_GAPB(6, C1, 8); AT_GAPB(7, C1, 12); \
        if (first && step > 0) { attn_finish(P, o0, o1, lrun, fb, fhkv, fqb, g, wsub, r32, hi); \
            _Pragma("unroll") for (int r = 0; r < 16; ++r) { o0[r] = 0.f; o1[r] = 0.f; } lrun = (hi == 0 ? __builtin_amdgcn_exp2f(sink_c) : 0.f) * fres; } \
        else if (first) { lrun = (hi == 0 ? __builtin_amdgcn_exp2f(sink_c) : 0.f) * fres; } \
        else if (resc) { lrun *= fres; _Pragma("unroll") for (int r = 0; r < 16; ++r) { o0[r] *= fres; o1[r] *= fres; } } \
        ++it; ++step; vslot = cslot; cslot = nslot; \
        if (it == ci.ntile) { it = 0; ++cu; if (cu < nun) ci = attn_decode(ubase + GY * cu); } \
        if (step < total) { \
            const int ahead = pstep - step;        \
            if (ahead >= 3) AT_WAIT(2); else AT_WAIT(0); \
            __builtin_amdgcn_s_barrier(); asm volatile("" ::: "memory"); \
            if (pstep < total) issue(); \
        } } while (0)

    while (step < total) {
        AT_STEP(pB0, pB1, pA0, pA1);
        if (step >= total) {
            attn_drain(P, lds, pB0, pB1, o0, o1, lrun, vslot, cu, nun, ubase, GY, g, wsub, r32, hi);
            break; }
        AT_STEP(pA0, pA1, pB0, pB1);
        if (step >= total) { attn_drain(P, lds, pA0, pA1, o0, o1, lrun, vslot, cu, nun, ubase, GY, g, wsub, r32, hi); break; }
    }
    AT_WAIT(0);
    __syncthreads();
#undef AT_STEP
#undef AT_GAPA
#undef AT_GAPB
#undef AT_PK
#undef AT_PV
#undef AT_FA
#undef AT_WAIT
#undef AT_SB
}
__device__ __forceinline__ void ph_mix(const Params& P, LAS unsigned char* lds) {
    const int G = gridDim.x;
    attn_phase(P, lds);
#if (FK_DBL >> 11) & 1
    attn_phase(P, lds);
#endif
#if (FK_DBL >> 12) & 1
    for (int rep = 0; rep < 2; ++rep)
#endif
    const bf16_t* Z = (const bf16_t*)(P.ws + WS_Z); const bf16_t* BB = (const bf16_t*)(P.ws + WS_BB); bf16_t* AO = (bf16_t*)(P.ws + WS_AO);
    for (int it = blockIdx.x * 512 + threadIdx.x; it < (M / 16) * 128; it += G * 512) {
        const int cch = it & 127, tr = it >> 7, row0 = tr * 16, tl = row0 & 2047;
        const f32x4 wa = *(const f32x4*)(P.conv_w + cch * 8), wb = *(const f32x4*)(P.conv_w + cch * 8 + 4);
        const f32x4 wc0 = *(const f32x4*)(P.conv_w + 1024 + cch * 8), wc1 = *(const f32x4*)(P.conv_w + 1024 + cch * 8 + 4);
        const f32x4 we0 = *(const f32x4*)(P.conv_w + 2048 + cch * 8), we1 = *(const f32x4*)(P.conv_w + 2048 + cch * 8 + 4);
        const bf16_t* zp = Z + (size_t)row0 * 1024 + cch * 8;
        u32x4 zm = tl > 0 ? *(const u32x4*)(zp - 1024) : (u32x4){0u, 0u, 0u, 0u};
        u32x4 zc = *(const u32x4*)zp;
#pragma unroll 4
        for (int i = 0; i < 16; ++i) {
            const u32x4 zn = (tl + i + 1 < 2048) ? *(const u32x4*)(zp + (size_t)(i + 1) * 1024) : (u32x4){0u, 0u, 0u, 0u};
            const u32x4 bv = *(const u32x4*)(BB + (size_t)(row0 + i) * 1024 + cch * 8);
            float y[8];
#pragma unroll
            for (int k = 0; k < 4; ++k) {
                const float w0l = k < 2 ? wa[2 * k] : wb[2 * k - 4], w0h = k < 2 ? wa[2 * k + 1] : wb[2 * k - 3];
                const float w1l = k < 2 ? wc0[2 * k] : wc1[2 * k - 4], w1h = k < 2 ? wc0[2 * k + 1] : wc1[2 * k - 3];
                const float w2l = k < 2 ? we0[2 * k] : we1[2 * k - 4], w2h = k < 2 ? we0[2 * k + 1] : we1[2 * k - 3];
                y[2 * k] = bf_lo(bv[k]) * (w0l * bf_lo(zm[k]) + w1l * bf_lo(zc[k]) + w2l * bf_lo(zn[k]));
                y[2 * k + 1] = bf_hi(bv[k]) * (w0h * bf_hi(zm[k]) + w1h * bf_hi(zc[k]) + w2h * bf_hi(zn[k]));
            }
            u32x4 o; o.x = cvt_pk_bf16(y[0], y[1]); o.y = cvt_pk_bf16(y[2], y[3]); o.z = cvt_pk_bf16(y[4], y[5]); o.w = cvt_pk_bf16(y[6], y[7]);
            *(u32x4*)(AO + (size_t)(row0 + i) * 2048 + 1024 + cch * 8) = o;
            zm = zc; zc = zn;
        }
    }
}

struct RowColSched {
    int G, c, nM, nN; const char *A, *B; size_t ts;
    __device__ __forceinline__ bool next(int i, Unit& u) const {
        const int nwg = nM * nN, Lx = i * G + c; if (Lx >= nwg) return false;
        const int wgid = (Lx % 8) * (nwg / 8) + Lx / 8;
        const int nig = 8 * nN, gid = wgid / nig, w = wgid % nig;
        u.pm = gid * 8 + (w % 8); u.pn = w / 8; u.a = A + (size_t)u.pm * ts; u.b = B + (size_t)u.pn * ts; u.kind = 0; u.aux = 0; u.rows = nullptr; return true;
    }
};
struct EpiProj {
    const bf16_t *rb, *sgc; bf16_t* mb;
    __device__ __forceinline__ void mid(f32x4 (&acc)[2][2][4][2], const Unit& u, int wr, int wc, int fr, int fq) const {
#pragma unroll
        for (int ai = 0; ai < 2; ++ai)
#pragma unroll
            for (int m = 0; m < 4; ++m) { const int r = u.pm * 256 + 128 * ai + 64 * wr + 16 * m + fr;
#pragma unroll
                for (int bj = 0; bj < 2; ++bj) { const u32x4 w = *(const u32x4*)(rb + (size_t)r * 1024 + u.pn * 256 + 128 * bj + 32 * wc + 8 * fq);
                    acc[ai][bj][m][0] *= (f32x4){bf_lo(w.x), bf_hi(w.x), bf_lo(w.y), bf_hi(w.y)}; acc[ai][bj][m][1] *= (f32x4){bf_lo(w.z), bf_hi(w.z), bf_lo(w.w), bf_hi(w.w)}; } }
    }
    __device__ __forceinline__ void operator()(const f32x4 (&acc)[2][2][4][2], const Unit& u, int wr, int wc, int fr, int fq) const {
#pragma unroll
        for (int ai = 0; ai < 2; ++ai)
#pragma unroll
            for (int m = 0; m < 4; ++m) { const int r = u.pm * 256 + 128 * ai + 64 * wr + 16 * m + fr;
#pragma unroll
                for (int bj = 0; bj < 2; ++bj) { const size_t off = (size_t)r * 1024 + u.pn * 256 + 128 * bj + 32 * wc + 8 * fq; const u32x4 w = *(const u32x4*)(sgc + off);
                    const f32x4 v0 = acc[ai][bj][m][0] * (f32x4){bf_lo(w.x), bf_hi(w.x), bf_lo(w.y), bf_hi(w.y)}, v1 = acc[ai][bj][m][1] * (f32x4){bf_lo(w.z), bf_hi(w.z), bf_lo(w.w), bf_hi(w.w)};
                    u32x4 o; o.x = cvt_pk_bf16(v0.x, v0.y); o.y = cvt_pk_bf16(v0.z, v0.w); o.z = cvt_pk_bf16(v1.x, v1.y); o.w = cvt_pk_bf16(v1.z, v1.w);
                    *(u32x4*)(mb + off) = o; } }
    }
};
__device__ __forceinline__ void ph_proj(const Params& P, LAS unsigned char* lds) {
    RowColSched S; S.G = gridDim.x; S.c = blockIdx.x; S.nM = M / 256; S.nN = 4; S.A = (const char*)(P.ws + WS_AO); S.B = (const char*)(P.ws + WS_WP); S.ts = (size_t)256 * 2048 * 2;
    EpiProj E; E.rb = (const bf16_t*)(P.ob + OB_RB); E.sgc = (const bf16_t*)(P.ob + OB_SGC); E.mb = (bf16_t*)(P.ws + WS_MB);
    gemm_phase<EpiProj, RowColSched, true>(lds, 2048, S, E);
}
struct EpiOut {
    const float* mod; bf16_t* dl;
    __device__ __forceinline__ void operator()(const f32x4 (&acc)[2][2][4][2], const Unit& u, int wr, int wc, int fr, int fq) const {
        const int b = (u.pm * 256) >> 11;
#pragma unroll
        for (int bj = 0; bj < 2; ++bj) { const int col = u.pn * 256 + 128 * bj + 32 * wc + 8 * fq;
            const f32x4 g0 = *(const f32x4*)(mod + b * 6144 + 2048 + col), g1 = *(const f32x4*)(mod + b * 6144 + 2048 + col + 4);
#pragma unroll
            for (int ai = 0; ai < 2; ++ai)
#pragma unroll
                for (int m = 0; m < 4; ++m) { const size_t off = (size_t)(u.pm * 256 + 128 * ai + 64 * wr + 16 * m + fr) * 1024 + col;
                    const f32x4 v0 = g0 * acc[ai][bj][m][0], v1 = g1 * acc[ai][bj][m][1];
                    u32x4 w; w.x = cvt_pk_bf16(v0.x, v0.y); w.y = cvt_pk_bf16(v0.z, v0.w); w.z = cvt_pk_bf16(v1.x, v1.y); w.w = cvt_pk_bf16(v1.z, v1.w);
                    *(u32x4*)(dl + off) = w; } }
    }
};
__device__ __forceinline__ void ph_out(const Params& P, LAS unsigned char* lds) {
    RowColSched S; S.G = gridDim.x; S.c = blockIdx.x; S.nM = M / 256; S.nN = 4; S.A = (const char*)(P.ws + WS_MB); S.B = (const char*)(P.ws + WS_WO); S.ts = (size_t)256 * 1024 * 2;
    EpiOut E; E.mod = (const float*)(P.ws + WS_MOD); E.dl = (bf16_t*)(P.ws + WS_DL);
    gemm_phase<EpiOut, RowColSched, false>(lds, 1024, S, E);
}

__device__ __forceinline__ void ph_router(const Params& P, LAS unsigned char* lds) {
    const int tid = threadIdx.x, lane = tid & 63, wave = tid >> 6;
    LAS float* wt = (LAS float*)lds;
    for (int i = tid; i < 16384; i += 512) { const int k = i >> 4, e = i & 15; wt[e * 1024 + k] = P.w_router[i]; }
    __syncthreads();
    const bf16_t* DL = (const bf16_t*)(P.ws + WS_DL); const float* mod = (const float*)(P.ws + WS_MOD);
    bf16_t* HX2 = (bf16_t*)(P.ws + WS_HX2); float* AFF = (float*)(P.ws + WS_AFF);
    f32x4 nx0[4], nx1[4]; u32x4 nd0[2], nd1[2];
    const int rp0 = blockIdx.x * 8 + wave, rstep = gridDim.x * 8;
#define RT_LOAD(rpv) do { _Pragma("unroll") for (int j = 0; j < 2; ++j) { const size_t o0 = (size_t)((rpv) * 2) * D + 8 * lane + 512 * j; \
        nx0[2 * j] = __builtin_nontemporal_load((const f32x4*)(P.x + o0)); nx0[2 * j + 1] = __builtin_nontemporal_load((const f32x4*)(P.x + o0 + 4)); nx1[2 * j] = __builtin_nontemporal_load((const f32x4*)(P.x + o0 + D)); nx1[2 * j + 1] = __builtin_nontemporal_load((const f32x4*)(P.x + o0 + D + 4)); \
        nd0[j] = *(const u32x4*)(DL + o0); nd1[j] = *(const u32x4*)(DL + o0 + D); } } while (0)
    if (rp0 < M / 2) RT_LOAD(rp0);
    for (int rp = rp0; rp < M / 2; rp += rstep) {
        const int row = rp * 2, b = row >> 11; const float* mv = mod + b * 6144;
        f32x4 v0[4], v1[4]; float s0 = 0.f, s1 = 0.f;
#pragma unroll
        for (int j = 0; j < 2; ++j) { f32x4 a, c; bf8_to_f32(nd0[j], a, c); v0[2 * j] = nx0[2 * j] + a; v0[2 * j + 1] = nx0[2 * j + 1] + c; bf8_to_f32(nd1[j], a, c); v1[2 * j] = nx1[2 * j] + a; v1[2 * j + 1] = nx1[2 * j + 1] + c;
            s0 += sq4(v0[2 * j]) + sq4(v0[2 * j + 1]); s1 += sq4(v1[2 * j]) + sq4(v1[2 * j + 1]); }
        if (rp + rstep < M / 2) RT_LOAD(rp + rstep);
        const float r0 = 1.0f / sqrtf(wave_sum(s0) * (1.f / D) + 1e-6f), r1 = 1.0f / sqrtf(wave_sum(s1) * (1.f / D) + 1e-6f);
#pragma unroll
        for (int j = 0; j < 2; ++j) { const int c0 = 8 * lane + 512 * j;
            const f32x4 g0 = *(const f32x4*)(P.norm2_g + c0) * (*(const f32x4*)(mv + 4096 + c0) + 1.0f), g1 = *(const f32x4*)(P.norm2_g + c0 + 4) * (*(const f32x4*)(mv + 4096 + c0 + 4) + 1.0f);
            const f32x4 sh0 = *(const f32x4*)(mv + 3072 + c0), sh1 = *(const f32x4*)(mv + 3072 + c0 + 4);
            v0[2 * j] = v0[2 * j] * r0 * g0 + sh0; v0[2 * j + 1] = v0[2 * j + 1] * r0 * g1 + sh1; v1[2 * j] = v1[2 * j] * r1 * g0 + sh0; v1[2 * j + 1] = v1[2 * j + 1] * r1 * g1 + sh1;
            *(u32x4*)(HX2 + (size_t)row * D + c0) = f32_to_bf8(v0[2 * j], v0[2 * j + 1]); *(u32x4*)(HX2 + (size_t)(row + 1) * D + c0) = f32_to_bf8(v1[2 * j], v1[2 * j + 1]); }
        float pa[16], pc[16];
#pragma unroll
        for (int e = 0; e < 16; ++e) { float a = 0.f, c = 0.f;
#pragma unroll
            for (int j = 0; j < 4; ++j) { const f32x4 w = *(const LAS f32x4*)(wt + e * 1024 + 8 * lane + 512 * (j >> 1) + 4 * (j & 1));
                a += dot4(v0[j], w); c += dot4(v1[j], w); }
            pa[e] = a; pc[e] = c;
            if ((e & 1) == 1) __builtin_amdgcn_sched_barrier(0); }
#define RT_HALVE(H, DIST) do { const bool up = (lane & (DIST)) != 0; _Pragma("unroll") for (int i = 0; i < (H); ++i) { \
            const float ka = up ? pa[i + (H)] : pa[i], sa = up ? pa[i] : pa[i + (H)], kc = up ? pc[i + (H)] : pc[i], sc = up ? pc[i] : pc[i + (H)]; \
            pa[i] = ka + __shfl_xor(sa, (DIST)); pc[i] = kc + __shfl_xor(sc, (DIST)); } } while (0)
        RT_HALVE(8, 32); RT_HALVE(4, 16); RT_HALVE(2, 8); RT_HALVE(1, 4);
#undef RT_HALVE
        float l0 = pa[0], l1 = pc[0];
        l0 += __shfl_xor(l0, 2); l1 += __shfl_xor(l1, 2); l0 += __shfl_xor(l0, 1); l1 += __shfl_xor(l1, 1);
        float m0 = l0, m1 = l1;
#pragma unroll
        for (int o = 4; o < 64; o <<= 1) { m0 = fmaxf(m0, __shfl_xor(m0, o)); m1 = fmaxf(m1, __shfl_xor(m1, o)); }
        const float e0 = expf(l0 - m0), e1 = expf(l1 - m1);
        float z0 = e0, z1 = e1;
#pragma unroll
        for (int o = 4; o < 64; o <<= 1) { z0 += __shfl_xor(z0, o); z1 += __shfl_xor(z1, o); }
        if ((lane & 3) == 0) { const int ex = ((lane >> 5) & 1) * 8 + ((lane >> 4) & 1) * 4 + ((lane >> 3) & 1) * 2 + ((lane >> 2) & 1); const int t = row & 2047;
            AFF[(size_t)(b * 16 + ex) * T + t] = e0 / z0; AFF[(size_t)(b * 16 + ex) * T + t + 1] = e1 / z1; }
    }
}

__device__ __forceinline__ int block_count4(bool p0, bool p1, bool p2, bool p3, LAS int* red, int par, int wave, int lane) {
    const int c = __builtin_popcountll(__ballot(p0)) + __builtin_popcountll(__ballot(p1)) + __builtin_popcountll(__ballot(p2)) + __builtin_popcountll(__ballot(p3));
    if (lane == 0) red[par * 8 + wave] = c;
    __syncthreads();
    const LAS int* r = red + par * 8;
    return (r[0] + r[1]) + (r[2] + r[3]) + (r[4] + r[5]) + (r[6] + r[7]);
}
__device__ __forceinline__ int block_excl_prefix(int v, LAS int* red, int wave, int lane, int& total) {
    int inc = v;
#pragma unroll
    for (int o = 1; o < 64; o <<= 1) { const int n = __shfl_up(inc, o); if (lane >= o) inc += n; }
    __syncthreads();
    if (lane == 63) red[wave] = inc;
    __syncthreads();
    int base = 0, tot = 0;
#pragma unroll
    for (int w = 0; w < 8; ++w) { const int s = red[w]; if (w < wave) base += s; tot += s; }
    total = tot; return base + inc - v;
}
__device__ __forceinline__ void ph_topk(const Params& P, LAS unsigned char* lds) {
    const int tid = threadIdx.x, lane = tid & 63, wave = tid >> 6;
    LAS int* red = (LAS int*)lds;
    const float* AFF = (const float*)(P.ws + WS_AFF); int* IDX = (int*)(P.ws + WS_IDX); float* GATE = (float*)(P.ws + WS_GATE); int* SEL = (int*)(P.ws + WS_SEL);
    for (int be = blockIdx.x; be < NBF * 16; be += gridDim.x) {
        const int b = be >> 4, e = be & 15;
        const u32x4 kv = *(const u32x4*)(AFF + (size_t)be * T + tid * 4);
        unsigned thr = 0u;
        for (int bit = 31; bit >= 0; --bit) { const unsigned cand = thr | (1u << bit);
            const int cnt = block_count4(kv.x >= cand, kv.y >= cand, kv.z >= cand, kv.w >= cand, red, bit & 1, wave, lane);
            if (cnt >= CAP) thr = cand; }
        const int ngt = block_count4(kv.x > thr, kv.y > thr, kv.z > thr, kv.w > thr, red, 1, wave, lane);
        const int need = CAP - ngt;
        int tot;
        const int e0 = kv.x == thr, e1 = kv.y == thr, e2 = kv.z == thr, e3 = kv.w == thr;
        const int eqb = block_excl_prefix(e0 + e1 + e2 + e3, red + 32, wave, lane, tot);
        const int s0 = (kv.x > thr) || (e0 && eqb < need), s1 = (kv.y > thr) || (e1 && eqb + e0 < need), s2 = (kv.z > thr) || (e2 && eqb + e0 + e1 < need),
                  s3 = (kv.w > thr) || (e3 && eqb + e0 + e1 + e2 < need);
        const int sb = block_excl_prefix(s0 + s1 + s2 + s3, red + 32, wave, lane, tot);
        const int p0 = sb, p1 = sb + s0, p2 = p1 + s1, p3 = p2 + s2;
        const int t0 = 4 * tid;
        if (s0) { IDX[be * CAP + p0] = t0; GATE[be * CAP + p0] = __uint_as_float(kv.x); }
        if (s1) { IDX[be * CAP + p1] = t0 + 1; GATE[be * CAP + p1] = __uint_as_float(kv.y); }
        if (s2) { IDX[be * CAP + p2] = t0 + 2; GATE[be * CAP + p2] = __uint_as_float(kv.z); }
        if (s3) { IDX[be * CAP + p3] = t0 + 3; GATE[be * CAP + p3] = __uint_as_float(kv.w); }
        SEL[(size_t)(b * T + t0) * 16 + e] = s0 ? p0 : -1; SEL[(size_t)(b * T + t0 + 1) * 16 + e] = s1 ? p1 : -1;
        SEL[(size_t)(b * T + t0 + 2) * 16 + e] = s2 ? p2 : -1; SEL[(size_t)(b * T + t0 + 3) * 16 + e] = s3 ? p3 : -1;
        __syncthreads();
    }
}

struct MoeUpSched {
    int G, c; const char *hx2, *wgu; const int* idx;
    __device__ __forceinline__ bool next(int i, Unit& u) const {
        const int Lx = i * G + c; if (Lx >= NBF * 128) return false;
        const int x = Lx & 7, j = Lx >> 3, e = 2 * x + j / (NBF * 8), jj = j % (NBF * 8), rg = jj >> 5, w = jj & 31;
        const int smp = 8 * (rg >> 1) + (w & 7), pn = 4 * (rg & 1) + (w >> 3), be = smp * 16 + e;
        u.pm = be; u.pn = pn; u.kind = 0; u.aux = e; u.a = hx2 + (size_t)smp * ((size_t)T * 1024 * 2); u.rows = idx + be * CAP; u.b = wgu + ((size_t)e * 2048 + pn * 256) * 2048; return true;
    }
};
struct EpiUp {
    bf16_t* hb;
    __device__ __forceinline__ void operator()(const f32x4 (&acc)[2][2][4][2], const Unit& u, int wr, int wc, int fr, int fq) const {
#pragma unroll
        for (int ai = 0; ai < 2; ++ai)
#pragma unroll
            for (int m = 0; m < 4; ++m) { const int r = u.pm * 256 + 128 * ai + 64 * wr + 16 * m + fr;
                f32x4 h[2];
#pragma unroll
                for (int n = 0; n < 2; ++n)
#pragma unroll
                    for (int j = 0; j < 4; ++j) { const float a = acc[ai][0][m][n][j]; h[n][j] = a * __builtin_amdgcn_rcpf(1.f + __expf(-a)) * acc[ai][1][m][n][j]; }
                u32x4 w; w.x = cvt_pk_bf16(h[0].x, h[0].y); w.y = cvt_pk_bf16(h[0].z, h[0].w); w.z = cvt_pk_bf16(h[1].x, h[1].y); w.w = cvt_pk_bf16(h[1].z, h[1].w);
                *(u32x4*)(hb + (size_t)r * 1024 + u.pn * 128 + 32 * wc + 8 * fq) = w; }
    }
};
__device__ __forceinline__ void ph_moe_up(const Params& P, LAS unsigned char* lds) {
    MoeUpSched S; S.G = gridDim.x; S.c = blockIdx.x; S.hx2 = (const char*)(P.ws + WS_HX2); S.idx = (const int*)(P.ws + WS_IDX); S.wgu = (const char*)(P.ws + WS_WGU);
    EpiUp E; E.hb = (bf16_t*)(P.ob + OB_HB);
    gemm_phase<EpiUp, MoeUpSched, false, true>(lds, 1024, S, E);
}
struct MoeDownSched {
    int G, c; const char *hb, *wd;
    __device__ __forceinline__ bool next(int i, Unit& u) const {
        const int Lx = i * G + c; if (Lx >= NBF * 64) return false;
        const int x = Lx & 7, j = Lx >> 3, e = 2 * x + j / (NBF * 4), jj = j % (NBF * 4), rg = jj >> 5, w = jj & 31;
        const int smp = 8 * rg + (w & 7), pn = w >> 3, be = smp * 16 + e;
        u.pm = be; u.pn = pn; u.kind = 0; u.aux = e; u.rows = nullptr; u.a = hb + (size_t)be * (256 * 1024 * 2); u.b = wd + ((size_t)e * 1024 + pn * 256) * 2048; return true;
    }
};
struct EpiDown {
    const float* gate; bf16_t* ye;
    __device__ __forceinline__ void operator()(const f32x4 (&acc)[2][2][4][2], const Unit& u, int wr, int wc, int fr, int fq) const {
#pragma unroll
        for (int ai = 0; ai < 2; ++ai)
#pragma unroll
            for (int m = 0; m < 4; ++m) { const int r = u.pm * 256 + 128 * ai + 64 * wr + 16 * m + fr; const float gt = gate[r];
#pragma unroll
                for (int bj = 0; bj < 2; ++bj) { const f32x4 v0 = acc[ai][bj][m][0] * gt, v1 = acc[ai][bj][m][1] * gt;
                    u32x4 w; w.x = cvt_pk_bf16(v0.x, v0.y); w.y = cvt_pk_bf16(v0.z, v0.w); w.z = cvt_pk_bf16(v1.x, v1.y); w.w = cvt_pk_bf16(v1.z, v1.w);
                    *(u32x4*)(ye + (size_t)r * 1024 + u.pn * 256 + 128 * bj + 32 * wc + 8 * fq) = w; } }
    }
};
__device__ __forceinline__ void ph_moe_down(const Params& P, LAS unsigned char* lds) {
    MoeDownSched S; S.G = gridDim.x; S.c = blockIdx.x; S.hb = (const char*)(P.ob + OB_HB); S.wd = (const char*)(P.ws + WS_WD);
    EpiDown E; E.gate = (const float*)(P.ws + WS_GATE); E.ye = (bf16_t*)(P.ws + WS_YE);
    gemm_phase<EpiDown, MoeDownSched, false>(lds, 1024, S, E);
}

__device__ __forceinline__ void ph_final(const Params& P) {
    const int lane = threadIdx.x & 63, wave = threadIdx.x >> 6;
    const bf16_t* DL = (const bf16_t*)(P.ws + WS_DL); const float* mod = (const float*)(P.ws + WS_MOD); const int* SEL = (const int*)(P.ws + WS_SEL); const bf16_t* YE = (const bf16_t*)(P.ws + WS_YE);
    constexpr int NR = 2;
#ifdef FK_TS
    float ts_eps; { const unsigned long long* tsp = (const unsigned long long*)(P.ws + WS_CTL) + 1800;
        const unsigned long long t0 = __hip_atomic_load(tsp + FK_TS, __ATOMIC_RELAXED, __HIP_MEMORY_SCOPE_AGENT); unsigned long long t1 = 0ull;
        for (int sp = 0; sp < 100000 && (t1 = __hip_atomic_load(tsp + FK_TS2, __ATOMIC_RELAXED, __HIP_MEMORY_SCOPE_AGENT)) == 0ull; ++sp) __builtin_amdgcn_s_sleep(2);
        ts_eps = (float)(t1 - t0) * FK_TS_SCALE; }
#endif
    for (int row0 = (blockIdx.x * 8 + wave) * NR; row0 < M; row0 += gridDim.x * 8 * NR) {
        const int b = row0 >> 11;
        int sv[NR]; f32x4 xv[NR][4]; u32x4 dv[NR][2];
#pragma unroll
        for (int r = 0; r < NR; ++r) { sv[r] = SEL[(size_t)(row0 + r) * 16 + (lane & 15)];
#pragma unroll
            for (int j = 0; j < 2; ++j) { const size_t o = (size_t)(row0 + r) * D + 8 * lane + 512 * j; xv[r][2 * j] = __builtin_nontemporal_load((const f32x4*)(P.x + o)); xv[r][2 * j + 1] = __builtin_nontemporal_load((const f32x4*)(P.x + o + 4)); dv[r][j] = __builtin_nontemporal_load((const u32x4*)(DL + o)); } }
        f32x4 mo[NR][4];
#pragma unroll
        for (int r = 0; r < NR; ++r)
#pragma unroll
            for (int j = 0; j < 4; ++j) mo[r][j] = (f32x4){0.f, 0.f, 0.f, 0.f};
#pragma unroll
        for (int e = 0; e < 16; ++e) {
#pragma unroll
            for (int r = 0; r < NR; ++r) { const int sl = __builtin_amdgcn_readlane(sv[r], e);
                if (sl >= 0) { const bf16_t* yr = YE + ((size_t)(b * 16 + e) * CAP + sl) * D + 8 * lane;
#pragma unroll
                    for (int j = 0; j < 2; ++j) { f32x4 a, c; bf8_to_f32(__builtin_nontemporal_load((const u32x4*)(yr + 512 * j)), a, c); mo[r][2 * j] += a; mo[r][2 * j + 1] += c; } } } }
#pragma unroll
        for (int r = 0; r < NR; ++r) { float ss = 0.f; f32x4 v[4];
#pragma unroll
            for (int j = 0; j < 2; ++j) { const int c0 = 8 * lane + 512 * j; f32x4 a, c; bf8_to_f32(dv[r][j], a, c);
                v[2 * j] = xv[r][2 * j] + a + *(const f32x4*)(mod + b * 6144 + 5120 + c0) * mo[r][2 * j]; v[2 * j + 1] = xv[r][2 * j + 1] + c + *(const f32x4*)(mod + b * 6144 + 5120 + c0 + 4) * mo[r][2 * j + 1];
                ss += sq4(v[2 * j]) + sq4(v[2 * j + 1]); }
            const float rs = 1.0f / sqrtf(wave_sum(ss) * (1.f / D) + 1e-6f);
#pragma unroll
            for (int j = 0; j < 2; ++j) { const int c0 = 8 * lane + 512 * j;
#ifdef FK_TS
                { const f32x4 tsa = {1.f + ts_eps, 1.f - ts_eps, 1.f + ts_eps, 1.f - ts_eps};
                  *(f32x4*)(P.out + (size_t)(row0 + r) * D + c0) = v[2 * j] * rs * *(const f32x4*)(P.fg + c0) * tsa; *(f32x4*)(P.out + (size_t)(row0 + r) * D + c0 + 4) = v[2 * j + 1] * rs * *(const f32x4*)(P.fg + c0 + 4) * tsa; } } }
#else
                __builtin_nontemporal_store(v[2 * j] * rs * *(const f32x4*)(P.fg + c0), (f32x4*)(P.out + (size_t)(row0 + r) * D + c0)); __builtin_nontemporal_store(v[2 * j + 1] * rs * *(const f32x4*)(P.fg + c0 + 4), (f32x4*)(P.out + (size_t)(row0 + r) * D + c0 + 4)); } }
#endif
    }
}

#define XB_TMO      128
#define XB_XCNT(j)  (256  + 64 * (j))
#define XB_XSUB(j)  (1280 + 64 * (j))
#define XB_XGEN(j)  (2304 + 64 * (j))
#define XB_TOP      3328
#define XB_TOPGEN   3392
#define XCD_BAR_WORDS 3456
#define XB_SPIN_CAP (1u << 20)
__device__ __forceinline__ unsigned xb_ld(unsigned* p)              { return __hip_atomic_load(p, __ATOMIC_RELAXED, __HIP_MEMORY_SCOPE_AGENT); }
__device__ __forceinline__ unsigned xb_add(unsigned* p, unsigned v) { return __hip_atomic_fetch_add(p, v, __ATOMIC_RELAXED, __HIP_MEMORY_SCOPE_AGENT); }
__device__ __forceinline__ unsigned xb_xcc_id() { return (unsigned)__builtin_amdgcn_s_getreg((3 << 11) | 20) & 0xFu; }
#define XB_SPIN(cond, bar) do { unsigned _sp = 0; while (cond) { __builtin_amdgcn_s_sleep(1); \
    if ((++_sp & 255u) == 0u) { if (xb_ld(&(bar)[XB_TMO])) break; if (_sp > XB_SPIN_CAP) { atomicAdd(&(bar)[XB_TMO], 1u); break; } } } } while (0)
struct XcdBarrier { unsigned* bar; unsigned x; volatile LAS unsigned* st; };
__device__ __forceinline__ XcdBarrier xcd_barrier_post(unsigned* bar, volatile LAS unsigned* st) {
    XcdBarrier b; b.bar = bar; b.x = xb_xcc_id(); b.st = st;
    if (threadIdx.x == 0) (void)xb_add(&bar[XB_XCNT(b.x)], 1u);
    return b;
}
__device__ __forceinline__ void xcd_barrier_complete(unsigned* bar, unsigned x, unsigned& nloc, unsigned& nx) {
    const unsigned G = gridDim.x * gridDim.y * gridDim.z;
    unsigned sum, cnt, mine, sp = 0u;
    for (;;) {
        sum = 0u; cnt = 0u; mine = 0u;
#pragma unroll
        for (unsigned j = 0; j < 16; ++j) { const unsigned c = xb_ld(&bar[XB_XCNT(j)]); sum += c; cnt += (c > 0u) ? 1u : 0u; mine = (j == x) ? c : mine; }
        if (sum == G) break;
        __builtin_amdgcn_s_sleep(1);
        if ((++sp & 255u) == 0u) { if (xb_ld(&bar[XB_TMO])) break; if (sp > XB_SPIN_CAP) { atomicAdd(&bar[XB_TMO], 1u); break; } }
    }
    nloc = mine > 0u ? mine : 1u; nx = cnt > 0u ? cnt : 1u;
}
__device__ __forceinline__ void xcd_barrier(const XcdBarrier& b) {
    asm volatile("s_waitcnt vmcnt(0)" ::: "memory");
    __syncthreads();
    if (threadIdx.x == 0) {
        unsigned* bar = b.bar;
        __builtin_amdgcn_s_waitcnt(0);
        unsigned nloc = b.st[0], nx = b.st[1];
        if (nloc == 0u) { xcd_barrier_complete(bar, b.x, nloc, nx); b.st[0] = nloc; b.st[1] = nx; }
        const unsigned old = xb_add(&bar[XB_XSUB(b.x)], 1u);
        const unsigned gen = old / nloc;
        if (old + 1u == (gen + 1u) * nloc) {
            __builtin_amdgcn_fence(__ATOMIC_RELEASE, "agent");
            asm volatile("s_waitcnt vmcnt(0)" ::: "memory");
            const unsigned og = xb_add(&bar[XB_TOP], 1u);
            const unsigned tg = og / nx;
            if (og + 1u == (tg + 1u) * nx) xb_add(&bar[XB_TOPGEN], 1u);
            else XB_SPIN(xb_ld(&bar[XB_TOPGEN]) == tg, bar);
            __builtin_amdgcn_fence(__ATOMIC_ACQUIRE, "agent");
            xb_add(&bar[XB_XGEN(b.x)], 1u);
            asm volatile("s_waitcnt vmcnt(0)" ::: "memory");
        } else {
            XB_SPIN(xb_ld(&bar[XB_XGEN(b.x)]) == gen, bar);
            __builtin_amdgcn_fence(__ATOMIC_ACQUIRE, "agent");
            asm volatile("s_waitcnt vmcnt(0)" ::: "memory");
        }
    }
    __syncthreads();
}


#ifdef FK_COPYPROBE
#ifndef FK_COPYMODE
#define FK_COPYMODE 0
#endif
__device__ __forceinline__ void ph_copyprobe(const Params& P) {
    const int lane = threadIdx.x & 63, wave = threadIdx.x >> 6;
    const u32x4* src = (const u32x4*)P.wg; u32x4* dst = (u32x4*)(P.ws + WS_AO);
    const size_t nchunk = (size_t)16 * 1024 * 1024 * 4 / 4096;
    constexpr int CH = FK_COPYMODE == 1 ? 12 : 4;
    constexpr int NJ = (FK_COPYMODE == 2 || FK_COPYMODE == 3) ? 1 : 4;
    constexpr int CSTR = FK_COPYMODE == 3 ? 4 : 1;
#if FK_COPYMODE == 7
    return;
#endif
#if FK_COPYMODE == 5 || FK_COPYMODE == 6
    u32x4 acc4 = {0u, 0u, 0u, 0u};
    for (size_t c0 = (size_t)(blockIdx.x * 8 + wave) * CH; c0 < nchunk; c0 += (size_t)gridDim.x * 8 * CH) {
#pragma unroll
        for (int r = 0; r < CH; ++r)
#pragma unroll
            for (int j = 0; j < NJ; ++j) { const size_t c = c0 + r < nchunk ? c0 + r : nchunk - 1;
                if (FK_COPYMODE == 5) { const u32x4 t = src[c * 256 + lane + 64 * j]; acc4.x ^= t.x; acc4.y ^= t.y; acc4.z ^= t.z; acc4.w ^= t.w; }
                else dst[c * 256 + lane + 64 * j] = (u32x4){(unsigned)c, 1u, 2u, 3u}; }
    }
    if (FK_COPYMODE == 5) dst[(size_t)(blockIdx.x * 8 + wave) * 64 + lane] = acc4;
    return;
#endif
#if FK_COPYMODE == 4
    const size_t per = nchunk / ((size_t)gridDim.x * 8), cbeg = (size_t)(blockIdx.x * 8 + wave) * per;
    for (size_t c0 = cbeg; c0 < cbeg + per; c0 += CH) {
#else
    for (size_t c0 = (size_t)(blockIdx.x * 8 + wave) * CH; c0 < nchunk; c0 += (size_t)gridDim.x * 8 * CH) {
#endif
        u32x4 v[CH][NJ];
#pragma unroll
        for (int r = 0; r < CH; ++r)
#pragma unroll
            for (int j = 0; j < NJ; ++j) { const size_t c = c0 + r < nchunk ? c0 + r : nchunk - 1; v[r][j] = src[(c / CSTR * CSTR) * 256 + lane + 64 * j]; }
#pragma unroll
        for (int r = 0; r < CH; ++r)
#pragma unroll
            for (int j = 0; j < NJ; ++j) { const size_t c = c0 + r < nchunk ? c0 + r : nchunk - 1; dst[(c / CSTR * CSTR) * 256 + lane + 64 * j] = v[r][j]; }
    }
}
#endif
constexpr int NPHASE = 11;
constexpr size_t CTL_ZERO_BYTES = 16384;
#ifndef FK_MASK
#define FK_MASK 0x7ff
#endif
#ifndef FK_CGSYNC
#define FK_CGSYNC 0
#endif
__global__ void __launch_bounds__(512, 2) mega(Params P) {
    extern __shared__ __attribute__((aligned(16))) unsigned char lds_raw[];
    LAS unsigned char* lds = (LAS unsigned char*)lds_raw;
    cg::grid_group grid = cg::this_grid();
    volatile LAS unsigned* misc = (volatile LAS unsigned*)(lds + LDS_MISC);
    if (threadIdx.x < 2) misc[threadIdx.x] = 0u;
    __syncthreads();
    const XcdBarrier bar = xcd_barrier_post((unsigned*)(P.ws + WS_CTL), misc);
    const int lo = P.ph_lo, hi = P.ph_hi;
    if (lo < 0) grid.sync();
#define FK_SYNC(k) do { if ((k) < FK_CGSYNC) grid.sync(); else xcd_barrier(bar); } while (0)
    typedef const __attribute__((address_space(4))) Params* KArgPtr;
#if defined(__HIP_DEVICE_COMPILE__)
#define FK_ARGS(name) KArgPtr kp_##name = (KArgPtr)__builtin_amdgcn_kernarg_segment_ptr(); asm volatile("" : "+s"(kp_##name)); const Params name = *(const Params*)kp_##name
#else
#define FK_ARGS(name) const Params name = P
#endif
#define FK_PH(k, call) if (((FK_MASK >> (k)) & 1) && lo <= (k) && (k) < hi) { { FK_ARGS(L); call; } if ((FK_DBL >> (k)) & 1) { FK_SYNC(k); { FK_ARGS(L); call; } } if ((k) + 1 < hi) { FK_SYNC(k); FK_STAMP((k) + 1); } }
    FK_STAMP(0);
    FK_PH(0, ph_prep(L, lds))
#ifdef FK_COPYPROBE
    for (int rep = 0; rep < FK_COPYPROBE; ++rep) { { FK_ARGS(L); ph_copyprobe(L); } xcd_barrier(bar); }
#endif
    FK_PH(1, ph_norm1(L, lds))
    FK_PH(2, ph_inproj(L, lds))
    FK_PH(3, ph_mix(L, lds))
    FK_PH(4, ph_proj(L, lds))
    FK_PH(5, ph_out(L, lds))
    FK_PH(6, ph_router(L, lds))
    FK_PH(7, ph_topk(L, lds))
    FK_PH(8, ph_moe_up(L, lds))
    FK_PH(9, ph_moe_down(L, lds))
    FK_PH(10, ph_final(L))
#undef FK_ARGS
#undef FK_PH
#undef FK_SYNC
}
}
static void fk_launch(fk::Params p, int lo, int hi, hipStream_t stream);
#if HYB >= 0
#include <hip/hip_runtime.h>

namespace nv {
constexpr int D = 1024, T = 2048, L = 256, NB = 16, INW = 6656, NE = 16, CAP = 256;

__global__ void k_mod(const float* __restrict__ c, const float* __restrict__ c_ctx, const float* __restrict__ w_mod,
                      const float* __restrict__ b_mod, float* __restrict__ mod) {
    const int n = blockIdx.x * 256 + threadIdx.x, r = blockIdx.y;
    const float* cv = r < 16 ? c + r * 1024 : c_ctx;
    float acc = 0.f;
    for (int k = 0; k < 1024; ++k) { const float v = cv[k]; const float s = v / (1.f + expf(-v)); acc += s * w_mod[(size_t)k * 6144 + n]; }
    mod[r * 6144 + n] = acc + b_mod[n];
}

__device__ __forceinline__ float block_sum256(float v, float* red) {
#pragma unroll
    for (int o = 32; o > 0; o >>= 1) v += __shfl_xor(v, o);
    __syncthreads();
    if ((threadIdx.x & 63) == 0) red[threadIdx.x >> 6] = v;
    __syncthreads();
    return red[0] + red[1] + red[2] + red[3];
}

__global__ void k_norm_mod(const float* __restrict__ x, const float* __restrict__ g, const float* __restrict__ shift,
                           const float* __restrict__ scale, float* __restrict__ out) {
    __shared__ float red[4];
    const int row = blockIdx.x, t = threadIdx.x;
    const float* xr = x + (size_t)row * D;
    float v[4]; float ss = 0.f;
#pragma unroll
    for (int j = 0; j < 4; ++j) { v[j] = xr[t + 256 * j]; ss += v[j] * v[j]; }
    const float tot = block_sum256(ss, red);
    const float rs = 1.0f / sqrtf(tot * (1.f / D) + 1e-6f);
#pragma unroll
    for (int j = 0; j < 4; ++j) { const int cidx = t + 256 * j; out[(size_t)row * D + cidx] = v[j] * rs * g[cidx] * (1.f + scale[cidx]) + shift[cidx]; }
}

__global__ __launch_bounds__(256) void k_sgemm(const float* __restrict__ A, int lda, const int* __restrict__ rows, long sA, long sRows,
                                               const float* __restrict__ B, int ldb, long sB, float* __restrict__ C, int ldc, long sC, int K) {
    __shared__ float As[16][65];
    __shared__ float Bs[16][64];
    const int z = blockIdx.z;
    A += (size_t)z * sA; B += (size_t)z * sB; C += (size_t)z * sC; if (rows) rows += (size_t)z * sRows;
    const int tx = threadIdx.x & 15, ty = threadIdx.x >> 4;
    const int m0 = blockIdx.y * 64, n0 = blockIdx.x * 64;
    float acc[4][4];
#pragma unroll
    for (int i = 0; i < 4; ++i)
#pragma unroll
        for (int j = 0; j < 4; ++j) acc[i][j] = 0.f;
    for (int k0 = 0; k0 < K; k0 += 16) {
#pragma unroll
        for (int ii = 0; ii < 4; ++ii) { const int i = threadIdx.x + 256 * ii; const int r = i >> 4, kk = i & 15; const int row = m0 + r; const int src = rows ? rows[row] : row;
            As[kk][r] = A[(size_t)src * lda + k0 + kk]; }
#pragma unroll
        for (int ii = 0; ii < 4; ++ii) { const int i = threadIdx.x + 256 * ii; const int kk = i >> 6, cc = i & 63; Bs[kk][cc] = B[(size_t)(k0 + kk) * ldb + n0 + cc]; }
        __syncthreads();
#pragma unroll
        for (int kk = 0; kk < 16; ++kk) {
            float a[4], b[4];
#pragma unroll
            for (int i = 0; i < 4; ++i) a[i] = As[kk][ty * 4 + i];
#pragma unroll
            for (int j = 0; j < 4; ++j) b[j] = Bs[kk][tx * 4 + j];
#pragma unroll
            for (int i = 0; i < 4; ++i)
#pragma unroll
                for (int j = 0; j < 4; ++j) acc[i][j] += a[i] * b[j];
        }
        __syncthreads();
    }
#pragma unroll
    for (int i = 0; i < 4; ++i)
#pragma unroll
        for (int j = 0; j < 4; ++j) C[(size_t)(m0 + ty * 4 + i) * ldc + n0 + tx * 4 + j] = acc[i][j];
}

__global__ void k_rope(float* __restrict__ P) {
    const int gid = blockIdx.x * 256 + threadIdx.x;
    const int pr = gid & 31, hs = (gid >> 5) % 20, t = gid / (32 * 20);
    if (t >= T) return;
    const int half = pr >> 4, i = pr & 15;
    const float pos = half == 0 ? (float)(t / 64) : (float)(t % 64);
    const float inv_freq = powf(10000.f, -(float)i / 16.f);
    const float ang = pos * inv_freq;
    const float cs = cosf(ang), sn = sinf(ang);
    float* p = P + (size_t)t * INW + hs * 64 + half * 32 + i;
    const float x1 = p[0], x2 = p[16];
    p[0] = x1 * cs - x2 * sn;
    p[16] = x2 * cs + x1 * sn;
}

__global__ __launch_bounds__(64) void k_attn(const float* __restrict__ P, const float* __restrict__ kvc, const float* __restrict__ sink, float* __restrict__ o) {
    __shared__ float qs[64];
    __shared__ float sc[257 + 256];
    const int t = blockIdx.x, h = blockIdx.y, hkv = h >> 2, d = threadIdx.x;
    qs[d] = P[(size_t)t * INW + h * 64 + d];
    __syncthreads();
    const int lo = t - 128 < 0 ? 0 : t - 128, hi = t + 128 > T - 1 ? T - 1 : t + 128, nw = hi - lo + 1, ntot = nw + L;
    for (int j = d; j < ntot; j += 64) {
        const float* kp = j < nw ? P + (size_t)(lo + j) * INW + 1024 + hkv * 64 : kvc + (size_t)(j - nw) * 512 + hkv * 64;
        float s = 0.f;
        for (int dd = 0; dd < 64; ++dd) s += qs[dd] * kp[dd];
        sc[j] = s * 0.125f;
    }
    __syncthreads();
    const float sk = sink[h];
    float m = sk;
    for (int j = d; j < ntot; j += 64) m = fmaxf(m, sc[j]);
#pragma unroll
    for (int off = 32; off > 0; off >>= 1) m = fmaxf(m, __shfl_xor(m, off));
    float l = 0.f;
    for (int j = d; j < ntot; j += 64) { const float p = expf(sc[j] - m); sc[j] = p; l += p; }
#pragma unroll
    for (int off = 32; off > 0; off >>= 1) l += __shfl_xor(l, off);
    l += expf(sk - m);
    __syncthreads();
    float acc = 0.f;
    for (int j = 0; j < ntot; ++j) {
        const float* vp = j < nw ? P + (size_t)(lo + j) * INW + 1280 + hkv * 64 : kvc + (size_t)(j - nw) * 512 + 256 + hkv * 64;
        acc += sc[j] * vp[d];
    }
    o[(size_t)t * D + h * 64 + d] = acc / l;
}

__global__ void k_conv(const float* __restrict__ P, const float* __restrict__ cw, float* __restrict__ y) {
    const int gid = blockIdx.x * 256 + threadIdx.x; const int ch = gid & 1023, t = gid >> 10;
    const float* pr = P + (size_t)t * INW;
    const float z1 = pr[3584 + ch] * pr[1536 + ch];
    const float z0 = t > 0 ? pr[3584 + ch - INW] * pr[1536 + ch - INW] : 0.f;
    const float z2 = t < T - 1 ? pr[3584 + ch + INW] * pr[1536 + ch + INW] : 0.f;
    y[gid] = pr[2560 + ch] * (cw[ch] * z0 + cw[1024 + ch] * z1 + cw[2048 + ch] * z2);
}

__global__ void k_merge(const float* __restrict__ P, float* __restrict__ a, const float* __restrict__ s) {
    const int gid = blockIdx.x * 256 + threadIdx.x; const int ch = gid & 1023, t = gid >> 10;
    const float ga = P[(size_t)t * INW + 4608 + ch], gc = P[(size_t)t * INW + 5632 + ch];
    a[gid] = a[gid] / (1.f + expf(-ga)) + s[gid] / (1.f + expf(-gc));
}

__global__ void k_resid(const float* __restrict__ x, const float* __restrict__ g, const float* __restrict__ o, float* __restrict__ x1) {
    const int gid = blockIdx.x * 256 + threadIdx.x; const int ch = gid & 1023;
    x1[gid] = x[gid] + g[ch] * o[gid];
}

__global__ void k_router(const float* __restrict__ x1, const float* __restrict__ g, const float* __restrict__ shift, const float* __restrict__ scale,
                         const float* __restrict__ w_router, float* __restrict__ hx2, float* __restrict__ aff) {
    __shared__ float red[4];
    __shared__ float lg[16];
    const int row = blockIdx.x, t = threadIdx.x;
    const float* xr = x1 + (size_t)row * D;
    float v[4]; float ss = 0.f;
#pragma unroll
    for (int j = 0; j < 4; ++j) { v[j] = xr[t + 256 * j]; ss += v[j] * v[j]; }
    const float tot = block_sum256(ss, red);
    const float rs = 1.0f / sqrtf(tot * (1.f / D) + 1e-6f);
#pragma unroll
    for (int j = 0; j < 4; ++j) { const int cidx = t + 256 * j; v[j] = v[j] * rs * g[cidx] * (1.f + scale[cidx]) + shift[cidx]; hx2[(size_t)row * D + cidx] = v[j]; }
    for (int e = 0; e < 16; ++e) {
        float p = 0.f;
#pragma unroll
        for (int j = 0; j < 4; ++j) p += v[j] * w_router[(size_t)(t + 256 * j) * 16 + e];
        const float s = block_sum256(p, red);
        if (t == 0) lg[e] = s;
    }
    __syncthreads();
    if (t < 16) {
        float m = lg[0];
        for (int e = 1; e < 16; ++e) m = fmaxf(m, lg[e]);
        float sum = 0.f;
        for (int e = 0; e < 16; ++e) sum += expf(lg[e] - m);
        aff[(size_t)t * T + row] = expf(lg[t] - m) / sum;
    }
}

__global__ void k_topk(const float* __restrict__ aff, int* __restrict__ idx, float* __restrict__ gate, int* __restrict__ sel) {
    __shared__ float a[T];
    const int e = blockIdx.x;
    for (int i = threadIdx.x; i < T; i += 256) a[i] = aff[(size_t)e * T + i];
    __syncthreads();
    for (int i = threadIdx.x; i < T; i += 256) {
        const float v = a[i]; int rank = 0;
        for (int j = 0; j < T; ++j) { const float w = a[j]; rank += (w > v || (w == v && j < i)) ? 1 : 0; }
        if (rank < CAP) { idx[e * CAP + rank] = i; gate[e * CAP + rank] = v; sel[i * 16 + e] = rank; }
        else sel[i * 16 + e] = -1;
    }
}

__global__ void k_silu_mul(float* __restrict__ a, const float* __restrict__ u) {
    const size_t gid = (size_t)blockIdx.x * 256 + threadIdx.x;
    const float v = a[gid];
    a[gid] = v / (1.f + expf(-v)) * u[gid];
}

__global__ void k_combine(const float* __restrict__ x1, const float* __restrict__ g2, const float* __restrict__ ye, const float* __restrict__ gate,
                          const int* __restrict__ sel, const float* __restrict__ fg, float* __restrict__ out) {
    __shared__ float red[4];
    const int row = blockIdx.x, t = threadIdx.x;
    float m[4] = {0.f, 0.f, 0.f, 0.f};
    for (int e = 0; e < 16; ++e) {
        const int s = sel[row * 16 + e];
        if (s >= 0) { const float gt = gate[e * CAP + s]; const float* yr = ye + ((size_t)e * CAP + s) * D;
#pragma unroll
            for (int j = 0; j < 4; ++j) m[j] += gt * yr[t + 256 * j]; }
    }
    float v[4]; float ss = 0.f;
#pragma unroll
    for (int j = 0; j < 4; ++j) { const int cidx = t + 256 * j; v[j] = x1[(size_t)row * D + cidx] + g2[cidx] * m[j]; ss += v[j] * v[j]; }
    const float tot = block_sum256(ss, red);
    const float rs = 1.0f / sqrtf(tot * (1.f / D) + 1e-6f);
#pragma unroll
    for (int j = 0; j < 4; ++j) { const int cidx = t + 256 * j; out[(size_t)row * D + cidx] = v[j] * rs * fg[cidx]; }
}

struct Inputs {
    const float *x, *c, *ctx, *c_ctx, *w_mod, *b_mod, *norm1_g, *w_in, *sink, *conv_w, *wpa, *wpc, *wo, *norm2_g, *w_router, *wg, *wu, *wd, *fg;
};
struct Scratch {
    float *mod, *hx, *hc, *P, *kvc, *oat, *yc, *a, *s, *o1, *x1, *hx2, *aff, *gate, *ea, *eu, *ye; int *idx, *sel;
};
inline size_t carve(Scratch& S, char* base) {
    size_t off = 0;
    auto take = [&](size_t bytes) { char* p = base + off; off += (bytes + 255) & ~(size_t)255; return p; };
    S.mod = (float*)take(17 * 6144 * 4);
    S.hx = (float*)take((size_t)T * D * 4); S.hc = (float*)take((size_t)L * D * 4);
    S.P = (float*)take((size_t)T * INW * 4); S.kvc = (float*)take((size_t)L * 512 * 4);
    S.oat = (float*)take((size_t)T * D * 4); S.yc = (float*)take((size_t)T * D * 4);
    S.a = (float*)take((size_t)T * D * 4); S.s = (float*)take((size_t)T * D * 4); S.o1 = (float*)take((size_t)T * D * 4);
    S.x1 = (float*)take((size_t)T * D * 4); S.hx2 = (float*)take((size_t)T * D * 4);
    S.aff = (float*)take((size_t)NE * T * 4); S.gate = (float*)take(NE * CAP * 4); S.idx = (int*)take(NE * CAP * 4); S.sel = (int*)take((size_t)T * 16 * 4);
    S.ea = S.P; S.eu = S.P + (size_t)NE * CAP * D; S.ye = S.P + (size_t)2 * NE * CAP * D;
    return off;
}

inline void run_mod(const Inputs& I, const Scratch& S, hipStream_t st) { k_mod<<<dim3(24, 17), 256, 0, st>>>(I.c, I.c_ctx, I.w_mod, I.b_mod, S.mod); }
inline void s1a_norm(const Inputs& I, const Scratch& S, int b, hipStream_t st) {
    const float* mb = S.mod + b * 6144; const float* mc = S.mod + 16 * 6144;
    k_norm_mod<<<T, 256, 0, st>>>(I.x + (size_t)b * T * D, I.norm1_g, mb, mb + 1024, S.hx);
    k_norm_mod<<<L, 256, 0, st>>>(I.ctx + (size_t)b * L * D, I.norm1_g, mc, mc + 1024, S.hc);
}
inline void s1b_gemm(const Inputs& I, const Scratch& S, int b, hipStream_t st) {
    k_sgemm<<<dim3(INW / 64, T / 64, 1), 256, 0, st>>>(S.hx, D, nullptr, 0, 0, I.w_in, INW, 0, S.P, INW, 0, D);
    k_sgemm<<<dim3(512 / 64, L / 64, 1), 256, 0, st>>>(S.hc, D, nullptr, 0, 0, I.w_in + 1024, INW, 0, S.kvc, 512, 0, D);
    k_rope<<<T * 20 * 32 / 256, 256, 0, st>>>(S.P);
}
inline void s2_mix(const Inputs& I, const Scratch& S, int b, hipStream_t st) {
    k_attn<<<dim3(T, 16), 64, 0, st>>>(S.P, S.kvc, I.sink, S.oat);
    k_conv<<<T * D / 256, 256, 0, st>>>(S.P, I.conv_w, S.yc);
}
inline void s3_merge(const Inputs& I, const Scratch& S, int b, hipStream_t st) {
    k_sgemm<<<dim3(D / 64, T / 64, 1), 256, 0, st>>>(S.oat, D, nullptr, 0, 0, I.wpa, D, 0, S.a, D, 0, D);
    k_sgemm<<<dim3(D / 64, T / 64, 1), 256, 0, st>>>(S.yc, D, nullptr, 0, 0, I.wpc, D, 0, S.s, D, 0, D);
    k_merge<<<T * D / 256, 256, 0, st>>>(S.P, S.a, S.s);
}
inline void s4_out(const Inputs& I, const Scratch& S, int b, hipStream_t st) {
    k_sgemm<<<dim3(D / 64, T / 64, 1), 256, 0, st>>>(S.a, D, nullptr, 0, 0, I.wo, D, 0, S.o1, D, 0, D);
    k_resid<<<T * D / 256, 256, 0, st>>>(I.x + (size_t)b * T * D, S.mod + b * 6144 + 2048, S.o1, S.x1);
}
inline void s5_router(const Inputs& I, const Scratch& S, int b, hipStream_t st) {
    const float* mb = S.mod + b * 6144;
    k_router<<<T, 256, 0, st>>>(S.x1, I.norm2_g, mb + 3072, mb + 4096, I.w_router, S.hx2, S.aff);
}
inline void s6_topk(const Inputs& I, const Scratch& S, int b, hipStream_t st) { k_topk<<<NE, 256, 0, st>>>(S.aff, S.idx, S.gate, S.sel); }
inline void s7_up(const Inputs& I, const Scratch& S, int b, hipStream_t st) {
    k_sgemm<<<dim3(D / 64, CAP / 64, NE), 256, 0, st>>>(S.hx2, D, S.idx, 0, CAP, I.wg, D, (long)D * D, S.ea, D, (long)CAP * D, D);
    k_sgemm<<<dim3(D / 64, CAP / 64, NE), 256, 0, st>>>(S.hx2, D, S.idx, 0, CAP, I.wu, D, (long)D * D, S.eu, D, (long)CAP * D, D);
    k_silu_mul<<<NE * CAP * D / 256, 256, 0, st>>>(S.ea, S.eu);
}
inline void s8_down(const Inputs& I, const Scratch& S, int b, hipStream_t st) {
    k_sgemm<<<dim3(D / 64, CAP / 64, NE), 256, 0, st>>>(S.ea, D, nullptr, (long)CAP * D, 0, I.wd, D, (long)D * D, S.ye, D, (long)CAP * D, D);
}
inline void s9_final(const Inputs& I, const Scratch& S, int b, float* out, hipStream_t st) {
    k_combine<<<T, 256, 0, st>>>(S.x1, S.mod + b * 6144 + 5120, S.ye, S.gate, S.sel, I.fg, out + (size_t)b * T * D);
}
}
namespace hyb {
using fk::bf16_t;
__device__ __forceinline__ float bf2f(bf16_t v) { return __uint_as_float((unsigned)v << 16); }
__global__ void k_cv_bf16(const bf16_t* __restrict__ src, size_t spitch, float* __restrict__ dst, int cols, size_t n) {
    const size_t gid = (size_t)blockIdx.x * 256 + threadIdx.x; if (gid >= n) return;
    const size_t r = gid / cols; const int c = (int)(gid % cols);
    dst[gid] = bf2f(src[r * spitch + c]);
}
__global__ void k_copy_f32(const float* __restrict__ src, float* __restrict__ dst, size_t n) { const size_t gid = (size_t)blockIdx.x * 256 + threadIdx.x; if (gid < n) dst[gid] = src[gid]; }
__global__ void k_copy_i32(const int* __restrict__ src, int* __restrict__ dst, size_t n) { const size_t gid = (size_t)blockIdx.x * 256 + threadIdx.x; if (gid < n) dst[gid] = src[gid]; }
__global__ void k_fill_f32(float* __restrict__ dst, float v, size_t n) { const size_t gid = (size_t)blockIdx.x * 256 + threadIdx.x; if (gid < n) dst[gid] = v; }
__device__ __forceinline__ float logit_(float p) { return p >= 1.f ? 30.f : (p <= 0.f ? -30.f : logf(p / (1.f - p))); }
__global__ void k_cv_P(const unsigned char* __restrict__ ws, const unsigned char* __restrict__ ob, int b, float* __restrict__ Pn) {
    const size_t gid = (size_t)blockIdx.x * 256 + threadIdx.x; if (gid >= (size_t)2048 * 6656) return;
    const int t = (int)(gid / 6656), col = (int)(gid % 6656); const size_t row = (size_t)b * 2048 + t;
    float v;
    if (col < 1024) v = bf2f(((const bf16_t*)(ws + fk::WS_Q))[row * 1024 + col]) / fk::C2;
    else if (col < 1280) { const int hkv = (col - 1024) >> 6, d = col & 63; const size_t blk = (size_t)((b * 4 + hkv) * 32 + (t >> 6));
        v = bf2f(*(const bf16_t*)(ws + fk::WS_KB + blk * 8192 + (d >> 3) * 1024 + (t & 63) * 16 + (d & 7) * 2)); }
    else if (col < 1536) { const int hkv = (col - 1280) >> 6, d = col & 63; const size_t blk = (size_t)((b * 4 + hkv) * 32 + (t >> 6));
        const int kk = t & 63, s = kk >> 4, w = kk & 15, h = (w >> 2) & 1, e = w >> 3, jj = w & 3;
        v = bf2f(*(const bf16_t*)(ws + fk::WS_VB + blk * 8192 + (2 * s + h) * 1024 + d * 16 + 8 * e + 2 * jj)); }
    else if (col < 2560) v = bf2f(((const bf16_t*)(ws + fk::WS_Z))[row * 1024 + col - 1536]);
    else if (col < 3584) v = bf2f(((const bf16_t*)(ws + fk::WS_BB))[row * 1024 + col - 2560]);
    else if (col < 4608) v = 1.f;
    else { const int ch = col < 5632 ? col - 4608 : col - 5632;
        const float r = bf2f(((const bf16_t*)(ob + fk::OB_RB))[row * 1024 + ch]), sg = bf2f(((const bf16_t*)(ob + fk::OB_SGC))[row * 1024 + ch]);
        v = col < 5632 ? logit_(r * sg) : logit_(sg); }
    Pn[gid] = v;
}
__global__ void k_cv_kvc(const unsigned char* __restrict__ ws, int b, float* __restrict__ kvc) {
    const int gid = blockIdx.x * 256 + threadIdx.x; if (gid >= 256 * 512) return;
    const int l = gid >> 9, col = gid & 511;
    if (col < 256) { const int hkv = col >> 6, d = col & 63; const size_t blk = (size_t)((b * 4 + hkv) * 4 + (l >> 6));
        kvc[gid] = bf2f(*(const bf16_t*)(ws + fk::WS_KCB + blk * 8192 + (d >> 3) * 1024 + (l & 63) * 16 + (d & 7) * 2)); }
    else { const int hkv = (col - 256) >> 6, d = col & 63; const size_t blk = (size_t)((b * 4 + hkv) * 4 + (l >> 6));
        const int kk = l & 63, s = kk >> 4, w = kk & 15, h = (w >> 2) & 1, e = w >> 3, jj = w & 3;
        kvc[gid] = bf2f(*(const bf16_t*)(ws + fk::WS_VCB + blk * 8192 + (2 * s + h) * 1024 + d * 16 + 8 * e + 2 * jj)); }
}
inline unsigned nblk(size_t n) { return (unsigned)((n + 255) / 256); }

inline void run(fk::Params p, void* const* d_in, float* out, char* nbase, size_t nbytes, hipStream_t st) {
    nv::Inputs I; const float** ip = (const float**)&I; for (int i = 0; i < 19; ++i) ip[i] = (const float*)d_in[i];
    nv::Scratch S; const size_t need = nv::carve(S, nbase);
    if (need > nbytes) { fprintf(stderr, "hybrid: scratch too small %zu > %zu\n", need, nbytes); return; }
    constexpr int X = HYB;
    if (X >= 10) { fk_launch(p, 0, fk::NPHASE, st); }
    else { fk_launch(p, 0, X + 1, st); }
    nv::run_mod(I, S, st);
    const unsigned char* ws = p.ws; const unsigned char* ob = p.ob;
    constexpr size_t TD = (size_t)2048 * 1024;
    for (int b = 0; b < 16; ++b) {
        const bool fast = b < fk::NBF;
        if (b == fk::NBF && X == 0) nv::run_mod(I, S, st);
        int from = 0;
        if (fast) {
            const size_t r0 = (size_t)b * 2048;
            if (X == 0) { k_copy_f32<<<nblk(17 * 6144), 256, 0, st>>>((const float*)(ws + fk::WS_MOD), S.mod, 17 * 6144); from = 0; }
            else if (X == 1) { k_cv_bf16<<<nblk(TD), 256, 0, st>>>((const bf16_t*)(ws + fk::WS_HX) + r0 * 1024, 1024, S.hx, 1024, TD);
                k_cv_bf16<<<nblk(256 * 1024), 256, 0, st>>>((const bf16_t*)(ws + fk::WS_HX) + ((size_t)fk::M + (size_t)b * 256) * 1024, 1024, S.hc, 1024, (size_t)256 * 1024); from = 1; }
            else if (X == 2 || X == 3) { k_cv_P<<<nblk((size_t)2048 * 6656), 256, 0, st>>>(ws, ob, b, S.P); k_cv_kvc<<<512, 256, 0, st>>>(ws, b, S.kvc); from = 2;
                if (X == 3) { k_cv_bf16<<<nblk(TD), 256, 0, st>>>((const bf16_t*)(ws + fk::WS_AO) + r0 * 2048, 2048, S.oat, 1024, TD);
                    k_cv_bf16<<<nblk(TD), 256, 0, st>>>((const bf16_t*)(ws + fk::WS_AO) + r0 * 2048 + 1024, 2048, S.yc, 1024, TD); from = 3; } }
            else if (X == 4) { k_cv_bf16<<<nblk(TD), 256, 0, st>>>((const bf16_t*)(ws + fk::WS_MB) + r0 * 1024, 1024, S.a, 1024, TD); from = 4; }
            else {
                k_cv_bf16<<<nblk(TD), 256, 0, st>>>((const bf16_t*)(ws + fk::WS_DL) + r0 * 1024, 1024, S.o1, 1024, TD); nv::k_resid<<<nblk(TD), 256, 0, st>>>(I.x + r0 * 1024, S.one, S.o1, S.x1); from = 5;
                if (X >= 6) { k_cv_bf16<<<nblk(TD), 256, 0, st>>>((const bf16_t*)(ws + fk::WS_HX2) + r0 * 1024, 1024, S.hx2, 1024, TD);
                    k_copy_f32<<<nblk(16 * 2048), 256, 0, st>>>((const float*)(ws + fk::WS_AFF) + (size_t)b * 16 * 2048, S.aff, 16 * 2048); from = 6; }
                if (X >= 7) { k_copy_i32<<<nblk(16 * 256), 256, 0, st>>>((const int*)(ws + fk::WS_IDX) + b * 16 * 256, S.idx, 16 * 256);
                    k_copy_f32<<<nblk(16 * 256), 256, 0, st>>>((const float*)(ws + fk::WS_GATE) + b * 16 * 256, S.gate, 16 * 256);
                    k_copy_i32<<<nblk(2048 * 16), 256, 0, st>>>((const int*)(ws + fk::WS_SEL) + r0 * 16, S.sel, 2048 * 16); from = 7; }
                if (X >= 8) { k_cv_bf16<<<nblk((size_t)4096 * 1024), 256, 0, st>>>((const bf16_t*)(ob + fk::OB_HB) + (size_t)b * 4096 * 1024, 1024, S.ea, 1024, (size_t)4096 * 1024); from = 8; }
                if (X >= 9) { k_cv_bf16<<<nblk((size_t)4096 * 1024), 256, 0, st>>>((const bf16_t*)(ws + fk::WS_YE) + (size_t)b * 4096 * 1024, 1024, S.ye, 1024, (size_t)4096 * 1024);
                    k_fill_f32<<<nblk(16 * 256), 256, 0, st>>>(S.gate, 1.f, 16 * 256); from = 9; }
                if (X >= 10) from = 10;
            }
        }
        if (from <= 0) nv::s1a_norm(I, S, b, st);
        if (from <= 1) nv::s1b_gemm(I, S, b, st);
        if (from <= 2) nv::s2_mix(I, S, b, st);
        if (from <= 3) nv::s3_merge(I, S, b, st);
        if (from <= 4) nv::s4_out(I, S, b, st);
        if (from <= 5) nv::s5_router(I, S, b, st);
        if (from <= 6) nv::s6_topk(I, S, b, st);
        if (from <= 7) nv::s7_up(I, S, b, st);
        if (from <= 8) nv::s8_down(I, S, b, st);
        if (from <= 9) nv::s9_final(I, S, b, out, st);
    }
}
}
#endif

static int fk_grid = 0;
static bool fk_setup() {
    if (fk_grid) return fk_grid > 0;
    int dev = 0, cus = 0, per_cu = 0;
    if (hipGetDevice(&dev) != hipSuccess || hipDeviceGetAttribute(&cus, hipDeviceAttributeMultiprocessorCount, dev) != hipSuccess) { fk_grid = -1; return false; }
    if (hipFuncSetAttribute((const void*)fk::mega, hipFuncAttributeMaxDynamicSharedMemorySize, fk::LDS_BYTES) != hipSuccess) { fprintf(stderr, "kernel_launch: hipFuncSetAttribute failed\n"); fk_grid = -1; return false; }
    if (hipOccupancyMaxActiveBlocksPerMultiprocessor(&per_cu, (const void*)fk::mega, 512, fk::LDS_BYTES) != hipSuccess || per_cu < 1) { fprintf(stderr, "kernel_launch: occupancy query says %d\n", per_cu); fk_grid = -1; return false; }
    fk_grid = cus * per_cu;
    return true;
}
static void fk_launch(fk::Params p, int lo, int hi, hipStream_t stream) {
    p.ph_lo = lo; p.ph_hi = hi;
    if (hipMemsetAsync(p.ws + fk::WS_CTL, 0, fk::CTL_ZERO_BYTES, stream) != hipSuccess) { fprintf(stderr, "kernel_launch: memset failed\n"); return; }
    void* args[] = {&p};
    hipError_t e = hipLaunchCooperativeKernel((const void*)fk::mega, dim3(fk_grid), dim3(512), args, fk::LDS_BYTES, stream);
    if (e != hipSuccess) fprintf(stderr, "kernel_launch: cooperative launch failed: %s (grid %d)\n", hipGetErrorString(e), fk_grid);
}

extern "C" void kernel_launch(void* const* d_in, const int* in_sizes, int n_in, void* d_out, int out_size, void* d_ws, size_t ws_size, hipStream_t stream) {
    if (n_in != 19 || !fk_setup()) { fprintf(stderr, "kernel_launch: bad setup (n_in %d)\n", n_in); return; }
    fk::Params p{};
    const float** ip = (const float**)&p;
    for (int i = 0; i < 19; ++i) ip[i] = (const float*)d_in[i];
    p.out = (float*)d_out; p.ws = (unsigned char*)d_ws;
#if HYB < 0
    if (ws_size < fk::R_END) { fprintf(stderr, "kernel_launch: workspace too small: %zu < %zu\n", ws_size, (size_t)fk::R_END); return; }
    p.ob = (unsigned char*)d_out;
    fk_launch(p, 0, fk::NPHASE, stream);
#else
    p.ob = (unsigned char*)d_ws + fk::R_END;
    hyb::run(p, d_in, (float*)d_out, (char*)d_ws + fk::R_END + fk::OB_BYTES, ws_size - fk::R_END - fk::OB_BYTES, stream);
#endif
}
```

```cpp
#include <hip/hip_runtime.h>
#include <hip/hip_cooperative_groups.h>
#include <cstdio>
#include <cstdint>
#ifndef HYB
#define HYB -1
#endif
#if HYB >= 0
#define FK_NBF 8
#endif
namespace g8 {
#define G8_LAS __attribute__((address_space(3)))
typedef unsigned short bf16_t;
typedef short bf16x8 __attribute__((ext_vector_type(8)));
typedef float f32x4 __attribute__((ext_vector_type(4)));
typedef float f32x2 __attribute__((ext_vector_type(2)));
typedef unsigned u32x4 __attribute__((ext_vector_type(4)));
typedef unsigned u32x2 __attribute__((ext_vector_type(2)));
constexpr int BM = 256, BK = 64, HALF = 128, HTB = HALF * BK * 2, STAGE_BYTES = 8 * HTB;

__host__ __device__ __forceinline__ int lds_byte(int r, int c) { const int st = (r >> 4) * 2 + (c >> 5), rr = r & 15, cc = c & 31, ob = rr * 64 + cc * 2; return st * 1024 + (ob ^ (((ob >> 9) & 1) << 5)); }
__host__ __device__ __forceinline__ void stage_rc(int b, int& R, int& C) { const int st = b / 1024, sb = b % 1024, swz = sb ^ (((sb >> 9) & 1) << 5); R = (st >> 1) * 16 + swz / 64; C = (st & 1) * 32 + (swz % 64) / 2; }
__host__ __device__ __forceinline__ int perm32(int rho) { const int n = rho >> 4, i = rho & 15; return 8 * (i >> 2) + 4 * n + (i & 3); }
__host__ __device__ __forceinline__ int pinv32(int x) { return 16 * ((x >> 2) & 1) + 4 * (x >> 3) + (x & 3); }

struct Unit { const char* a; const char* b; const int* rows; int kind; int pm; int pn; int aux; };

__device__ __forceinline__ unsigned cvt_pk_bf16(float lo, float hi) { unsigned r; asm volatile("v_cvt_pk_bf16_f32 %0, %1, %2" : "=v"(r) : "v"(lo), "v"(hi)); return r; }
__device__ __forceinline__ float bf_lo(unsigned w) { return __uint_as_float(w << 16); }
__device__ __forceinline__ float bf_hi(unsigned w) { return __uint_as_float(w & 0xffff0000u); }

template <class Epi, class Sched, bool HAS_MID, bool GATHER = false, int KREP = 1>
__device__ __forceinline__ void gemm_phase(G8_LAS unsigned char* lds, const int K, const Sched& S, const Epi& E) {
    const int tid = threadIdx.x, wid = __builtin_amdgcn_readfirstlane(tid >> 6), lane = tid & 63, wr = wid >> 2, wc = wid & 3, fr = lane & 15, fq = lane >> 4;
    const int nt = K / BK;
    unsigned voff[2];
#pragma unroll
    for (int i = 0; i < 2; ++i) { int R, C; stage_rc(tid * 16 + i * 8192, R, C); voff[i] = (unsigned)(R * K + C) * 2u; }
    const size_t kstep = (size_t)(BK * 2);
    const size_t hstep = (size_t)HALF * K * 2;
    const unsigned ldsw = (unsigned)wid * 1024u;
    const int aoff = lds_byte(wr * 64 + fr, fq * 8), boff = lds_byte(wc * 32 + fr, fq * 8);
#define G8_SA(b, h) (((b) * 2 + (h)) * HTB)
#define G8_SB(b, h) ((4 + (b) * 2 + (h)) * HTB)
#define G8_STAGE(bufoff, gbase) do { _Pragma("unroll") for (int _i = 0; _i < 2; ++_i) \
        __builtin_amdgcn_global_load_lds((const unsigned*)((const char*)(gbase) + voff[_i]), (G8_LAS unsigned*)(lds + (bufoff) + ldsw + _i * 8192), 16, 0, 0); } while (0)
#define G8_STAGE_V(bufoff, gbase, vv) do { _Pragma("unroll") for (int _i = 0; _i < 2; ++_i) \
        __builtin_amdgcn_global_load_lds((const unsigned*)((const char*)(gbase) + (vv)[_i]), (G8_LAS unsigned*)(lds + (bufoff) + ldsw + _i * 8192), 16, 0, 0); } while (0)
#define G8_STAGE_A(bufoff, gbase, h) do { if constexpr (GATHER) G8_STAGE_V(bufoff, gbase, va[h]); else G8_STAGE(bufoff, (gbase) + (h) * hstep); } while (0)
#define G8_LDA(dst, b, h) do { _Pragma("unroll") for (int m = 0; m < 4; ++m) _Pragma("unroll") for (int k = 0; k < 2; ++k) dst[m][k] = *(const G8_LAS bf16x8*)(lds + G8_SA(b, h) + aoff + m * 2048 + k * 1024); } while (0)
#define G8_LDB(dst, b, h) do { _Pragma("unroll") for (int n = 0; n < 2; ++n) _Pragma("unroll") for (int k = 0; k < 2; ++k) dst[n][k] = *(const G8_LAS bf16x8*)(lds + G8_SB(b, h) + boff + n * 2048 + k * 1024); } while (0)
#define G8_MMA(ai, bj, At, Bt) do { __builtin_amdgcn_s_setprio(1); _Pragma("unroll") for (int m = 0; m < 4; ++m) _Pragma("unroll") for (int n = 0; n < 2; ++n) _Pragma("unroll") for (int k = 0; k < 2; ++k) \
        acc[ai][bj][m][n] = __builtin_amdgcn_mfma_f32_16x16x32_bf16(Bt[n][k], At[m][k], acc[ai][bj][m][n], 0, 0, 0); __builtin_amdgcn_s_setprio(0); } while (0)
#define G8_WAIT_V(n) asm volatile("s_waitcnt vmcnt(" #n ")" ::: "memory")
#define G8_WAIT_L(n) asm volatile("s_waitcnt lgkmcnt(" #n ")" ::: "memory")
#define G8_BAR __builtin_amdgcn_s_barrier()
#define G8_SCHED __builtin_amdgcn_sched_barrier(0)
    Unit cur, nxt; int ui = 0;
    if (!S.next(0, cur)) return;
    f32x4 acc[2][2][4][2];
#pragma unroll
    for (int a = 0; a < 2; ++a)
#pragma unroll
        for (int b = 0; b < 2; ++b)
#pragma unroll
            for (int m = 0; m < 4; ++m)
#pragma unroll
                for (int n = 0; n < 2; ++n) acc[a][b][m][n] = (f32x4){0.f, 0.f, 0.f, 0.f};
    bf16x8 At[4][2], B0[2][2], B1[2][2];
    const char* cA = cur.a; const char* cB = cur.b;
    unsigned va[2][2], vn[2][2];
    int gR[2], gC[2];
#pragma unroll
    for (int i = 0; i < 2; ++i) stage_rc(tid * 16 + i * 8192, gR[i], gC[i]);
    if constexpr (GATHER) {
#pragma unroll
        for (int h = 0; h < 2; ++h)
#pragma unroll
            for (int i = 0; i < 2; ++i) { va[h][i] = (unsigned)(cur.rows[128 * h + gR[i]] * K + gC[i]) * 2u; vn[h][i] = va[h][i]; }
    }
    G8_STAGE(G8_SB(0, 0), cB); G8_STAGE(G8_SB(0, 1), cB + hstep); G8_STAGE_A(G8_SA(0, 0), cA, 0); G8_STAGE_A(G8_SA(0, 1), cA, 1);
    if (wr == 1) G8_BAR;
    G8_WAIT_V(2); G8_BAR;
    G8_STAGE(G8_SB(1, 0), cB + kstep); G8_STAGE_A(G8_SA(1, 0), cA + kstep, 0); G8_STAGE(G8_SB(1, 1), cB + hstep + kstep);
    G8_WAIT_V(6); G8_BAR;
    for (;;) {
        const bool has_next = S.next(ui + 1, nxt);
        const char* nA = has_next ? nxt.a : cA; const char* nB = has_next ? nxt.b : cB;
        if constexpr (GATHER) { if (has_next) {
#pragma unroll
            for (int h = 0; h < 2; ++h)
#pragma unroll
                for (int i = 0; i < 2; ++i) vn[h][i] = (unsigned)(nxt.rows[128 * h + gR[i]] * K + gC[i]) * 2u; } }
        constexpr int KR = (KREP == 3) ? 1 : KREP;
        for (int tt = 0; tt < KR * nt; tt += 2) {
            const bool last = (tt == KR * nt - 2);
            const int t = (KREP == 1 || KREP == 3) ? tt : (tt >= nt ? tt - nt : tt);
            const char* a1 = cA + (size_t)(t + 1) * kstep;
            const int t2 = (KR > 1 && t + 2 >= nt) ? 0 : t + 2;
            const char* a2 = last ? nA : cA + (size_t)t2 * kstep; const char* b2 = last ? nB : cB + (size_t)t2 * kstep;
            const char* a3 = a2 + kstep; const char* b3 = b2 + kstep;
            if constexpr (HAS_MID) { if (t == (nt >> 1)) E.mid(acc, cur, wr, wc, fr, fq); }
            G8_LDB(B0, 0, 0); G8_LDB(B1, 0, 1); G8_SCHED; G8_LDA(At, 0, 0); G8_STAGE_A(G8_SA(1, 1), a1, 1);
            if constexpr (GATHER) { if (last) { va[0][0] = vn[0][0]; va[0][1] = vn[0][1]; va[1][0] = vn[1][0]; va[1][1] = vn[1][1]; } }
            G8_WAIT_V(8); G8_WAIT_L(0); G8_BAR; G8_MMA(0, 0, At, B0); G8_MMA(0, 1, At, B1); G8_BAR; G8_SCHED;
            G8_LDA(At, 0, 1); G8_STAGE(G8_SB(0, 0), b2); G8_STAGE(G8_SB(0, 1), b2 + hstep); G8_STAGE_A(G8_SA(0, 0), a2, 0);
            G8_WAIT_V(8); G8_WAIT_L(0); G8_BAR; G8_MMA(1, 0, At, B0); G8_MMA(1, 1, At, B1); G8_BAR; G8_SCHED;
            G8_LDB(B0, 1, 0); G8_LDB(B1, 1, 1); G8_SCHED; G8_LDA(At, 1, 0); G8_STAGE_A(G8_SA(0, 1), a2, 1);
            G8_WAIT_V(8); G8_WAIT_L(0); G8_BAR; G8_MMA(0, 0, At, B0); G8_MMA(0, 1, At, B1); G8_BAR; G8_SCHED;
            G8_LDA(At, 1, 1); G8_STAGE(G8_SB(1, 0), b3); G8_STAGE(G8_SB(1, 1), b3 + hstep); G8_STAGE_A(G8_SA(1, 0), a3, 0);
            G8_WAIT_V(8); G8_WAIT_L(0); G8_BAR; G8_MMA(1, 0, At, B0); G8_MMA(1, 1, At, B1); G8_BAR; G8_SCHED;
        }
        if (wr == 0) G8_BAR;
        if constexpr (KR > 1) {
#pragma unroll
            for (int a = 0; a < 2; ++a)
#pragma unroll
                for (int b = 0; b < 2; ++b)
#pragma unroll
                    for (int m = 0; m < 4; ++m)
#pragma unroll
                        for (int n = 0; n < 2; ++n) acc[a][b][m][n] *= (1.0f / KR);
        }
        E(acc, cur, wr, wc, fr, fq);
#ifdef FK_EPI2_PROBE
        if constexpr (KREP == 3) { asm volatile("" ::: "memory"); E(acc, cur, wr, wc, fr, fq); }
#endif
        if (!has_next) break;
#pragma unroll
        for (int a = 0; a < 2; ++a)
#pragma unroll
            for (int b = 0; b < 2; ++b)
#pragma unroll
                for (int m = 0; m < 4; ++m)
#pragma unroll
                    for (int n = 0; n < 2; ++n) acc[a][b][m][n] = (f32x4){0.f, 0.f, 0.f, 0.f};
        cur = nxt; cA = nA; cB = nB; ++ui;
        if (wr == 1) G8_BAR;
    }
    G8_WAIT_V(0);
    G8_BAR;
#undef G8_SA
#undef G8_SB
#undef G8_STAGE
#undef G8_LDA
#undef G8_STAGE_V
#undef G8_STAGE_A
#undef G8_LDB
#undef G8_MMA
#undef G8_WAIT_V
#undef G8_WAIT_L
#undef G8_BAR
#undef G8_SCHED
}
}
namespace fk {
using namespace g8;
namespace cg = cooperative_groups;
#define LAS G8_LAS
#ifndef FK_NBF
#define FK_NBF 16
#endif
#ifndef FK_DBL
#define FK_DBL 0
#endif
constexpr int NBF = FK_NBF;
constexpr int D = 1024, T = 2048, LC = 256, NE = 16, CAP = 256;
constexpr int M = NBF * T, MC = NBF * LC, MA = M + MC;
constexpr int NT_IN = 25;
constexpr float LOG2E = 1.4426950408889634f;
constexpr float C2 = 0.125f * LOG2E;
typedef float f32x16 __attribute__((ext_vector_type(16)));

constexpr size_t MiB = (size_t)1 << 20;
constexpr size_t SC = (size_t)NBF << 16;
constexpr size_t WS_CTL = 0, WS_MOD = 1 * MiB, WS_ROPE = 1 * MiB + 512 * 1024, WS_IDX = 2 * MiB, WS_GATE = 2 * MiB + 256 * 1024,
                 WS_AFF = 2 * MiB + 512 * 1024, WS_SEL = 5 * MiB;
constexpr size_t WS_WIN = 8 * MiB, WS_WV = WS_WIN + (size_t)6400 * 2048, WS_WP = 21 * MiB, WS_WO = 25 * MiB, WS_WGU = 27 * MiB, WS_WD = 91 * MiB;
constexpr size_t R0 = 124 * MiB;
constexpr size_t WS_Q = R0, WS_KB = R0 + 64 * SC, WS_KCB = R0 + 80 * SC, WS_VB = R0 + 82 * SC, WS_VCB = R0 + 98 * SC, WS_Z = R0 + 100 * SC, WS_BB = R0 + 164 * SC,
                 WS_AO = R0 + 228 * SC, WS_HX = R0 + 284 * SC, WS_MB = R0, WS_DL = R0 + 64 * SC, WS_HX2 = R0, WS_XE = R0 + 192 * SC, WS_YE = R0 + 192 * SC;
constexpr size_t R_END = R0 + 356 * SC;
constexpr size_t OB_RB = 0, OB_SGC = 64 * SC, OB_HB = 0, OB_BYTES = 128 * SC;

constexpr int LDS_BYTES = 147456;
constexpr int LDS_MISC = 140 * 1024;
constexpr int LDS_MISC_Q = 140 * 1024 + 64;

#ifdef FK_TS
#define FK_STAMP_WG(k, wgsel) do { if (blockIdx.x == (wgsel) && threadIdx.x == 0) { const unsigned long long t_ = __builtin_amdgcn_s_memrealtime(); \
        __hip_atomic_store((unsigned long long*)(P.ws + WS_CTL) + 1800 + (k), t_, __ATOMIC_RELAXED, __HIP_MEMORY_SCOPE_AGENT); } } while (0)
#else
#define FK_STAMP_WG(k, wgsel) do { } while (0)
#endif
#define FK_STAMP(k) FK_STAMP_WG(k, 0)

struct Params {
    const float *x, *c, *ctx, *c_ctx, *w_mod, *b_mod, *norm1_g, *w_in, *sink, *conv_w, *wpa, *wpc, *wo, *norm2_g, *w_router, *wg, *wu, *wd, *fg;
    float* out; unsigned char* ws; unsigned char* ob;
    int ph_lo, ph_hi;
};

__device__ __forceinline__ float wave_sum(float v) {
#pragma unroll
    for (int o = 1; o < 64; o <<= 1) v += __shfl_xor(v, o);
    return v;
}
__device__ __forceinline__ unsigned f2bf(float f) { unsigned u = __builtin_bit_cast(unsigned, f); return (u + 0x7fffu + ((u >> 16) & 1u)) >> 16; }
__device__ __forceinline__ unsigned pk2(float lo, float hi) { return f2bf(lo) | (f2bf(hi) << 16); }
__device__ __forceinline__ void bf8_to_f32(const u32x4 w, f32x4& lo, f32x4& hi4) { lo = (f32x4){bf_lo(w.x), bf_hi(w.x), bf_lo(w.y), bf_hi(w.y)}; hi4 = (f32x4){bf_lo(w.z), bf_hi(w.z), bf_lo(w.w), bf_hi(w.w)}; }
__device__ __forceinline__ u32x4 f32_to_bf8(const f32x4 a, const f32x4 b) { u32x4 w; w.x = pk2(a.x, a.y); w.y = pk2(a.z, a.w); w.z = pk2(b.x, b.y); w.w = pk2(b.z, b.w); return w; }
__device__ __forceinline__ float sq4(const f32x4 v) { return (v.x * v.x + v.y * v.y) + (v.z * v.z + v.w * v.w); }
__device__ __forceinline__ float dot4(const f32x4 a, const f32x4 b) { return (a.x * b.x + a.y * b.y) + (a.z * b.z + a.w * b.w); }
__device__ __forceinline__ float sigmoidf_(float v) { return 1.f / (1.f + __expf(-v)); }

__device__ __forceinline__ void transpose_item64(const float* __restrict__ W, int N, int k0, int n0, bf16_t* __restrict__ dst, int pitch, bool perm, int lane) {
    const float* src = W + (size_t)k0 * N + n0 + lane;
    const int dr = perm ? ((lane & 32) + pinv32(lane & 31)) : lane;
    bf16_t* drow = dst + (size_t)dr * pitch + k0;
#pragma unroll
    for (int h = 0; h < 2; ++h) {
        float v[32];
#pragma unroll
        for (int j = 0; j < 32; ++j) v[j] = __builtin_nontemporal_load(src + (size_t)(32 * h + j) * N);
#pragma unroll
        for (int c = 0; c < 4; ++c) { u32x4 o; o.x = pk2(v[8 * c], v[8 * c + 1]); o.y = pk2(v[8 * c + 2], v[8 * c + 3]); o.z = pk2(v[8 * c + 4], v[8 * c + 5]); o.w = pk2(v[8 * c + 6], v[8 * c + 7]);
            *(u32x4*)(drow + 32 * h + 8 * c) = o; }
    }
}

constexpr int CV_IN = 16 * 104, CV_SQ = 256, CV_TOTAL = CV_IN + 3 * CV_SQ + 48 * CV_SQ;
__device__ __forceinline__ void conv_item(const Params& P, int it, int lane) {
    bf16_t* WIN = (bf16_t*)(P.ws + WS_WIN); bf16_t* WV = (bf16_t*)(P.ws + WS_WV); bf16_t* WP = (bf16_t*)(P.ws + WS_WP); bf16_t* WO = (bf16_t*)(P.ws + WS_WO);
    bf16_t* WGU = (bf16_t*)(P.ws + WS_WGU); bf16_t* WD = (bf16_t*)(P.ws + WS_WD);
    int r = it;
    if (r < CV_IN) {
        const int kb = r / 104, nb = r % 104, k0 = 64 * kb, n0 = 64 * nb;
        bf16_t* dst; bool perm = true;
        if (n0 < 1280) { dst = WIN + (size_t)n0 * 1024; perm = false; }
        else if (n0 < 1536) { dst = WV + (size_t)(n0 - 1280) * 1024; perm = false; }
        else if (n0 < 2560) { const int ch = n0 - 1536; dst = WIN + (size_t)(1280 + (ch >> 7) * 256 + (ch & 127)) * 1024; }
        else if (n0 < 3584) { dst = WIN + (size_t)(3328 + (n0 - 2560)) * 1024; }
        else if (n0 < 4608) { const int ch = n0 - 3584; dst = WIN + (size_t)(1280 + (ch >> 7) * 256 + 128 + (ch & 127)) * 1024; }
        else if (n0 < 5632) { const int ch = n0 - 4608; dst = WIN + (size_t)(4352 + (ch >> 7) * 256 + (ch & 127)) * 1024; }
        else { const int ch = n0 - 5632; dst = WIN + (size_t)(4352 + (ch >> 7) * 256 + 128 + (ch & 127)) * 1024; }
        transpose_item64(P.w_in, 6656, k0, n0, dst, 1024, perm, lane);
        return;
    }
    r -= CV_IN;
    const int mat = r / CV_SQ, q = r % CV_SQ, kb = q / 16, nb = q % 16, k0 = 64 * kb, n0 = 64 * nb;
    if (mat == 0) transpose_item64(P.wpa, 1024, k0, n0, WP + (size_t)n0 * 2048, 2048, true, lane);
    else if (mat == 1) transpose_item64(P.wpc, 1024, k0, n0, WP + (size_t)n0 * 2048 + 1024, 2048, true, lane);
    else if (mat == 2) transpose_item64(P.wo, 1024, k0, n0, WO + (size_t)n0 * 1024, 1024, true, lane);
    else {
        const int m2 = mat - 3, kind = m2 >> 4, e = m2 & 15;
        if (kind == 0) transpose_item64(P.wg + (size_t)e * 1048576, 1024, k0, n0, WGU + ((size_t)e * 2048 + (n0 >> 7) * 256 + (n0 & 127)) * 1024, 1024, true, lane);
        else if (kind == 1) transpose_item64(P.wu + (size_t)e * 1048576, 1024, k0, n0, WGU + ((size_t)e * 2048 + (n0 >> 7) * 256 + 128 + (n0 & 127)) * 1024, 1024, true, lane);
        else transpose_item64(P.wd + (size_t)e * 1048576, 1024, k0, n0, WD + ((size_t)e * 1024 + n0) * 1024, 1024, true, lane);
    }
}

__device__ __forceinline__ void ph_prep(const Params& P, LAS unsigned char* lds) {
    const int tid = threadIdx.x, lane = tid & 63, wave = __builtin_amdgcn_readfirstlane(tid >> 6);
    const int G = gridDim.x, wg = blockIdx.x;
    float* mod = (float*)(P.ws + WS_MOD);
    if (wg < 96) {
        LAS float* sl = (LAS float*)lds;
        LAS float* red = (LAS float*)(lds + 17 * 1024 * 4);
        for (int i = tid; i < 17 * 1024; i += 512) { const int r = i >> 10, k = i & 1023; const float v = r < 16 ? P.c[r * 1024 + k] : P.c_ctx[k]; sl[i] = v / (1.f + __expf(-v)); }
        __syncthreads();
        const int col = tid & 63, kg = wave, n = wg * 64 + col;
        float acc[17];
#pragma unroll
        for (int r = 0; r < 17; ++r) acc[r] = 0.f;
        for (int kb = kg * 128; kb < kg * 128 + 128; kb += 16) {
            float w[16];
#pragma unroll
            for (int j = 0; j < 16; ++j) w[j] = P.w_mod[(size_t)(kb + j) * 6144 + n];
#pragma unroll
            for (int j = 0; j < 16; ++j)
#pragma unroll
                for (int r = 0; r < 17; ++r) acc[r] += sl[r * 1024 + kb + j] * w[j]; }
#pragma unroll
        for (int r = 0; r < 17; ++r) red[(kg * 17 + r) * 64 + col] = acc[r];
        __syncthreads();
        for (int i = tid; i < 17 * 64; i += 512) { const int r = i >> 6, cc = i & 63; float s = 0.f;
#pragma unroll
            for (int g = 0; g < 8; ++g) s += red[(g * 17 + r) * 64 + cc];
            mod[r * 6144 + wg * 64 + cc] = s + P.b_mod[wg * 64 + cc]; }
        __syncthreads();
    } else if (wg == 96) {
        float2* rope = (float2*)(P.ws + WS_ROPE);
        for (int i = tid; i < 64 * 16; i += 512) { const int pos = i >> 4, f = i & 15; const float ang = (float)pos * powf(10000.f, -(float)f / 16.f); rope[i] = make_float2(cosf(ang), sinf(ang)); }
    }
    constexpr int I_IN = 16 * 104;
    if (wg >= 96) { for (int it = (wg - 96) * 8 + wave; it < 1280; it += (G - 96) * 8) conv_item(P, it, lane); }
    else { for (int it = 1280 + wg * 8 + wave; it < I_IN; it += 96 * 8) conv_item(P, it, lane); }
}

template <int NR>
__device__ __forceinline__ void norm1_rows(const Params& P, int row0, int lane) {
    const float* mod = (const float*)(P.ws + WS_MOD);
    bf16_t* HX = (bf16_t*)(P.ws + WS_HX);
    const float* xr; const float* mv;
    if (row0 < M) { xr = P.x + (size_t)row0 * D; mv = mod + (row0 >> 11) * 6144; } else { xr = P.ctx + (size_t)(row0 - M) * D; mv = mod + 16 * 6144; }
    f32x4 v[NR][4];
#pragma unroll
    for (int r = 0; r < NR; ++r)
#pragma unroll
        for (int j = 0; j < 2; ++j) { v[r][2 * j] = __builtin_nontemporal_load((const f32x4*)(xr + (size_t)r * D + 8 * lane + 512 * j)); v[r][2 * j + 1] = __builtin_nontemporal_load((const f32x4*)(xr + (size_t)r * D + 8 * lane + 512 * j + 4)); }
    float rs[NR];
#pragma unroll
    for (int r = 0; r < NR; ++r) { const float ss = (sq4(v[r][0]) + sq4(v[r][1])) + (sq4(v[r][2]) + sq4(v[r][3])); rs[r] = 1.0f / sqrtf(wave_sum(ss) * (1.f / D) + 1e-6f); }
#pragma unroll
    for (int j = 0; j < 2; ++j) { const int c0 = 8 * lane + 512 * j;
        const f32x4 g0 = *(const f32x4*)(P.norm1_g + c0) * (*(const f32x4*)(mv + 1024 + c0) + 1.0f), g1 = *(const f32x4*)(P.norm1_g + c0 + 4) * (*(const f32x4*)(mv + 1024 + c0 + 4) + 1.0f);
        const f32x4 sh0 = *(const f32x4*)(mv + c0), sh1 = *(const f32x4*)(mv + c0 + 4);
#pragma unroll
        for (int r = 0; r < NR; ++r) *(u32x4*)(HX + (size_t)(row0 + r) * D + c0) = f32_to_bf8(v[r][2 * j] * rs[r] * g0 + sh0, v[r][2 * j + 1] * rs[r] * g1 + sh1); }
}
enum { KD_Q = 0, KD_K = 1, KD_KC = 2, KD_VT = 3, KD_VTC = 4, KD_UC = 5, KD_BC = 6, KD_GG = 7 };
struct InprojSched {
    int G, c; const char *hx, *win, *wv;
    static constexpr int NMAIN = (M / 256) * NT_IN, NVT = M / 256, NC = MC / 256, NTOT = NMAIN + NVT;
    __device__ __forceinline__ bool next(int i, Unit& u) const {
        const int Lx = i * G + c; if (Lx >= NTOT) return false;
        constexpr size_t TS = (size_t)256 * 1024 * 2;
        if (Lx < NMAIN) {
            const int wgid = (Lx % 8) * (NMAIN / 8) + Lx / 8;
            constexpr int nig = 8 * NT_IN; const int gid = wgid / nig, w = wgid % nig;
            u.pm = gid * 8 + (w % 8); u.pn = w / 8;
            u.a = hx + (size_t)u.pm * TS; u.b = win + (size_t)u.pn * TS;
            u.kind = u.pn < 4 ? KD_Q : u.pn == 4 ? KD_K : u.pn < 13 ? KD_UC : u.pn < 17 ? KD_BC : KD_GG; u.aux = 0; u.rows = nullptr;
        } else {
            const int xq = Lx - NMAIN;
            u.kind = KD_VT; u.pm = 0; u.pn = xq; u.a = wv; u.b = hx + (size_t)xq * TS;
            u.aux = 0; u.rows = nullptr;
        }
        return true;
    }
};
struct CtxSched {
    int c; const char *hx, *win, *wv;
    __device__ __forceinline__ bool next(int i, Unit& u) const {
        if (i != 0) return false;
        constexpr size_t TS = (size_t)256 * 1024 * 2; constexpr int NC = MC / 256;
        if (c < NC) { u.kind = KD_KC; u.pm = M / 256 + c; u.pn = 4; u.a = hx + (size_t)u.pm * TS; u.b = win + (size_t)4 * TS; }
        else { u.kind = KD_VTC; u.pm = 0; u.pn = c - NC; u.a = wv; u.b = hx + (size_t)(M / 256 + u.pn) * TS; }
        u.aux = 0; u.rows = nullptr; return true;
    }
};
struct EpiInproj {
    bf16_t *q, *z, *bb, *rb, *sgc; unsigned char *kb, *kcb, *vb, *vcb; const float* rope;
    __device__ __forceinline__ void operator()(const f32x4 (&acc)[2][2][4][2], const Unit& u, int wr, int wc, int fr, int fq) const {
        const int kind = u.kind;
        if (kind == KD_Q || kind == KD_K) {
#pragma unroll
            for (int ai = 0; ai < 2; ++ai)
#pragma unroll
                for (int m = 0; m < 4; ++m) {
                    const int r = u.pm * 256 + 128 * ai + 64 * wr + 16 * m + fr, t = r & 2047, b = r >> 11;
                    const int pos = (wc & 1) ? (t & 63) : (t >> 6);
                    const float* tb = rope + (pos * 16 + 4 * fq) * 2;
                    const f32x4 t0 = *(const f32x4*)tb, t1 = *(const f32x4*)(tb + 4);
                    const f32x4 cs = {t0.x, t0.z, t1.x, t1.z}, sn = {t0.y, t0.w, t1.y, t1.w};
#pragma unroll
                    for (int bj = 0; bj < 2; ++bj) {
                        const f32x4 x0 = acc[ai][bj][m][0], x1 = acc[ai][bj][m][1];
                        f32x4 o0 = x0 * cs - x1 * sn, o1 = x1 * cs + x0 * sn;
                        if (kind == KD_Q) {
                            o0 = o0 * C2; o1 = o1 * C2;
                            bf16_t* dst = q + (size_t)r * 1024 + u.pn * 256 + 128 * bj + 32 * wc + 4 * fq;
                            u32x2 w0, w1; w0.x = cvt_pk_bf16(o0.x, o0.y); w0.y = cvt_pk_bf16(o0.z, o0.w); w1.x = cvt_pk_bf16(o1.x, o1.y); w1.y = cvt_pk_bf16(o1.z, o1.w);
                            *(u32x2*)dst = w0; *(u32x2*)(dst + 16) = w1;
                        } else {
                            const int hkv = 2 * bj + (wc >> 1), ch0 = 4 * (wc & 1) + (fq >> 1);
                            unsigned char* dst = kb + ((size_t)((b * 4 + hkv) * 32 + (t >> 6))) * 8192 + ch0 * 1024 + (t & 63) * 16 + 8 * (fq & 1);
                            u32x2 w0, w1; w0.x = cvt_pk_bf16(o0.x, o0.y); w0.y = cvt_pk_bf16(o0.z, o0.w); w1.x = cvt_pk_bf16(o1.x, o1.y); w1.y = cvt_pk_bf16(o1.z, o1.w);
                            *(u32x2*)dst = w0; *(u32x2*)(dst + 2048) = w1;
                        }
                    }
                }
        } else if (kind == KD_KC) {
#pragma unroll
            for (int ai = 0; ai < 2; ++ai)
#pragma unroll
                for (int m = 0; m < 4; ++m) {
                    const int r = (u.pm - M / 256) * 256 + 128 * ai + 64 * wr + 16 * m + fr, l = r & 255, b = r >> 8;
#pragma unroll
                    for (int bj = 0; bj < 2; ++bj) {
                        const int hkv = 2 * bj + (wc >> 1), ch0 = 4 * (wc & 1) + (fq >> 1);
                        unsigned char* dst = kcb + ((size_t)((b * 4 + hkv) * 4 + (l >> 6))) * 8192 + ch0 * 1024 + (l & 63) * 16 + 8 * (fq & 1);
#pragma unroll
                        for (int n = 0; n < 2; ++n) { const f32x4 v = acc[ai][bj][m][n]; u32x2 w; w.x = cvt_pk_bf16(v.x, v.y); w.y = cvt_pk_bf16(v.z, v.w); *(u32x2*)(dst + n * 2048) = w; }
                    }
                }
        } else if (kind == KD_VT || kind == KD_VTC) {
#pragma unroll
            for (int ai = 0; ai < 2; ++ai)
#pragma unroll
                for (int m = 0; m < 4; ++m) {
                    const int hkv = 2 * ai + wr, d = 16 * m + fr;
#pragma unroll
                    for (int bj = 0; bj < 2; ++bj) {
                        size_t blk;
                        if (kind == KD_VT) blk = (size_t)(((u.pn >> 3) * 4 + hkv) * 32 + 4 * (u.pn & 7) + 2 * bj + (wc >> 1));
                        else blk = (size_t)((u.pn * 4 + hkv) * 4 + 2 * bj + (wc >> 1));
                        unsigned char* base = (kind == KD_VT ? vb : vcb) + blk * 8192 + d * 16 + 8 * (fq >> 1);
#pragma unroll
                        for (int n = 0; n < 2; ++n) { const f32x4 v = acc[ai][bj][m][n]; u32x2 w; w.x = cvt_pk_bf16(v.x, v.y); w.y = cvt_pk_bf16(v.z, v.w);
                            *(u32x2*)(base + (2 * (2 * (wc & 1) + n) + (fq & 1)) * 1024) = w; }
                    }
                }
        } else if (kind == KD_UC) {
#pragma unroll
            for (int ai = 0; ai < 2; ++ai)
#pragma unroll
                for (int m = 0; m < 4; ++m) {
                    const int r = u.pm * 256 + 128 * ai + 64 * wr + 16 * m + fr;
                    const f32x4 v0 = acc[ai][0][m][0] * acc[ai][1][m][0], v1 = acc[ai][0][m][1] * acc[ai][1][m][1];
                    u32x4 w; w.x = cvt_pk_bf16(v0.x, v0.y); w.y = cvt_pk_bf16(v0.z, v0.w); w.z = cvt_pk_bf16(v1.x, v1.y); w.w = cvt_pk_bf16(v1.z, v1.w);
                    *(u32x4*)(z + (size_t)r * 1024 + (u.pn - 5) * 128 + 32 * wc + 8 * fq) = w;
                }
        } else if (kind == KD_BC) {
#pragma unroll
            for (int ai = 0; ai < 2; ++ai)
#pragma unroll
                for (int m = 0; m < 4; ++m) {
                    const int r = u.pm * 256 + 128 * ai + 64 * wr + 16 * m + fr;
#pragma unroll
                    for (int bj = 0; bj < 2; ++bj) { const f32x4 v0 = acc[ai][bj][m][0], v1 = acc[ai][bj][m][1];
                        u32x4 w; w.x = cvt_pk_bf16(v0.x, v0.y); w.y = cvt_pk_bf16(v0.z, v0.w); w.z = cvt_pk_bf16(v1.x, v1.y); w.w = cvt_pk_bf16(v1.z, v1.w);
                        *(u32x4*)(bb + (size_t)r * 1024 + (u.pn - 13) * 256 + 128 * bj + 32 * wc + 8 * fq) = w; }
                }
        } else {
#pragma unroll
            for (int ai = 0; ai < 2; ++ai)
#pragma unroll
                for (int m = 0; m < 4; ++m) {
                    const int r = u.pm * 256 + 128 * ai + 64 * wr + 16 * m + fr;
                    f32x4 rr[2], sg[2];
#pragma unroll
                    for (int n = 0; n < 2; ++n)
#pragma unroll
                        for (int j = 0; j < 4; ++j) { const float ea = __expf(-acc[ai][0][m][n][j]), ec = __expf(-acc[ai][1][m][n][j]);
                            rr[n][j] = (1.f + ec) * __builtin_amdgcn_rcpf(1.f + ea); sg[n][j] = __builtin_amdgcn_rcpf(1.f + ec); }
                    const size_t off = (size_t)r * 1024 + (u.pn - 17) * 128 + 32 * wc + 8 * fq;
                    u32x4 w; w.x = cvt_pk_bf16(rr[0].x, rr[0].y); w.y = cvt_pk_bf16(rr[0].z, rr[0].w); w.z = cvt_pk_bf16(rr[1].x, rr[1].y); w.w = cvt_pk_bf16(rr[1].z, rr[1].w);
                    *(u32x4*)(rb + off) = w;
                    w.x = cvt_pk_bf16(sg[0].x, sg[0].y); w.y = cvt_pk_bf16(sg[0].z, sg[0].w); w.z = cvt_pk_bf16(sg[1].x, sg[1].y); w.w = cvt_pk_bf16(sg[1].z, sg[1].w);
                    *(u32x4*)(sgc + off) = w;
                }
        }
    }
};
__device__ __forceinline__ void ph_inproj(const Params& P, LAS unsigned char* lds) {
    InprojSched S; S.G = gridDim.x; S.c = blockIdx.x; S.hx = (const char*)(P.ws + WS_HX); S.win = (const char*)(P.ws + WS_WIN); S.wv = (const char*)(P.ws + WS_WV);
    EpiInproj E; E.q = (bf16_t*)(P.ws + WS_Q); E.z = (bf16_t*)(P.ws + WS_Z); E.bb = (bf16_t*)(P.ws + WS_BB); E.rb = (bf16_t*)(P.ob + OB_RB); E.sgc = (bf16_t*)(P.ob + OB_SGC);
    E.kb = P.ws + WS_KB; E.kcb = P.ws + WS_KCB; E.vb = P.ws + WS_VB; E.vcb = P.ws + WS_VCB; E.rope = (const float*)(P.ws + WS_ROPE);
#ifdef FK_STAGGER_PROBE
    { const unsigned long long t0 = __builtin_amdgcn_s_memrealtime(); const unsigned long long dt = (unsigned long long)((blockIdx.x >> 3) & 31) * FK_STAGGER_PROBE;
      while (__builtin_amdgcn_s_memrealtime() - t0 < dt) __builtin_amdgcn_s_sleep(4); }
#endif
#if defined(FK_EPI2_PROBE)
    gemm_phase<EpiInproj, InprojSched, false, false, 3>(lds, 1024, S, E);
#elif defined(FK_KREP_INPROJ)
    gemm_phase<EpiInproj, InprojSched, false, false, 2>(lds, 1024, S, E);
#else
    gemm_phase<EpiInproj, InprojSched, false>(lds, 1024, S, E);
#endif
}

constexpr int CW_QUEUE = 3584;
__device__ __forceinline__ void ph_norm1(const Params& P, LAS unsigned char* lds) {
    const int tid = threadIdx.x, lane = tid & 63, wave = __builtin_amdgcn_readfirstlane(tid >> 6), wg = blockIdx.x, G = gridDim.x;
    constexpr int NC = MC / 256;
    if (wg < 2 * NC && G > 2 * NC) {
        const int tile = wg < NC ? wg : wg - NC;
        for (int r = wave * 4; r < 256; r += 32) norm1_rows<4>(P, M + tile * 256 + r, lane);
        asm volatile("s_waitcnt vmcnt(0)" ::: "memory");
        __syncthreads();
        CtxSched S; S.c = wg; S.hx = (const char*)(P.ws + WS_HX); S.win = (const char*)(P.ws + WS_WIN); S.wv = (const char*)(P.ws + WS_WV);
        EpiInproj E; E.q = nullptr; E.z = nullptr; E.bb = nullptr; E.rb = nullptr; E.sgc = nullptr;
        E.kb = P.ws + WS_KB; E.kcb = P.ws + WS_KCB; E.vb = P.ws + WS_VB; E.vcb = P.ws + WS_VCB; E.rope = (const float*)(P.ws + WS_ROPE);
        gemm_phase<EpiInproj, CtxSched, false>(lds, 1024, S, E);
        FK_STAMP_WG(14, 0);
    } else {
        const int nw = (G - 2 * NC) * 8, gw = (wg - 2 * NC) * 8 + wave;
        for (int row = gw * 4; row < M; row += nw * 4) norm1_rows<4>(P, row, lane);
        __syncthreads(); FK_STAMP_WG(12, 40);
    }
    unsigned* head = (unsigned*)(P.ws + WS_CTL) + CW_QUEUE;
    LAS unsigned* slot = (LAS unsigned*)(lds + LDS_MISC_Q);
    for (;;) {
        __syncthreads();
        if (tid == 0) slot[0] = __hip_atomic_fetch_add(head, 32u, __ATOMIC_RELAXED, __HIP_MEMORY_SCOPE_AGENT);
        __syncthreads();
        const int base = CV_IN + (int)slot[0];
        if (base >= CV_TOTAL) break;
#pragma unroll 1
        for (int k = 0; k < 4; ++k) { const int it = base + wave * 4 + k; if (it < CV_TOTAL) conv_item(P, it, lane); }
    }
    FK_STAMP_WG(13, 40); FK_STAMP_WG(15, 0);
}

__device__ __forceinline__ int crow(int r, int hi) { return (r & 3) + 8 * (r >> 2) + 4 * hi; }
#ifndef FK_ATT_THR
#define FK_ATT_THR 24.0f
#endif
constexpr float ATT_THR = FK_ATT_THR;
constexpr int ATT_NS = 5;
struct AttnUnitInfo { int b, hkv, qb, w_lo, nwin, ntile; };
__device__ __forceinline__ AttnUnitInfo attn_decode(int uidx) {
    AttnUnitInfo u; u.b = uidx >> 7; u.hkv = (uidx >> 5) & 3; u.qb = uidx & 31;
    u.w_lo = u.qb - 2 < 0 ? 0 : u.qb - 2; const int w_hi = u.qb + 2 > 31 ? 31 : u.qb + 2; u.nwin = w_hi - u.w_lo + 1; u.ntile = u.nwin + 4; return u;
}
__device__ __forceinline__ float max3f(float a, float b, float c) { float r; asm("v_max3_f32 %0, %1, %2, %3" : "=v"(r) : "v"(a), "v"(b), "v"(c)); return r; }
__device__ __forceinline__ void attn_finish(const Params& P, const f32x16& o0, const f32x16& o1, float lrun, int b, int hkv, int qb, int g, int wsub, int r32, int hi) {
    const float ltot = lrun + __shfl_xor(lrun, 32), inv = 1.f / ltot;
    bf16_t* AO = (bf16_t*)(P.ws + WS_AO) + (size_t)(b * T + qb * 64 + 32 * wsub + r32) * 2048 + (hkv * 4 + g) * 64 + 4 * hi;
#pragma unroll
    for (int g4 = 0; g4 < 4; ++g4) {
        u32x2 w; w.x = cvt_pk_bf16(o0[4 * g4] * inv, o0[4 * g4 + 1] * inv); w.y = cvt_pk_bf16(o0[4 * g4 + 2] * inv, o0[4 * g4 + 3] * inv); *(u32x2*)(AO + 8 * g4) = w;
        w.x = cvt_pk_bf16(o1[4 * g4] * inv, o1[4 * g4 + 1] * inv); w.y = cvt_pk_bf16(o1[4 * g4 + 2] * inv, o1[4 * g4 + 3] * inv); *(u32x2*)(AO + 32 + 8 * g4) = w;
    }
}
__device__ __forceinline__ void attn_drain(const Params& P, LAS unsigned char* lds, const f32x16& Pa, const f32x16& Pb, f32x16& o0, f32x16& o1, float lrun, int vslot,
                                           int cu, int nun, int ubase, int GY, int g, int wsub, int r32, int hi) {
    float sacc = 0.f;
#pragma unroll
    for (int r = 0; r < 16; ++r) sacc += Pa[r] + Pb[r];
    lrun += sacc;
    const LAS unsigned char* Vp = lds + vslot * 16384 + 8192 + hi * 1024 + r32 * 16;
#pragma unroll
    for (int ks = 0; ks < 4; ++ks) {
        const f32x16& S = ks < 2 ? Pa : Pb; const int o = 8 * (ks & 1);
        const u32x4 pw = (u32x4){cvt_pk_bf16(S[o], S[o + 1]), cvt_pk_bf16(S[o + 2], S[o + 3]), cvt_pk_bf16(S[o + 4], S[o + 5]), cvt_pk_bf16(S[o + 6], S[o + 7])};
        const bf16x8 v0 = *(const LAS bf16x8*)(Vp + (2 * ks) * 1024), v1 = *(const LAS bf16x8*)(Vp + (2 * ks) * 1024 + 512);
        const bf16x8 pb = __builtin_bit_cast(bf16x8, pw);
        o0 = __builtin_amdgcn_mfma_f32_32x32x16_bf16(v0, pb, o0, 0, 0, 0); o1 = __builtin_amdgcn_mfma_f32_32x32x16_bf16(v1, pb, o1, 0, 0, 0);
    }
    const AttnUnitInfo li = attn_decode(ubase + GY * (nun - 1));
    attn_finish(P, o0, o1, lrun, li.b, li.hkv, li.qb, g, wsub, r32, hi);
}
__device__ __forceinline__ void attn_phase(const Params& P, LAS unsigned char* lds) {
    const int tid = threadIdx.x, lane = tid & 63, wid = __builtin_amdgcn_readfirstlane(tid >> 6), r32 = lane & 31, hi = lane >> 5;
    constexpr int NU = NBF * 4 * 32;
    const int G = gridDim.x, xg = blockIdx.x & 7, yg = blockIdx.x >> 3, GY = G >> 3;
    const int nun = (NU / 8 - yg + GY - 1) / GY;
    if (nun <= 0) return;
    const int ubase = xg * (NU / 8) + yg;
    const bf16_t* Q = (const bf16_t*)(P.ws + WS_Q);
    const unsigned char* KB = P.ws + WS_KB; const unsigned char* VB = P.ws + WS_VB; const unsigned char* KCB = P.ws + WS_KCB; const unsigned char* VCB = P.ws + WS_VCB;
    const int g = wid >> 1, wsub = wid & 1;
#define AT_WAIT(n) asm volatile("s_waitcnt vmcnt(" #n ")" ::: "memory")
#define AT_SB() __builtin_amdgcn_sched_barrier(0)
    int pu = 0, pit = 0, pstep = 0, pslot = 0; AttnUnitInfo pinfo = attn_decode(ubase);
    auto issue = [&]() {
        const size_t bh = (size_t)(pinfo.b * 4 + pinfo.hkv);
        const unsigned char* ks = pit < pinfo.nwin ? KB + (bh * 32 + pinfo.w_lo + pit) * 8192 : KCB + (bh * 4 + (pit - pinfo.nwin)) * 8192;
        const unsigned char* vs = pit < pinfo.nwin ? VB + (bh * 32 + pinfo.w_lo + pit) * 8192 : VCB + (bh * 4 + (pit - pinfo.nwin)) * 8192;
        LAS unsigned char* dst = lds + pslot * 16384 + wid * 1024;
        __builtin_amdgcn_global_load_lds((const unsigned*)(ks + wid * 1024 + lane * 16), (LAS unsigned*)dst, 16, 0, 0);
        __builtin_amdgcn_global_load_lds((const unsigned*)(vs + wid * 1024 + lane * 16), (LAS unsigned*)(dst + 8192), 16, 0, 0);
        ++pstep; pslot = pslot == ATT_NS - 1 ? 0 : pslot + 1; ++pit;
        if (pit == pinfo.ntile) { pit = 0; ++pu; if (pu < nun) pinfo = attn_decode(ubase + GY * pu); }
    };
    int total = 0;
    for (int k = 0; k < nun; ++k) total += attn_decode(ubase + GY * k).ntile;
    *(LAS u32x4*)(lds + (ATT_NS - 1) * 16384 + 8192 + tid * 16) = (u32x4){0u, 0u, 0u, 0u};
    __syncthreads();
    int cu = 0, it = 0, step = 0, cslot = 0, vslot = ATT_NS - 1; AttnUnitInfo ci = attn_decode(ubase);
    int fb = 0, fhkv = 0, fqb = 0;
    constexpr int ATT_QOFF = ATT_NS * 16384;
    auto issueQ = [&](const AttnUnitInfo& ui) {
        const bf16_t* qp = Q + (size_t)(ui.b * T + ui.qb * 64 + 32 * wsub + r32) * 1024 + (ui.hkv * 4 + g) * 64 + hi * 8;
#pragma unroll
        for (int j = 0; j < 4; ++j)
            __builtin_amdgcn_global_load_lds((const unsigned*)(qp + 16 * j), (LAS unsigned*)(lds + ATT_QOFF + wid * 4096 + j * 1024), 16, 0, 0);
    };
    float sk0 = P.sink[0 * 4 + g] * LOG2E, sk1 = P.sink[1 * 4 + g] * LOG2E, sk2 = P.sink[2 * 4 + g] * LOG2E, sk3 = P.sink[3 * 4 + g] * LOG2E;
    asm volatile("s_waitcnt vmcnt(0)" : "+v"(sk0), "+v"(sk1), "+v"(sk2), "+v"(sk3) :: "memory");
    bf16x8 qf[4];
    float sink_c = 0.f;
    const f32x16 zero16 = {0.f, 0.f, 0.f, 0.f, 0.f, 0.f, 0.f, 0.f, 0.f, 0.f, 0.f, 0.f, 0.f, 0.f, 0.f, 0.f};
    f32x16 o0, o1, pA0, pA1, pB0, pB1;
    float mrun = 0.f, lrun = 0.f; bool slow = false;
#pragma unroll
    for (int r = 0; r < 16; ++r) { o0[r] = 0.f; o1[r] = 0.f; pA0[r] = 0.f; pA1[r] = 0.f; pB0[r] = 0.f; pB1[r] = 0.f; }
    bf16x8 fr[4]; u32x4 pw[4];
    issueQ(ci);
    issue(); if (total > 1) issue(); if (total > 2) issue();
    if (total > 2) AT_WAIT(2); else AT_WAIT(0);
    __builtin_amdgcn_s_barrier(); asm volatile("" ::: "memory");
    if (pstep < total) issue();
#define AT_FA(base, i) (*(const LAS bf16x8*)((base) + (((i) >> 1) * 2) * 1024 + ((i) & 1) * 512))
    { const LAS unsigned char* K0 = lds + hi * 1024 + r32 * 16; fr[0] = AT_FA(K0, 0); fr[1] = AT_FA(K0, 1); fr[2] = AT_FA(K0, 2); }

#define AT_PK(Pa, Pb, w) cvt_pk_bf16((w) < 8 ? Pa[2 * (w)] : Pb[2 * (w) - 16], (w) < 8 ? Pa[2 * (w) + 1] : Pb[2 * (w) - 15])
#define AT_PV(Pa, Pb, i) ((i) < 16 ? Pa[(i)] : Pb[(i) - 16])
#define AT_GAPA(gi, Cn, Pa, Pb) do { \
        Cn = __builtin_amdgcn_mfma_f32_32x32x16_bf16(fr[(gi) & 3], qf[(gi) >> 1], (gi) < 2 ? zero16 : Cn, 0, 0, 0); \
        if ((gi) + 3 < 8) fr[((gi) + 3) & 3] = AT_FA(Kc, (gi) + 3); else fr[((gi) + 3) & 3] = AT_FA(Vp, (gi) + 3 - 8); \
        sacc += AT_PV(Pa, Pb, 4 * (gi)) + AT_PV(Pa, Pb, 4 * (gi) + 1); sacc2 += AT_PV(Pa, Pb, 4 * (gi) + 2) + AT_PV(Pa, Pb, 4 * (gi) + 3); \
        pw[(gi) >> 1][2 * ((gi) & 1)] = AT_PK(Pa, Pb, 2 * (gi)); pw[(gi) >> 1][2 * ((gi) & 1) + 1] = AT_PK(Pa, Pb, 2 * (gi) + 1); AT_SB(); } while (0)
#define AT_GAPB(gi, Cx, cb) do { \
        if ((gi) & 1) o1 = __builtin_amdgcn_mfma_f32_32x32x16_bf16(fr[(gi) & 3], __builtin_bit_cast(bf16x8, pw[(gi) >> 1]), o1, 0, 0, 0); \
        else o0 = __builtin_amdgcn_mfma_f32_32x32x16_bf16(fr[(gi) & 3], __builtin_bit_cast(bf16x8, pw[(gi) >> 1]), o0, 0, 0, 0); \
        if ((gi) + 3 < 8) fr[((gi) + 3) & 3] = AT_FA(Vp, (gi) + 3); else fr[((gi) + 3) & 3] = AT_FA(Kn, (gi) + 3 - 8); \
        Cx[cb] = __builtin_amdgcn_exp2f(Cx[cb]); Cx[cb + 1] = __builtin_amdgcn_exp2f(Cx[cb + 1]); Cx[cb + 2] = __builtin_amdgcn_exp2f(Cx[cb + 2]); Cx[cb + 3] = __builtin_amdgcn_exp2f(Cx[cb + 3]); \
        AT_SB(); } while (0)
#define AT_STEP(C0, C1, Pa, Pb) do { \
        const bool first = (it == 0); \
        if (first) { fb = ci.b; fhkv = ci.hkv; fqb = ci.qb; if (step > 0) { const AttnUnitInfo pi = attn_decode(ubase + GY * (cu - 1)); fb = pi.b; fhkv = pi.hkv; fqb = pi.qb; } \
            sink_c = ci.hkv == 0 ? sk0 : ci.hkv == 1 ? sk1 : ci.hkv == 2 ? sk2 : sk3; mrun = 0.f; slow = false; \
            _Pragma("unroll") for (int ks = 0; ks < 4; ++ks) qf[ks] = *(const LAS bf16x8*)(lds + ATT_QOFF + wid * 4096 + (2 * ks + hi) * 512 + r32 * 16); \
            asm volatile("s_waitcnt lgkmcnt(0)" ::: "memory"); \
            if (cu + 1 < nun) issueQ(attn_decode(ubase + GY * (cu + 1))); } \
        const LAS unsigned char* Kc = lds + cslot * 16384 + hi * 1024 + r32 * 16; \
        const LAS unsigned char* Vp = lds + vslot * 16384 + 8192 + hi * 1024 + r32 * 16; \
        const int nslot = cslot == ATT_NS - 1 ? 0 : cslot + 1; \
        const LAS unsigned char* Kn = lds + nslot * 16384 + hi * 1024 + r32 * 16; \
        float sacc = 0.f, sacc2 = 0.f; AT_SB(); \
        AT_GAPA(0, C0, Pa, Pb); AT_GAPA(1, C1, Pa, Pb); AT_GAPA(2, C0, Pa, Pb); AT_GAPA(3, C1, Pa, Pb); AT_GAPA(4, C0, Pa, Pb); AT_GAPA(5, C1, Pa, Pb); AT_GAPA(6, C0, Pa, Pb); AT_GAPA(7, C1, Pa, Pb); \
        lrun += sacc + sacc2; \
        if (slow) { _Pragma("unroll") for (int r = 0; r < 16; ++r) { C0[r] -= mrun; C1[r] -= mrun; } } \
        if (it < ci.nwin) { const int wt = ci.w_lo + it, dq = wt - ci.qb; \
            if (dq == 2 || dq == -2) { const int base = ci.qb * 64 + 32 * wsub + r32 - 64 * wt; \
                _Pragma("unroll") for (int r = 0; r < 16; ++r) { const int d0 = base - crow(r, hi), d1 = d0 - 32; \
                    if (d0 > 128 || d0 < -128) C0[r] = -1e30f; if (d1 > 128 || d1 < -128) C1[r] = -1e30f; } } } \
        float mx; { float ma = max3f(C0[0], C0[1], C1[0]), mb = max3f(C0[2], C0[3], C1[1]); ma = max3f(ma, C1[2], C1[3]); \
            _Pragma("unroll") for (int r = 4; r < 16; r += 4) { ma = max3f(ma, C0[r], C0[r + 1]); mb = max3f(mb, C0[r + 2], C0[r + 3]); ma = max3f(ma, C1[r], C1[r + 1]); mb = max3f(mb, C1[r + 2], C1[r + 3]); } \
            mx = fmaxf(ma, mb); mx = fmaxf(mx, __shfl_xor(mx, 32)); } \
        float fres = 1.f; bool resc = false; \
        if (__any(mx > ATT_THR)) { const float dl = fmaxf(mx, 0.f); fres = __builtin_amdgcn_exp2f(-dl); mrun += dl; resc = true; slow = true; \
            _Pragma("unroll") for (int r = 0; r < 16; ++r) { C0[r] -= dl; C1[r] -= dl; } } \
        AT_SB(); \
        AT_GAPB(0, C0, 0); AT_GAPB(1, C0, 4); AT_GAPB(2, C0, 8); AT_GAPB(3, C0, 12); AT_GAPB(4, C1, 0); AT_GAPB(5, C1, 4); AT_GAPB(6, C1, 8); AT_GAPB(7, C1, 12); \
        if (first && step > 0) { attn_finish(P, o0, o1, lrun, fb, fhkv, fqb, g, wsub, r32, hi); \
            _Pragma("unroll") for (int r = 0; r < 16; ++r) { o0[r] = 0.f; o1[r] = 0.f; } lrun = (hi == 0 ? __builtin_amdgcn_exp2f(sink_c) : 0.f) * fres; } \
        else if (first) { lrun = (hi == 0 ? __builtin_amdgcn_exp2f(sink_c) : 0.f) * fres; } \
        else if (resc) { lrun *= fres; _Pragma("unroll") for (int r = 0; r < 16; ++r) { o0[r] *= fres; o1[r] *= fres; } } \
        ++it; ++step; vslot = cslot; cslot = nslot; \
        if (it == ci.ntile) { it = 0; ++cu; if (cu < nun) ci = attn_decode(ubase + GY * cu); } \
        if (step < total) { \
            const int ahead = pstep - step;        \
            if (ahead >= 3) AT_WAIT(2); else AT_WAIT(0); \
            __builtin_amdgcn_s_barrier(); asm volatile("" ::: "memory"); \
            if (pstep < total) issue(); \
        } } while (0)

    while (step < total) {
        AT_STEP(pB0, pB1, pA0, pA1);
        if (step >= total) {
            attn_drain(P, lds, pB0, pB1, o0, o1, lrun, vslot, cu, nun, ubase, GY, g, wsub, r32, hi);
            break; }
        AT_STEP(pA0, pA1, pB0, pB1);
        if (step >= total) { attn_drain(P, lds, pA0, pA1, o0, o1, lrun, vslot, cu, nun, ubase, GY, g, wsub, r32, hi); break; }
    }
    AT_WAIT(0);
    __syncthreads();
#undef AT_STEP
#undef AT_GAPA
#undef AT_GAPB
#undef AT_PK
#undef AT_PV
#undef AT_FA
#undef AT_WAIT
#undef AT_SB
}
__device__ __forceinline__ void ph_mix(const Params& P, LAS unsigned char* lds) {
    const int G = gridDim.x;
    attn_phase(P, lds);
#if (FK_DBL >> 11) & 1
    attn_phase(P, lds);
#endif
#if (FK_DBL >> 12) & 1
    for (int rep = 0; rep < 2; ++rep)
#endif
    const bf16_t* Z = (const bf16_t*)(P.ws + WS_Z); const bf16_t* BB = (const bf16_t*)(P.ws + WS_BB); bf16_t* AO = (bf16_t*)(P.ws + WS_AO);
    for (int it = blockIdx.x * 512 + threadIdx.x; it < (M / 16) * 128; it += G * 512) {
        const int cch = it & 127, tr = it >> 7, row0 = tr * 16, tl = row0 & 2047;
        const f32x4 wa = *(const f32x4*)(P.conv_w + cch * 8), wb = *(const f32x4*)(P.conv_w + cch * 8 + 4);
        const f32x4 wc0 = *(const f32x4*)(P.conv_w + 1024 + cch * 8), wc1 = *(const f32x4*)(P.conv_w + 1024 + cch * 8 + 4);
        const f32x4 we0 = *(const f32x4*)(P.conv_w + 2048 + cch * 8), we1 = *(const f32x4*)(P.conv_w + 2048 + cch * 8 + 4);
        const bf16_t* zp = Z + (size_t)row0 * 1024 + cch * 8;
        u32x4 zm = tl > 0 ? *(const u32x4*)(zp - 1024) : (u32x4){0u, 0u, 0u, 0u};
        u32x4 zc = *(const u32x4*)zp;
#pragma unroll 4
        for (int i = 0; i < 16; ++i) {
            const u32x4 zn = (tl + i + 1 < 2048) ? *(const u32x4*)(zp + (size_t)(i + 1) * 1024) : (u32x4){0u, 0u, 0u, 0u};
            const u32x4 bv = *(const u32x4*)(BB + (size_t)(row0 + i) * 1024 + cch * 8);
            float y[8];
#pragma unroll
            for (int k = 0; k < 4; ++k) {
                const float w0l = k < 2 ? wa[2 * k] : wb[2 * k - 4], w0h = k < 2 ? wa[2 * k + 1] : wb[2 * k - 3];
                const float w1l = k < 2 ? wc0[2 * k] : wc1[2 * k - 4], w1h = k < 2 ? wc0[2 * k + 1] : wc1[2 * k - 3];
                const float w2l = k < 2 ? we0[2 * k] : we1[2 * k - 4], w2h = k < 2 ? we0[2 * k + 1] : we1[2 * k - 3];
                y[2 * k] = bf_lo(bv[k]) * (w0l * bf_lo(zm[k]) + w1l * bf_lo(zc[k]) + w2l * bf_lo(zn[k]));
                y[2 * k + 1] = bf_hi(bv[k]) * (w0h * bf_hi(zm[k]) + w1h * bf_hi(zc[k]) + w2h * bf_hi(zn[k]));
            }
            u32x4 o; o.x = cvt_pk_bf16(y[0], y[1]); o.y = cvt_pk_bf16(y[2], y[3]); o.z = cvt_pk_bf16(y[4], y[5]); o.w = cvt_pk_bf16(y[6], y[7]);
            *(u32x4*)(AO + (size_t)(row0 + i) * 2048 + 1024 + cch * 8) = o;
            zm = zc; zc = zn;
        }
    }
}

struct RowColSched {
    int G, c, nM, nN; const char *A, *B; size_t ts;
    __device__ __forceinline__ bool next(int i, Unit& u) const {
        const int nwg = nM * nN, Lx = i * G + c; if (Lx >= nwg) return false;
        const int wgid = (Lx % 8) * (nwg / 8) + Lx / 8;
        const int nig = 8 * nN, gid = wgid / nig, w = wgid % nig;
        u.pm = gid * 8 + (w % 8); u.pn = w / 8; u.a = A + (size_t)u.pm * ts; u.b = B + (size_t)u.pn * ts; u.kind = 0; u.aux = 0; u.rows = nullptr; return true;
    }
};
struct EpiProj {
    const bf16_t *rb, *sgc; bf16_t* mb;
    __device__ __forceinline__ void mid(f32x4 (&acc)[2][2][4][2], const Unit& u, int wr, int wc, int fr, int fq) const {
#pragma unroll
        for (int ai = 0; ai < 2; ++ai)
#pragma unroll
            for (int m = 0; m < 4; ++m) { const int r = u.pm * 256 + 128 * ai + 64 * wr + 16 * m + fr;
#pragma unroll
                for (int bj = 0; bj < 2; ++bj) { const u32x4 w = *(const u32x4*)(rb + (size_t)r * 1024 + u.pn * 256 + 128 * bj + 32 * wc + 8 * fq);
                    acc[ai][bj][m][0] *= (f32x4){bf_lo(w.x), bf_hi(w.x), bf_lo(w.y), bf_hi(w.y)}; acc[ai][bj][m][1] *= (f32x4){bf_lo(w.z), bf_hi(w.z), bf_lo(w.w), bf_hi(w.w)}; } }
    }
    __device__ __forceinline__ void operator()(const f32x4 (&acc)[2][2][4][2], const Unit& u, int wr, int wc, int fr, int fq) const {
#pragma unroll
        for (int ai = 0; ai < 2; ++ai)
#pragma unroll
            for (int m = 0; m < 4; ++m) { const int r = u.pm * 256 + 128 * ai + 64 * wr + 16 * m + fr;
#pragma unroll
                for (int bj = 0; bj < 2; ++bj) { const size_t off = (size_t)r * 1024 + u.pn * 256 + 128 * bj + 32 * wc + 8 * fq; const u32x4 w = *(const u32x4*)(sgc + off);
                    const f32x4 v0 = acc[ai][bj][m][0] * (f32x4){bf_lo(w.x), bf_hi(w.x), bf_lo(w.y), bf_hi(w.y)}, v1 = acc[ai][bj][m][1] * (f32x4){bf_lo(w.z), bf_hi(w.z), bf_lo(w.w), bf_hi(w.w)};
                    u32x4 o; o.x = cvt_pk_bf16(v0.x, v0.y); o.y = cvt_pk_bf16(v0.z, v0.w); o.z = cvt_pk_bf16(v1.x, v1.y); o.w = cvt_pk_bf16(v1.z, v1.w);
                    *(u32x4*)(mb + off) = o; } }
    }
};
__device__ __forceinline__ void ph_proj(const Params& P, LAS unsigned char* lds) {
    RowColSched S; S.G = gridDim.x; S.c = blockIdx.x; S.nM = M / 256; S.nN = 4; S.A = (const char*)(P.ws + WS_AO); S.B = (const char*)(P.ws + WS_WP); S.ts = (size_t)256 * 2048 * 2;
    EpiProj E; E.rb = (const bf16_t*)(P.ob + OB_RB); E.sgc = (const bf16_t*)(P.ob + OB_SGC); E.mb = (bf16_t*)(P.ws + WS_MB);
    gemm_phase<EpiProj, RowColSched, true>(lds, 2048, S, E);
}
struct EpiOut {
    const float* mod; bf16_t* dl;
    __device__ __forceinline__ void operator()(const f32x4 (&acc)[2][2][4][2], const Unit& u, int wr, int wc, int fr, int fq) const {
        const int b = (u.pm * 256) >> 11;
#pragma unroll
        for (int bj = 0; bj < 2; ++bj) { const int col = u.pn * 256 + 128 * bj + 32 * wc + 8 * fq;
            const f32x4 g0 = *(const f32x4*)(mod + b * 6144 + 2048 + col), g1 = *(const f32x4*)(mod + b * 6144 + 2048 + col + 4);
#pragma unroll
            for (int ai = 0; ai < 2; ++ai)
#pragma unroll
                for (int m = 0; m < 4; ++m) { const size_t off = (size_t)(u.pm * 256 + 128 * ai + 64 * wr + 16 * m + fr) * 1024 + col;
                    const f32x4 v0 = g0 * acc[ai][bj][m][0], v1 = g1 * acc[ai][bj][m][1];
                    u32x4 w; w.x = cvt_pk_bf16(v0.x, v0.y); w.y = cvt_pk_bf16(v0.z, v0.w); w.z = cvt_pk_bf16(v1.x, v1.y); w.w = cvt_pk_bf16(v1.z, v1.w);
                    *(u32x4*)(dl + off) = w; } }
    }
};
__device__ __forceinline__ void ph_out(const Params& P, LAS unsigned char* lds) {
    RowColSched S; S.G = gridDim.x; S.c = blockIdx.x; S.nM = M / 256; S.nN = 4; S.A = (const char*)(P.ws + WS_MB); S.B = (const char*)(P.ws + WS_WO); S.ts = (size_t)256 * 1024 * 2;
    EpiOut E; E.mod = (const float*)(P.ws + WS_MOD); E.dl = (bf16_t*)(P.ws + WS_DL);
    gemm_phase<EpiOut, RowColSched, false>(lds, 1024, S, E);
}

__device__ __forceinline__ void ph_router(const Params& P, LAS unsigned char* lds) {
    const int tid = threadIdx.x, lane = tid & 63, wave = tid >> 6;
    LAS float* wt = (LAS float*)lds;
    for (int i = tid; i < 16384; i += 512) { const int k = i >> 4, e = i & 15; wt[e * 1024 + k] = P.w_router[i]; }
    __syncthreads();
    const bf16_t* DL = (const bf16_t*)(P.ws + WS_DL); const float* mod = (const float*)(P.ws + WS_MOD);
    bf16_t* HX2 = (bf16_t*)(P.ws + WS_HX2); float* AFF = (float*)(P.ws + WS_AFF);
    f32x4 nx0[4], nx1[4]; u32x4 nd0[2], nd1[2];
    const int rp0 = blockIdx.x * 8 + wave, rstep = gridDim.x * 8;
#define RT_LOAD(rpv) do { _Pragma("unroll") for (int j = 0; j < 2; ++j) { const size_t o0 = (size_t)((rpv) * 2) * D + 8 * lane + 512 * j; \
        nx0[2 * j] = *(const f32x4*)(P.x + o0); nx0[2 * j + 1] = *(const f32x4*)(P.x + o0 + 4); nx1[2 * j] = *(const f32x4*)(P.x + o0 + D); nx1[2 * j + 1] = *(const f32x4*)(P.x + o0 + D + 4); \
        nd0[j] = *(const u32x4*)(DL + o0); nd1[j] = *(const u32x4*)(DL + o0 + D); } } while (0)
    if (rp0 < M / 2) RT_LOAD(rp0);
    for (int rp = rp0; rp < M / 2; rp += rstep) {
        const int row = rp * 2, b = row >> 11; const float* mv = mod + b * 6144;
        f32x4 v0[4], v1[4]; float s0 = 0.f, s1 = 0.f;
#pragma unroll
        for (int j = 0; j < 2; ++j) { f32x4 a, c; bf8_to_f32(nd0[j], a, c); v0[2 * j] = nx0[2 * j] + a; v0[2 * j + 1] = nx0[2 * j + 1] + c; bf8_to_f32(nd1[j], a, c); v1[2 * j] = nx1[2 * j] + a; v1[2 * j + 1] = nx1[2 * j + 1] + c;
            s0 += sq4(v0[2 * j]) + sq4(v0[2 * j + 1]); s1 += sq4(v1[2 * j]) + sq4(v1[2 * j + 1]); }
        if (rp + rstep < M / 2) RT_LOAD(rp + rstep);
        const float r0 = 1.0f / sqrtf(wave_sum(s0) * (1.f / D) + 1e-6f), r1 = 1.0f / sqrtf(wave_sum(s1) * (1.f / D) + 1e-6f);
#pragma unroll
        for (int j = 0; j < 2; ++j) { const int c0 = 8 * lane + 512 * j;
            const f32x4 g0 = *(const f32x4*)(P.norm2_g + c0) * (*(const f32x4*)(mv + 4096 + c0) + 1.0f), g1 = *(const f32x4*)(P.norm2_g + c0 + 4) * (*(const f32x4*)(mv + 4096 + c0 + 4) + 1.0f);
            const f32x4 sh0 = *(const f32x4*)(mv + 3072 + c0), sh1 = *(const f32x4*)(mv + 3072 + c0 + 4);
            v0[2 * j] = v0[2 * j] * r0 * g0 + sh0; v0[2 * j + 1] = v0[2 * j + 1] * r0 * g1 + sh1; v1[2 * j] = v1[2 * j] * r1 * g0 + sh0; v1[2 * j + 1] = v1[2 * j + 1] * r1 * g1 + sh1;
            *(u32x4*)(HX2 + (size_t)row * D + c0) = f32_to_bf8(v0[2 * j], v0[2 * j + 1]); *(u32x4*)(HX2 + (size_t)(row + 1) * D + c0) = f32_to_bf8(v1[2 * j], v1[2 * j + 1]); }
        float pa[16], pc[16];
#pragma unroll
        for (int e = 0; e < 16; ++e) { float a = 0.f, c = 0.f;
#pragma unroll
            for (int j = 0; j < 4; ++j) { const f32x4 w = *(const LAS f32x4*)(wt + e * 1024 + 8 * lane + 512 * (j >> 1) + 4 * (j & 1));
                a += dot4(v0[j], w); c += dot4(v1[j], w); }
            pa[e] = a; pc[e] = c;
            if ((e & 1) == 1) __builtin_amdgcn_sched_barrier(0); }
#define RT_HALVE(H, DIST) do { const bool up = (lane & (DIST)) != 0; _Pragma("unroll") for (int i = 0; i < (H); ++i) { \
            const float ka = up ? pa[i + (H)] : pa[i], sa = up ? pa[i] : pa[i + (H)], kc = up ? pc[i + (H)] : pc[i], sc = up ? pc[i] : pc[i + (H)]; \
            pa[i] = ka + __shfl_xor(sa, (DIST)); pc[i] = kc + __shfl_xor(sc, (DIST)); } } while (0)
        RT_HALVE(8, 32); RT_HALVE(4, 16); RT_HALVE(2, 8); RT_HALVE(1, 4);
#undef RT_HALVE
        float l0 = pa[0], l1 = pc[0];
        l0 += __shfl_xor(l0, 2); l1 += __shfl_xor(l1, 2); l0 += __shfl_xor(l0, 1); l1 += __shfl_xor(l1, 1);
        float m0 = l0, m1 = l1;
#pragma unroll
        for (int o = 4; o < 64; o <<= 1) { m0 = fmaxf(m0, __shfl_xor(m0, o)); m1 = fmaxf(m1, __shfl_xor(m1, o)); }
        const float e0 = expf(l0 - m0), e1 = expf(l1 - m1);
        float z0 = e0, z1 = e1;
#pragma unroll
        for (int o = 4; o < 64; o <<= 1) { z0 += __shfl_xor(z0, o); z1 += __shfl_xor(z1, o); }
        if ((lane & 3) == 0) { const int ex = ((lane >> 5) & 1) * 8 + ((lane >> 4) & 1) * 4 + ((lane >> 3) & 1) * 2 + ((lane >> 2) & 1); const int t = row & 2047;
            AFF[(size_t)(b * 16 + ex) * T + t] = e0 / z0; AFF[(size_t)(b * 16 + ex) * T + t + 1] = e1 / z1; }
    }
}

__device__ __forceinline__ int block_count4(bool p0, bool p1, bool p2, bool p3, LAS int* red, int par, int wave, int lane) {
    const int c = __builtin_popcountll(__ballot(p0)) + __builtin_popcountll(__ballot(p1)) + __builtin_popcountll(__ballot(p2)) + __builtin_popcountll(__ballot(p3));
    if (lane == 0) red[par * 8 + wave] = c;
    __syncthreads();
    const LAS int* r = red + par * 8;
    return (r[0] + r[1]) + (r[2] + r[3]) + (r[4] + r[5]) + (r[6] + r[7]);
}
__device__ __forceinline__ int block_excl_prefix(int v, LAS int* red, int wave, int lane, int& total) {
    int inc = v;
#pragma unroll
    for (int o = 1; o < 64; o <<= 1) { const int n = __shfl_up(inc, o); if (lane >= o) inc += n; }
    __syncthreads();
    if (lane == 63) red[wave] = inc;
    __syncthreads();
    int base = 0, tot = 0;
#pragma unroll
    for (int w = 0; w < 8; ++w) { const int s = red[w]; if (w < wave) base += s; tot += s; }
    total = tot; return base + inc - v;
}
__device__ __forceinline__ void ph_topk(const Params& P, LAS unsigned char* lds) {
    const int tid = threadIdx.x, lane = tid & 63, wave = tid >> 6;
    LAS int* red = (LAS int*)lds;
    const float* AFF = (const float*)(P.ws + WS_AFF); int* IDX = (int*)(P.ws + WS_IDX); float* GATE = (float*)(P.ws + WS_GATE); int* SEL = (int*)(P.ws + WS_SEL);
    for (int be = blockIdx.x; be < NBF * 16; be += gridDim.x) {
        const int b = be >> 4, e = be & 15;
        const u32x4 kv = *(const u32x4*)(AFF + (size_t)be * T + tid * 4);
        unsigned thr = 0u;
        for (int bit = 31; bit >= 0; --bit) { const unsigned cand = thr | (1u << bit);
            const int cnt = block_count4(kv.x >= cand, kv.y >= cand, kv.z >= cand, kv.w >= cand, red, bit & 1, wave, lane);
            if (cnt >= CAP) thr = cand; }
        const int ngt = block_count4(kv.x > thr, kv.y > thr, kv.z > thr, kv.w > thr, red, 1, wave, lane);
        const int need = CAP - ngt;
        int tot;
        const int e0 = kv.x == thr, e1 = kv.y == thr, e2 = kv.z == thr, e3 = kv.w == thr;
        const int eqb = block_excl_prefix(e0 + e1 + e2 + e3, red + 32, wave, lane, tot);
        const int s0 = (kv.x > thr) || (e0 && eqb < need), s1 = (kv.y > thr) || (e1 && eqb + e0 < need), s2 = (kv.z > thr) || (e2 && eqb + e0 + e1 < need),
                  s3 = (kv.w > thr) || (e3 && eqb + e0 + e1 + e2 < need);
        const int sb = block_excl_prefix(s0 + s1 + s2 + s3, red + 32, wave, lane, tot);
        const int p0 = sb, p1 = sb + s0, p2 = p1 + s1, p3 = p2 + s2;
        const int t0 = 4 * tid;
        if (s0) { IDX[be * CAP + p0] = t0; GATE[be * CAP + p0] = __uint_as_float(kv.x); }
        if (s1) { IDX[be * CAP + p1] = t0 + 1; GATE[be * CAP + p1] = __uint_as_float(kv.y); }
        if (s2) { IDX[be * CAP + p2] = t0 + 2; GATE[be * CAP + p2] = __uint_as_float(kv.z); }
        if (s3) { IDX[be * CAP + p3] = t0 + 3; GATE[be * CAP + p3] = __uint_as_float(kv.w); }
        SEL[(size_t)(b * T + t0) * 16 + e] = s0 ? p0 : -1; SEL[(size_t)(b * T + t0 + 1) * 16 + e] = s1 ? p1 : -1;
        SEL[(size_t)(b * T + t0 + 2) * 16 + e] = s2 ? p2 : -1; SEL[(size_t)(b * T + t0 + 3) * 16 + e] = s3 ? p3 : -1;
        __syncthreads();
    }
}

struct MoeUpSched {
    int G, c; const char *hx2, *wgu; const int* idx;
    __device__ __forceinline__ bool next(int i, Unit& u) const {
        const int Lx = i * G + c; if (Lx >= NBF * 128) return false;
        const int x = Lx & 7, j = Lx >> 3, e = 2 * x + j / (NBF * 8), jj = j % (NBF * 8), rg = jj >> 5, w = jj & 31;
        const int smp = 8 * (rg >> 1) + (w & 7), pn = 4 * (rg & 1) + (w >> 3), be = smp * 16 + e;
        u.pm = be; u.pn = pn; u.kind = 0; u.aux = e; u.a = hx2 + (size_t)smp * ((size_t)T * 1024 * 2); u.rows = idx + be * CAP; u.b = wgu + ((size_t)e * 2048 + pn * 256) * 2048; return true;
    }
};
struct EpiUp {
    bf16_t* hb;
    __device__ __forceinline__ void operator()(const f32x4 (&acc)[2][2][4][2], const Unit& u, int wr, int wc, int fr, int fq) const {
#pragma unroll
        for (int ai = 0; ai < 2; ++ai)
#pragma unroll
            for (int m = 0; m < 4; ++m) { const int r = u.pm * 256 + 128 * ai + 64 * wr + 16 * m + fr;
                f32x4 h[2];
#pragma unroll
                for (int n = 0; n < 2; ++n)
#pragma unroll
                    for (int j = 0; j < 4; ++j) { const float a = acc[ai][0][m][n][j]; h[n][j] = a * __builtin_amdgcn_rcpf(1.f + __expf(-a)) * acc[ai][1][m][n][j]; }
                u32x4 w; w.x = cvt_pk_bf16(h[0].x, h[0].y); w.y = cvt_pk_bf16(h[0].z, h[0].w); w.z = cvt_pk_bf16(h[1].x, h[1].y); w.w = cvt_pk_bf16(h[1].z, h[1].w);
                *(u32x4*)(hb + (size_t)r * 1024 + u.pn * 128 + 32 * wc + 8 * fq) = w; }
    }
};
__device__ __forceinline__ void ph_moe_up(const Params& P, LAS unsigned char* lds) {
    MoeUpSched S; S.G = gridDim.x; S.c = blockIdx.x; S.hx2 = (const char*)(P.ws + WS_HX2); S.idx = (const int*)(P.ws + WS_IDX); S.wgu = (const char*)(P.ws + WS_WGU);
    EpiUp E; E.hb = (bf16_t*)(P.ob + OB_HB);
    gemm_phase<EpiUp, MoeUpSched, false, true>(lds, 1024, S, E);
}
struct MoeDownSched {
    int G, c; const char *hb, *wd;
    __device__ __forceinline__ bool next(int i, Unit& u) const {
        const int Lx = i * G + c; if (Lx >= NBF * 64) return false;
        const int x = Lx & 7, j = Lx >> 3, e = 2 * x + j / (NBF * 4), jj = j % (NBF * 4), rg = jj >> 5, w = jj & 31;
        const int smp = 8 * rg + (w & 7), pn = w >> 3, be = smp * 16 + e;
        u.pm = be; u.pn = pn; u.kind = 0; u.aux = e; u.rows = nullptr; u.a = hb + (size_t)be * (256 * 1024 * 2); u.b = wd + ((size_t)e * 1024 + pn * 256) * 2048; return true;
    }
};
struct EpiDown {
    const float* gate; bf16_t* ye;
    __device__ __forceinline__ void operator()(const f32x4 (&acc)[2][2][4][2], const Unit& u, int wr, int wc, int fr, int fq) const {
#pragma unroll
        for (int ai = 0; ai < 2; ++ai)
#pragma unroll
            for (int m = 0; m < 4; ++m) { const int r = u.pm * 256 + 128 * ai + 64 * wr + 16 * m + fr; const float gt = gate[r];
#pragma unroll
                for (int bj = 0; bj < 2; ++bj) { const f32x4 v0 = acc[ai][bj][m][0] * gt, v1 = acc[ai][bj][m][1] * gt;
                    u32x4 w; w.x = cvt_pk_bf16(v0.x, v0.y); w.y = cvt_pk_bf16(v0.z, v0.w); w.z = cvt_pk_bf16(v1.x, v1.y); w.w = cvt_pk_bf16(v1.z, v1.w);
                    *(u32x4*)(ye + (size_t)r * 1024 + u.pn * 256 + 128 * bj + 32 * wc + 8 * fq) = w; } }
    }
};
__device__ __forceinline__ void ph_moe_down(const Params& P, LAS unsigned char* lds) {
    MoeDownSched S; S.G = gridDim.x; S.c = blockIdx.x; S.hb = (const char*)(P.ob + OB_HB); S.wd = (const char*)(P.ws + WS_WD);
    EpiDown E; E.gate = (const float*)(P.ws + WS_GATE); E.ye = (bf16_t*)(P.ws + WS_YE);
    gemm_phase<EpiDown, MoeDownSched, false>(lds, 1024, S, E);
}

__device__ __forceinline__ void ph_final(const Params& P) {
    const int lane = threadIdx.x & 63, wave = threadIdx.x >> 6;
    const bf16_t* DL = (const bf16_t*)(P.ws + WS_DL); const float* mod = (const float*)(P.ws + WS_MOD); const int* SEL = (const int*)(P.ws + WS_SEL); const bf16_t* YE = (const bf16_t*)(P.ws + WS_YE);
    constexpr int NR = 2;
#ifdef FK_TS
    float ts_eps; { const unsigned long long* tsp = (const unsigned long long*)(P.ws + WS_CTL) + 1800;
        const unsigned long long t0 = __hip_atomic_load(tsp + FK_TS, __ATOMIC_RELAXED, __HIP_MEMORY_SCOPE_AGENT); unsigned long long t1 = 0ull;
        for (int sp = 0; sp < 100000 && (t1 = __hip_atomic_load(tsp + FK_TS2, __ATOMIC_RELAXED, __HIP_MEMORY_SCOPE_AGENT)) == 0ull; ++sp) __builtin_amdgcn_s_sleep(2);
        ts_eps = (float)(t1 - t0) * FK_TS_SCALE; }
#endif
    for (int row0 = (blockIdx.x * 8 + wave) * NR; row0 < M; row0 += gridDim.x * 8 * NR) {
        const int b = row0 >> 11;
        int sv[NR]; f32x4 xv[NR][4]; u32x4 dv[NR][2];
#pragma unroll
        for (int r = 0; r < NR; ++r) { sv[r] = SEL[(size_t)(row0 + r) * 16 + (lane & 15)];
#pragma unroll
            for (int j = 0; j < 2; ++j) { const size_t o = (size_t)(row0 + r) * D + 8 * lane + 512 * j; xv[r][2 * j] = *(const f32x4*)(P.x + o); xv[r][2 * j + 1] = *(const f32x4*)(P.x + o + 4); dv[r][j] = *(const u32x4*)(DL + o); } }
        f32x4 mo[NR][4];
#pragma unroll
        for (int r = 0; r < NR; ++r)
#pragma unroll
            for (int j = 0; j < 4; ++j) mo[r][j] = (f32x4){0.f, 0.f, 0.f, 0.f};
#pragma unroll
        for (int e = 0; e < 16; ++e) {
#pragma unroll
            for (int r = 0; r < NR; ++r) { const int sl = __builtin_amdgcn_readlane(sv[r], e);
                if (sl >= 0) { const bf16_t* yr = YE + ((size_t)(b * 16 + e) * CAP + sl) * D + 8 * lane;
#pragma unroll
                    for (int j = 0; j < 2; ++j) { f32x4 a, c; bf8_to_f32(*(const u32x4*)(yr + 512 * j), a, c); mo[r][2 * j] += a; mo[r][2 * j + 1] += c; } } } }
#pragma unroll
        for (int r = 0; r < NR; ++r) { float ss = 0.f; f32x4 v[4];
#pragma unroll
            for (int j = 0; j < 2; ++j) { const int c0 = 8 * lane + 512 * j; f32x4 a, c; bf8_to_f32(dv[r][j], a, c);
                v[2 * j] = xv[r][2 * j] + a + *(const f32x4*)(mod + b * 6144 + 5120 + c0) * mo[r][2 * j]; v[2 * j + 1] = xv[r][2 * j + 1] + c + *(const f32x4*)(mod + b * 6144 + 5120 + c0 + 4) * mo[r][2 * j + 1];
                ss += sq4(v[2 * j]) + sq4(v[2 * j + 1]); }
            const float rs = 1.0f / sqrtf(wave_sum(ss) * (1.f / D) + 1e-6f);
#pragma unroll
            for (int j = 0; j < 2; ++j) { const int c0 = 8 * lane + 512 * j;
#ifdef FK_TS
                { const f32x4 tsa = {1.f + ts_eps, 1.f - ts_eps, 1.f + ts_eps, 1.f - ts_eps};
                  *(f32x4*)(P.out + (size_t)(row0 + r) * D + c0) = v[2 * j] * rs * *(const f32x4*)(P.fg + c0) * tsa; *(f32x4*)(P.out + (size_t)(row0 + r) * D + c0 + 4) = v[2 * j + 1] * rs * *(const f32x4*)(P.fg + c0 + 4) * tsa; } } }
#else
                *(f32x4*)(P.out + (size_t)(row0 + r) * D + c0) = v[2 * j] * rs * *(const f32x4*)(P.fg + c0); *(f32x4*)(P.out + (size_t)(row0 + r) * D + c0 + 4) = v[2 * j + 1] * rs * *(const f32x4*)(P.fg + c0 + 4); } }
#endif
    }
}

#define XB_TMO      128
#define XB_XCNT(j)  (256  + 64 * (j))
#define XB_XSUB(j)  (1280 + 64 * (j))
#define XB_XGEN(j)  (2304 + 64 * (j))
#define XB_TOP      3328
#define XB_TOPGEN   3392
#define XCD_BAR_WORDS 3456
#define XB_SPIN_CAP (1u << 20)
__device__ __forceinline__ unsigned xb_ld(unsigned* p)              { return __hip_atomic_load(p, __ATOMIC_RELAXED, __HIP_MEMORY_SCOPE_AGENT); }
__device__ __forceinline__ unsigned xb_add(unsigned* p, unsigned v) { return __hip_atomic_fetch_add(p, v, __ATOMIC_RELAXED, __HIP_MEMORY_SCOPE_AGENT); }
__device__ __forceinline__ unsigned xb_xcc_id() { return (unsigned)__builtin_amdgcn_s_getreg((3 << 11) | 20) & 0xFu; }
#define XB_SPIN(cond, bar) do { unsigned _sp = 0; while (cond) { __builtin_amdgcn_s_sleep(1); \
    if ((++_sp & 255u) == 0u) { if (xb_ld(&(bar)[XB_TMO])) break; if (_sp > XB_SPIN_CAP) { atomicAdd(&(bar)[XB_TMO], 1u); break; } } } } while (0)
struct XcdBarrier { unsigned* bar; unsigned x; volatile LAS unsigned* st; };
__device__ __forceinline__ XcdBarrier xcd_barrier_post(unsigned* bar, volatile LAS unsigned* st) {
    XcdBarrier b; b.bar = bar; b.x = xb_xcc_id(); b.st = st;
    if (threadIdx.x == 0) (void)xb_add(&bar[XB_XCNT(b.x)], 1u);
    return b;
}
__device__ __forceinline__ void xcd_barrier_complete(unsigned* bar, unsigned x, unsigned& nloc, unsigned& nx) {
    const unsigned G = gridDim.x * gridDim.y * gridDim.z;
    unsigned sum, cnt, mine, sp = 0u;
    for (;;) {
        sum = 0u; cnt = 0u; mine = 0u;
#pragma unroll
        for (unsigned j = 0; j < 16; ++j) { const unsigned c = xb_ld(&bar[XB_XCNT(j)]); sum += c; cnt += (c > 0u) ? 1u : 0u; mine = (j == x) ? c : mine; }
        if (sum == G) break;
        __builtin_amdgcn_s_sleep(1);
        if ((++sp & 255u) == 0u) { if (xb_ld(&bar[XB_TMO])) break; if (sp > XB_SPIN_CAP) { atomicAdd(&bar[XB_TMO], 1u); break; } }
    }
    nloc = mine > 0u ? mine : 1u; nx = cnt > 0u ? cnt : 1u;
}
__device__ __forceinline__ void xcd_barrier(const XcdBarrier& b) {
    asm volatile("s_waitcnt vmcnt(0)" ::: "memory");
    __syncthreads();
    if (threadIdx.x == 0) {
        unsigned* bar = b.bar;
        __builtin_amdgcn_s_waitcnt(0);
        unsigned nloc = b.st[0], nx = b.st[1];
        if (nloc == 0u) { xcd_barrier_complete(bar, b.x, nloc, nx); b.st[0] = nloc; b.st[1] = nx; }
        const unsigned old = xb_add(&bar[XB_XSUB(b.x)], 1u);
        const unsigned gen = old / nloc;
        if (old + 1u == (gen + 1u) * nloc) {
            __builtin_amdgcn_fence(__ATOMIC_RELEASE, "agent");
            asm volatile("s_waitcnt vmcnt(0)" ::: "memory");
            const unsigned og = xb_add(&bar[XB_TOP], 1u);
            const unsigned tg = og / nx;
            if (og + 1u == (tg + 1u) * nx) xb_add(&bar[XB_TOPGEN], 1u);
            else XB_SPIN(xb_ld(&bar[XB_TOPGEN]) == tg, bar);
            __builtin_amdgcn_fence(__ATOMIC_ACQUIRE, "agent");
            xb_add(&bar[XB_XGEN(b.x)], 1u);
            asm volatile("s_waitcnt vmcnt(0)" ::: "memory");
        } else {
            XB_SPIN(xb_ld(&bar[XB_XGEN(b.x)]) == gen, bar);
            __builtin_amdgcn_fence(__ATOMIC_ACQUIRE, "agent");
            asm volatile("s_waitcnt vmcnt(0)" ::: "memory");
        }
    }
    __syncthreads();
}


#ifdef FK_COPYPROBE
#ifndef FK_COPYMODE
#define FK_COPYMODE 0
#endif
__device__ __forceinline__ void ph_copyprobe(const Params& P) {
    const int lane = threadIdx.x & 63, wave = threadIdx.x >> 6;
    const u32x4* src = (const u32x4*)P.wg; u32x4* dst = (u32x4*)(P.ws + WS_AO);
    const size_t nchunk = (size_t)16 * 1024 * 1024 * 4 / 4096;
    constexpr int CH = FK_COPYMODE == 1 ? 12 : 4;
    constexpr int NJ = (FK_COPYMODE == 2 || FK_COPYMODE == 3) ? 1 : 4;
    constexpr int CSTR = FK_COPYMODE == 3 ? 4 : 1;
#if FK_COPYMODE == 7
    return;
#endif
#if FK_COPYMODE == 5 || FK_COPYMODE == 6
    u32x4 acc4 = {0u, 0u, 0u, 0u};
    for (size_t c0 = (size_t)(blockIdx.x * 8 + wave) * CH; c0 < nchunk; c0 += (size_t)gridDim.x * 8 * CH) {
#pragma unroll
        for (int r = 0; r < CH; ++r)
#pragma unroll
            for (int j = 0; j < NJ; ++j) { const size_t c = c0 + r < nchunk ? c0 + r : nchunk - 1;
                if (FK_COPYMODE == 5) { const u32x4 t = src[c * 256 + lane + 64 * j]; acc4.x ^= t.x; acc4.y ^= t.y; acc4.z ^= t.z; acc4.w ^= t.w; }
                else dst[c * 256 + lane + 64 * j] = (u32x4){(unsigned)c, 1u, 2u, 3u}; }
    }
    if (FK_COPYMODE == 5) dst[(size_t)(blockIdx.x * 8 + wave) * 64 + lane] = acc4;
    return;
#endif
#if FK_COPYMODE == 4
    const size_t per = nchunk / ((size_t)gridDim.x * 8), cbeg = (size_t)(blockIdx.x * 8 + wave) * per;
    for (size_t c0 = cbeg; c0 < cbeg + per; c0 += CH) {
#else
    for (size_t c0 = (size_t)(blockIdx.x * 8 + wave) * CH; c0 < nchunk; c0 += (size_t)gridDim.x * 8 * CH) {
#endif
        u32x4 v[CH][NJ];
#pragma unroll
        for (int r = 0; r < CH; ++r)
#pragma unroll
            for (int j = 0; j < NJ; ++j) { const size_t c = c0 + r < nchunk ? c0 + r : nchunk - 1; v[r][j] = src[(c / CSTR * CSTR) * 256 + lane + 64 * j]; }
#pragma unroll
        for (int r = 0; r < CH; ++r)
#pragma unroll
            for (int j = 0; j < NJ; ++j) { const size_t c = c0 + r < nchunk ? c0 + r : nchunk - 1; dst[(c / CSTR * CSTR) * 256 + lane + 64 * j] = v[r][j]; }
    }
}
#endif
constexpr int NPHASE = 11;
constexpr size_t CTL_ZERO_BYTES = 16384;
#ifndef FK_MASK
#define FK_MASK 0x7ff
#endif
#ifndef FK_CGSYNC
#define FK_CGSYNC 0
#endif
__global__ void __launch_bounds__(512, 2) mega(Params P) {
    extern __shared__ __attribute__((aligned(16))) unsigned char lds_raw[];
    LAS unsigned char* lds = (LAS unsigned char*)lds_raw;
    cg::grid_group grid = cg::this_grid();
    volatile LAS unsigned* misc = (volatile LAS unsigned*)(lds + LDS_MISC);
    if (threadIdx.x < 2) misc[threadIdx.x] = 0u;
    __syncthreads();
    const XcdBarrier bar = xcd_barrier_post((unsigned*)(P.ws + WS_CTL), misc);
    const int lo = P.ph_lo, hi = P.ph_hi;
    if (lo < 0) grid.sync();
#define FK_SYNC(k) do { if ((k) < FK_CGSYNC) grid.sync(); else xcd_barrier(bar); } while (0)
    typedef const __attribute__((address_space(4))) Params* KArgPtr;
#if defined(__HIP_DEVICE_COMPILE__)
#define FK_ARGS(name) KArgPtr kp_##name = (KArgPtr)__builtin_amdgcn_kernarg_segment_ptr(); asm volatile("" : "+s"(kp_##name)); const Params name = *(const Params*)kp_##name
#else
#define FK_ARGS(name) const Params name = P
#endif
#define FK_PH(k, call) if (((FK_MASK >> (k)) & 1) && lo <= (k) && (k) < hi) { { FK_ARGS(L); call; } if ((FK_DBL >> (k)) & 1) { FK_SYNC(k); { FK_ARGS(L); call; } } if ((k) + 1 < hi) { FK_SYNC(k); FK_STAMP((k) + 1); } }
    FK_STAMP(0);
    FK_PH(0, ph_prep(L, lds))
#ifdef FK_COPYPROBE
    for (int rep = 0; rep < FK_COPYPROBE; ++rep) { { FK_ARGS(L); ph_copyprobe(L); } xcd_barrier(bar); }
#endif
    FK_PH(1, ph_norm1(L, lds))
    FK_PH(2, ph_inproj(L, lds))
    FK_PH(3, ph_mix(L, lds))
    FK_PH(4, ph_proj(L, lds))
    FK_PH(5, ph_out(L, lds))
    FK_PH(6, ph_router(L, lds))
    FK_PH(7, ph_topk(L, lds))
    FK_PH(8, ph_moe_up(L, lds))
    FK_PH(9, ph_moe_down(L, lds))
    FK_PH(10, ph_final(L))
#undef FK_ARGS
#undef FK_PH
#undef FK_SYNC
}
}
static void fk_launch(fk::Params p, int lo, int hi, hipStream_t stream);
#if HYB >= 0
#include <hip/hip_runtime.h>

namespace nv {
constexpr int D = 1024, T = 2048, L = 256, NB = 16, INW = 6656, NE = 16, CAP = 256;

__global__ void k_mod(const float* __restrict__ c, const float* __restrict__ c_ctx, const float* __restrict__ w_mod,
                      const float* __restrict__ b_mod, float* __restrict__ mod) {
    const int n = blockIdx.x * 256 + threadIdx.x, r = blockIdx.y;
    const float* cv = r < 16 ? c + r * 1024 : c_ctx;
    float acc = 0.f;
    for (int k = 0; k < 1024; ++k) { const float v = cv[k]; const float s = v / (1.f + expf(-v)); acc += s * w_mod[(size_t)k * 6144 + n]; }
    mod[r * 6144 + n] = acc + b_mod[n];
}

__device__ __forceinline__ float block_sum256(float v, float* red) {
#pragma unroll
    for (int o = 32; o > 0; o >>= 1) v += __shfl_xor(v, o);
    __syncthreads();
    if ((threadIdx.x & 63) == 0) red[threadIdx.x >> 6] = v;
    __syncthreads();
    return red[0] + red[1] + red[2] + red[3];
}

__global__ void k_norm_mod(const float* __restrict__ x, const float* __restrict__ g, const float* __restrict__ shift,
                           const float* __restrict__ scale, float* __restrict__ out) {
    __shared__ float red[4];
    const int row = blockIdx.x, t = threadIdx.x;
    const float* xr = x + (size_t)row * D;
    float v[4]; float ss = 0.f;
#pragma unroll
    for (int j = 0; j < 4; ++j) { v[j] = xr[t + 256 * j]; ss += v[j] * v[j]; }
    const float tot = block_sum256(ss, red);
    const float rs = 1.0f / sqrtf(tot * (1.f / D) + 1e-6f);
#pragma unroll
    for (int j = 0; j < 4; ++j) { const int cidx = t + 256 * j; out[(size_t)row * D + cidx] = v[j] * rs * g[cidx] * (1.f + scale[cidx]) + shift[cidx]; }
}

__global__ __launch_bounds__(256) void k_sgemm(const float* __restrict__ A, int lda, const int* __restrict__ rows, long sA, long sRows,
                                               const float* __restrict__ B, int ldb, long sB, float* __restrict__ C, int ldc, long sC, int K) {
    __shared__ float As[16][65];
    __shared__ float Bs[16][64];
    const int z = blockIdx.z;
    A += (size_t)z * sA; B += (size_t)z * sB; C += (size_t)z * sC; if (rows) rows += (size_t)z * sRows;
    const int tx = threadIdx.x & 15, ty = threadIdx.x >> 4;
    const int m0 = blockIdx.y * 64, n0 = blockIdx.x * 64;
    float acc[4][4];
#pragma unroll
    for (int i = 0; i < 4; ++i)
#pragma unroll
        for (int j = 0; j < 4; ++j) acc[i][j] = 0.f;
    for (int k0 = 0; k0 < K; k0 += 16) {
#pragma unroll
        for (int ii = 0; ii < 4; ++ii) { const int i = threadIdx.x + 256 * ii; const int r = i >> 4, kk = i & 15; const int row = m0 + r; const int src = rows ? rows[row] : row;
            As[kk][r] = A[(size_t)src * lda + k0 + kk]; }
#pragma unroll
        for (int ii = 0; ii < 4; ++ii) { const int i = threadIdx.x + 256 * ii; const int kk = i >> 6, cc = i & 63; Bs[kk][cc] = B[(size_t)(k0 + kk) * ldb + n0 + cc]; }
        __syncthreads();
#pragma unroll
        for (int kk = 0; kk < 16; ++kk) {
            float a[4], b[4];
#pragma unroll
            for (int i = 0; i < 4; ++i) a[i] = As[kk][ty * 4 + i];
#pragma unroll
            for (int j = 0; j < 4; ++j) b[j] = Bs[kk][tx * 4 + j];
#pragma unroll
            for (int i = 0; i < 4; ++i)
#pragma unroll
                for (int j = 0; j < 4; ++j) acc[i][j] += a[i] * b[j];
        }
        __syncthreads();
    }
#pragma unroll
    for (int i = 0; i < 4; ++i)
#pragma unroll
        for (int j = 0; j < 4; ++j) C[(size_t)(m0 + ty * 4 + i) * ldc + n0 + tx * 4 + j] = acc[i][j];
}

__global__ void k_rope(float* __restrict__ P) {
    const int gid = blockIdx.x * 256 + threadIdx.x;
    const int pr = gid & 31, hs = (gid >> 5) % 20, t = gid / (32 * 20);
    if (t >= T) return;
    const int half = pr >> 4, i = pr & 15;
    const float pos = half == 0 ? (float)(t / 64) : (float)(t % 64);
    const float inv_freq = powf(10000.f, -(float)i / 16.f);
    const float ang = pos * inv_freq;
    const float cs = cosf(ang), sn = sinf(ang);
    float* p = P + (size_t)t * INW + hs * 64 + half * 32 + i;
    const float x1 = p[0], x2 = p[16];
    p[0] = x1 * cs - x2 * sn;
    p[16] = x2 * cs + x1 * sn;
}

__global__ __launch_bounds__(64) void k_attn(const float* __restrict__ P, const float* __restrict__ kvc, const float* __restrict__ sink, float* __restrict__ o) {
    __shared__ float qs[64];
    __shared__ float sc[257 + 256];
    const int t = blockIdx.x, h = blockIdx.y, hkv = h >> 2, d = threadIdx.x;
    qs[d] = P[(size_t)t * INW + h * 64 + d];
    __syncthreads();
    const int lo = t - 128 < 0 ? 0 : t - 128, hi = t + 128 > T - 1 ? T - 1 : t + 128, nw = hi - lo + 1, ntot = nw + L;
    for (int j = d; j < ntot; j += 64) {
        const float* kp = j < nw ? P + (size_t)(lo + j) * INW + 1024 + hkv * 64 : kvc + (size_t)(j - nw) * 512 + hkv * 64;
        float s = 0.f;
        for (int dd = 0; dd < 64; ++dd) s += qs[dd] * kp[dd];
        sc[j] = s * 0.125f;
    }
    __syncthreads();
    const float sk = sink[h];
    float m = sk;
    for (int j = d; j < ntot; j += 64) m = fmaxf(m, sc[j]);
#pragma unroll
    for (int off = 32; off > 0; off >>= 1) m = fmaxf(m, __shfl_xor(m, off));
    float l = 0.f;
    for (int j = d; j < ntot; j += 64) { const float p = expf(sc[j] - m); sc[j] = p; l += p; }
#pragma unroll
    for (int off = 32; off > 0; off >>= 1) l += __shfl_xor(l, off);
    l += expf(sk - m);
    __syncthreads();
    float acc = 0.f;
    for (int j = 0; j < ntot; ++j) {
        const float* vp = j < nw ? P + (size_t)(lo + j) * INW + 1280 + hkv * 64 : kvc + (size_t)(j - nw) * 512 + 256 + hkv * 64;
        acc += sc[j] * vp[d];
    }
    o[(size_t)t * D + h * 64 + d] = acc / l;
}

__global__ void k_conv(const float* __restrict__ P, const float* __restrict__ cw, float* __restrict__ y) {
    const int gid = blockIdx.x * 256 + threadIdx.x; const int ch = gid & 1023, t = gid >> 10;
    const float* pr = P + (size_t)t * INW;
    const float z1 = pr[3584 + ch] * pr[1536 + ch];
    const float z0 = t > 0 ? pr[3584 + ch - INW] * pr[1536 + ch - INW] : 0.f;
    const float z2 = t < T - 1 ? pr[3584 + ch + INW] * pr[1536 + ch + INW] : 0.f;
    y[gid] = pr[2560 + ch] * (cw[ch] * z0 + cw[1024 + ch] * z1 + cw[2048 + ch] * z2);
}

__global__ void k_merge(const float* __restrict__ P, float* __restrict__ a, const float* __restrict__ s) {
    const int gid = blockIdx.x * 256 + threadIdx.x; const int ch = gid & 1023, t = gid >> 10;
    const float ga = P[(size_t)t * INW + 4608 + ch], gc = P[(size_t)t * INW + 5632 + ch];
    a[gid] = a[gid] / (1.f + expf(-ga)) + s[gid] / (1.f + expf(-gc));
}

__global__ void k_resid(const float* __restrict__ x, const float* __restrict__ g, const float* __restrict__ o, float* __restrict__ x1) {
    const int gid = blockIdx.x * 256 + threadIdx.x; const int ch = gid & 1023;
    x1[gid] = x[gid] + g[ch] * o[gid];
}

__global__ void k_router(const float* __restrict__ x1, const float* __restrict__ g, const float* __restrict__ shift, const float* __restrict__ scale,
                         const float* __restrict__ w_router, float* __restrict__ hx2, float* __restrict__ aff) {
    __shared__ float red[4];
    __shared__ float lg[16];
    const int row = blockIdx.x, t = threadIdx.x;
    const float* xr = x1 + (size_t)row * D;
    float v[4]; float ss = 0.f;
#pragma unroll
    for (int j = 0; j < 4; ++j) { v[j] = xr[t + 256 * j]; ss += v[j] * v[j]; }
    const float tot = block_sum256(ss, red);
    const float rs = 1.0f / sqrtf(tot * (1.f / D) + 1e-6f);
#pragma unroll
    for (int j = 0; j < 4; ++j) { const int cidx = t + 256 * j; v[j] = v[j] * rs * g[cidx] * (1.f + scale[cidx]) + shift[cidx]; hx2[(size_t)row * D + cidx] = v[j]; }
    for (int e = 0; e < 16; ++e) {
        float p = 0.f;
#pragma unroll
        for (int j = 0; j < 4; ++j) p += v[j] * w_router[(size_t)(t + 256 * j) * 16 + e];
        const float s = block_sum256(p, red);
        if (t == 0) lg[e] = s;
    }
    __syncthreads();
    if (t < 16) {
        float m = lg[0];
        for (int e = 1; e < 16; ++e) m = fmaxf(m, lg[e]);
        float sum = 0.f;
        for (int e = 0; e < 16; ++e) sum += expf(lg[e] - m);
        aff[(size_t)t * T + row] = expf(lg[t] - m) / sum;
    }
}

__global__ void k_topk(const float* __restrict__ aff, int* __restrict__ idx, float* __restrict__ gate, int* __restrict__ sel) {
    __shared__ float a[T];
    const int e = blockIdx.x;
    for (int i = threadIdx.x; i < T; i += 256) a[i] = aff[(size_t)e * T + i];
    __syncthreads();
    for (int i = threadIdx.x; i < T; i += 256) {
        const float v = a[i]; int rank = 0;
        for (int j = 0; j < T; ++j) { const float w = a[j]; rank += (w > v || (w == v && j < i)) ? 1 : 0; }
        if (rank < CAP) { idx[e * CAP + rank] = i; gate[e * CAP + rank] = v; sel[i * 16 + e] = rank; }
        else sel[i * 16 + e] = -1;
    }
}

__global__ void k_silu_mul(float* __restrict__ a, const float* __restrict__ u) {
    const size_t gid = (size_t)blockIdx.x * 256 + threadIdx.x;
    const float v = a[gid];
    a[gid] = v / (1.f + expf(-v)) * u[gid];
}

__global__ void k_combine(const float* __restrict__ x1, const float* __restrict__ g2, const float* __restrict__ ye, const float* __restrict__ gate,
                          const int* __restrict__ sel, const float* __restrict__ fg, float* __restrict__ out) {
    __shared__ float red[4];
    const int row = blockIdx.x, t = threadIdx.x;
    float m[4] = {0.f, 0.f, 0.f, 0.f};
    for (int e = 0; e < 16; ++e) {
        const int s = sel[row * 16 + e];
        if (s >= 0) { const float gt = gate[e * CAP + s]; const float* yr = ye + ((size_t)e * CAP + s) * D;
#pragma unroll
            for (int j = 0; j < 4; ++j) m[j] += gt * yr[t + 256 * j]; }
    }
    float v[4]; float ss = 0.f;
#pragma unroll
    for (int j = 0; j < 4; ++j) { const int cidx = t + 256 * j; v[j] = x1[(size_t)row * D + cidx] + g2[cidx] * m[j]; ss += v[j] * v[j]; }
    const float tot = block_sum256(ss, red);
    const float rs = 1.0f / sqrtf(tot * (1.f / D) + 1e-6f);
#pragma unroll
    for (int j = 0; j < 4; ++j) { const int cidx = t + 256 * j; out[(size_t)row * D + cidx] = v[j] * rs * fg[cidx]; }
}

struct Inputs {
    const float *x, *c, *ctx, *c_ctx, *w_mod, *b_mod, *norm1_g, *w_in, *sink, *conv_w, *wpa, *wpc, *wo, *norm2_g, *w_router, *wg, *wu, *wd, *fg;
};
struct Scratch {
    float *mod, *hx, *hc, *P, *kvc, *oat, *yc, *a, *s, *o1, *x1, *hx2, *aff, *gate, *ea, *eu, *ye; int *idx, *sel;
};
inline size_t carve(Scratch& S, char* base) {
    size_t off = 0;
    auto take = [&](size_t bytes) { char* p = base + off; off += (bytes + 255) & ~(size_t)255; return p; };
    S.mod = (float*)take(17 * 6144 * 4);
    S.hx = (float*)take((size_t)T * D * 4); S.hc = (float*)take((size_t)L * D * 4);
    S.P = (float*)take((size_t)T * INW * 4); S.kvc = (float*)take((size_t)L * 512 * 4);
    S.oat = (float*)take((size_t)T * D * 4); S.yc = (float*)take((size_t)T * D * 4);
    S.a = (float*)take((size_t)T * D * 4); S.s = (float*)take((size_t)T * D * 4); S.o1 = (float*)take((size_t)T * D * 4);
    S.x1 = (float*)take((size_t)T * D * 4); S.hx2 = (float*)take((size_t)T * D * 4);
    S.aff = (float*)take((size_t)NE * T * 4); S.gate = (float*)take(NE * CAP * 4); S.idx = (int*)take(NE * CAP * 4); S.sel = (int*)take((size_t)T * 16 * 4);
    S.ea = S.P; S.eu = S.P + (size_t)NE * CAP * D; S.ye = S.P + (size_t)2 * NE * CAP * D;
    return off;
}

inline void run_mod(const Inputs& I, const Scratch& S, hipStream_t st) { k_mod<<<dim3(24, 17), 256, 0, st>>>(I.c, I.c_ctx, I.w_mod, I.b_mod, S.mod); }
inline void s1a_norm(const Inputs& I, const Scratch& S, int b, hipStream_t st) {
    const float* mb = S.mod + b * 6144; const float* mc = S.mod + 16 * 6144;
    k_norm_mod<<<T, 256, 0, st>>>(I.x + (size_t)b * T * D, I.norm1_g, mb, mb + 1024, S.hx);
    k_norm_mod<<<L, 256, 0, st>>>(I.ctx + (size_t)b * L * D, I.norm1_g, mc, mc + 1024, S.hc);
}
inline void s1b_gemm(const Inputs& I, const Scratch& S, int b, hipStream_t st) {
    k_sgemm<<<dim3(INW / 64, T / 64, 1), 256, 0, st>>>(S.hx, D, nullptr, 0, 0, I.w_in, INW, 0, S.P, INW, 0, D);
    k_sgemm<<<dim3(512 / 64, L / 64, 1), 256, 0, st>>>(S.hc, D, nullptr, 0, 0, I.w_in + 1024, INW, 0, S.kvc, 512, 0, D);
    k_rope<<<T * 20 * 32 / 256, 256, 0, st>>>(S.P);
}
inline void s2_mix(const Inputs& I, const Scratch& S, int b, hipStream_t st) {
    k_attn<<<dim3(T, 16), 64, 0, st>>>(S.P, S.kvc, I.sink, S.oat);
    k_conv<<<T * D / 256, 256, 0, st>>>(S.P, I.conv_w, S.yc);
}
inline void s3_merge(const Inputs& I, const Scratch& S, int b, hipStream_t st) {
    k_sgemm<<<dim3(D / 64, T / 64, 1), 256, 0, st>>>(S.oat, D, nullptr, 0, 0, I.wpa, D, 0, S.a, D, 0, D);
    k_sgemm<<<dim3(D / 64, T / 64, 1), 256, 0, st>>>(S.yc, D, nullptr, 0, 0, I.wpc, D, 0, S.s, D, 0, D);
    k_merge<<<T * D / 256, 256, 0, st>>>(S.P, S.a, S.s);
}
inline void s4_out(const Inputs& I, const Scratch& S, int b, hipStream_t st) {
    k_sgemm<<<dim3(D / 64, T / 64, 1), 256, 0, st>>>(S.a, D, nullptr, 0, 0, I.wo, D, 0, S.o1, D, 0, D);
    k_resid<<<T * D / 256, 256, 0, st>>>(I.x + (size_t)b * T * D, S.mod + b * 6144 + 2048, S.o1, S.x1);
}
inline void s5_router(const Inputs& I, const Scratch& S, int b, hipStream_t st) {
    const float* mb = S.mod + b * 6144;
    k_router<<<T, 256, 0, st>>>(S.x1, I.norm2_g, mb + 3072, mb + 4096, I.w_router, S.hx2, S.aff);
}
inline void s6_topk(const Inputs& I, const Scratch& S, int b, hipStream_t st) { k_topk<<<NE, 256, 0, st>>>(S.aff, S.idx, S.gate, S.sel); }
inline void s7_up(const Inputs& I, const Scratch& S, int b, hipStream_t st) {
    k_sgemm<<<dim3(D / 64, CAP / 64, NE), 256, 0, st>>>(S.hx2, D, S.idx, 0, CAP, I.wg, D, (long)D * D, S.ea, D, (long)CAP * D, D);
    k_sgemm<<<dim3(D / 64, CAP / 64, NE), 256, 0, st>>>(S.hx2, D, S.idx, 0, CAP, I.wu, D, (long)D * D, S.eu, D, (long)CAP * D, D);
    k_silu_mul<<<NE * CAP * D / 256, 256, 0, st>>>(S.ea, S.eu);
}
inline void s8_down(const Inputs& I, const Scratch& S, int b, hipStream_t st) {
    k_sgemm<<<dim3(D / 64, CAP / 64, NE), 256, 0, st>>>(S.ea, D, nullptr, (long)CAP * D, 0, I.wd, D, (long)D * D, S.ye, D, (long)CAP * D, D);
}
inline void s9_final(const Inputs& I, const Scratch& S, int b, float* out, hipStream_t st) {
    k_combine<<<T, 256, 0, st>>>(S.x1, S.mod + b * 6144 + 5120, S.ye, S.gate, S.sel, I.fg, out + (size_t)b * T * D);
}
}
namespace hyb {
using fk::bf16_t;
__device__ __forceinline__ float bf2f(bf16_t v) { return __uint_as_float((unsigned)v << 16); }
__global__ void k_cv_bf16(const bf16_t* __restrict__ src, size_t spitch, float* __restrict__ dst, int cols, size_t n) {
    const size_t gid = (size_t)blockIdx.x * 256 + threadIdx.x; if (gid >= n) return;
    const size_t r = gid / cols; const int c = (int)(gid % cols);
    dst[gid] = bf2f(src[r * spitch + c]);
}
__global__ void k_copy_f32(const float* __restrict__ src, float* __restrict__ dst, size_t n) { const size_t gid = (size_t)blockIdx.x * 256 + threadIdx.x; if (gid < n) dst[gid] = src[gid]; }
__global__ void k_copy_i32(const int* __restrict__ src, int* __restrict__ dst, size_t n) { const size_t gid = (size_t)blockIdx.x * 256 + threadIdx.x; if (gid < n) dst[gid] = src[gid]; }
__global__ void k_fill_f32(float* __restrict__ dst, float v, size_t n) { const size_t gid = (size_t)blockIdx.x * 256 + threadIdx.x; if (gid < n) dst[gid] = v; }
__device__ __forceinline__ float logit_(float p) { return p >= 1.f ? 30.f : (p <= 0.f ? -30.f : logf(p / (1.f - p))); }
__global__ void k_cv_P(const unsigned char* __restrict__ ws, const unsigned char* __restrict__ ob, int b, float* __restrict__ Pn) {
    const size_t gid = (size_t)blockIdx.x * 256 + threadIdx.x; if (gid >= (size_t)2048 * 6656) return;
    const int t = (int)(gid / 6656), col = (int)(gid % 6656); const size_t row = (size_t)b * 2048 + t;
    float v;
    if (col < 1024) v = bf2f(((const bf16_t*)(ws + fk::WS_Q))[row * 1024 + col]) / fk::C2;
    else if (col < 1280) { const int hkv = (col - 1024) >> 6, d = col & 63; const size_t blk = (size_t)((b * 4 + hkv) * 32 + (t >> 6));
        v = bf2f(*(const bf16_t*)(ws + fk::WS_KB + blk * 8192 + (d >> 3) * 1024 + (t & 63) * 16 + (d & 7) * 2)); }
    else if (col < 1536) { const int hkv = (col - 1280) >> 6, d = col & 63; const size_t blk = (size_t)((b * 4 + hkv) * 32 + (t >> 6));
        const int kk = t & 63, s = kk >> 4, w = kk & 15, h = (w >> 2) & 1, e = w >> 3, jj = w & 3;
        v = bf2f(*(const bf16_t*)(ws + fk::WS_VB + blk * 8192 + (2 * s + h) * 1024 + d * 16 + 8 * e + 2 * jj)); }
    else if (col < 2560) v = bf2f(((const bf16_t*)(ws + fk::WS_Z))[row * 1024 + col - 1536]);
    else if (col < 3584) v = bf2f(((const bf16_t*)(ws + fk::WS_BB))[row * 1024 + col - 2560]);
    else if (col < 4608) v = 1.f;
    else { const int ch = col < 5632 ? col - 4608 : col - 5632;
        const float r = bf2f(((const bf16_t*)(ob + fk::OB_RB))[row * 1024 + ch]), sg = bf2f(((const bf16_t*)(ob + fk::OB_SGC))[row * 1024 + ch]);
        v = col < 5632 ? logit_(r * sg) : logit_(sg); }
    Pn[gid] = v;
}
__global__ void k_cv_kvc(const unsigned char* __restrict__ ws, int b, float* __restrict__ kvc) {
    const int gid = blockIdx.x * 256 + threadIdx.x; if (gid >= 256 * 512) return;
    const int l = gid >> 9, col = gid & 511;
    if (col < 256) { const int hkv = col >> 6, d = col & 63; const size_t blk = (size_t)((b * 4 + hkv) * 4 + (l >> 6));
        kvc[gid] = bf2f(*(const bf16_t*)(ws + fk::WS_KCB + blk * 8192 + (d >> 3) * 1024 + (l & 63) * 16 + (d & 7) * 2)); }
    else { const int hkv = (col - 256) >> 6, d = col & 63; const size_t blk = (size_t)((b * 4 + hkv) * 4 + (l >> 6));
        const int kk = l & 63, s = kk >> 4, w = kk & 15, h = (w >> 2) & 1, e = w >> 3, jj = w & 3;
        kvc[gid] = bf2f(*(const bf16_t*)(ws + fk::WS_VCB + blk * 8192 + (2 * s + h) * 1024 + d * 16 + 8 * e + 2 * jj)); }
}
inline unsigned nblk(size_t n) { return (unsigned)((n + 255) / 256); }

inline void run(fk::Params p, void* const* d_in, float* out, char* nbase, size_t nbytes, hipStream_t st) {
    nv::Inputs I; const float** ip = (const float**)&I; for (int i = 0; i < 19; ++i) ip[i] = (const float*)d_in[i];
    nv::Scratch S; const size_t need = nv::carve(S, nbase);
    if (need > nbytes) { fprintf(stderr, "hybrid: scratch too small %zu > %zu\n", need, nbytes); return; }
    constexpr int X = HYB;
    if (X >= 10) { fk_launch(p, 0, fk::NPHASE, st); }
    else { fk_launch(p, 0, X + 1, st); }
    nv::run_mod(I, S, st);
    const unsigned char* ws = p.ws; const unsigned char* ob = p.ob;
    constexpr size_t TD = (size_t)2048 * 1024;
    for (int b = 0; b < 16; ++b) {
        const bool fast = b < fk::NBF;
        if (b == fk::NBF && X == 0) nv::run_mod(I, S, st);
        int from = 0;
        if (fast) {
            const size_t r0 = (size_t)b * 2048;
            if (X == 0) { k_copy_f32<<<nblk(17 * 6144), 256, 0, st>>>((const float*)(ws + fk::WS_MOD), S.mod, 17 * 6144); from = 0; }
            else if (X == 1) { k_cv_bf16<<<nblk(TD), 256, 0, st>>>((const bf16_t*)(ws + fk::WS_HX) + r0 * 1024, 1024, S.hx, 1024, TD);
                k_cv_bf16<<<nblk(256 * 1024), 256, 0, st>>>((const bf16_t*)(ws + fk::WS_HX) + ((size_t)fk::M + (size_t)b * 256) * 1024, 1024, S.hc, 1024, (size_t)256 * 1024); from = 1; }
            else if (X == 2 || X == 3) { k_cv_P<<<nblk((size_t)2048 * 6656), 256, 0, st>>>(ws, ob, b, S.P); k_cv_kvc<<<512, 256, 0, st>>>(ws, b, S.kvc); from = 2;
                if (X == 3) { k_cv_bf16<<<nblk(TD), 256, 0, st>>>((const bf16_t*)(ws + fk::WS_AO) + r0 * 2048, 2048, S.oat, 1024, TD);
                    k_cv_bf16<<<nblk(TD), 256, 0, st>>>((const bf16_t*)(ws + fk::WS_AO) + r0 * 2048 + 1024, 2048, S.yc, 1024, TD); from = 3; } }
            else if (X == 4) { k_cv_bf16<<<nblk(TD), 256, 0, st>>>((const bf16_t*)(ws + fk::WS_MB) + r0 * 1024, 1024, S.a, 1024, TD); from = 4; }
            else {
                k_cv_bf16<<<nblk(TD), 256, 0, st>>>((const bf16_t*)(ws + fk::WS_DL) + r0 * 1024, 1024, S.o1, 1024, TD); nv::k_resid<<<nblk(TD), 256, 0, st>>>(I.x + r0 * 1024, S.one, S.o1, S.x1); from = 5;
                if (X >= 6) { k_cv_bf16<<<nblk(TD), 256, 0, st>>>((const bf16_t*)(ws + fk::WS_HX2) + r0 * 1024, 1024, S.hx2, 1024, TD);
                    k_copy_f32<<<nblk(16 * 2048), 256, 0, st>>>((const float*)(ws + fk::WS_AFF) + (size_t)b * 16 * 2048, S.aff, 16 * 2048); from = 6; }
                if (X >= 7) { k_copy_i32<<<nblk(16 * 256), 256, 0, st>>>((const int*)(ws + fk::WS_IDX) + b * 16 * 256, S.idx, 16 * 256);
                    k_copy_f32<<<nblk(16 * 256), 256, 0, st>>>((const float*)(ws + fk::WS_GATE) + b * 16 * 256, S.gate, 16 * 256);
                    k_copy_i32<<<nblk(2048 * 16), 256, 0, st>>>((const int*)(ws + fk::WS_SEL) + r0 * 16, S.sel, 2048 * 16); from = 7; }
                if (X >= 8) { k_cv_bf16<<<nblk((size_t)4096 * 1024), 256, 0, st>>>((const bf16_t*)(ob + fk::OB_HB) + (size_t)b * 4096 * 1024, 1024, S.ea, 1024, (size_t)4096 * 1024); from = 8; }
                if (X >= 9) { k_cv_bf16<<<nblk((size_t)4096 * 1024), 256, 0, st>>>((const bf16_t*)(ws + fk::WS_YE) + (size_t)b * 4096 * 1024, 1024, S.ye, 1024, (size_t)4096 * 1024);
                    k_fill_f32<<<nblk(16 * 256), 256, 0, st>>>(S.gate, 1.f, 16 * 256); from = 9; }
                if (X >= 10) from = 10;
            }
        }
        if (from <= 0) nv::s1a_norm(I, S, b, st);
        if (from <= 1) nv::s1b_gemm(I, S, b, st);
        if (from <= 2) nv::s2_mix(I, S, b, st);
        if (from <= 3) nv::s3_merge(I, S, b, st);
        if (from <= 4) nv::s4_out(I, S, b, st);
        if (from <= 5) nv::s5_router(I, S, b, st);
        if (from <= 6) nv::s6_topk(I, S, b, st);
        if (from <= 7) nv::s7_up(I, S, b, st);
        if (from <= 8) nv::s8_down(I, S, b, st);
        if (from <= 9) nv::s9_final(I, S, b, out, st);
    }
}
}
#endif

static int fk_grid = 0;
static bool fk_setup() {
    if (fk_grid) return fk_grid > 0;
    int dev = 0, cus = 0, per_cu = 0;
    if (hipGetDevice(&dev) != hipSuccess || hipDeviceGetAttribute(&cus, hipDeviceAttributeMultiprocessorCount, dev) != hipSuccess) { fk_grid = -1; return false; }
    if (hipFuncSetAttribute((const void*)fk::mega, hipFuncAttributeMaxDynamicSharedMemorySize, fk::LDS_BYTES) != hipSuccess) { fprintf(stderr, "kernel_launch: hipFuncSetAttribute failed\n"); fk_grid = -1; return false; }
    if (hipOccupancyMaxActiveBlocksPerMultiprocessor(&per_cu, (const void*)fk::mega, 512, fk::LDS_BYTES) != hipSuccess || per_cu < 1) { fprintf(stderr, "kernel_launch: occupancy query says %d\n", per_cu); fk_grid = -1; return false; }
    fk_grid = cus * per_cu;
    return true;
}
static void fk_launch(fk::Params p, int lo, int hi, hipStream_t stream) {
    p.ph_lo = lo; p.ph_hi = hi;
    if (hipMemsetAsync(p.ws + fk::WS_CTL, 0, fk::CTL_ZERO_BYTES, stream) != hipSuccess) { fprintf(stderr, "kernel_launch: memset failed\n"); return; }
    void* args[] = {&p};
    hipError_t e = hipLaunchCooperativeKernel((const void*)fk::mega, dim3(fk_grid), dim3(512), args, fk::LDS_BYTES, stream);
    if (e != hipSuccess) fprintf(stderr, "kernel_launch: cooperative launch failed: %s (grid %d)\n", hipGetErrorString(e), fk_grid);
}

extern "C" void kernel_launch(void* const* d_in, const int* in_sizes, int n_in, void* d_out, int out_size, void* d_ws, size_t ws_size, hipStream_t stream) {
    if (n_in != 19 || !fk_setup()) { fprintf(stderr, "kernel_launch: bad setup (n_in %d)\n", n_in); return; }
    fk::Params p{};
    const float** ip = (const float**)&p;
    for (int i = 0; i < 19; ++i) ip[i] = (const float*)d_in[i];
    p.out = (float*)d_out; p.ws = (unsigned char*)d_ws;
#if HYB < 0
    if (ws_size < fk::R_END) { fprintf(stderr, "kernel_launch: workspace too small: %zu < %zu\n", ws_size, (size_t)fk::R_END); return; }
    p.ob = (unsigned char*)d_out;
    fk_launch(p, 0, fk::NPHASE, stream);
#else
    p.ob = (unsigned char*)d_ws + fk::R_END;
    hyb::run(p, d_in, (float*)d_out, (char*)d_ws + fk::R_END + fk::OB_BYTES, ws_size - fk::R_END - fk::OB_BYTES, stream);
#endif
}
```

```cpp
#include <hip/hip_runtime.h>
#include <hip/hip_cooperative_groups.h>
#include <cstdio>
#include <cstdint>
#ifndef HYB
#define HYB -1
#endif
#if HYB >= 0
#define FK_NBF 8
#endif
namespace g8 {
#define G8_LAS __attribute__((address_space(3)))
typedef unsigned short bf16_t;
typedef short bf16x8 __attribute__((ext_vector_type(8)));
typedef float f32x4 __attribute__((ext_vector_type(4)));
typedef float f32x2 __attribute__((ext_vector_type(2)));
typedef unsigned u32x4 __attribute__((ext_vector_type(4)));
typedef unsigned u32x2 __attribute__((ext_vector_type(2)));
constexpr int BM = 256, BK = 64, HALF = 128, HTB = HALF * BK * 2, STAGE_BYTES = 8 * HTB;

__host__ __device__ __forceinline__ int lds_byte(int r, int c) { const int st = (r >> 4) * 2 + (c >> 5), rr = r & 15, cc = c & 31, ob = rr * 64 + cc * 2; return st * 1024 + (ob ^ (((ob >> 9) & 1) << 5)); }
__host__ __device__ __forceinline__ void stage_rc(int b, int& R, int& C) { const int st = b / 1024, sb = b % 1024, swz = sb ^ (((sb >> 9) & 1) << 5); R = (st >> 1) * 16 + swz / 64; C = (st & 1) * 32 + (swz % 64) / 2; }
__host__ __device__ __forceinline__ int perm32(int rho) { const int n = rho >> 4, i = rho & 15; return 8 * (i >> 2) + 4 * n + (i & 3); }
__host__ __device__ __forceinline__ int pinv32(int x) { return 16 * ((x >> 2) & 1) + 4 * (x >> 3) + (x & 3); }

struct Unit { const char* a; const char* b; const int* rows; int kind; int pm; int pn; int aux; };

__device__ __forceinline__ unsigned cvt_pk_bf16(float lo, float hi) { unsigned r; asm volatile("v_cvt_pk_bf16_f32 %0, %1, %2" : "=v"(r) : "v"(lo), "v"(hi)); return r; }
__device__ __forceinline__ float bf_lo(unsigned w) { return __uint_as_float(w << 16); }
__device__ __forceinline__ float bf_hi(unsigned w) { return __uint_as_float(w & 0xffff0000u); }

template <class Epi, class Sched, bool HAS_MID, bool GATHER = false, int KREP = 1>
__device__ __forceinline__ void gemm_phase(G8_LAS unsigned char* lds, const int K, const Sched& S, const Epi& E) {
    const int tid = threadIdx.x, wid = __builtin_amdgcn_readfirstlane(tid >> 6), lane = tid & 63, wr = wid >> 2, wc = wid & 3, fr = lane & 15, fq = lane >> 4;
    const int nt = K / BK;
    unsigned voff[2];
#pragma unroll
    for (int i = 0; i < 2; ++i) { int R, C; stage_rc(tid * 16 + i * 8192, R, C); voff[i] = (unsigned)(R * K + C) * 2u; }
    const size_t kstep = (size_t)(BK * 2);
    const size_t hstep = (size_t)HALF * K * 2;
    const unsigned ldsw = (unsigned)wid * 1024u;
    const int aoff = lds_byte(wr * 64 + fr, fq * 8), boff = lds_byte(wc * 32 + fr, fq * 8);
#define G8_SA(b, h) (((b) * 2 + (h)) * HTB)
#define G8_SB(b, h) ((4 + (b) * 2 + (h)) * HTB)
#define G8_STAGE(bufoff, gbase) do { _Pragma("unroll") for (int _i = 0; _i < 2; ++_i) \
        __builtin_amdgcn_global_load_lds((const unsigned*)((const char*)(gbase) + voff[_i]), (G8_LAS unsigned*)(lds + (bufoff) + ldsw + _i * 8192), 16, 0, 0); } while (0)
#define G8_STAGE_V(bufoff, gbase, vv) do { _Pragma("unroll") for (int _i = 0; _i < 2; ++_i) \
        __builtin_amdgcn_global_load_lds((const unsigned*)((const char*)(gbase) + (vv)[_i]), (G8_LAS unsigned*)(lds + (bufoff) + ldsw + _i * 8192), 16, 0, 0); } while (0)
#define G8_STAGE_A(bufoff, gbase, h) do { if constexpr (GATHER) G8_STAGE_V(bufoff, gbase, va[h]); else G8_STAGE(bufoff, (gbase) + (h) * hstep); } while (0)
#define G8_LDA(dst, b, h) do { _Pragma("unroll") for (int m = 0; m < 4; ++m) _Pragma("unroll") for (int k = 0; k < 2; ++k) dst[m][k] = *(const G8_LAS bf16x8*)(lds + G8_SA(b, h) + aoff + m * 2048 + k * 1024); } while (0)
#define G8_LDB(dst, b, h) do { _Pragma("unroll") for (int n = 0; n < 2; ++n) _Pragma("unroll") for (int k = 0; k < 2; ++k) dst[n][k] = *(const G8_LAS bf16x8*)(lds + G8_SB(b, h) + boff + n * 2048 + k * 1024); } while (0)
#define G8_MMA(ai, bj, At, Bt) do { __builtin_amdgcn_s_setprio(1); _Pragma("unroll") for (int m = 0; m < 4; ++m) _Pragma("unroll") for (int n = 0; n < 2; ++n) _Pragma("unroll") for (int k = 0; k < 2; ++k) \
        acc[ai][bj][m][n] = __builtin_amdgcn_mfma_f32_16x16x32_bf16(Bt[n][k], At[m][k], acc[ai][bj][m][n], 0, 0, 0); __builtin_amdgcn_s_setprio(0); } while (0)
#define G8_WAIT_V(n) asm volatile("s_waitcnt vmcnt(" #n ")" ::: "memory")
#define G8_WAIT_L(n) asm volatile("s_waitcnt lgkmcnt(" #n ")" ::: "memory")
#define G8_BAR __builtin_amdgcn_s_barrier()
#define G8_SCHED __builtin_amdgcn_sched_barrier(0)
    Unit cur, nxt; int ui = 0;
    if (!S.next(0, cur)) return;
    f32x4 acc[2][2][4][2];
#pragma unroll
    for (int a = 0; a < 2; ++a)
#pragma unroll
        for (int b = 0; b < 2; ++b)
#pragma unroll
            for (int m = 0; m < 4; ++m)
#pragma unroll
                for (int n = 0; n < 2; ++n) acc[a][b][m][n] = (f32x4){0.f, 0.f, 0.f, 0.f};
    bf16x8 At[4][2], B0[2][2], B1[2][2];
    const char* cA = cur.a; const char* cB = cur.b;
    unsigned va[2][2], vn[2][2];
    int gR[2], gC[2];
#pragma unroll
    for (int i = 0; i < 2; ++i) stage_rc(tid * 16 + i * 8192, gR[i], gC[i]);
    if constexpr (GATHER) {
#pragma unroll
        for (int h = 0; h < 2; ++h)
#pragma unroll
            for (int i = 0; i < 2; ++i) { va[h][i] = (unsigned)(cur.rows[128 * h + gR[i]] * K + gC[i]) * 2u; vn[h][i] = va[h][i]; }
    }
    G8_STAGE(G8_SB(0, 0), cB); G8_STAGE(G8_SB(0, 1), cB + hstep); G8_STAGE_A(G8_SA(0, 0), cA, 0); G8_STAGE_A(G8_SA(0, 1), cA, 1);
    if (wr == 1) G8_BAR;
    G8_WAIT_V(2); G8_BAR;
    G8_STAGE(G8_SB(1, 0), cB + kstep); G8_STAGE_A(G8_SA(1, 0), cA + kstep, 0); G8_STAGE(G8_SB(1, 1), cB + hstep + kstep);
    G8_WAIT_V(6); G8_BAR;
    for (;;) {
        const bool has_next = S.next(ui + 1, nxt);
        const char* nA = has_next ? nxt.a : cA; const char* nB = has_next ? nxt.b : cB;
        if constexpr (GATHER) { if (has_next) {
#pragma unroll
            for (int h = 0; h < 2; ++h)
#pragma unroll
                for (int i = 0; i < 2; ++i) vn[h][i] = (unsigned)(nxt.rows[128 * h + gR[i]] * K + gC[i]) * 2u; } }
        constexpr int KR = (KREP == 3) ? 1 : KREP;
        for (int tt = 0; tt < KR * nt; tt += 2) {
            const bool last = (tt == KR * nt - 2);
            const int t = (KREP == 1 || KREP == 3) ? tt : (tt >= nt ? tt - nt : tt);
            const char* a1 = cA + (size_t)(t + 1) * kstep;
            const int t2 = (KR > 1 && t + 2 >= nt) ? 0 : t + 2;
            const char* a2 = last ? nA : cA + (size_t)t2 * kstep; const char* b2 = last ? nB : cB + (size_t)t2 * kstep;
            const char* a3 = a2 + kstep; const char* b3 = b2 + kstep;
            if constexpr (HAS_MID) { if (t == (nt >> 1)) E.mid(acc, cur, wr, wc, fr, fq); }
            G8_LDB(B0, 0, 0); G8_LDB(B1, 0, 1); G8_SCHED; G8_LDA(At, 0, 0); G8_STAGE_A(G8_SA(1, 1), a1, 1);
            if constexpr (GATHER) { if (last) { va[0][0] = vn[0][0]; va[0][1] = vn[0][1]; va[1][0] = vn[1][0]; va[1][1] = vn[1][1]; } }
            G8_WAIT_V(8); G8_WAIT_L(0); G8_BAR; G8_MMA(0, 0, At, B0); G8_MMA(0, 1, At, B1); G8_BAR; G8_SCHED;
            G8_LDA(At, 0, 1); G8_STAGE(G8_SB(0, 0), b2); G8_STAGE(G8_SB(0, 1), b2 + hstep); G8_STAGE_A(G8_SA(0, 0), a2, 0);
            G8_WAIT_V(8); G8_WAIT_L(0); G8_BAR; G8_MMA(1, 0, At, B0); G8_MMA(1, 1, At, B1); G8_BAR; G8_SCHED;
            G8_LDB(B0, 1, 0); G8_LDB(B1, 1, 1); G8_SCHED; G8_LDA(At, 1, 0); G8_STAGE_A(G8_SA(0, 1), a2, 1);
            G8_WAIT_V(8); G8_WAIT_L(0); G8_BAR; G8_MMA(0, 0, At, B0); G8_MMA(0, 1, At, B1); G8_BAR; G8_SCHED;
            G8_LDA(At, 1, 1); G8_STAGE(G8_SB(1, 0), b3); G8_STAGE(G8_SB(1, 1), b3 + hstep); G8_STAGE_A(G8_SA(1, 0), a3, 0);
            G8_WAIT_V(8); G8_WAIT_L(0); G8_BAR; G8_MMA(1, 0, At, B0); G8_MMA(1, 1, At, B1); G8_BAR; G8_SCHED;
        }
        if (wr == 0) G8_BAR;
        if constexpr (KR > 1) {
#pragma unroll
            for (int a = 0; a < 2; ++a)
#pragma unroll
                for (int b = 0; b < 2; ++b)
#pragma unroll
                    for (int m = 0; m < 4; ++m)
#pragma unroll
                        for (int n = 0; n < 2; ++n) acc[a][b][m][n] *= (1.0f / KR);
        }
        E(acc, cur, wr, wc, fr, fq);
#ifdef FK_EPI2_PROBE
        if constexpr (KREP == 3) { asm volatile("" ::: "memory"); E(acc, cur, wr, wc, fr, fq); }
#endif
        if (!has_next) break;
#pragma unroll
        for (int a = 0; a < 2; ++a)
#pragma unroll
            for (int b = 0; b < 2; ++b)
#pragma unroll
                for (int m = 0; m < 4; ++m)
#pragma unroll
                    for (int n = 0; n < 2; ++n) acc[a][b][m][n] = (f32x4){0.f, 0.f, 0.f, 0.f};
        cur = nxt; cA = nA; cB = nB; ++ui;
        if (wr == 1) G8_BAR;
    }
    G8_WAIT_V(0);
    G8_BAR;
#undef G8_SA
#undef G8_SB
#undef G8_STAGE
#undef G8_LDA
#undef G8_STAGE_V
#undef G8_STAGE_A
#undef G8_LDB
#undef G8_MMA
#undef G8_WAIT_V
#undef G8_WAIT_L
#undef G8_BAR
#undef G8_SCHED
}
}
namespace fk {
using namespace g8;
namespace cg = cooperative_groups;
#define LAS G8_LAS
#ifndef FK_NBF
#define FK_NBF 16
#endif
#ifndef FK_DBL
#define FK_DBL 0
#endif
constexpr int NBF = FK_NBF;
constexpr int D = 1024, T = 2048, LC = 256, NE = 16, CAP = 256;
constexpr int M = NBF * T, MC = NBF * LC, MA = M + MC;
constexpr int NT_IN = 25;
constexpr float LOG2E = 1.4426950408889634f;
constexpr float C2 = 0.125f * LOG2E;
typedef float f32x16 __attribute__((ext_vector_type(16)));

constexpr size_t MiB = (size_t)1 << 20;
constexpr size_t SC = (size_t)NBF << 16;
constexpr size_t WS_CTL = 0, WS_MOD = 1 * MiB, WS_ROPE = 1 * MiB + 512 * 1024, WS_IDX = 2 * MiB, WS_GATE = 2 * MiB + 256 * 1024,
                 WS_AFF = 2 * MiB + 512 * 1024, WS_SEL = 5 * MiB;
constexpr size_t WS_WIN = 8 * MiB, WS_WV = WS_WIN + (size_t)6400 * 2048, WS_WP = 21 * MiB, WS_WO = 25 * MiB, WS_WGU = 27 * MiB, WS_WD = 91 * MiB;
constexpr size_t R0 = 124 * MiB;
constexpr size_t WS_Q = R0, WS_KB = R0 + 64 * SC, WS_KCB = R0 + 80 * SC, WS_VB = R0 + 82 * SC, WS_VCB = R0 + 98 * SC, WS_Z = R0 + 100 * SC, WS_BB = R0 + 164 * SC,
                 WS_AO = R0 + 228 * SC, WS_HX = R0 + 284 * SC, WS_MB = R0, WS_DL = R0 + 64 * SC, WS_HX2 = R0, WS_XE = R0 + 192 * SC, WS_YE = R0 + 192 * SC;
constexpr size_t R_END = R0 + 356 * SC;
constexpr size_t OB_RB = 0, OB_SGC = 64 * SC, OB_HB = 0, OB_BYTES = 128 * SC;

constexpr int LDS_BYTES = 147456;
constexpr int LDS_MISC = 140 * 1024;
constexpr int LDS_MISC_Q = 140 * 1024 + 64;

#ifdef FK_TS
#define FK_STAMP_WG(k, wgsel) do { if (blockIdx.x == (wgsel) && threadIdx.x == 0) { const unsigned long long t_ = __builtin_amdgcn_s_memrealtime(); \
        __hip_atomic_store((unsigned long long*)(P.ws + WS_CTL) + 1800 + (k), t_, __ATOMIC_RELAXED, __HIP_MEMORY_SCOPE_AGENT); } } while (0)
#else
#define FK_STAMP_WG(k, wgsel) do { } while (0)
#endif
#define FK_STAMP(k) FK_STAMP_WG(k, 0)

struct Params {
    const float *x, *c, *ctx, *c_ctx, *w_mod, *b_mod, *norm1_g, *w_in, *sink, *conv_w, *wpa, *wpc, *wo, *norm2_g, *w_router, *wg, *wu, *wd, *fg;
    float* out; unsigned char* ws; unsigned char* ob;
    int ph_lo, ph_hi;
};

__device__ __forceinline__ float wave_sum(float v) {
#pragma unroll
    for (int o = 1; o < 64; o <<= 1) v += __shfl_xor(v, o);
    return v;
}
__device__ __forceinline__ unsigned f2bf(float f) { unsigned u = __builtin_bit_cast(unsigned, f); return (u + 0x7fffu + ((u >> 16) & 1u)) >> 16; }
__device__ __forceinline__ unsigned pk2(float lo, float hi) { return f2bf(lo) | (f2bf(hi) << 16); }
__device__ __forceinline__ void bf8_to_f32(const u32x4 w, f32x4& lo, f32x4& hi4) { lo = (f32x4){bf_lo(w.x), bf_hi(w.x), bf_lo(w.y), bf_hi(w.y)}; hi4 = (f32x4){bf_lo(w.z), bf_hi(w.z), bf_lo(w.w), bf_hi(w.w)}; }
__device__ __forceinline__ u32x4 f32_to_bf8(const f32x4 a, const f32x4 b) { u32x4 w; w.x = pk2(a.x, a.y); w.y = pk2(a.z, a.w); w.z = pk2(b.x, b.y); w.w = pk2(b.z, b.w); return w; }
__device__ __forceinline__ float sq4(const f32x4 v) { return (v.x * v.x + v.y * v.y) + (v.z * v.z + v.w * v.w); }
__device__ __forceinline__ float dot4(const f32x4 a, const f32x4 b) { return (a.x * b.x + a.y * b.y) + (a.z * b.z + a.w * b.w); }
__device__ __forceinline__ float sigmoidf_(float v) { return 1.f / (1.f + __expf(-v)); }

__device__ __forceinline__ void transpose_item64(const float* __restrict__ W, int N, int k0, int n0, bf16_t* __restrict__ dst, int pitch, bool perm, int lane) {
    const float* src = W + (size_t)k0 * N + n0 + lane;
    const int dr = perm ? ((lane & 32) + pinv32(lane & 31)) : lane;
    bf16_t* drow = dst + (size_t)dr * pitch + k0;
#pragma unroll
    for (int h = 0; h < 2; ++h) {
        float v[32];
#pragma unroll
        for (int j = 0; j < 32; ++j) v[j] = __builtin_nontemporal_load(src + (size_t)(32 * h + j) * N);
#pragma unroll
        for (int c = 0; c < 4; ++c) { u32x4 o; o.x = pk2(v[8 * c], v[8 * c + 1]); o.y = pk2(v[8 * c + 2], v[8 * c + 3]); o.z = pk2(v[8 * c + 4], v[8 * c + 5]); o.w = pk2(v[8 * c + 6], v[8 * c + 7]);
            *(u32x4*)(drow + 32 * h + 8 * c) = o; }
    }
}

constexpr int CV_IN = 16 * 104, CV_SQ = 256, CV_TOTAL = CV_IN + 3 * CV_SQ + 48 * CV_SQ;
__device__ __forceinline__ void conv_item(const Params& P, int it, int lane) {
    bf16_t* WIN = (bf16_t*)(P.ws + WS_WIN); bf16_t* WV = (bf16_t*)(P.ws + WS_WV); bf16_t* WP = (bf16_t*)(P.ws + WS_WP); bf16_t* WO = (bf16_t*)(P.ws + WS_WO);
    bf16_t* WGU = (bf16_t*)(P.ws + WS_WGU); bf16_t* WD = (bf16_t*)(P.ws + WS_WD);
    int r = it;
    if (r < CV_IN) {
        const int kb = r / 104, nb = r % 104, k0 = 64 * kb, n0 = 64 * nb;
        bf16_t* dst; bool perm = true;
        if (n0 < 1280) { dst = WIN + (size_t)n0 * 1024; perm = false; }
        else if (n0 < 1536) { dst = WV + (size_t)(n0 - 1280) * 1024; perm = false; }
        else if (n0 < 2560) { const int ch = n0 - 1536; dst = WIN + (size_t)(1280 + (ch >> 7) * 256 + (ch & 127)) * 1024; }
        else if (n0 < 3584) { dst = WIN + (size_t)(3328 + (n0 - 2560)) * 1024; }
        else if (n0 < 4608) { const int ch = n0 - 3584; dst = WIN + (size_t)(1280 + (ch >> 7) * 256 + 128 + (ch & 127)) * 1024; }
        else if (n0 < 5632) { const int ch = n0 - 4608; dst = WIN + (size_t)(4352 + (ch >> 7) * 256 + (ch & 127)) * 1024; }
        else { const int ch = n0 - 5632; dst = WIN + (size_t)(4352 + (ch >> 7) * 256 + 128 + (ch & 127)) * 1024; }
        transpose_item64(P.w_in, 6656, k0, n0, dst, 1024, perm, lane);
        return;
    }
    r -= CV_IN;
    const int mat = r / CV_SQ, q = r % CV_SQ, kb = q / 16, nb = q % 16, k0 = 64 * kb, n0 = 64 * nb;
    if (mat == 0) transpose_item64(P.wpa, 1024, k0, n0, WP + (size_t)n0 * 2048, 2048, true, lane);
    else if (mat == 1) transpose_item64(P.wpc, 1024, k0, n0, WP + (size_t)n0 * 2048 + 1024, 2048, true, lane);
    else if (mat == 2) transpose_item64(P.wo, 1024, k0, n0, WO + (size_t)n0 * 1024, 1024, true, lane);
    else {
        const int m2 = mat - 3, kind = m2 >> 4, e = m2 & 15;
        if (kind == 0) transpose_item64(P.wg + (size_t)e * 1048576, 1024, k0, n0, WGU + ((size_t)e * 2048 + (n0 >> 7) * 256 + (n0 & 127)) * 1024, 1024, true, lane);
        else if (kind == 1) transpose_item64(P.wu + (size_t)e * 1048576, 1024, k0, n0, WGU + ((size_t)e * 2048 + (n0 >> 7) * 256 + 128 + (n0 & 127)) * 1024, 1024, true, lane);
        else transpose_item64(P.wd + (size_t)e * 1048576, 1024, k0, n0, WD + ((size_t)e * 1024 + n0) * 1024, 1024, true, lane);
    }
}

__device__ __forceinline__ void ph_prep(const Params& P, LAS unsigned char* lds) {
    const int tid = threadIdx.x, lane = tid & 63, wave = __builtin_amdgcn_readfirstlane(tid >> 6);
    const int G = gridDim.x, wg = blockIdx.x;
    float* mod = (float*)(P.ws + WS_MOD);
    constexpr int NMODWG = 192;
    if (wg < NMODWG) {
        const int cg_ = wg >> 1, kh = wg & 1;
        LAS float* sl = (LAS float*)lds;
        LAS float* red = (LAS float*)(lds + 17 * 512 * 4);
        { float cv[17];
#pragma unroll
          for (int r = 0; r < 17; ++r) cv[r] = r < 16 ? P.c[r * 1024 + 512 * kh + tid] : P.c_ctx[512 * kh + tid];
#pragma unroll
          for (int r = 0; r < 17; ++r) sl[r * 512 + tid] = cv[r] / (1.f + __expf(-cv[r])); }
        __syncthreads(); FK_STAMP_WG(16, 0);
        const int col = tid & 63, kg = wave, n = cg_ * 64 + col;
        float acc[17];
#pragma unroll
        for (int r = 0; r < 17; ++r) acc[r] = 0.f;
        { float w[64];
#pragma unroll
          for (int j = 0; j < 64; ++j) w[j] = __builtin_nontemporal_load(P.w_mod + (size_t)(512 * kh + 64 * kg + j) * 6144 + n);
#pragma unroll
          for (int j = 0; j < 64; ++j)
#pragma unroll
              for (int r = 0; r < 17; ++r) acc[r] += sl[r * 512 + 64 * kg + j] * w[j]; }
#pragma unroll
        for (int r = 0; r < 17; ++r) red[(kg * 17 + r) * 64 + col] = acc[r];
        __syncthreads(); FK_STAMP_WG(17, 0);
        for (int i = tid; i < 17 * 64; i += 512) { const int r = i >> 6, cc = i & 63; float sm = kh == 0 ? P.b_mod[cg_ * 64 + cc] : 0.f;
#pragma unroll
            for (int g = 0; g < 8; ++g) sm += red[(g * 17 + r) * 64 + cc];
            atomicAdd(mod + r * 6144 + cg_ * 64 + cc, sm); }
        __syncthreads(); FK_STAMP_WG(18, 0);
    } else if (wg == NMODWG) {
        float2* rope = (float2*)(P.ws + WS_ROPE);
        for (int i = tid; i < 64 * 16; i += 512) { const int pos = i >> 4, f = i & 15; const float ang = (float)pos * powf(10000.f, -(float)f / 16.f); rope[i] = make_float2(cosf(ang), sinf(ang)); }
    }
    constexpr int I_IN = 16 * 104;
    const int npure = (G - NMODWG) * 8;
    if (wg >= NMODWG) { for (int it = (wg - NMODWG) * 8 + wave; it < 2 * npure && it < I_IN; it += npure) conv_item(P, it, lane); }
    else { for (int it = 2 * npure + wg * 8 + wave; it < I_IN; it += NMODWG * 8) conv_item(P, it, lane); }
    __syncthreads(); FK_STAMP_WG(19, 0); FK_STAMP_WG(20, 200);
}

template <int NR>
__device__ __forceinline__ void norm1_rows(const Params& P, int row0, int lane) {
    const float* mod = (const float*)(P.ws + WS_MOD);
    bf16_t* HX = (bf16_t*)(P.ws + WS_HX);
    const float* xr; const float* mv;
    if (row0 < M) { xr = P.x + (size_t)row0 * D; mv = mod + (row0 >> 11) * 6144; } else { xr = P.ctx + (size_t)(row0 - M) * D; mv = mod + 16 * 6144; }
    f32x4 v[NR][4];
#pragma unroll
    for (int r = 0; r < NR; ++r)
#pragma unroll
        for (int j = 0; j < 2; ++j) { v[r][2 * j] = __builtin_nontemporal_load((const f32x4*)(xr + (size_t)r * D + 8 * lane + 512 * j)); v[r][2 * j + 1] = __builtin_nontemporal_load((const f32x4*)(xr + (size_t)r * D + 8 * lane + 512 * j + 4)); }
    float rs[NR];
#pragma unroll
    for (int r = 0; r < NR; ++r) { const float ss = (sq4(v[r][0]) + sq4(v[r][1])) + (sq4(v[r][2]) + sq4(v[r][3])); rs[r] = 1.0f / sqrtf(wave_sum(ss) * (1.f / D) + 1e-6f); }
#pragma unroll
    for (int j = 0; j < 2; ++j) { const int c0 = 8 * lane + 512 * j;
        const f32x4 g0 = *(const f32x4*)(P.norm1_g + c0) * (*(const f32x4*)(mv + 1024 + c0) + 1.0f), g1 = *(const f32x4*)(P.norm1_g + c0 + 4) * (*(const f32x4*)(mv + 1024 + c0 + 4) + 1.0f);
        const f32x4 sh0 = *(const f32x4*)(mv + c0), sh1 = *(const f32x4*)(mv + c0 + 4);
#pragma unroll
        for (int r = 0; r < NR; ++r) *(u32x4*)(HX + (size_t)(row0 + r) * D + c0) = f32_to_bf8(v[r][2 * j] * rs[r] * g0 + sh0, v[r][2 * j + 1] * rs[r] * g1 + sh1); }
}
enum { KD_Q = 0, KD_K = 1, KD_KC = 2, KD_VT = 3, KD_VTC = 4, KD_UC = 5, KD_BC = 6, KD_GG = 7 };
struct InprojSched {
    int G, c; const char *hx, *win, *wv;
    static constexpr int NMAIN = (M / 256) * NT_IN, NVT = M / 256, NC = MC / 256, NTOT = NMAIN + NVT;
    __device__ __forceinline__ bool next(int i, Unit& u) const {
        const int Lx = i * G + c; if (Lx >= NTOT) return false;
        constexpr size_t TS = (size_t)256 * 1024 * 2;
        if (Lx < NMAIN) {
            const int wgid = (Lx % 8) * (NMAIN / 8) + Lx / 8;
            constexpr int nig = 8 * NT_IN; const int gid = wgid / nig, w = wgid % nig;
            u.pm = gid * 8 + (w % 8); u.pn = w / 8;
            u.a = hx + (size_t)u.pm * TS; u.b = win + (size_t)u.pn * TS;
            u.kind = u.pn < 4 ? KD_Q : u.pn == 4 ? KD_K : u.pn < 13 ? KD_UC : u.pn < 17 ? KD_BC : KD_GG; u.aux = 0; u.rows = nullptr;
        } else {
            const int xq = Lx - NMAIN;
            u.kind = KD_VT; u.pm = 0; u.pn = xq; u.a = wv; u.b = hx + (size_t)xq * TS;
            u.aux = 0; u.rows = nullptr;
        }
        return true;
    }
};
struct CtxSched {
    int c; const char *hx, *win, *wv;
    __device__ __forceinline__ bool next(int i, Unit& u) const {
        if (i != 0) return false;
        constexpr size_t TS = (size_t)256 * 1024 * 2; constexpr int NC = MC / 256;
        if (c < NC) { u.kind = KD_KC; u.pm = M / 256 + c; u.pn = 4; u.a = hx + (size_t)u.pm * TS; u.b = win + (size_t)4 * TS; }
        else { u.kind = KD_VTC; u.pm = 0; u.pn = c - NC; u.a = wv; u.b = hx + (size_t)(M / 256 + u.pn) * TS; }
        u.aux = 0; u.rows = nullptr; return true;
    }
};
struct EpiInproj {
    bf16_t *q, *z, *bb, *rb, *sgc; unsigned char *kb, *kcb, *vb, *vcb; const float* rope;
    __device__ __forceinline__ void operator()(const f32x4 (&acc)[2][2][4][2], const Unit& u, int wr, int wc, int fr, int fq) const {
        const int kind = u.kind;
        if (kind == KD_Q || kind == KD_K) {
#pragma unroll
            for (int ai = 0; ai < 2; ++ai)
#pragma unroll
                for (int m = 0; m < 4; ++m) {
                    const int r = u.pm * 256 + 128 * ai + 64 * wr + 16 * m + fr, t = r & 2047, b = r >> 11;
                    const int pos = (wc & 1) ? (t & 63) : (t >> 6);
                    const float* tb = rope + (pos * 16 + 4 * fq) * 2;
                    const f32x4 t0 = *(const f32x4*)tb, t1 = *(const f32x4*)(tb + 4);
                    const f32x4 cs = {t0.x, t0.z, t1.x, t1.z}, sn = {t0.y, t0.w, t1.y, t1.w};
#pragma unroll
                    for (int bj = 0; bj < 2; ++bj) {
                        const f32x4 x0 = acc[ai][bj][m][0], x1 = acc[ai][bj][m][1];
                        f32x4 o0 = x0 * cs - x1 * sn, o1 = x1 * cs + x0 * sn;
                        if (kind == KD_Q) {
                            o0 = o0 * C2; o1 = o1 * C2;
                            bf16_t* dst = q + (size_t)r * 1024 + u.pn * 256 + 128 * bj + 32 * wc + 4 * fq;
                            u32x2 w0, w1; w0.x = cvt_pk_bf16(o0.x, o0.y); w0.y = cvt_pk_bf16(o0.z, o0.w); w1.x = cvt_pk_bf16(o1.x, o1.y); w1.y = cvt_pk_bf16(o1.z, o1.w);
                            *(u32x2*)dst = w0; *(u32x2*)(dst + 16) = w1;
                        } else {
                            const int hkv = 2 * bj + (wc >> 1), ch0 = 4 * (wc & 1) + (fq >> 1);
                            unsigned char* dst = kb + ((size_t)((b * 4 + hkv) * 32 + (t >> 6))) * 8192 + ch0 * 1024 + (t & 63) * 16 + 8 * (fq & 1);
                            u32x2 w0, w1; w0.x = cvt_pk_bf16(o0.x, o0.y); w0.y = cvt_pk_bf16(o0.z, o0.w); w1.x = cvt_pk_bf16(o1.x, o1.y); w1.y = cvt_pk_bf16(o1.z, o1.w);
                            *(u32x2*)dst = w0; *(u32x2*)(dst + 2048) = w1;
                        }
                    }
                }
        } else if (kind == KD_KC) {
#pragma unroll
            for (int ai = 0; ai < 2; ++ai)
#pragma unroll
                for (int m = 0; m < 4; ++m) {
                    const int r = (u.pm - M / 256) * 256 + 128 * ai + 64 * wr + 16 * m + fr, l = r & 255, b = r >> 8;
#pragma unroll
                    for (int bj = 0; bj < 2; ++bj) {
                        const int hkv = 2 * bj + (wc >> 1), ch0 = 4 * (wc & 1) + (fq >> 1);
                        unsigned char* dst = kcb + ((size_t)((b * 4 + hkv) * 4 + (l >> 6))) * 8192 + ch0 * 1024 + (l & 63) * 16 + 8 * (fq & 1);
#pragma unroll
                        for (int n = 0; n < 2; ++n) { const f32x4 v = acc[ai][bj][m][n]; u32x2 w; w.x = cvt_pk_bf16(v.x, v.y); w.y = cvt_pk_bf16(v.z, v.w); *(u32x2*)(dst + n * 2048) = w; }
                    }
                }
        } else if (kind == KD_VT || kind == KD_VTC) {
#pragma unroll
            for (int ai = 0; ai < 2; ++ai)
#pragma unroll
                for (int m = 0; m < 4; ++m) {
                    const int hkv = 2 * ai + wr, d = 16 * m + fr;
#pragma unroll
                    for (int bj = 0; bj < 2; ++bj) {
                        size_t blk;
                        if (kind == KD_VT) blk = (size_t)(((u.pn >> 3) * 4 + hkv) * 32 + 4 * (u.pn & 7) + 2 * bj + (wc >> 1));
                        else blk = (size_t)((u.pn * 4 + hkv) * 4 + 2 * bj + (wc >> 1));
                        unsigned char* base = (kind == KD_VT ? vb : vcb) + blk * 8192 + d * 16 + 8 * (fq >> 1);
#pragma unroll
                        for (int n = 0; n < 2; ++n) { const f32x4 v = acc[ai][bj][m][n]; u32x2 w; w.x = cvt_pk_bf16(v.x, v.y); w.y = cvt_pk_bf16(v.z, v.w);
                            *(u32x2*)(base + (2 * (2 * (wc & 1) + n) + (fq & 1)) * 1024) = w; }
                    }
                }
        } else if (kind == KD_UC) {
#pragma unroll
            for (int ai = 0; ai < 2; ++ai)
#pragma unroll
                for (int m = 0; m < 4; ++m) {
                    const int r = u.pm * 256 + 128 * ai + 64 * wr + 16 * m + fr;
                    const f32x4 v0 = acc[ai][0][m][0] * acc[ai][1][m][0], v1 = acc[ai][0][m][1] * acc[ai][1][m][1];
                    u32x4 w; w.x = cvt_pk_bf16(v0.x, v0.y); w.y = cvt_pk_bf16(v0.z, v0.w); w.z = cvt_pk_bf16(v1.x, v1.y); w.w = cvt_pk_bf16(v1.z, v1.w);
                    *(u32x4*)(z + (size_t)r * 1024 + (u.pn - 5) * 128 + 32 * wc + 8 * fq) = w;
                }
        } else if (kind == KD_BC) {
#pragma unroll
            for (int ai = 0; ai < 2; ++ai)
#pragma unroll
                for (int m = 0; m < 4; ++m) {
                    const int r = u.pm * 256 + 128 * ai + 64 * wr + 16 * m + fr;
#pragma unroll
                    for (int bj = 0; bj < 2; ++bj) { const f32x4 v0 = acc[ai][bj][m][0], v1 = acc[ai][bj][m][1];
                        u32x4 w; w.x = cvt_pk_bf16(v0.x, v0.y); w.y = cvt_pk_bf16(v0.z, v0.w); w.z = cvt_pk_bf16(v1.x, v1.y); w.w = cvt_pk_bf16(v1.z, v1.w);
                        *(u32x4*)(bb + (size_t)r * 1024 + (u.pn - 13) * 256 + 128 * bj + 32 * wc + 8 * fq) = w; }
                }
        } else {
#pragma unroll
            for (int ai = 0; ai < 2; ++ai)
#pragma unroll
                for (int m = 0; m < 4; ++m) {
                    const int r = u.pm * 256 + 128 * ai + 64 * wr + 16 * m + fr;
                    f32x4 rr[2], sg[2];
#pragma unroll
                    for (int n = 0; n < 2; ++n)
#pragma unroll
                        for (int j = 0; j < 4; ++j) { const float ea = __expf(-acc[ai][0][m][n][j]), ec = __expf(-acc[ai][1][m][n][j]);
                            rr[n][j] = (1.f + ec) * __builtin_amdgcn_rcpf(1.f + ea); sg[n][j] = __builtin_amdgcn_rcpf(1.f + ec); }
                    const size_t off = (size_t)r * 1024 + (u.pn - 17) * 128 + 32 * wc + 8 * fq;
                    u32x4 w; w.x = cvt_pk_bf16(rr[0].x, rr[0].y); w.y = cvt_pk_bf16(rr[0].z, rr[0].w); w.z = cvt_pk_bf16(rr[1].x, rr[1].y); w.w = cvt_pk_bf16(rr[1].z, rr[1].w);
                    *(u32x4*)(rb + off) = w;
                    w.x = cvt_pk_bf16(sg[0].x, sg[0].y); w.y = cvt_pk_bf16(sg[0].z, sg[0].w); w.z = cvt_pk_bf16(sg[1].x, sg[1].y); w.w = cvt_pk_bf16(sg[1].z, sg[1].w);
                    *(u32x4*)(sgc + off) = w;
                }
        }
    }
};
__device__ __forceinline__ void ph_inproj(const Params& P, LAS unsigned char* lds) {
    InprojSched S; S.G = gridDim.x; S.c = blockIdx.x; S.hx = (const char*)(P.ws + WS_HX); S.win = (const char*)(P.ws + WS_WIN); S.wv = (const char*)(P.ws + WS_WV);
    EpiInproj E; E.q = (bf16_t*)(P.ws + WS_Q); E.z = (bf16_t*)(P.ws + WS_Z); E.bb = (bf16_t*)(P.ws + WS_BB); E.rb = (bf16_t*)(P.ob + OB_RB); E.sgc = (bf16_t*)(P.ob + OB_SGC);
    E.kb = P.ws + WS_KB; E.kcb = P.ws + WS_KCB; E.vb = P.ws + WS_VB; E.vcb = P.ws + WS_VCB; E.rope = (const float*)(P.ws + WS_ROPE);
#ifdef FK_STAGGER_PROBE
    { const unsigned long long t0 = __builtin_amdgcn_s_memrealtime(); const unsigned long long dt = (unsigned long long)((blockIdx.x >> 3) & 31) * FK_STAGGER_PROBE;
      while (__builtin_amdgcn_s_memrealtime() - t0 < dt) __builtin_amdgcn_s_sleep(4); }
#endif
#if defined(FK_EPI2_PROBE)
    gemm_phase<EpiInproj, InprojSched, false, false, 3>(lds, 1024, S, E);
#elif defined(FK_KREP_INPROJ)
    gemm_phase<EpiInproj, InprojSched, false, false, 2>(lds, 1024, S, E);
#else
    gemm_phase<EpiInproj, InprojSched, false>(lds, 1024, S, E);
#endif
}

constexpr int CW_QUEUE = 3584;
__device__ __forceinline__ void ph_norm1(const Params& P, LAS unsigned char* lds) {
    const int tid = threadIdx.x, lane = tid & 63, wave = __builtin_amdgcn_readfirstlane(tid >> 6), wg = blockIdx.x, G = gridDim.x;
    constexpr int NC = MC / 256;
    if (wg < 2 * NC && G > 2 * NC) {
        const int tile = wg < NC ? wg : wg - NC;
        for (int r = wave * 4; r < 256; r += 32) norm1_rows<4>(P, M + tile * 256 + r, lane);
        asm volatile("s_waitcnt vmcnt(0)" ::: "memory");
        __syncthreads();
        CtxSched S; S.c = wg; S.hx = (const char*)(P.ws + WS_HX); S.win = (const char*)(P.ws + WS_WIN); S.wv = (const char*)(P.ws + WS_WV);
        EpiInproj E; E.q = nullptr; E.z = nullptr; E.bb = nullptr; E.rb = nullptr; E.sgc = nullptr;
        E.kb = P.ws + WS_KB; E.kcb = P.ws + WS_KCB; E.vb = P.ws + WS_VB; E.vcb = P.ws + WS_VCB; E.rope = (const float*)(P.ws + WS_ROPE);
        gemm_phase<EpiInproj, CtxSched, false>(lds, 1024, S, E);
        FK_STAMP_WG(14, 0);
    } else {
        const int nw = (G - 2 * NC) * 8, gw = (wg - 2 * NC) * 8 + wave;
        for (int row = gw * 4; row < M; row += nw * 4) norm1_rows<4>(P, row, lane);
        __syncthreads(); FK_STAMP_WG(12, 40);
    }
    unsigned* head = (unsigned*)(P.ws + WS_CTL) + CW_QUEUE;
    LAS unsigned* slot = (LAS unsigned*)(lds + LDS_MISC_Q);
    for (;;) {
        __syncthreads();
        if (tid == 0) slot[0] = __hip_atomic_fetch_add(head, 32u, __ATOMIC_RELAXED, __HIP_MEMORY_SCOPE_AGENT);
        __syncthreads();
        const int base = CV_IN + (int)slot[0];
        if (base >= CV_TOTAL) break;
#pragma unroll 1
        for (int k = 0; k < 4; ++k) { const int it = base + wave * 4 + k; if (it < CV_TOTAL) conv_item(P, it, lane); }
    }
    FK_STAMP_WG(13, 40); FK_STAMP_WG(15, 0);
}

__device__ __forceinline__ int crow(int r, int hi) { return (r & 3) + 8 * (r >> 2) + 4 * hi; }
#ifndef FK_ATT_THR
#define FK_ATT_THR 24.0f
#endif
constexpr float ATT_THR = FK_ATT_THR;
constexpr int ATT_NS = 5;
struct AttnUnitInfo { int b, hkv, qb, w_lo, nwin, ntile; };
__device__ __forceinline__ AttnUnitInfo attn_decode(int uidx) {
    AttnUnitInfo u; u.b = uidx >> 7; u.hkv = (uidx >> 5) & 3; u.qb = uidx & 31;
    u.w_lo = u.qb - 2 < 0 ? 0 : u.qb - 2; const int w_hi = u.qb + 2 > 31 ? 31 : u.qb + 2; u.nwin = w_hi - u.w_lo + 1; u.ntile = u.nwin + 4; return u;
}
__device__ __forceinline__ float max3f(float a, float b, float c) { float r; asm("v_max3_f32 %0, %1, %2, %3" : "=v"(r) : "v"(a), "v"(b), "v"(c)); return r; }
__device__ __forceinline__ void attn_finish(const Params& P, const f32x16& o0, const f32x16& o1, float lrun, int b, int hkv, int qb, int g, int wsub, int r32, int hi) {
    const float ltot = lrun + __shfl_xor(lrun, 32), inv = 1.f / ltot;
    bf16_t* AO = (bf16_t*)(P.ws + WS_AO) + (size_t)(b * T + qb * 64 + 32 * wsub + r32) * 2048 + (hkv * 4 + g) * 64 + 4 * hi;
#pragma unroll
    for (int g4 = 0; g4 < 4; ++g4) {
        u32x2 w; w.x = cvt_pk_bf16(o0[4 * g4] * inv, o0[4 * g4 + 1] * inv); w.y = cvt_pk_bf16(o0[4 * g4 + 2] * inv, o0[4 * g4 + 3] * inv); *(u32x2*)(AO + 8 * g4) = w;
        w.x = cvt_pk_bf16(o1[4 * g4] * inv, o1[4 * g4 + 1] * inv); w.y = cvt_pk_bf16(o1[4 * g4 + 2] * inv, o1[4 * g4 + 3] * inv); *(u32x2*)(AO + 32 + 8 * g4) = w;
    }
}
__device__ __forceinline__ void attn_drain(const Params& P, LAS unsigned char* lds, const f32x16& Pa, const f32x16& Pb, f32x16& o0, f32x16& o1, float lrun, int vslot,
                                           int cu, int nun, int ubase, int GY, int g, int wsub, int r32, int hi) {
    float sacc = 0.f;
#pragma unroll
    for (int r = 0; r < 16; ++r) sacc += Pa[r] + Pb[r];
    lrun += sacc;
    const LAS unsigned char* Vp = lds + vslot * 16384 + 8192 + hi * 1024 + r32 * 16;
#pragma unroll
    for (int ks = 0; ks < 4; ++ks) {
        const f32x16& S = ks < 2 ? Pa : Pb; const int o = 8 * (ks & 1);
        const u32x4 pw = (u32x4){cvt_pk_bf16(S[o], S[o + 1]), cvt_pk_bf16(S[o + 2], S[o + 3]), cvt_pk_bf16(S[o + 4], S[o + 5]), cvt_pk_bf16(S[o + 6], S[o + 7])};
        const bf16x8 v0 = *(const LAS bf16x8*)(Vp + (2 * ks) * 1024), v1 = *(const LAS bf16x8*)(Vp + (2 * ks) * 1024 + 512);
        const bf16x8 pb = __builtin_bit_cast(bf16x8, pw);
        o0 = __builtin_amdgcn_mfma_f32_32x32x16_bf16(v0, pb, o0, 0, 0, 0); o1 = __builtin_amdgcn_mfma_f32_32x32x16_bf16(v1, pb, o1, 0, 0, 0);
    }
    const AttnUnitInfo li = attn_decode(ubase + GY * (nun - 1));
    attn_finish(P, o0, o1, lrun, li.b, li.hkv, li.qb, g, wsub, r32, hi);
}
__device__ __forceinline__ void attn_phase(const Params& P, LAS unsigned char* lds) {
    const int tid = threadIdx.x, lane = tid & 63, wid = __builtin_amdgcn_readfirstlane(tid >> 6), r32 = lane & 31, hi = lane >> 5;
    constexpr int NU = NBF * 4 * 32;
    const int G = gridDim.x, xg = blockIdx.x & 7, yg = blockIdx.x >> 3, GY = G >> 3;
    const int nun = (NU / 8 - yg + GY - 1) / GY;
    if (nun <= 0) return;
    const int ubase = xg * (NU / 8) + yg;
    const bf16_t* Q = (const bf16_t*)(P.ws + WS_Q);
    const unsigned char* KB = P.ws + WS_KB; const unsigned char* VB = P.ws + WS_VB; const unsigned char* KCB = P.ws + WS_KCB; const unsigned char* VCB = P.ws + WS_VCB;
    const int g = wid >> 1, wsub = wid & 1;
#define AT_WAIT(n) asm volatile("s_waitcnt vmcnt(" #n ")" ::: "memory")
#define AT_SB() __builtin_amdgcn_sched_barrier(0)
    int pu = 0, pit = 0, pstep = 0, pslot = 0; AttnUnitInfo pinfo = attn_decode(ubase);
    auto issue = [&]() {
        const size_t bh = (size_t)(pinfo.b * 4 + pinfo.hkv);
        const unsigned char* ks = pit < pinfo.nwin ? KB + (bh * 32 + pinfo.w_lo + pit) * 8192 : KCB + (bh * 4 + (pit - pinfo.nwin)) * 8192;
        const unsigned char* vs = pit < pinfo.nwin ? VB + (bh * 32 + pinfo.w_lo + pit) * 8192 : VCB + (bh * 4 + (pit - pinfo.nwin)) * 8192;
        LAS unsigned char* dst = lds + pslot * 16384 + wid * 1024;
        __builtin_amdgcn_global_load_lds((const unsigned*)(ks + wid * 1024 + lane * 16), (LAS unsigned*)dst, 16, 0, 0);
        __builtin_amdgcn_global_load_lds((const unsigned*)(vs + wid * 1024 + lane * 16), (LAS unsigned*)(dst + 8192), 16, 0, 0);
        ++pstep; pslot = pslot == ATT_NS - 1 ? 0 : pslot + 1; ++pit;
        if (pit == pinfo.ntile) { pit = 0; ++pu; if (pu < nun) pinfo = attn_decode(ubase + GY * pu); }
    };
    int total = 0;
    for (int k = 0; k < nun; ++k) total += attn_decode(ubase + GY * k).ntile;
    *(LAS u32x4*)(lds + (ATT_NS - 1) * 16384 + 8192 + tid * 16) = (u32x4){0u, 0u, 0u, 0u};
    __syncthreads();
    int cu = 0, it = 0, step = 0, cslot = 0, vslot = ATT_NS - 1; AttnUnitInfo ci = attn_decode(ubase);
    int fb = 0, fhkv = 0, fqb = 0;
    constexpr int ATT_QOFF = ATT_NS * 16384;
    auto issueQ = [&](const AttnUnitInfo& ui) {
        const bf16_t* qp = Q + (size_t)(ui.b * T + ui.qb * 64 + 32 * wsub + r32) * 1024 + (ui.hkv * 4 + g) * 64 + hi * 8;
#pragma unroll
        for (int j = 0; j < 4; ++j)
            __builtin_amdgcn_global_load_lds((const unsigned*)(qp + 16 * j), (LAS unsigned*)(lds + ATT_QOFF + wid * 4096 + j * 1024), 16, 0, 0);
    };
    float sk0 = P.sink[0 * 4 + g] * LOG2E, sk1 = P.sink[1 * 4 + g] * LOG2E, sk2 = P.sink[2 * 4 + g] * LOG2E, sk3 = P.sink[3 * 4 + g] * LOG2E;
    asm volatile("s_waitcnt vmcnt(0)" : "+v"(sk0), "+v"(sk1), "+v"(sk2), "+v"(sk3) :: "memory");
    bf16x8 qf[4];
    float sink_c = 0.f;
    const f32x16 zero16 = {0.f, 0.f, 0.f, 0.f, 0.f, 0.f, 0.f, 0.f, 0.f, 0.f, 0.f, 0.f, 0.f, 0.f, 0.f, 0.f};
    f32x16 o0, o1, pA0, pA1, pB0, pB1;
    float mrun = 0.f, lrun = 0.f; bool slow = false;
#pragma unroll
    for (int r = 0; r < 16; ++r) { o0[r] = 0.f; o1[r] = 0.f; pA0[r] = 0.f; pA1[r] = 0.f; pB0[r] = 0.f; pB1[r] = 0.f; }
    bf16x8 fr[4]; u32x4 pw[4];
    issueQ(ci);
    issue(); if (total > 1) issue(); if (total > 2) issue();
    if (total > 2) AT_WAIT(2); else AT_WAIT(0);
    __builtin_amdgcn_s_barrier(); asm volatile("" ::: "memory");
    if (pstep < total) issue();
#define AT_FA(base, i) (*(const LAS bf16x8*)((base) + (((i) >> 1) * 2) * 1024 + ((i) & 1) * 512))
    { const LAS unsigned char* K0 = lds + hi * 1024 + r32 * 16; fr[0] = AT_FA(K0, 0); fr[1] = AT_FA(K0, 1); fr[2] = AT_FA(K0, 2); }

#define AT_PK(Pa, Pb, w) cvt_pk_bf16((w) < 8 ? Pa[2 * (w)] : Pb[2 * (w) - 16], (w) < 8 ? Pa[2 * (w) + 1] : Pb[2 * (w) - 15])
#define AT_PV(Pa, Pb, i) ((i) < 16 ? Pa[(i)] : Pb[(i) - 16])
#define AT_GAPA(gi, Cn, Pa, Pb) do { \
        Cn = __builtin_amdgcn_mfma_f32_32x32x16_bf16(fr[(gi) & 3], qf[(gi) >> 1], (gi) < 2 ? zero16 : Cn, 0, 0, 0); \
        if ((gi) + 3 < 8) fr[((gi) + 3) & 3] = AT_FA(Kc, (gi) + 3); else fr[((gi) + 3) & 3] = AT_FA(Vp, (gi) + 3 - 8); \
        sacc += AT_PV(Pa, Pb, 4 * (gi)) + AT_PV(Pa, Pb, 4 * (gi) + 1); sacc2 += AT_PV(Pa, Pb, 4 * (gi) + 2) + AT_PV(Pa, Pb, 4 * (gi) + 3); \
        pw[(gi) >> 1][2 * ((gi) & 1)] = AT_PK(Pa, Pb, 2 * (gi)); pw[(gi) >> 1][2 * ((gi) & 1) + 1] = AT_PK(Pa, Pb, 2 * (gi) + 1); AT_SB(); } while (0)
#define AT_GAPB(gi, Cx, cb) do { \
        if ((gi) & 1) o1 = __builtin_amdgcn_mfma_f32_32x32x16_bf16(fr[(gi) & 3], __builtin_bit_cast(bf16x8, pw[(gi) >> 1]), o1, 0, 0, 0); \
        else o0 = __builtin_amdgcn_mfma_f32_32x32x16_bf16(fr[(gi) & 3], __builtin_bit_cast(bf16x8, pw[(gi) >> 1]), o0, 0, 0, 0); \
        if ((gi) + 3 < 8) fr[((gi) + 3) & 3] = AT_FA(Vp, (gi) + 3); else fr[((gi) + 3) & 3] = AT_FA(Kn, (gi) + 3 - 8); \
        Cx[cb] = __builtin_amdgcn_exp2f(Cx[cb]); Cx[cb + 1] = __builtin_amdgcn_exp2f(Cx[cb + 1]); Cx[cb + 2] = __builtin_amdgcn_exp2f(Cx[cb + 2]); Cx[cb + 3] = __builtin_amdgcn_exp2f(Cx[cb + 3]); \
        AT_SB(); } while (0)
#define AT_STEP(C0, C1, Pa, Pb) do { \
        const bool first = (it == 0); \
        if (first) { fb = ci.b; fhkv = ci.hkv; fqb = ci.qb; if (step > 0) { const AttnUnitInfo pi = attn_decode(ubase + GY * (cu - 1)); fb = pi.b; fhkv = pi.hkv; fqb = pi.qb; } \
            sink_c = ci.hkv == 0 ? sk0 : ci.hkv == 1 ? sk1 : ci.hkv == 2 ? sk2 : sk3; mrun = 0.f; slow = false; \
            _Pragma("unroll") for (int ks = 0; ks < 4; ++ks) qf[ks] = *(const LAS bf16x8*)(lds + ATT_QOFF + wid * 4096 + (2 * ks + hi) * 512 + r32 * 16); \
            asm volatile("s_waitcnt lgkmcnt(0)" ::: "memory"); \
            if (cu + 1 < nun) issueQ(attn_decode(ubase + GY * (cu + 1))); } \
        const LAS unsigned char* Kc = lds + cslot * 16384 + hi * 1024 + r32 * 16; \
        const LAS unsigned char* Vp = lds + vslot * 16384 + 8192 + hi * 1024 + r32 * 16; \
        const int nslot = cslot == ATT_NS - 1 ? 0 : cslot + 1; \
        const LAS unsigned char* Kn = lds + nslot * 16384 + hi * 1024 + r32 * 16; \
        float sacc = 0.f, sacc2 = 0.f; AT_SB(); \
        AT_GAPA(0, C0, Pa, Pb); AT_GAPA(1, C1, Pa, Pb); AT_GAPA(2, C0, Pa, Pb); AT_GAPA(3, C1, Pa, Pb); AT_GAPA(4, C0, Pa, Pb); AT_GAPA(5, C1, Pa, Pb); AT_GAPA(6, C0, Pa, Pb); AT_GAPA(7, C1, Pa, Pb); \
        lrun += sacc + sacc2; \
        if (slow) { _Pragma("unroll") for (int r = 0; r < 16; ++r) { C0[r] -= mrun; C1[r] -= mrun; } } \
        if (it < ci.nwin) { const int wt = ci.w_lo + it, dq = wt - ci.qb; \
            if (dq == 2 || dq == -2) { const int base = ci.qb * 64 + 32 * wsub + r32 - 64 * wt; \
                _Pragma("unroll") for (int r = 0; r < 16; ++r) { const int d0 = base - crow(r, hi), d1 = d0 - 32; \
                    if (d0 > 128 || d0 < -128) C0[r] = -1e30f; if (d1 > 128 || d1 < -128) C1[r] = -1e30f; } } } \
        float mx; { float ma = max3f(C0[0], C0[1], C1[0]), mb = max3f(C0[2], C0[3], C1[1]); ma = max3f(ma, C1[2], C1[3]); \
            _Pragma("unroll") for (int r = 4; r < 16; r += 4) { ma = max3f(ma, C0[r], C0[r + 1]); mb = max3f(mb, C0[r + 2], C0[r + 3]); ma = max3f(ma, C1[r], C1[r + 1]); mb = max3f(mb, C1[r + 2], C1[r + 3]); } \
            mx = fmaxf(ma, mb); mx = fmaxf(mx, __shfl_xor(mx, 32)); } \
        float fres = 1.f; bool resc = false; \
        if (__any(mx > ATT_THR)) { const float dl = fmaxf(mx, 0.f); fres = __builtin_amdgcn_exp2f(-dl); mrun += dl; resc = true; slow = true; \
            _Pragma("unroll") for (int r = 0; r < 16; ++r) { C0[r] -= dl; C1[r] -= dl; } } \
        AT_SB(); \
        AT_GAPB(0, C0, 0); AT_GAPB(1, C0, 4); AT_GAPB(2, C0, 8); AT_GAPB(3, C0, 12); AT_GAPB(4, C1, 0); AT_GAPB(5, C1, 4); AT_GAPB(6, C1, 8); AT_GAPB(7, C1, 12); \
        if (first && step > 0) { attn_finish(P, o0, o1, lrun, fb, fhkv, fqb, g, wsub, r32, hi); \
            _Pragma("unroll") for (int r = 0; r < 16; ++r) { o0[r] = 0.f; o1[r] = 0.f; } lrun = (hi == 0 ? __builtin_amdgcn_exp2f(sink_c) : 0.f) * fres; } \
        else if (first) { lrun = (hi == 0 ? __builtin_amdgcn_exp2f(sink_c) : 0.f) * fres; } \
        else if (resc) { lrun *= fres; _Pragma("unroll") for (int r = 0; r < 16; ++r) { o0[r] *= fres; o1[r] *= fres; } } \
        ++it; ++step; vslot = cslot; cslot = nslot; \
        if (it == ci.ntile) { it = 0; ++cu; if (cu < nun) ci = attn_decode(ubase + GY * cu); } \
        if (step < total) { \
            const int ahead = pstep - step;        \
            if (ahead >= 3) AT_WAIT(2); else AT_WAIT(0); \
            __builtin_amdgcn_s_barrier(); asm volatile("" ::: "memory"); \
            if (pstep < total) issue(); \
        } } while (0)

    while (step < total) {
        AT_STEP(pB0, pB1, pA0, pA1);
        if (step >= total) {
            attn_drain(P, lds, pB0, pB1, o0, o1, lrun, vslot, cu, nun, ubase, GY, g, wsub, r32, hi);
            break; }
        AT_STEP(pA0, pA1, pB0, pB1);
        if (step >= total) { attn_drain(P, lds, pA0, pA1, o0, o1, lrun, vslot, cu, nun, ubase, GY, g, wsub, r32, hi); break; }
    }
    AT_WAIT(0);
    __syncthreads();
#undef AT_STEP
#undef AT_GAPA
#undef AT_GAPB
#undef AT_PK
#undef AT_PV
#undef AT_FA
#undef AT_WAIT
#undef AT_SB
}
__device__ __forceinline__ void ph_mix(const Params& P, LAS unsigned char* lds) {
    const int G = gridDim.x;
    attn_phase(P, lds);
#if (FK_DBL >> 11) & 1
    attn_phase(P, lds);
#endif
#if (FK_DBL >> 12) & 1
    for (int rep = 0; rep < 2; ++rep)
#endif
    const bf16_t* Z = (const bf16_t*)(P.ws + WS_Z); const bf16_t* BB = (const bf16_t*)(P.ws + WS_BB); bf16_t* AO = (bf16_t*)(P.ws + WS_AO);
    for (int it = blockIdx.x * 512 + threadIdx.x; it < (M / 16) * 128; it += G * 512) {
        const int cch = it & 127, tr = it >> 7, row0 = tr * 16, tl = row0 & 2047;
        const f32x4 wa = *(const f32x4*)(P.conv_w + cch * 8), wb = *(const f32x4*)(P.conv_w + cch * 8 + 4);
        const f32x4 wc0 = *(const f32x4*)(P.conv_w + 1024 + cch * 8), wc1 = *(const f32x4*)(P.conv_w + 1024 + cch * 8 + 4);
        const f32x4 we0 = *(const f32x4*)(P.conv_w + 2048 + cch * 8), we1 = *(const f32x4*)(P.conv_w + 2048 + cch * 8 + 4);
        const bf16_t* zp = Z + (size_t)row0 * 1024 + cch * 8;
        u32x4 zm = tl > 0 ? *(const u32x4*)(zp - 1024) : (u32x4){0u, 0u, 0u, 0u};
        u32x4 zc = *(const u32x4*)zp;
#pragma unroll 4
        for (int i = 0; i < 16; ++i) {
            const u32x4 zn = (tl + i + 1 < 2048) ? *(const u32x4*)(zp + (size_t)(i + 1) * 1024) : (u32x4){0u, 0u, 0u, 0u};
            const u32x4 bv = *(const u32x4*)(BB + (size_t)(row0 + i) * 1024 + cch * 8);
            float y[8];
#pragma unroll
            for (int k = 0; k < 4; ++k) {
                const float w0l = k < 2 ? wa[2 * k] : wb[2 * k - 4], w0h = k < 2 ? wa[2 * k + 1] : wb[2 * k - 3];
                const float w1l = k < 2 ? wc0[2 * k] : wc1[2 * k - 4], w1h = k < 2 ? wc0[2 * k + 1] : wc1[2 * k - 3];
                const float w2l = k < 2 ? we0[2 * k] : we1[2 * k - 4], w2h = k < 2 ? we0[2 * k + 1] : we1[2 * k - 3];
                y[2 * k] = bf_lo(bv[k]) * (w0l * bf_lo(zm[k]) + w1l * bf_lo(zc[k]) + w2l * bf_lo(zn[k]));
                y[2 * k + 1] = bf_hi(bv[k]) * (w0h * bf_hi(zm[k]) + w1h * bf_hi(zc[k]) + w2h * bf_hi(zn[k]));
            }
            u32x4 o; o.x = cvt_pk_bf16(y[0], y[1]); o.y = cvt_pk_bf16(y[2], y[3]); o.z = cvt_pk_bf16(y[4], y[5]); o.w = cvt_pk_bf16(y[6], y[7]);
            *(u32x4*)(AO + (size_t)(row0 + i) * 2048 + 1024 + cch * 8) = o;
            zm = zc; zc = zn;
        }
    }
}

struct RowColSched {
    int G, c, nM, nN; const char *A, *B; size_t ts;
    __device__ __forceinline__ bool next(int i, Unit& u) const {
        const int nwg = nM * nN, Lx = i * G + c; if (Lx >= nwg) return false;
        const int wgid = (Lx % 8) * (nwg / 8) + Lx / 8;
        const int nig = 8 * nN, gid = wgid / nig, w = wgid % nig;
        u.pm = gid * 8 + (w % 8); u.pn = w / 8; u.a = A + (size_t)u.pm * ts; u.b = B + (size_t)u.pn * ts; u.kind = 0; u.aux = 0; u.rows = nullptr; return true;
    }
};
struct EpiProj {
    const bf16_t *rb, *sgc; bf16_t* mb;
    __device__ __forceinline__ void mid(f32x4 (&acc)[2][2][4][2], const Unit& u, int wr, int wc, int fr, int fq) const {
#pragma unroll
        for (int ai = 0; ai < 2; ++ai)
#pragma unroll
            for (int m = 0; m < 4; ++m) { const int r = u.pm * 256 + 128 * ai + 64 * wr + 16 * m + fr;
#pragma unroll
                for (int bj = 0; bj < 2; ++bj) { const u32x4 w = *(const u32x4*)(rb + (size_t)r * 1024 + u.pn * 256 + 128 * bj + 32 * wc + 8 * fq);
                    acc[ai][bj][m][0] *= (f32x4){bf_lo(w.x), bf_hi(w.x), bf_lo(w.y), bf_hi(w.y)}; acc[ai][bj][m][1] *= (f32x4){bf_lo(w.z), bf_hi(w.z), bf_lo(w.w), bf_hi(w.w)}; } }
    }
    __device__ __forceinline__ void operator()(const f32x4 (&acc)[2][2][4][2], const Unit& u, int wr, int wc, int fr, int fq) const {
#pragma unroll
        for (int ai = 0; ai < 2; ++ai)
#pragma unroll
            for (int m = 0; m < 4; ++m) { const int r = u.pm * 256 + 128 * ai + 64 * wr + 16 * m + fr;
#pragma unroll
                for (int bj = 0; bj < 2; ++bj) { const size_t off = (size_t)r * 1024 + u.pn * 256 + 128 * bj + 32 * wc + 8 * fq; const u32x4 w = *(const u32x4*)(sgc + off);
                    const f32x4 v0 = acc[ai][bj][m][0] * (f32x4){bf_lo(w.x), bf_hi(w.x), bf_lo(w.y), bf_hi(w.y)}, v1 = acc[ai][bj][m][1] * (f32x4){bf_lo(w.z), bf_hi(w.z), bf_lo(w.w), bf_hi(w.w)};
                    u32x4 o; o.x = cvt_pk_bf16(v0.x, v0.y); o.y = cvt_pk_bf16(v0.z, v0.w); o.z = cvt_pk_bf16(v1.x, v1.y); o.w = cvt_pk_bf16(v1.z, v1.w);
                    *(u32x4*)(mb + off) = o; } }
    }
};
__device__ __forceinline__ void ph_proj(const Params& P, LAS unsigned char* lds) {
    RowColSched S; S.G = gridDim.x; S.c = blockIdx.x; S.nM = M / 256; S.nN = 4; S.A = (const char*)(P.ws + WS_AO); S.B = (const char*)(P.ws + WS_WP); S.ts = (size_t)256 * 2048 * 2;
    EpiProj E; E.rb = (const bf16_t*)(P.ob + OB_RB); E.sgc = (const bf16_t*)(P.ob + OB_SGC); E.mb = (bf16_t*)(P.ws + WS_MB);
    gemm_phase<EpiProj, RowColSched, true>(lds, 2048, S, E);
}
struct EpiOut {
    const float* mod; bf16_t* dl;
    __device__ __forceinline__ void operator()(const f32x4 (&acc)[2][2][4][2], const Unit& u, int wr, int wc, int fr, int fq) const {
        const int b = (u.pm * 256) >> 11;
#pragma unroll
        for (int bj = 0; bj < 2; ++bj) { const int col = u.pn * 256 + 128 * bj + 32 * wc + 8 * fq;
            const f32x4 g0 = *(const f32x4*)(mod + b * 6144 + 2048 + col), g1 = *(const f32x4*)(mod + b * 6144 + 2048 + col + 4);
#pragma unroll
            for (int ai = 0; ai < 2; ++ai)
#pragma unroll
                for (int m = 0; m < 4; ++m) { const size_t off = (size_t)(u.pm * 256 + 128 * ai + 64 * wr + 16 * m + fr) * 1024 + col;
                    const f32x4 v0 = g0 * acc[ai][bj][m][0], v1 = g1 * acc[ai][bj][m][1];
                    u32x4 w; w.x = cvt_pk_bf16(v0.x, v0.y); w.y = cvt_pk_bf16(v0.z, v0.w); w.z = cvt_pk_bf16(v1.x, v1.y); w.w = cvt_pk_bf16(v1.z, v1.w);
                    *(u32x4*)(dl + off) = w; } }
    }
};
__device__ __forceinline__ void ph_out(const Params& P, LAS unsigned char* lds) {
    RowColSched S; S.G = gridDim.x; S.c = blockIdx.x; S.nM = M / 256; S.nN = 4; S.A = (const char*)(P.ws + WS_MB); S.B = (const char*)(P.ws + WS_WO); S.ts = (size_t)256 * 1024 * 2;
    EpiOut E; E.mod = (const float*)(P.ws + WS_MOD); E.dl = (bf16_t*)(P.ws + WS_DL);
    gemm_phase<EpiOut, RowColSched, false>(lds, 1024, S, E);
}

__device__ __forceinline__ void ph_router(const Params& P, LAS unsigned char* lds) {
    const int tid = threadIdx.x, lane = tid & 63, wave = tid >> 6;
    LAS float* wt = (LAS float*)lds;
    for (int i = tid; i < 16384; i += 512) { const int k = i >> 4, e = i & 15; wt[e * 1024 + k] = P.w_router[i]; }
    __syncthreads();
    const bf16_t* DL = (const bf16_t*)(P.ws + WS_DL); const float* mod = (const float*)(P.ws + WS_MOD);
    bf16_t* HX2 = (bf16_t*)(P.ws + WS_HX2); float* AFF = (float*)(P.ws + WS_AFF);
    f32x4 nx0[4], nx1[4]; u32x4 nd0[2], nd1[2];
    const int rp0 = blockIdx.x * 8 + wave, rstep = gridDim.x * 8;
#define RT_LOAD(rpv) do { _Pragma("unroll") for (int j = 0; j < 2; ++j) { const size_t o0 = (size_t)((rpv) * 2) * D + 8 * lane + 512 * j; \
        nx0[2 * j] = *(const f32x4*)(P.x + o0); nx0[2 * j + 1] = *(const f32x4*)(P.x + o0 + 4); nx1[2 * j] = *(const f32x4*)(P.x + o0 + D); nx1[2 * j + 1] = *(const f32x4*)(P.x + o0 + D + 4); \
        nd0[j] = *(const u32x4*)(DL + o0); nd1[j] = *(const u32x4*)(DL + o0 + D); } } while (0)
    if (rp0 < M / 2) RT_LOAD(rp0);
    for (int rp = rp0; rp < M / 2; rp += rstep) {
        const int row = rp * 2, b = row >> 11; const float* mv = mod + b * 6144;
        f32x4 v0[4], v1[4]; float s0 = 0.f, s1 = 0.f;
#pragma unroll
        for (int j = 0; j < 2; ++j) { f32x4 a, c; bf8_to_f32(nd0[j], a, c); v0[2 * j] = nx0[2 * j] + a; v0[2 * j + 1] = nx0[2 * j + 1] + c; bf8_to_f32(nd1[j], a, c); v1[2 * j] = nx1[2 * j] + a; v1[2 * j + 1] = nx1[2 * j + 1] + c;
            s0 += sq4(v0[2 * j]) + sq4(v0[2 * j + 1]); s1 += sq4(v1[2 * j]) + sq4(v1[2 * j + 1]); }
        if (rp + rstep < M / 2) RT_LOAD(rp + rstep);
        const float r0 = 1.0f / sqrtf(wave_sum(s0) * (1.f / D) + 1e-6f), r1 = 1.0f / sqrtf(wave_sum(s1) * (1.f / D) + 1e-6f);
#pragma unroll
        for (int j = 0; j < 2; ++j) { const int c0 = 8 * lane + 512 * j;
            const f32x4 g0 = *(const f32x4*)(P.norm2_g + c0) * (*(const f32x4*)(mv + 4096 + c0) + 1.0f), g1 = *(const f32x4*)(P.norm2_g + c0 + 4) * (*(const f32x4*)(mv + 4096 + c0 + 4) + 1.0f);
            const f32x4 sh0 = *(const f32x4*)(mv + 3072 + c0), sh1 = *(const f32x4*)(mv + 3072 + c0 + 4);
            v0[2 * j] = v0[2 * j] * r0 * g0 + sh0; v0[2 * j + 1] = v0[2 * j + 1] * r0 * g1 + sh1; v1[2 * j] = v1[2 * j] * r1 * g0 + sh0; v1[2 * j + 1] = v1[2 * j + 1] * r1 * g1 + sh1;
            *(u32x4*)(HX2 + (size_t)row * D + c0) = f32_to_bf8(v0[2 * j], v0[2 * j + 1]); *(u32x4*)(HX2 + (size_t)(row + 1) * D + c0) = f32_to_bf8(v1[2 * j], v1[2 * j + 1]); }
        float pa[16], pc[16];
#pragma unroll
        for (int e = 0; e < 16; ++e) { float a = 0.f, c = 0.f;
#pragma unroll
            for (int j = 0; j < 4; ++j) { const f32x4 w = *(const LAS f32x4*)(wt + e * 1024 + 8 * lane + 512 * (j >> 1) + 4 * (j & 1));
                a += dot4(v0[j], w); c += dot4(v1[j], w); }
            pa[e] = a; pc[e] = c;
            if ((e & 1) == 1) __builtin_amdgcn_sched_barrier(0); }
#define RT_HALVE(H, DIST) do { const bool up = (lane & (DIST)) != 0; _Pragma("unroll") for (int i = 0; i < (H); ++i) { \
            const float ka = up ? pa[i + (H)] : pa[i], sa = up ? pa[i] : pa[i + (H)], kc = up ? pc[i + (H)] : pc[i], sc = up ? pc[i] : pc[i + (H)]; \
            pa[i] = ka + __shfl_xor(sa, (DIST)); pc[i] = kc + __shfl_xor(sc, (DIST)); } } while (0)
        RT_HALVE(8, 32); RT_HALVE(4, 16); RT_HALVE(2, 8); RT_HALVE(1, 4);
#undef RT_HALVE
        float l0 = pa[0], l1 = pc[0];
        l0 += __shfl_xor(l0, 2); l1 += __shfl_xor(l1, 2); l0 += __shfl_xor(l0, 1); l1 += __shfl_xor(l1, 1);
        float m0 = l0, m1 = l1;
#pragma unroll
        for (int o = 4; o < 64; o <<= 1) { m0 = fmaxf(m0, __shfl_xor(m0, o)); m1 = fmaxf(m1, __shfl_xor(m1, o)); }
        const float e0 = expf(l0 - m0), e1 = expf(l1 - m1);
        float z0 = e0, z1 = e1;
#pragma unroll
        for (int o = 4; o < 64; o <<= 1) { z0 += __shfl_xor(z0, o); z1 += __shfl_xor(z1, o); }
        if ((lane & 3) == 0) { const int ex = ((lane >> 5) & 1) * 8 + ((lane >> 4) & 1) * 4 + ((lane >> 3) & 1) * 2 + ((lane >> 2) & 1); const int t = row & 2047;
            AFF[(size_t)(b * 16 + ex) * T + t] = e0 / z0; AFF[(size_t)(b * 16 + ex) * T + t + 1] = e1 / z1; }
    }
}

__device__ __forceinline__ int block_count4(bool p0, bool p1, bool p2, bool p3, LAS int* red, int par, int wave, int lane) {
    const int c = __builtin_popcountll(__ballot(p0)) + __builtin_popcountll(__ballot(p1)) + __builtin_popcountll(__ballot(p2)) + __builtin_popcountll(__ballot(p3));
    if (lane == 0) red[par * 8 + wave] = c;
    __syncthreads();
    const LAS int* r = red + par * 8;
    return (r[0] + r[1]) + (r[2] + r[3]) + (r[4] + r[5]) + (r[6] + r[7]);
}
__device__ __forceinline__ int block_excl_prefix(int v, LAS int* red, int wave, int lane, int& total) {
    int inc = v;
#pragma unroll
    for (int o = 1; o < 64; o <<= 1) { const int n = __shfl_up(inc, o); if (lane >= o) inc += n; }
    __syncthreads();
    if (lane == 63) red[wave] = inc;
    __syncthreads();
    int base = 0, tot = 0;
#pragma unroll
    for (int w = 0; w < 8; ++w) { const int s = red[w]; if (w < wave) base += s; tot += s; }
    total = tot; return base + inc - v;
}
__device__ __forceinline__ void ph_topk(const Params& P, LAS unsigned char* lds) {
    const int tid = threadIdx.x, lane = tid & 63, wave = tid >> 6;
    LAS int* red = (LAS int*)lds;
    const float* AFF = (const float*)(P.ws + WS_AFF); int* IDX = (int*)(P.ws + WS_IDX); float* GATE = (float*)(P.ws + WS_GATE); int* SEL = (int*)(P.ws + WS_SEL);
    for (int be = blockIdx.x; be < NBF * 16; be += gridDim.x) {
        const int b = be >> 4, e = be & 15;
        const u32x4 kv = *(const u32x4*)(AFF + (size_t)be * T + tid * 4);
        unsigned thr = 0u;
        for (int bit = 31; bit >= 0; --bit) { const unsigned cand = thr | (1u << bit);
            const int cnt = block_count4(kv.x >= cand, kv.y >= cand, kv.z >= cand, kv.w >= cand, red, bit & 1, wave, lane);
            if (cnt >= CAP) thr = cand; }
        const int ngt = block_count4(kv.x > thr, kv.y > thr, kv.z > thr, kv.w > thr, red, 1, wave, lane);
        const int need = CAP - ngt;
        int tot;
        const int e0 = kv.x == thr, e1 = kv.y == thr, e2 = kv.z == thr, e3 = kv.w == thr;
        const int eqb = block_excl_prefix(e0 + e1 + e2 + e3, red + 32, wave, lane, tot);
        const int s0 = (kv.x > thr) || (e0 && eqb < need), s1 = (kv.y > thr) || (e1 && eqb + e0 < need), s2 = (kv.z > thr) || (e2 && eqb + e0 + e1 < need),
                  s3 = (kv.w > thr) || (e3 && eqb + e0 + e1 + e2 < need);
        const int sb = block_excl_prefix(s0 + s1 + s2 + s3, red + 32, wave, lane, tot);
        const int p0 = sb, p1 = sb + s0, p2 = p1 + s1, p3 = p2 + s2;
        const int t0 = 4 * tid;
        if (s0) { IDX[be * CAP + p0] = t0; GATE[be * CAP + p0] = __uint_as_float(kv.x); }
        if (s1) { IDX[be * CAP + p1] = t0 + 1; GATE[be * CAP + p1] = __uint_as_float(kv.y); }
        if (s2) { IDX[be * CAP + p2] = t0 + 2; GATE[be * CAP + p2] = __uint_as_float(kv.z); }
        if (s3) { IDX[be * CAP + p3] = t0 + 3; GATE[be * CAP + p3] = __uint_as_float(kv.w); }
        SEL[(size_t)(b * T + t0) * 16 + e] = s0 ? p0 : -1; SEL[(size_t)(b * T + t0 + 1) * 16 + e] = s1 ? p1 : -1;
        SEL[(size_t)(b * T + t0 + 2) * 16 + e] = s2 ? p2 : -1; SEL[(size_t)(b * T + t0 + 3) * 16 + e] = s3 ? p3 : -1;
        __syncthreads();
    }
}

struct MoeUpSched {
    int G, c; const char *hx2, *wgu; const int* idx;
    __device__ __forceinline__ bool next(int i, Unit& u) const {
        const int Lx = i * G + c; if (Lx >= NBF * 128) return false;
        const int x = Lx & 7, j = Lx >> 3, e = 2 * x + j / (NBF * 8), jj = j % (NBF * 8), rg = jj >> 5, w = jj & 31;
        const int smp = 8 * (rg >> 1) + (w & 7), pn = 4 * (rg & 1) + (w >> 3), be = smp * 16 + e;
        u.pm = be; u.pn = pn; u.kind = 0; u.aux = e; u.a = hx2 + (size_t)smp * ((size_t)T * 1024 * 2); u.rows = idx + be * CAP; u.b = wgu + ((size_t)e * 2048 + pn * 256) * 2048; return true;
    }
};
struct EpiUp {
    bf16_t* hb;
    __device__ __forceinline__ void operator()(const f32x4 (&acc)[2][2][4][2], const Unit& u, int wr, int wc, int fr, int fq) const {
#pragma unroll
        for (int ai = 0; ai < 2; ++ai)
#pragma unroll
            for (int m = 0; m < 4; ++m) { const int r = u.pm * 256 + 128 * ai + 64 * wr + 16 * m + fr;
                f32x4 h[2];
#pragma unroll
                for (int n = 0; n < 2; ++n)
#pragma unroll
                    for (int j = 0; j < 4; ++j) { const float a = acc[ai][0][m][n][j]; h[n][j] = a * __builtin_amdgcn_rcpf(1.f + __expf(-a)) * acc[ai][1][m][n][j]; }
                u32x4 w; w.x = cvt_pk_bf16(h[0].x, h[0].y); w.y = cvt_pk_bf16(h[0].z, h[0].w); w.z = cvt_pk_bf16(h[1].x, h[1].y); w.w = cvt_pk_bf16(h[1].z, h[1].w);
                *(u32x4*)(hb + (size_t)r * 1024 + u.pn * 128 + 32 * wc + 8 * fq) = w; }
    }
};
__device__ __forceinline__ void ph_moe_up(const Params& P, LAS unsigned char* lds) {
    MoeUpSched S; S.G = gridDim.x; S.c = blockIdx.x; S.hx2 = (const char*)(P.ws + WS_HX2); S.idx = (const int*)(P.ws + WS_IDX); S.wgu = (const char*)(P.ws + WS_WGU);
    EpiUp E; E.hb = (bf16_t*)(P.ob + OB_HB);
    gemm_phase<EpiUp, MoeUpSched, false, true>(lds, 1024, S, E);
}
struct MoeDownSched {
    int G, c; const char *hb, *wd;
    __device__ __forceinline__ bool next(int i, Unit& u) const {
        const int Lx = i * G + c; if (Lx >= NBF * 64) return false;
        const int x = Lx & 7, j = Lx >> 3, e = 2 * x + j / (NBF * 4), jj = j % (NBF * 4), rg = jj >> 5, w = jj & 31;
        const int smp = 8 * rg + (w & 7), pn = w >> 3, be = smp * 16 + e;
        u.pm = be; u.pn = pn; u.kind = 0; u.aux = e; u.rows = nullptr; u.a = hb + (size_t)be * (256 * 1024 * 2); u.b = wd + ((size_t)e * 1024 + pn * 256) * 2048; return true;
    }
};
struct EpiDown {
    const float* gate; bf16_t* ye;
    __device__ __forceinline__ void operator()(const f32x4 (&acc)[2][2][4][2], const Unit& u, int wr, int wc, int fr, int fq) const {
#pragma unroll
        for (int ai = 0; ai < 2; ++ai)
#pragma unroll
            for (int m = 0; m < 4; ++m) { const int r = u.pm * 256 + 128 * ai + 64 * wr + 16 * m + fr; const float gt = gate[r];
#pragma unroll
                for (int bj = 0; bj < 2; ++bj) { const f32x4 v0 = acc[ai][bj][m][0] * gt, v1 = acc[ai][bj][m][1] * gt;
                    u32x4 w; w.x = cvt_pk_bf16(v0.x, v0.y); w.y = cvt_pk_bf16(v0.z, v0.w); w.z = cvt_pk_bf16(v1.x, v1.y); w.w = cvt_pk_bf16(v1.z, v1.w);
                    *(u32x4*)(ye + (size_t)r * 1024 + u.pn * 256 + 128 * bj + 32 * wc + 8 * fq) = w; } }
    }
};
__device__ __forceinline__ void ph_moe_down(const Params& P, LAS unsigned char* lds) {
    MoeDownSched S; S.G = gridDim.x; S.c = blockIdx.x; S.hb = (const char*)(P.ob + OB_HB); S.wd = (const char*)(P.ws + WS_WD);
    EpiDown E; E.gate = (const float*)(P.ws + WS_GATE); E.ye = (bf16_t*)(P.ws + WS_YE);
    gemm_phase<EpiDown, MoeDownSched, false>(lds, 1024, S, E);
}

__device__ __forceinline__ void ph_final(const Params& P) {
    const int lane = threadIdx.x & 63, wave = threadIdx.x >> 6;
    const bf16_t* DL = (const bf16_t*)(P.ws + WS_DL); const float* mod = (const float*)(P.ws + WS_MOD); const int* SEL = (const int*)(P.ws + WS_SEL); const bf16_t* YE = (const bf16_t*)(P.ws + WS_YE);
    constexpr int NR = 2;
#ifdef FK_TS
    float ts_eps; { const unsigned long long* tsp = (const unsigned long long*)(P.ws + WS_CTL) + 1800;
        const unsigned long long t0 = __hip_atomic_load(tsp + FK_TS, __ATOMIC_RELAXED, __HIP_MEMORY_SCOPE_AGENT); unsigned long long t1 = 0ull;
        for (int sp = 0; sp < 100000 && (t1 = __hip_atomic_load(tsp + FK_TS2, __ATOMIC_RELAXED, __HIP_MEMORY_SCOPE_AGENT)) == 0ull; ++sp) __builtin_amdgcn_s_sleep(2);
        ts_eps = (float)(t1 - t0) * FK_TS_SCALE; }
#endif
    for (int row0 = (blockIdx.x * 8 + wave) * NR; row0 < M; row0 += gridDim.x * 8 * NR) {
        const int b = row0 >> 11;
        int sv[NR]; f32x4 xv[NR][4]; u32x4 dv[NR][2];
#pragma unroll
        for (int r = 0; r < NR; ++r) { sv[r] = SEL[(size_t)(row0 + r) * 16 + (lane & 15)];
#pragma unroll
            for (int j = 0; j < 2; ++j) { const size_t o = (size_t)(row0 + r) * D + 8 * lane + 512 * j; xv[r][2 * j] = *(const f32x4*)(P.x + o); xv[r][2 * j + 1] = *(const f32x4*)(P.x + o + 4); dv[r][j] = *(const u32x4*)(DL + o); } }
        f32x4 mo[NR][4];
#pragma unroll
        for (int r = 0; r < NR; ++r)
#pragma unroll
            for (int j = 0; j < 4; ++j) mo[r][j] = (f32x4){0.f, 0.f, 0.f, 0.f};
#pragma unroll
        for (int e = 0; e < 16; ++e) {
#pragma unroll
            for (int r = 0; r < NR; ++r) { const int sl = __builtin_amdgcn_readlane(sv[r], e);
                if (sl >= 0) { const bf16_t* yr = YE + ((size_t)(b * 16 + e) * CAP + sl) * D + 8 * lane;
#pragma unroll
                    for (int j = 0; j < 2; ++j) { f32x4 a, c; bf8_to_f32(*(const u32x4*)(yr + 512 * j), a, c); mo[r][2 * j] += a; mo[r][2 * j + 1] += c; } } } }
#pragma unroll
        for (int r = 0; r < NR; ++r) { float ss = 0.f; f32x4 v[4];
#pragma unroll
            for (int j = 0; j < 2; ++j) { const int c0 = 8 * lane + 512 * j; f32x4 a, c; bf8_to_f32(dv[r][j], a, c);
                v[2 * j] = xv[r][2 * j] + a + *(const f32x4*)(mod + b * 6144 + 5120 + c0) * mo[r][2 * j]; v[2 * j + 1] = xv[r][2 * j + 1] + c + *(const f32x4*)(mod + b * 6144 + 5120 + c0 + 4) * mo[r][2 * j + 1];
                ss += sq4(v[2 * j]) + sq4(v[2 * j + 1]); }
            const float rs = 1.0f / sqrtf(wave_sum(ss) * (1.f / D) + 1e-6f);
#pragma unroll
            for (int j = 0; j < 2; ++j) { const int c0 = 8 * lane + 512 * j;
#ifdef FK_TS
                { const f32x4 tsa = {1.f + ts_eps, 1.f - ts_eps, 1.f + ts_eps, 1.f - ts_eps};
                  *(f32x4*)(P.out + (size_t)(row0 + r) * D + c0) = v[2 * j] * rs * *(const f32x4*)(P.fg + c0) * tsa; *(f32x4*)(P.out + (size_t)(row0 + r) * D + c0 + 4) = v[2 * j + 1] * rs * *(const f32x4*)(P.fg + c0 + 4) * tsa; } } }
#else
                *(f32x4*)(P.out + (size_t)(row0 + r) * D + c0) = v[2 * j] * rs * *(const f32x4*)(P.fg + c0); *(f32x4*)(P.out + (size_t)(row0 + r) * D + c0 + 4) = v[2 * j + 1] * rs * *(const f32x4*)(P.fg + c0 + 4); } }
#endif
    }
}

#define XB_TMO      128
#define XB_XCNT(j)  (256  + 64 * (j))
#define XB_XSUB(j)  (1280 + 64 * (j))
#define XB_XGEN(j)  (2304 + 64 * (j))
#define XB_TOP      3328
#define XB_TOPGEN   3392
#define XCD_BAR_WORDS 3456
#define XB_SPIN_CAP (1u << 20)
__device__ __forceinline__ unsigned xb_ld(unsigned* p)              { return __hip_atomic_load(p, __ATOMIC_RELAXED, __HIP_MEMORY_SCOPE_AGENT); }
__device__ __forceinline__ unsigned xb_add(unsigned* p, unsigned v) { return __hip_atomic_fetch_add(p, v, __ATOMIC_RELAXED, __HIP_MEMORY_SCOPE_AGENT); }
__device__ __forceinline__ unsigned xb_xcc_id() { return (unsigned)__builtin_amdgcn_s_getreg((3 << 11) | 20) & 0xFu; }
#define XB_SPIN(cond, bar) do { unsigned _sp = 0; while (cond) { __builtin_amdgcn_s_sleep(1); \
    if ((++_sp & 255u) == 0u) { if (xb_ld(&(bar)[XB_TMO])) break; if (_sp > XB_SPIN_CAP) { atomicAdd(&(bar)[XB_TMO], 1u); break; } } } } while (0)
struct XcdBarrier { unsigned* bar; unsigned x; volatile LAS unsigned* st; };
__device__ __forceinline__ XcdBarrier xcd_barrier_post(unsigned* bar, volatile LAS unsigned* st) {
    XcdBarrier b; b.bar = bar; b.x = xb_xcc_id(); b.st = st;
    if (threadIdx.x == 0) (void)xb_add(&bar[XB_XCNT(b.x)], 1u);
    return b;
}
__device__ __forceinline__ void xcd_barrier_complete(unsigned* bar, unsigned x, unsigned& nloc, unsigned& nx) {
    const unsigned G = gridDim.x * gridDim.y * gridDim.z;
    unsigned sum, cnt, mine, sp = 0u;
    for (;;) {
        sum = 0u; cnt = 0u; mine = 0u;
#pragma unroll
        for (unsigned j = 0; j < 16; ++j) { const unsigned c = xb_ld(&bar[XB_XCNT(j)]); sum += c; cnt += (c > 0u) ? 1u : 0u; mine = (j == x) ? c : mine; }
        if (sum == G) break;
        __builtin_amdgcn_s_sleep(1);
        if ((++sp & 255u) == 0u) { if (xb_ld(&bar[XB_TMO])) break; if (sp > XB_SPIN_CAP) { atomicAdd(&bar[XB_TMO], 1u); break; } }
    }
    nloc = mine > 0u ? mine : 1u; nx = cnt > 0u ? cnt : 1u;
}
__device__ __forceinline__ void xcd_barrier(const XcdBarrier& b) {
    asm volatile("s_waitcnt vmcnt(0)" ::: "memory");
    __syncthreads();
    if (threadIdx.x == 0) {
        unsigned* bar = b.bar;
        __builtin_amdgcn_s_waitcnt(0);
        unsigned nloc = b.st[0], nx = b.st[1];
        if (nloc == 0u) { xcd_barrier_complete(bar, b.x, nloc, nx); b.st[0] = nloc; b.st[1] = nx; }
        const unsigned old = xb_add(&bar[XB_XSUB(b.x)], 1u);
        const unsigned gen = old / nloc;
        if (old + 1u == (gen + 1u) * nloc) {
            __builtin_amdgcn_fence(__ATOMIC_RELEASE, "agent");
            asm volatile("s_waitcnt vmcnt(0)" ::: "memory");
            const unsigned og = xb_add(&bar[XB_TOP], 1u);
            const unsigned tg = og / nx;
            if (og + 1u == (tg + 1u) * nx) xb_add(&bar[XB_TOPGEN], 1u);
            else XB_SPIN(xb_ld(&bar[XB_TOPGEN]) == tg, bar);
            __builtin_amdgcn_fence(__ATOMIC_ACQUIRE, "agent");
            xb_add(&bar[XB_XGEN(b.x)], 1u);
            asm volatile("s_waitcnt vmcnt(0)" ::: "memory");
        } else {
            XB_SPIN(xb_ld(&bar[XB_XGEN(b.x)]) == gen, bar);
            __builtin_amdgcn_fence(__ATOMIC_ACQUIRE, "agent");
            asm volatile("s_waitcnt vmcnt(0)" ::: "memory");
        }
    }
    __syncthreads();
}


#ifdef FK_COPYPROBE
#ifndef FK_COPYMODE
#define FK_COPYMODE 0
#endif
__device__ __forceinline__ void ph_copyprobe(const Params& P) {
    const int lane = threadIdx.x & 63, wave = threadIdx.x >> 6;
    const u32x4* src = (const u32x4*)P.wg; u32x4* dst = (u32x4*)(P.ws + WS_AO);
    const size_t nchunk = (size_t)16 * 1024 * 1024 * 4 / 4096;
    constexpr int CH = FK_COPYMODE == 1 ? 12 : 4;
    constexpr int NJ = (FK_COPYMODE == 2 || FK_COPYMODE == 3) ? 1 : 4;
    constexpr int CSTR = FK_COPYMODE == 3 ? 4 : 1;
#if FK_COPYMODE == 7
    return;
#endif
#if FK_COPYMODE == 5 || FK_COPYMODE == 6
    u32x4 acc4 = {0u, 0u, 0u, 0u};
    for (size_t c0 = (size_t)(blockIdx.x * 8 + wave) * CH; c0 < nchunk; c0 += (size_t)gridDim.x * 8 * CH) {
#pragma unroll
        for (int r = 0; r < CH; ++r)
#pragma unroll
            for (int j = 0; j < NJ; ++j) { const size_t c = c0 + r < nchunk ? c0 + r : nchunk - 1;
                if (FK_COPYMODE == 5) { const u32x4 t = src[c * 256 + lane + 64 * j]; acc4.x ^= t.x; acc4.y ^= t.y; acc4.z ^= t.z; acc4.w ^= t.w; }
                else dst[c * 256 + lane + 64 * j] = (u32x4){(unsigned)c, 1u, 2u, 3u}; }
    }
    if (FK_COPYMODE == 5) dst[(size_t)(blockIdx.x * 8 + wave) * 64 + lane] = acc4;
    return;
#endif
#if FK_COPYMODE == 4
    const size_t per = nchunk / ((size_t)gridDim.x * 8), cbeg = (size_t)(blockIdx.x * 8 + wave) * per;
    for (size_t c0 = cbeg; c0 < cbeg + per; c0 += CH) {
#else
    for (size_t c0 = (size_t)(blockIdx.x * 8 + wave) * CH; c0 < nchunk; c0 += (size_t)gridDim.x * 8 * CH) {
#endif
        u32x4 v[CH][NJ];
#pragma unroll
        for (int r = 0; r < CH; ++r)
#pragma unroll
            for (int j = 0; j < NJ; ++j) { const size_t c = c0 + r < nchunk ? c0 + r : nchunk - 1; v[r][j] = src[(c / CSTR * CSTR) * 256 + lane + 64 * j]; }
#pragma unroll
        for (int r = 0; r < CH; ++r)
#pragma unroll
            for (int j = 0; j < NJ; ++j) { const size_t c = c0 + r < nchunk ? c0 + r : nchunk - 1; dst[(c / CSTR * CSTR) * 256 + lane + 64 * j] = v[r][j]; }
    }
}
#endif
constexpr int NPHASE = 11;
constexpr size_t CTL_ZERO_BYTES = 16384;
#ifndef FK_MASK
#define FK_MASK 0x7ff
#endif
#ifndef FK_CGSYNC
#define FK_CGSYNC 0
#endif
__global__ void __launch_bounds__(512, 2) mega(Params P) {
    extern __shared__ __attribute__((aligned(16))) unsigned char lds_raw[];
    LAS unsigned char* lds = (LAS unsigned char*)lds_raw;
    cg::grid_group grid = cg::this_grid();
    volatile LAS unsigned* misc = (volatile LAS unsigned*)(lds + LDS_MISC);
    if (threadIdx.x < 2) misc[threadIdx.x] = 0u;
    __syncthreads();
    const XcdBarrier bar = xcd_barrier_post((unsigned*)(P.ws + WS_CTL), misc);
    const int lo = P.ph_lo, hi = P.ph_hi;
    if (lo < 0) grid.sync();
#define FK_SYNC(k) do { if ((k) < FK_CGSYNC) grid.sync(); else xcd_barrier(bar); } while (0)
    typedef const __attribute__((address_space(4))) Params* KArgPtr;
#if defined(__HIP_DEVICE_COMPILE__)
#define FK_ARGS(name) KArgPtr kp_##name = (KArgPtr)__builtin_amdgcn_kernarg_segment_ptr(); asm volatile("" : "+s"(kp_##name)); const Params name = *(const Params*)kp_##name
#else
#define FK_ARGS(name) const Params name = P
#endif
#define FK_PH(k, call) if (((FK_MASK >> (k)) & 1) && lo <= (k) && (k) < hi) { { FK_ARGS(L); call; } if ((FK_DBL >> (k)) & 1) { FK_SYNC(k); { FK_ARGS(L); call; } } if ((k) + 1 < hi) { FK_SYNC(k); FK_STAMP((k) + 1); } }
    FK_STAMP(0);
    FK_PH(0, ph_prep(L, lds))
#ifdef FK_COPYPROBE
    for (int rep = 0; rep < FK_COPYPROBE; ++rep) { { FK_ARGS(L); ph_copyprobe(L); } xcd_barrier(bar); }
#endif
    FK_PH(1, ph_norm1(L, lds))
    FK_PH(2, ph_inproj(L, lds))
    FK_PH(3, ph_mix(L, lds))
    FK_PH(4, ph_proj(L, lds))
    FK_PH(5, ph_out(L, lds))
    FK_PH(6, ph_router(L, lds))
    FK_PH(7, ph_topk(L, lds))
    FK_PH(8, ph_moe_up(L, lds))
    FK_PH(9, ph_moe_down(L, lds))
    FK_PH(10, ph_final(L))
#undef FK_ARGS
#undef FK_PH
#undef FK_SYNC
}
}
static void fk_launch(fk::Params p, int lo, int hi, hipStream_t stream);
#if HYB >= 0
#include <hip/hip_runtime.h>

namespace nv {
constexpr int D = 1024, T = 2048, L = 256, NB = 16, INW = 6656, NE = 16, CAP = 256;

__global__ void k_mod(const float* __restrict__ c, const float* __restrict__ c_ctx, const float* __restrict__ w_mod,
                      const float* __restrict__ b_mod, float* __restrict__ mod) {
    const int n = blockIdx.x * 256 + threadIdx.x, r = blockIdx.y;
    const float* cv = r < 16 ? c + r * 1024 : c_ctx;
    float acc = 0.f;
    for (int k = 0; k < 1024; ++k) { const float v = cv[k]; const float s = v / (1.f + expf(-v)); acc += s * w_mod[(size_t)k * 6144 + n]; }
    mod[r * 6144 + n] = acc + b_mod[n];
}

__device__ __forceinline__ float block_sum256(float v, float* red) {
#pragma unroll
    for (int o = 32; o > 0; o >>= 1) v += __shfl_xor(v, o);
    __syncthreads();
    if ((threadIdx.x & 63) == 0) red[threadIdx.x >> 6] = v;
    __syncthreads();
    return red[0] + red[1] + red[2] + red[3];
}

__global__ void k_norm_mod(const float* __restrict__ x, const float* __restrict__ g, const float* __restrict__ shift,
                           const float* __restrict__ scale, float* __restrict__ out) {
    __shared__ float red[4];
    const int row = blockIdx.x, t = threadIdx.x;
    const float* xr = x + (size_t)row * D;
    float v[4]; float ss = 0.f;
#pragma unroll
    for (int j = 0; j < 4; ++j) { v[j] = xr[t + 256 * j]; ss += v[j] * v[j]; }
    const float tot = block_sum256(ss, red);
    const float rs = 1.0f / sqrtf(tot * (1.f / D) + 1e-6f);
#pragma unroll
    for (int j = 0; j < 4; ++j) { const int cidx = t + 256 * j; out[(size_t)row * D + cidx] = v[j] * rs * g[cidx] * (1.f + scale[cidx]) + shift[cidx]; }
}

__global__ __launch_bounds__(256) void k_sgemm(const float* __restrict__ A, int lda, const int* __restrict__ rows, long sA, long sRows,
                                               const float* __restrict__ B, int ldb, long sB, float* __restrict__ C, int ldc, long sC, int K) {
    __shared__ float As[16][65];
    __shared__ float Bs[16][64];
    const int z = blockIdx.z;
    A += (size_t)z * sA; B += (size_t)z * sB; C += (size_t)z * sC; if (rows) rows += (size_t)z * sRows;
    const int tx = threadIdx.x & 15, ty = threadIdx.x >> 4;
    const int m0 = blockIdx.y * 64, n0 = blockIdx.x * 64;
    float acc[4][4];
#pragma unroll
    for (int i = 0; i < 4; ++i)
#pragma unroll
        for (int j = 0; j < 4; ++j) acc[i][j] = 0.f;
    for (int k0 = 0; k0 < K; k0 += 16) {
#pragma unroll
        for (int ii = 0; ii < 4; ++ii) { const int i = threadIdx.x + 256 * ii; const int r = i >> 4, kk = i & 15; const int row = m0 + r; const int src = rows ? rows[row] : row;
            As[kk][r] = A[(size_t)src * lda + k0 + kk]; }
#pragma unroll
        for (int ii = 0; ii < 4; ++ii) { const int i = threadIdx.x + 256 * ii; const int kk = i >> 6, cc = i & 63; Bs[kk][cc] = B[(size_t)(k0 + kk) * ldb + n0 + cc]; }
        __syncthreads();
#pragma unroll
        for (int kk = 0; kk < 16; ++kk) {
            float a[4], b[4];
#pragma unroll
            for (int i = 0; i < 4; ++i) a[i] = As[kk][ty * 4 + i];
#pragma unroll
            for (int j = 0; j < 4; ++j) b[j] = Bs[kk][tx * 4 + j];
#pragma unroll
            for (int i = 0; i < 4; ++i)
#pragma unroll
                for (int j = 0; j < 4; ++j) acc[i][j] += a[i] * b[j];
        }
        __syncthreads();
    }
#pragma unroll
    for (int i = 0; i < 4; ++i)
#pragma unroll
        for (int j = 0; j < 4; ++j) C[(size_t)(m0 + ty * 4 + i) * ldc + n0 + tx * 4 + j] = acc[i][j];
}

__global__ void k_rope(float* __restrict__ P) {
    const int gid = blockIdx.x * 256 + threadIdx.x;
    const int pr = gid & 31, hs = (gid >> 5) % 20, t = gid / (32 * 20);
    if (t >= T) return;
    const int half = pr >> 4, i = pr & 15;
    const float pos = half == 0 ? (float)(t / 64) : (float)(t % 64);
    const float inv_freq = powf(10000.f, -(float)i / 16.f);
    const float ang = pos * inv_freq;
    const float cs = cosf(ang), sn = sinf(ang);
    float* p = P + (size_t)t * INW + hs * 64 + half * 32 + i;
    const float x1 = p[0], x2 = p[16];
    p[0] = x1 * cs - x2 * sn;
    p[16] = x2 * cs + x1 * sn;
}

__global__ __launch_bounds__(64) void k_attn(const float* __restrict__ P, const float* __restrict__ kvc, const float* __restrict__ sink, float* __restrict__ o) {
    __shared__ float qs[64];
    __shared__ float sc[257 + 256];
    const int t = blockIdx.x, h = blockIdx.y, hkv = h >> 2, d = threadIdx.x;
    qs[d] = P[(size_t)t * INW + h * 64 + d];
    __syncthreads();
    const int lo = t - 128 < 0 ? 0 : t - 128, hi = t + 128 > T - 1 ? T - 1 : t + 128, nw = hi - lo + 1, ntot = nw + L;
    for (int j = d; j < ntot; j += 64) {
        const float* kp = j < nw ? P + (size_t)(lo + j) * INW + 1024 + hkv * 64 : kvc + (size_t)(j - nw) * 512 + hkv * 64;
        float s = 0.f;
        for (int dd = 0; dd < 64; ++dd) s += qs[dd] * kp[dd];
        sc[j] = s * 0.125f;
    }
    __syncthreads();
    const float sk = sink[h];
    float m = sk;
    for (int j = d; j < ntot; j += 64) m = fmaxf(m, sc[j]);
#pragma unroll
    for (int off = 32; off > 0; off >>= 1) m = fmaxf(m, __shfl_xor(m, off));
    float l = 0.f;
    for (int j = d; j < ntot; j += 64) { const float p = expf(sc[j] - m); sc[j] = p; l += p; }
#pragma unroll
    for (int off = 32; off > 0; off >>= 1) l += __shfl_xor(l, off);
    l += expf(sk - m);
    __syncthreads();
    float acc = 0.f;
    for (int j = 0; j < ntot; ++j) {
        const float* vp = j < nw ? P + (size_t)(lo + j) * INW + 1280 + hkv * 64 : kvc + (size_t)(j - nw) * 512 + 256 + hkv * 64;
        acc += sc[j] * vp[d];
    }
    o[(size_t)t * D + h * 64 + d] = acc / l;
}

__global__ void k_conv(const float* __restrict__ P, const float* __restrict__ cw, float* __restrict__ y) {
    const int gid = blockIdx.x * 256 + threadIdx.x; const int ch = gid & 1023, t = gid >> 10;
    const float* pr = P + (size_t)t * INW;
    const float z1 = pr[3584 + ch] * pr[1536 + ch];
    const float z0 = t > 0 ? pr[3584 + ch - INW] * pr[1536 + ch - INW] : 0.f;
    const float z2 = t < T - 1 ? pr[3584 + ch + INW] * pr[1536 + ch + INW] : 0.f;
    y[gid] = pr[2560 + ch] * (cw[ch] * z0 + cw[1024 + ch] * z1 + cw[2048 + ch] * z2);
}

__global__ void k_merge(const float* __restrict__ P, float* __restrict__ a, const float* __restrict__ s) {
    const int gid = blockIdx.x * 256 + threadIdx.x; const int ch = gid & 1023, t = gid >> 10;
    const float ga = P[(size_t)t * INW + 4608 + ch], gc = P[(size_t)t * INW + 5632 + ch];
    a[gid] = a[gid] / (1.f + expf(-ga)) + s[gid] / (1.f + expf(-gc));
}

__global__ void k_resid(const float* __restrict__ x, const float* __restrict__ g, const float* __restrict__ o, float* __restrict__ x1) {
    const int gid = blockIdx.x * 256 + threadIdx.x; const int ch = gid & 1023;
    x1[gid] = x[gid] + g[ch] * o[gid];
}

__global__ void k_router(const float* __restrict__ x1, const float* __restrict__ g, const float* __restrict__ shift, const float* __restrict__ scale,
                         const float* __restrict__ w_router, float* __restrict__ hx2, float* __restrict__ aff) {
    __shared__ float red[4];
    __shared__ float lg[16];
    const int row = blockIdx.x, t = threadIdx.x;
    const float* xr = x1 + (size_t)row * D;
    float v[4]; float ss = 0.f;
#pragma unroll
    for (int j = 0; j < 4; ++j) { v[j] = xr[t + 256 * j]; ss += v[j] * v[j]; }
    const float tot = block_sum256(ss, red);
    const float rs = 1.0f / sqrtf(tot * (1.f / D) + 1e-6f);
#pragma unroll
    for (int j = 0; j < 4; ++j) { const int cidx = t + 256 * j; v[j] = v[j] * rs * g[cidx] * (1.f + scale[cidx]) + shift[cidx]; hx2[(size_t)row * D + cidx] = v[j]; }
    for (int e = 0; e < 16; ++e) {
        float p = 0.f;
#pragma unroll
        for (int j = 0; j < 4; ++j) p += v[j] * w_router[(size_t)(t + 256 * j) * 16 + e];
        const float s = block_sum256(p, red);
        if (t == 0) lg[e] = s;
    }
    __syncthreads();
    if (t < 16) {
        float m = lg[0];
        for (int e = 1; e < 16; ++e) m = fmaxf(m, lg[e]);
        float sum = 0.f;
        for (int e = 0; e < 16; ++e) sum += expf(lg[e] - m);
        aff[(size_t)t * T + row] = expf(lg[t] - m) / sum;
    }
}

__global__ void k_topk(const float* __restrict__ aff, int* __restrict__ idx, float* __restrict__ gate, int* __restrict__ sel) {
    __shared__ float a[T];
    const int e = blockIdx.x;
    for (int i = threadIdx.x; i < T; i += 256) a[i] = aff[(size_t)e * T + i];
    __syncthreads();
    for (int i = threadIdx.x; i < T; i += 256) {
        const float v = a[i]; int rank = 0;
        for (int j = 0; j < T; ++j) { const float w = a[j]; rank += (w > v || (w == v && j < i)) ? 1 : 0; }
        if (rank < CAP) { idx[e * CAP + rank] = i; gate[e * CAP + rank] = v; sel[i * 16 + e] = rank; }
        else sel[i * 16 + e] = -1;
    }
}

__global__ void k_silu_mul(float* __restrict__ a, const float* __restrict__ u) {
    const size_t gid = (size_t)blockIdx.x * 256 + threadIdx.x;
    const float v = a[gid];
    a[gid] = v / (1.f + expf(-v)) * u[gid];
}

__global__ void k_combine(const float* __restrict__ x1, const float* __restrict__ g2, const float* __restrict__ ye, const float* __restrict__ gate,
                          const int* __restrict__ sel, const float* __restrict__ fg, float* __restrict__ out) {
    __shared__ float red[4];
    const int row = blockIdx.x, t = threadIdx.x;
    float m[4] = {0.f, 0.f, 0.f, 0.f};
    for (int e = 0; e < 16; ++e) {
        const int s = sel[row * 16 + e];
        if (s >= 0) { const float gt = gate[e * CAP + s]; const float* yr = ye + ((size_t)e * CAP + s) * D;
#pragma unroll
            for (int j = 0; j < 4; ++j) m[j] += gt * yr[t + 256 * j]; }
    }
    float v[4]; float ss = 0.f;
#pragma unroll
    for (int j = 0; j < 4; ++j) { const int cidx = t + 256 * j; v[j] = x1[(size_t)row * D + cidx] + g2[cidx] * m[j]; ss += v[j] * v[j]; }
    const float tot = block_sum256(ss, red);
    const float rs = 1.0f / sqrtf(tot * (1.f / D) + 1e-6f);
#pragma unroll
    for (int j = 0; j < 4; ++j) { const int cidx = t + 256 * j; out[(size_t)row * D + cidx] = v[j] * rs * fg[cidx]; }
}

struct Inputs {
    const float *x, *c, *ctx, *c_ctx, *w_mod, *b_mod, *norm1_g, *w_in, *sink, *conv_w, *wpa, *wpc, *wo, *norm2_g, *w_router, *wg, *wu, *wd, *fg;
};
struct Scratch {
    float *mod, *hx, *hc, *P, *kvc, *oat, *yc, *a, *s, *o1, *x1, *hx2, *aff, *gate, *ea, *eu, *ye; int *idx, *sel;
};
inline size_t carve(Scratch& S, char* base) {
    size_t off = 0;
    auto take = [&](size_t bytes) { char* p = base + off; off += (bytes + 255) & ~(size_t)255; return p; };
    S.mod = (float*)take(17 * 6144 * 4);
    S.hx = (float*)take((size_t)T * D * 4); S.hc = (float*)take((size_t)L * D * 4);
    S.P = (float*)take((size_t)T * INW * 4); S.kvc = (float*)take((size_t)L * 512 * 4);
    S.oat = (float*)take((size_t)T * D * 4); S.yc = (float*)take((size_t)T * D * 4);
    S.a = (float*)take((size_t)T * D * 4); S.s = (float*)take((size_t)T * D * 4); S.o1 = (float*)take((size_t)T * D * 4);
    S.x1 = (float*)take((size_t)T * D * 4); S.hx2 = (float*)take((size_t)T * D * 4);
    S.aff = (float*)take((size_t)NE * T * 4); S.gate = (float*)take(NE * CAP * 4); S.idx = (int*)take(NE * CAP * 4); S.sel = (int*)take((size_t)T * 16 * 4);
    S.ea = S.P; S.eu = S.P + (size_t)NE * CAP * D; S.ye = S.P + (size_t)2 * NE * CAP * D;
    return off;
}

inline void run_mod(const Inputs& I, const Scratch& S, hipStream_t st) { k_mod<<<dim3(24, 17), 256, 0, st>>>(I.c, I.c_ctx, I.w_mod, I.b_mod, S.mod); }
inline void s1a_norm(const Inputs& I, const Scratch& S, int b, hipStream_t st) {
    const float* mb = S.mod + b * 6144; const float* mc = S.mod + 16 * 6144;
    k_norm_mod<<<T, 256, 0, st>>>(I.x + (size_t)b * T * D, I.norm1_g, mb, mb + 1024, S.hx);
    k_norm_mod<<<L, 256, 0, st>>>(I.ctx + (size_t)b * L * D, I.norm1_g, mc, mc + 1024, S.hc);
}
inline void s1b_gemm(const Inputs& I, const Scratch& S, int b, hipStream_t st) {
    k_sgemm<<<dim3(INW / 64, T / 64, 1), 256, 0, st>>>(S.hx, D, nullptr, 0, 0, I.w_in, INW, 0, S.P, INW, 0, D);
    k_sgemm<<<dim3(512 / 64, L / 64, 1), 256, 0, st>>>(S.hc, D, nullptr, 0, 0, I.w_in + 1024, INW, 0, S.kvc, 512, 0, D);
    k_rope<<<T * 20 * 32 / 256, 256, 0, st>>>(S.P);
}
inline void s2_mix(const Inputs& I, const Scratch& S, int b, hipStream_t st) {
    k_attn<<<dim3(T, 16), 64, 0, st>>>(S.P, S.kvc, I.sink, S.oat);
    k_conv<<<T * D / 256, 256, 0, st>>>(S.P, I.conv_w, S.yc);
}
inline void s3_merge(const Inputs& I, const Scratch& S, int b, hipStream_t st) {
    k_sgemm<<<dim3(D / 64, T / 64, 1), 256, 0, st>>>(S.oat, D, nullptr, 0, 0, I.wpa, D, 0, S.a, D, 0, D);
    k_sgemm<<<dim3(D / 64, T / 64, 1), 256, 0, st>>>(S.yc, D, nullptr, 0, 0, I.wpc, D, 0, S.s, D, 0, D);
    k_merge<<<T * D / 256, 256, 0, st>>>(S.P, S.a, S.s);
}
inline void s4_out(const Inputs& I, const Scratch& S, int b, hipStream_t st) {
    k_sgemm<<<dim3(D / 64, T / 64, 1), 256, 0, st>>>(S.a, D, nullptr, 0, 0, I.wo, D, 0, S.o1, D, 0, D);
    k_resid<<<T * D / 256, 256, 0, st>>>(I.x + (size_t)b * T * D, S.mod + b * 6144 + 2048, S.o1, S.x1);
}
inline void s5_router(const Inputs& I, const Scratch& S, int b, hipStream_t st) {
    const float* mb = S.mod + b * 6144;
    k_router<<<T, 256, 0, st>>>(S.x1, I.norm2_g, mb + 3072, mb + 4096, I.w_router, S.hx2, S.aff);
}
inline void s6_topk(const Inputs& I, const Scratch& S, int b, hipStream_t st) { k_topk<<<NE, 256, 0, st>>>(S.aff, S.idx, S.gate, S.sel); }
inline void s7_up(const Inputs& I, const Scratch& S, int b, hipStream_t st) {
    k_sgemm<<<dim3(D / 64, CAP / 64, NE), 256, 0, st>>>(S.hx2, D, S.idx, 0, CAP, I.wg, D, (long)D * D, S.ea, D, (long)CAP * D, D);
    k_sgemm<<<dim3(D / 64, CAP / 64, NE), 256, 0, st>>>(S.hx2, D, S.idx, 0, CAP, I.wu, D, (long)D * D, S.eu, D, (long)CAP * D, D);
    k_silu_mul<<<NE * CAP * D / 256, 256, 0, st>>>(S.ea, S.eu);
}
inline void s8_down(const Inputs& I, const Scratch& S, int b, hipStream_t st) {
    k_sgemm<<<dim3(D / 64, CAP / 64, NE), 256, 0, st>>>(S.ea, D, nullptr, (long)CAP * D, 0, I.wd, D, (long)D * D, S.ye, D, (long)CAP * D, D);
}
inline void s9_final(const Inputs& I, const Scratch& S, int b, float* out, hipStream_t st) {
    k_combine<<<T, 256, 0, st>>>(S.x1, S.mod + b * 6144 + 5120, S.ye, S.gate, S.sel, I.fg, out + (size_t)b * T * D);
}
}
namespace hyb {
using fk::bf16_t;
__device__ __forceinline__ float bf2f(bf16_t v) { return __uint_as_float((unsigned)v << 16); }
__global__ void k_cv_bf16(const bf16_t* __restrict__ src, size_t spitch, float* __restrict__ dst, int cols, size_t n) {
    const size_t gid = (size_t)blockIdx.x * 256 + threadIdx.x; if (gid >= n) return;
    const size_t r = gid / cols; const int c = (int)(gid % cols);
    dst[gid] = bf2f(src[r * spitch + c]);
}
__global__ void k_copy_f32(const float* __restrict__ src, float* __restrict__ dst, size_t n) { const size_t gid = (size_t)blockIdx.x * 256 + threadIdx.x; if (gid < n) dst[gid] = src[gid]; }
__global__ void k_copy_i32(const int* __restrict__ src, int* __restrict__ dst, size_t n) { const size_t gid = (size_t)blockIdx.x * 256 + threadIdx.x; if (gid < n) dst[gid] = src[gid]; }
__global__ void k_fill_f32(float* __restrict__ dst, float v, size_t n) { const size_t gid = (size_t)blockIdx.x * 256 + threadIdx.x; if (gid < n) dst[gid] = v; }
__device__ __forceinline__ float logit_(float p) { return p >= 1.f ? 30.f : (p <= 0.f ? -30.f : logf(p / (1.f - p))); }
__global__ void k_cv_P(const unsigned char* __restrict__ ws, const unsigned char* __restrict__ ob, int b, float* __restrict__ Pn) {
    const size_t gid = (size_t)blockIdx.x * 256 + threadIdx.x; if (gid >= (size_t)2048 * 6656) return;
    const int t = (int)(gid / 6656), col = (int)(gid % 6656); const size_t row = (size_t)b * 2048 + t;
    float v;
    if (col < 1024) v = bf2f(((const bf16_t*)(ws + fk::WS_Q))[row * 1024 + col]) / fk::C2;
    else if (col < 1280) { const int hkv = (col - 1024) >> 6, d = col & 63; const size_t blk = (size_t)((b * 4 + hkv) * 32 + (t >> 6));
        v = bf2f(*(const bf16_t*)(ws + fk::WS_KB + blk * 8192 + (d >> 3) * 1024 + (t & 63) * 16 + (d & 7) * 2)); }
    else if (col < 1536) { const int hkv = (col - 1280) >> 6, d = col & 63; const size_t blk = (size_t)((b * 4 + hkv) * 32 + (t >> 6));
        const int kk = t & 63, s = kk >> 4, w = kk & 15, h = (w >> 2) & 1, e = w >> 3, jj = w & 3;
        v = bf2f(*(const bf16_t*)(ws + fk::WS_VB + blk * 8192 + (2 * s + h) * 1024 + d * 16 + 8 * e + 2 * jj)); }
    else if (col < 2560) v = bf2f(((const bf16_t*)(ws + fk::WS_Z))[row * 1024 + col - 1536]);
    else if (col < 3584) v = bf2f(((const bf16_t*)(ws + fk::WS_BB))[row * 1024 + col - 2560]);
    else if (col < 4608) v = 1.f;
    else { const int ch = col < 5632 ? col - 4608 : col - 5632;
        const float r = bf2f(((const bf16_t*)(ob + fk::OB_RB))[row * 1024 + ch]), sg = bf2f(((const bf16_t*)(ob + fk::OB_SGC))[row * 1024 + ch]);
        v = col < 5632 ? logit_(r * sg) : logit_(sg); }
    Pn[gid] = v;
}
__global__ void k_cv_kvc(const unsigned char* __restrict__ ws, int b, float* __restrict__ kvc) {
    const int gid = blockIdx.x * 256 + threadIdx.x; if (gid >= 256 * 512) return;
    const int l = gid >> 9, col = gid & 511;
    if (col < 256) { const int hkv = col >> 6, d = col & 63; const size_t blk = (size_t)((b * 4 + hkv) * 4 + (l >> 6));
        kvc[gid] = bf2f(*(const bf16_t*)(ws + fk::WS_KCB + blk * 8192 + (d >> 3) * 1024 + (l & 63) * 16 + (d & 7) * 2)); }
    else { const int hkv = (col - 256) >> 6, d = col & 63; const size_t blk = (size_t)((b * 4 + hkv) * 4 + (l >> 6));
        const int kk = l & 63, s = kk >> 4, w = kk & 15, h = (w >> 2) & 1, e = w >> 3, jj = w & 3;
        kvc[gid] = bf2f(*(const bf16_t*)(ws + fk::WS_VCB + blk * 8192 + (2 * s + h) * 1024 + d * 16 + 8 * e + 2 * jj)); }
}
inline unsigned nblk(size_t n) { return (unsigned)((n + 255) / 256); }

inline void run(fk::Params p, void* const* d_in, float* out, char* nbase, size_t nbytes, hipStream_t st) {
    nv::Inputs I; const float** ip = (const float**)&I; for (int i = 0; i < 19; ++i) ip[i] = (const float*)d_in[i];
    nv::Scratch S; const size_t need = nv::carve(S, nbase);
    if (need > nbytes) { fprintf(stderr, "hybrid: scratch too small %zu > %zu\n", need, nbytes); return; }
    constexpr int X = HYB;
    if (X >= 10) { fk_launch(p, 0, fk::NPHASE, st); }
    else { fk_launch(p, 0, X + 1, st); }
    nv::run_mod(I, S, st);
    const unsigned char* ws = p.ws; const unsigned char* ob = p.ob;
    constexpr size_t TD = (size_t)2048 * 1024;
    for (int b = 0; b < 16; ++b) {
        const bool fast = b < fk::NBF;
        if (b == fk::NBF && X == 0) nv::run_mod(I, S, st);
        int from = 0;
        if (fast) {
            const size_t r0 = (size_t)b * 2048;
            if (X == 0) { k_copy_f32<<<nblk(17 * 6144), 256, 0, st>>>((const float*)(ws + fk::WS_MOD), S.mod, 17 * 6144); from = 0; }
            else if (X == 1) { k_cv_bf16<<<nblk(TD), 256, 0, st>>>((const bf16_t*)(ws + fk::WS_HX) + r0 * 1024, 1024, S.hx, 1024, TD);
                k_cv_bf16<<<nblk(256 * 1024), 256, 0, st>>>((const bf16_t*)(ws + fk::WS_HX) + ((size_t)fk::M + (size_t)b * 256) * 1024, 1024, S.hc, 1024, (size_t)256 * 1024); from = 1; }
            else if (X == 2 || X == 3) { k_cv_P<<<nblk((size_t)2048 * 6656), 256, 0, st>>>(ws, ob, b, S.P); k_cv_kvc<<<512, 256, 0, st>>>(ws, b, S.kvc); from = 2;
                if (X == 3) { k_cv_bf16<<<nblk(TD), 256, 0, st>>>((const bf16_t*)(ws + fk::WS_AO) + r0 * 2048, 2048, S.oat, 1024, TD);
                    k_cv_bf16<<<nblk(TD), 256, 0, st>>>((const bf16_t*)(ws + fk::WS_AO) + r0 * 2048 + 1024, 2048, S.yc, 1024, TD); from = 3; } }
            else if (X == 4) { k_cv_bf16<<<nblk(TD), 256, 0, st>>>((const bf16_t*)(ws + fk::WS_MB) + r0 * 1024, 1024, S.a, 1024, TD); from = 4; }
            else {
                k_cv_bf16<<<nblk(TD), 256, 0, st>>>((const bf16_t*)(ws + fk::WS_DL) + r0 * 1024, 1024, S.o1, 1024, TD); nv::k_resid<<<nblk(TD), 256, 0, st>>>(I.x + r0 * 1024, S.one, S.o1, S.x1); from = 5;
                if (X >= 6) { k_cv_bf16<<<nblk(TD), 256, 0, st>>>((const bf16_t*)(ws + fk::WS_HX2) + r0 * 1024, 1024, S.hx2, 1024, TD);
                    k_copy_f32<<<nblk(16 * 2048), 256, 0, st>>>((const float*)(ws + fk::WS_AFF) + (size_t)b * 16 * 2048, S.aff, 16 * 2048); from = 6; }
                if (X >= 7) { k_copy_i32<<<nblk(16 * 256), 256, 0, st>>>((const int*)(ws + fk::WS_IDX) + b * 16 * 256, S.idx, 16 * 256);
                    k_copy_f32<<<nblk(16 * 256), 256, 0, st>>>((const float*)(ws + fk::WS_GATE) + b * 16 * 256, S.gate, 16 * 256);
                    k_copy_i32<<<nblk(2048 * 16), 256, 0, st>>>((const int*)(ws + fk::WS_SEL) + r0 * 16, S.sel, 2048 * 16); from = 7; }
                if (X >= 8) { k_cv_bf16<<<nblk((size_t)4096 * 1024), 256, 0, st>>>((const bf16_t*)(ob + fk::OB_HB) + (size_t)b * 4096 * 1024, 1024, S.ea, 1024, (size_t)4096 * 1024); from = 8; }
                if (X >= 9) { k_cv_bf16<<<nblk((size_t)4096 * 1024), 256, 0, st>>>((const bf16_t*)(ws + fk::WS_YE) + (size_t)b * 4096 * 1024, 1024, S.ye, 1024, (size_t)4096 * 1024);
                    k_fill_f32<<<nblk(16 * 256), 256, 0, st>>>(S.gate, 1.f, 16 * 256); from = 9; }
                if (X >= 10) from = 10;
            }
        }
        if (from <= 0) nv::s1a_norm(I, S, b, st);
        if (from <= 1) nv::s1b_gemm(I, S, b, st);
        if (from <= 2) nv::s2_mix(I, S, b, st);
        if (from <= 3) nv::s3_merge(I, S, b, st);
        if (from <= 4) nv::s4_out(I, S, b, st);
        if (from <= 5) nv::s5_router(I, S, b, st);
        if (from <= 6) nv::s6_topk(I, S, b, st);
        if (from <= 7) nv::s7_up(I, S, b, st);
        if (from <= 8) nv::s8_down(I, S, b, st);
        if (from <= 9) nv::s9_final(I, S, b, out, st);
    }
}
}
#endif

static int fk_grid = 0;
static bool fk_setup() {
    if (fk_grid) return fk_grid > 0;
    int dev = 0, cus = 0, per_cu = 0;
    if (hipGetDevice(&dev) != hipSuccess || hipDeviceGetAttribute(&cus, hipDeviceAttributeMultiprocessorCount, dev) != hipSuccess) { fk_grid = -1; return false; }
    if (hipFuncSetAttribute((const void*)fk::mega, hipFuncAttributeMaxDynamicSharedMemorySize, fk::LDS_BYTES) != hipSuccess) { fprintf(stderr, "kernel_launch: hipFuncSetAttribute failed\n"); fk_grid = -1; return false; }
    if (hipOccupancyMaxActiveBlocksPerMultiprocessor(&per_cu, (const void*)fk::mega, 512, fk::LDS_BYTES) != hipSuccess || per_cu < 1) { fprintf(stderr, "kernel_launch: occupancy query says %d\n", per_cu); fk_grid = -1; return false; }
    fk_grid = cus * per_cu;
    return true;
}
static void fk_launch(fk::Params p, int lo, int hi, hipStream_t stream) {
    p.ph_lo = lo; p.ph_hi = hi;
    if (hipMemsetAsync(p.ws + fk::WS_CTL, 0, fk::CTL_ZERO_BYTES, stream) != hipSuccess) { fprintf(stderr, "kernel_launch: memset failed\n"); return; }
    if (lo == 0 && hipMemsetAsync(p.ws + fk::WS_MOD, 0, 17 * 6144 * 4, stream) != hipSuccess) { fprintf(stderr, "kernel_launch: memset failed\n"); return; }
    void* args[] = {&p};
    hipError_t e = hipLaunchCooperativeKernel((const void*)fk::mega, dim3(fk_grid), dim3(512), args, fk::LDS_BYTES, stream);
    if (e != hipSuccess) fprintf(stderr, "kernel_launch: cooperative launch failed: %s (grid %d)\n", hipGetErrorString(e), fk_grid);
}

extern "C" void kernel_launch(void* const* d_in, const int* in_sizes, int n_in, void* d_out, int out_size, void* d_ws, size_t ws_size, hipStream_t stream) {
    if (n_in != 19 || !fk_setup()) { fprintf(stderr, "kernel_launch: bad setup (n_in %d)\n", n_in); return; }
    fk::Params p{};
    const float** ip = (const float**)&p;
    for (int i = 0; i < 19; ++i) ip[i] = (const float*)d_in[i];
    p.out = (float*)d_out; p.ws = (unsigned char*)d_ws;
#if HYB < 0
    if (ws_size < fk::R_END) { fprintf(stderr, "kernel_launch: workspace too small: %zu < %zu\n", ws_size, (size_t)fk::R_END); return; }
    p.ob = (unsigned char*)d_out;
    fk_launch(p, 0, fk::NPHASE, stream);
#else
    p.ob = (unsigned char*)d_ws + fk::R_END;
    hyb::run(p, d_in, (float*)d_out, (char*)d_ws + fk::R_END + fk::OB_BYTES, ws_size - fk::R_END - fk::OB_BYTES, stream);
#endif
}
```

```cpp
#include <hip/hip_runtime.h>
#include <hip/hip_cooperative_groups.h>
#include <cstdio>
#include <cstdint>
#ifndef HYB
#define HYB -1
#endif
#if HYB >= 0
#define FK_NBF 8
#endif
namespace g8 {
#define G8_LAS __attribute__((address_space(3)))
typedef unsigned short bf16_t;
typedef short bf16x8 __attribute__((ext_vector_type(8)));
typedef float f32x4 __attribute__((ext_vector_type(4)));
typedef float f32x2 __attribute__((ext_vector_type(2)));
typedef unsigned u32x4 __attribute__((ext_vector_type(4)));
typedef unsigned u32x2 __attribute__((ext_vector_type(2)));
constexpr int BM = 256, BK = 64, HALF = 128, HTB = HALF * BK * 2, STAGE_BYTES = 8 * HTB;

__host__ __device__ __forceinline__ int lds_byte(int r, int c) { const int st = (r >> 4) * 2 + (c >> 5), rr = r & 15, cc = c & 31, ob = rr * 64 + cc * 2; return st * 1024 + (ob ^ (((ob >> 9) & 1) << 5)); }
__host__ __device__ __forceinline__ void stage_rc(int b, int& R, int& C) { const int st = b / 1024, sb = b % 1024, swz = sb ^ (((sb >> 9) & 1) << 5); R = (st >> 1) * 16 + swz / 64; C = (st & 1) * 32 + (swz % 64) / 2; }
__host__ __device__ __forceinline__ int perm32(int rho) { const int n = rho >> 4, i = rho & 15; return 8 * (i >> 2) + 4 * n + (i & 3); }
__host__ __device__ __forceinline__ int pinv32(int x) { return 16 * ((x >> 2) & 1) + 4 * (x >> 3) + (x & 3); }

struct Unit { const char* a; const char* b; const int* rows; int kind; int pm; int pn; int aux; };

__device__ __forceinline__ unsigned cvt_pk_bf16(float lo, float hi) { unsigned r; asm volatile("v_cvt_pk_bf16_f32 %0, %1, %2" : "=v"(r) : "v"(lo), "v"(hi)); return r; }
__device__ __forceinline__ float bf_lo(unsigned w) { return __uint_as_float(w << 16); }
__device__ __forceinline__ float bf_hi(unsigned w) { return __uint_as_float(w & 0xffff0000u); }

template <class Epi, class Sched, bool HAS_MID, bool GATHER = false, int KREP = 1>
__device__ __forceinline__ void gemm_phase(G8_LAS unsigned char* lds, const int K, const Sched& S, const Epi& E) {
    const int tid = threadIdx.x, wid = __builtin_amdgcn_readfirstlane(tid >> 6), lane = tid & 63, wr = wid >> 2, wc = wid & 3, fr = lane & 15, fq = lane >> 4;
    const int nt = K / BK;
    unsigned voff[2];
#pragma unroll
    for (int i = 0; i < 2; ++i) { int R, C; stage_rc(tid * 16 + i * 8192, R, C); voff[i] = (unsigned)(R * K + C) * 2u; }
    const size_t kstep = (size_t)(BK * 2);
    const size_t hstep = (size_t)HALF * K * 2;
    const unsigned ldsw = (unsigned)wid * 1024u;
    const int aoff = lds_byte(wr * 64 + fr, fq * 8), boff = lds_byte(wc * 32 + fr, fq * 8);
#define G8_SA(b, h) (((b) * 2 + (h)) * HTB)
#define G8_SB(b, h) ((4 + (b) * 2 + (h)) * HTB)
#define G8_STAGE(bufoff, gbase) do { _Pragma("unroll") for (int _i = 0; _i < 2; ++_i) \
        __builtin_amdgcn_global_load_lds((const unsigned*)((const char*)(gbase) + voff[_i]), (G8_LAS unsigned*)(lds + (bufoff) + ldsw + _i * 8192), 16, 0, 0); } while (0)
#define G8_STAGE_V(bufoff, gbase, vv) do { _Pragma("unroll") for (int _i = 0; _i < 2; ++_i) \
        __builtin_amdgcn_global_load_lds((const unsigned*)((const char*)(gbase) + (vv)[_i]), (G8_LAS unsigned*)(lds + (bufoff) + ldsw + _i * 8192), 16, 0, 0); } while (0)
#define G8_STAGE_A(bufoff, gbase, h) do { if constexpr (GATHER) G8_STAGE_V(bufoff, gbase, va[h]); else G8_STAGE(bufoff, (gbase) + (h) * hstep); } while (0)
#define G8_LDA(dst, b, h) do { _Pragma("unroll") for (int m = 0; m < 4; ++m) _Pragma("unroll") for (int k = 0; k < 2; ++k) dst[m][k] = *(const G8_LAS bf16x8*)(lds + G8_SA(b, h) + aoff + m * 2048 + k * 1024); } while (0)
#define G8_LDB(dst, b, h) do { _Pragma("unroll") for (int n = 0; n < 2; ++n) _Pragma("unroll") for (int k = 0; k < 2; ++k) dst[n][k] = *(const G8_LAS bf16x8*)(lds + G8_SB(b, h) + boff + n * 2048 + k * 1024); } while (0)
#define G8_MMA(ai, bj, At, Bt) do { __builtin_amdgcn_s_setprio(1); _Pragma("unroll") for (int m = 0; m < 4; ++m) _Pragma("unroll") for (int n = 0; n < 2; ++n) _Pragma("unroll") for (int k = 0; k < 2; ++k) \
        acc[ai][bj][m][n] = __builtin_amdgcn_mfma_f32_16x16x32_bf16(Bt[n][k], At[m][k], acc[ai][bj][m][n], 0, 0, 0); __builtin_amdgcn_s_setprio(0); } while (0)
#define G8_WAIT_V(n) asm volatile("s_waitcnt vmcnt(" #n ")" ::: "memory")
#define G8_WAIT_L(n) asm volatile("s_waitcnt lgkmcnt(" #n ")" ::: "memory")
#define G8_BAR __builtin_amdgcn_s_barrier()
#define G8_SCHED __builtin_amdgcn_sched_barrier(0)
    Unit cur, nxt; int ui = 0;
    if (!S.next(0, cur)) return;
    f32x4 acc[2][2][4][2];
#pragma unroll
    for (int a = 0; a < 2; ++a)
#pragma unroll
        for (int b = 0; b < 2; ++b)
#pragma unroll
            for (int m = 0; m < 4; ++m)
#pragma unroll
                for (int n = 0; n < 2; ++n) acc[a][b][m][n] = (f32x4){0.f, 0.f, 0.f, 0.f};
    bf16x8 At[4][2], B0[2][2], B1[2][2];
    const char* cA = cur.a; const char* cB = cur.b;
    unsigned va[2][2], vn[2][2];
    int gR[2], gC[2];
#pragma unroll
    for (int i = 0; i < 2; ++i) stage_rc(tid * 16 + i * 8192, gR[i], gC[i]);
    if constexpr (GATHER) {
#pragma unroll
        for (int h = 0; h < 2; ++h)
#pragma unroll
            for (int i = 0; i < 2; ++i) { va[h][i] = (unsigned)(cur.rows[128 * h + gR[i]] * K + gC[i]) * 2u; vn[h][i] = va[h][i]; }
    }
    G8_STAGE(G8_SB(0, 0), cB); G8_STAGE(G8_SB(0, 1), cB + hstep); G8_STAGE_A(G8_SA(0, 0), cA, 0); G8_STAGE_A(G8_SA(0, 1), cA, 1);
    if (wr == 1) G8_BAR;
    G8_WAIT_V(2); G8_BAR;
    G8_STAGE(G8_SB(1, 0), cB + kstep); G8_STAGE_A(G8_SA(1, 0), cA + kstep, 0); G8_STAGE(G8_SB(1, 1), cB + hstep + kstep);
    G8_WAIT_V(6); G8_BAR;
    for (;;) {
        const bool has_next = S.next(ui + 1, nxt);
        const char* nA = has_next ? nxt.a : cA; const char* nB = has_next ? nxt.b : cB;
        if constexpr (GATHER) { if (has_next) {
#pragma unroll
            for (int h = 0; h < 2; ++h)
#pragma unroll
                for (int i = 0; i < 2; ++i) vn[h][i] = (unsigned)(nxt.rows[128 * h + gR[i]] * K + gC[i]) * 2u; } }
        constexpr int KR = (KREP == 3) ? 1 : KREP;
        for (int tt = 0; tt < KR * nt; tt += 2) {
            const bool last = (tt == KR * nt - 2);
            const int t = (KREP == 1 || KREP == 3) ? tt : (tt >= nt ? tt - nt : tt);
            const char* a1 = cA + (size_t)(t + 1) * kstep;
            const int t2 = (KR > 1 && t + 2 >= nt) ? 0 : t + 2;
            const char* a2 = last ? nA : cA + (size_t)t2 * kstep; const char* b2 = last ? nB : cB + (size_t)t2 * kstep;
            const char* a3 = a2 + kstep; const char* b3 = b2 + kstep;
            if constexpr (HAS_MID) { if (t == (nt >> 1)) E.mid(acc, cur, wr, wc, fr, fq); }
            G8_LDB(B0, 0, 0); G8_LDB(B1, 0, 1); G8_SCHED; G8_LDA(At, 0, 0); G8_STAGE_A(G8_SA(1, 1), a1, 1);
            if constexpr (GATHER) { if (last) { va[0][0] = vn[0][0]; va[0][1] = vn[0][1]; va[1][0] = vn[1][0]; va[1][1] = vn[1][1]; } }
            G8_WAIT_V(8); G8_WAIT_L(0); G8_BAR; G8_MMA(0, 0, At, B0); G8_MMA(0, 1, At, B1); G8_BAR; G8_SCHED;
            G8_LDA(At, 0, 1); G8_STAGE(G8_SB(0, 0), b2); G8_STAGE(G8_SB(0, 1), b2 + hstep); G8_STAGE_A(G8_SA(0, 0), a2, 0);
            G8_WAIT_V(8); G8_WAIT_L(0); G8_BAR; G8_MMA(1, 0, At, B0); G8_MMA(1, 1, At, B1); G8_BAR; G8_SCHED;
            G8_LDB(B0, 1, 0); G8_LDB(B1, 1, 1); G8_SCHED; G8_LDA(At, 1, 0); G8_STAGE_A(G8_SA(0, 1), a2, 1);
            G8_WAIT_V(8); G8_WAIT_L(0); G8_BAR; G8_MMA(0, 0, At, B0); G8_MMA(0, 1, At, B1); G8_BAR; G8_SCHED;
            G8_LDA(At, 1, 1); G8_STAGE(G8_SB(1, 0), b3); G8_STAGE(G8_SB(1, 1), b3 + hstep); G8_STAGE_A(G8_SA(1, 0), a3, 0);
            G8_WAIT_V(8); G8_WAIT_L(0); G8_BAR; G8_MMA(1, 0, At, B0); G8_MMA(1, 1, At, B1); G8_BAR; G8_SCHED;
        }
        if (wr == 0) G8_BAR;
        if constexpr (KR > 1) {
#pragma unroll
            for (int a = 0; a < 2; ++a)
#pragma unroll
                for (int b = 0; b < 2; ++b)
#pragma unroll
                    for (int m = 0; m < 4; ++m)
#pragma unroll
                        for (int n = 0; n < 2; ++n) acc[a][b][m][n] *= (1.0f / KR);
        }
        E(acc, cur, wr, wc, fr, fq);
#ifdef FK_EPI2_PROBE
        if constexpr (KREP == 3) { asm volatile("" ::: "memory"); E(acc, cur, wr, wc, fr, fq); }
#endif
        if (!has_next) break;
#pragma unroll
        for (int a = 0; a < 2; ++a)
#pragma unroll
            for (int b = 0; b < 2; ++b)
#pragma unroll
                for (int m = 0; m < 4; ++m)
#pragma unroll
                    for (int n = 0; n < 2; ++n) acc[a][b][m][n] = (f32x4){0.f, 0.f, 0.f, 0.f};
        cur = nxt; cA = nA; cB = nB; ++ui;
        if (wr == 1) G8_BAR;
    }
    G8_WAIT_V(0);
    G8_BAR;
#undef G8_SA
#undef G8_SB
#undef G8_STAGE
#undef G8_LDA
#undef G8_STAGE_V
#undef G8_STAGE_A
#undef G8_LDB
#undef G8_MMA
#undef G8_WAIT_V
#undef G8_WAIT_L
#undef G8_BAR
#undef G8_SCHED
}
}
namespace fk {
using namespace g8;
namespace cg = cooperative_groups;
#define LAS G8_LAS
#ifndef FK_NBF
#define FK_NBF 16
#endif
#ifndef FK_DBL
#define FK_DBL 0
#endif
constexpr int NBF = FK_NBF;
constexpr int D = 1024, T = 2048, LC = 256, NE = 16, CAP = 256;
constexpr int M = NBF * T, MC = NBF * LC, MA = M + MC;
constexpr int NT_IN = 25;
constexpr float LOG2E = 1.4426950408889634f;
constexpr float C2 = 0.125f * LOG2E;
typedef float f32x16 __attribute__((ext_vector_type(16)));

constexpr size_t MiB = (size_t)1 << 20;
constexpr size_t SC = (size_t)NBF << 16;
constexpr size_t WS_CTL = 0, WS_MOD = 1 * MiB, WS_ROPE = 1 * MiB + 512 * 1024, WS_IDX = 2 * MiB, WS_GATE = 2 * MiB + 256 * 1024,
                 WS_AFF = 2 * MiB + 512 * 1024, WS_SEL = 5 * MiB;
constexpr size_t WS_WIN = 8 * MiB, WS_WV = WS_WIN + (size_t)6400 * 2048, WS_WP = 21 * MiB, WS_WO = 25 * MiB, WS_WGU = 27 * MiB, WS_WD = 91 * MiB;
constexpr size_t R0 = 124 * MiB;
constexpr size_t WS_Q = R0, WS_KB = R0 + 64 * SC, WS_KCB = R0 + 80 * SC, WS_VB = R0 + 82 * SC, WS_VCB = R0 + 98 * SC, WS_Z = R0 + 100 * SC, WS_BB = R0 + 164 * SC,
                 WS_AO = R0 + 228 * SC, WS_HX = R0 + 284 * SC, WS_MB = R0, WS_DL = R0 + 64 * SC, WS_HX2 = R0, WS_XE = R0 + 192 * SC, WS_YE = R0 + 192 * SC;
constexpr size_t R_END = R0 + 356 * SC;
constexpr size_t OB_RB = 0, OB_SGC = 64 * SC, OB_HB = 0, OB_BYTES = 128 * SC;

constexpr int LDS_BYTES = 147456;
constexpr int LDS_MISC = 140 * 1024;
constexpr int LDS_MISC_Q = 140 * 1024 + 64;

#ifdef FK_TS
#define FK_STAMP_WG(k, wgsel) do { if (blockIdx.x == (wgsel) && threadIdx.x == 0) { const unsigned long long t_ = __builtin_amdgcn_s_memrealtime(); \
        __hip_atomic_store((unsigned long long*)(P.ws + WS_CTL) + 1800 + (k), t_, __ATOMIC_RELAXED, __HIP_MEMORY_SCOPE_AGENT); } } while (0)
#else
#define FK_STAMP_WG(k, wgsel) do { } while (0)
#endif
#define FK_STAMP(k) FK_STAMP_WG(k, 0)

struct Params {
    const float *x, *c, *ctx, *c_ctx, *w_mod, *b_mod, *norm1_g, *w_in, *sink, *conv_w, *wpa, *wpc, *wo, *norm2_g, *w_router, *wg, *wu, *wd, *fg;
    float* out; unsigned char* ws; unsigned char* ob;
    int ph_lo, ph_hi;
};

__device__ __forceinline__ float wave_sum(float v) {
#pragma unroll
    for (int o = 1; o < 64; o <<= 1) v += __shfl_xor(v, o);
    return v;
}
__device__ __forceinline__ unsigned f2bf(float f) { unsigned u = __builtin_bit_cast(unsigned, f); return (u + 0x7fffu + ((u >> 16) & 1u)) >> 16; }
__device__ __forceinline__ unsigned pk2(float lo, float hi) { return f2bf(lo) | (f2bf(hi) << 16); }
__device__ __forceinline__ void bf8_to_f32(const u32x4 w, f32x4& lo, f32x4& hi4) { lo = (f32x4){bf_lo(w.x), bf_hi(w.x), bf_lo(w.y), bf_hi(w.y)}; hi4 = (f32x4){bf_lo(w.z), bf_hi(w.z), bf_lo(w.w), bf_hi(w.w)}; }
__device__ __forceinline__ u32x4 f32_to_bf8(const f32x4 a, const f32x4 b) { u32x4 w; w.x = pk2(a.x, a.y); w.y = pk2(a.z, a.w); w.z = pk2(b.x, b.y); w.w = pk2(b.z, b.w); return w; }
__device__ __forceinline__ float sq4(const f32x4 v) { return (v.x * v.x + v.y * v.y) + (v.z * v.z + v.w * v.w); }
__device__ __forceinline__ float dot4(const f32x4 a, const f32x4 b) { return (a.x * b.x + a.y * b.y) + (a.z * b.z + a.w * b.w); }
__device__ __forceinline__ float sigmoidf_(float v) { return 1.f / (1.f + __expf(-v)); }

__device__ __forceinline__ void transpose_item_w(const float* __restrict__ W, int N, int k0, int n0, bf16_t* __restrict__ dst, int pitch, bool perm, int lane) {
    const float* src = W + (size_t)k0 * N + n0 + lane;
    const int dr = perm ? ((lane & 32) + pinv32(lane & 31)) : lane;
    bf16_t* drow = dst + (size_t)dr * pitch + k0;
    float v[64];
#pragma unroll
    for (int j = 0; j < 32; ++j) { v[j] = __builtin_nontemporal_load(src + (size_t)j * N); v[32 + j] = __builtin_nontemporal_load(src + (size_t)j * N + 64); }
#pragma unroll
    for (int h = 0; h < 2; ++h)
#pragma unroll
        for (int c = 0; c < 4; ++c) { u32x4 o; const int b0 = 32 * h + 8 * c; o.x = pk2(v[b0], v[b0 + 1]); o.y = pk2(v[b0 + 2], v[b0 + 3]); o.z = pk2(v[b0 + 4], v[b0 + 5]); o.w = pk2(v[b0 + 6], v[b0 + 7]);
            *(u32x4*)(drow + (size_t)h * 64 * pitch + 8 * c) = o; }
}

constexpr int CV_IN = 16 * 104, CV_SQ = 256, CV_TOTAL = CV_IN + 3 * CV_SQ + 48 * CV_SQ;
__device__ __forceinline__ void conv_item(const Params& P, int it, int lane) {
    bf16_t* WIN = (bf16_t*)(P.ws + WS_WIN); bf16_t* WV = (bf16_t*)(P.ws + WS_WV); bf16_t* WP = (bf16_t*)(P.ws + WS_WP); bf16_t* WO = (bf16_t*)(P.ws + WS_WO);
    bf16_t* WGU = (bf16_t*)(P.ws + WS_WGU); bf16_t* WD = (bf16_t*)(P.ws + WS_WD);
    int r = it;
    if (r < CV_IN) {
        const int kb = r / 52, nb = r % 52, k0 = 32 * kb, n0 = 128 * nb;
        bf16_t* dst; bool perm = true;
        if (n0 < 1280) { dst = WIN + (size_t)n0 * 1024; perm = false; }
        else if (n0 < 1536) { dst = WV + (size_t)(n0 - 1280) * 1024; perm = false; }
        else if (n0 < 2560) { const int ch = n0 - 1536; dst = WIN + (size_t)(1280 + (ch >> 7) * 256) * 1024; }
        else if (n0 < 3584) { dst = WIN + (size_t)(3328 + (n0 - 2560)) * 1024; }
        else if (n0 < 4608) { const int ch = n0 - 3584; dst = WIN + (size_t)(1280 + (ch >> 7) * 256 + 128) * 1024; }
        else if (n0 < 5632) { const int ch = n0 - 4608; dst = WIN + (size_t)(4352 + (ch >> 7) * 256) * 1024; }
        else { const int ch = n0 - 5632; dst = WIN + (size_t)(4352 + (ch >> 7) * 256 + 128) * 1024; }
        transpose_item_w(P.w_in, 6656, k0, n0, dst, 1024, perm, lane);
        return;
    }
    r -= CV_IN;
    const int mat = r / CV_SQ, q = r % CV_SQ, kb = q / 8, nb = q % 8, k0 = 32 * kb, n0 = 128 * nb;
    if (mat == 0) transpose_item_w(P.wpa, 1024, k0, n0, WP + (size_t)n0 * 2048, 2048, true, lane);
    else if (mat == 1) transpose_item_w(P.wpc, 1024, k0, n0, WP + (size_t)n0 * 2048 + 1024, 2048, true, lane);
    else if (mat == 2) transpose_item_w(P.wo, 1024, k0, n0, WO + (size_t)n0 * 1024, 1024, true, lane);
    else {
        const int m2 = mat - 3, kind = m2 >> 4, e = m2 & 15;
        if (kind == 0) transpose_item_w(P.wg + (size_t)e * 1048576, 1024, k0, n0, WGU + ((size_t)e * 2048 + (n0 >> 7) * 256) * 1024, 1024, true, lane);
        else if (kind == 1) transpose_item_w(P.wu + (size_t)e * 1048576, 1024, k0, n0, WGU + ((size_t)e * 2048 + (n0 >> 7) * 256 + 128) * 1024, 1024, true, lane);
        else transpose_item_w(P.wd + (size_t)e * 1048576, 1024, k0, n0, WD + ((size_t)e * 1024 + n0) * 1024, 1024, true, lane);
    }
}

__device__ __forceinline__ void ph_prep(const Params& P, LAS unsigned char* lds) {
    const int tid = threadIdx.x, lane = tid & 63, wave = __builtin_amdgcn_readfirstlane(tid >> 6);
    const int G = gridDim.x, wg = blockIdx.x;
    float* mod = (float*)(P.ws + WS_MOD);
    constexpr int NMODWG = 192;
    if (wg < NMODWG) {
        const int cg_ = wg >> 1, kh = wg & 1;
        LAS float* sl = (LAS float*)lds;
        LAS float* red = (LAS float*)(lds + 17 * 512 * 4);
        { float cv[17];
#pragma unroll
          for (int r = 0; r < 17; ++r) cv[r] = r < 16 ? P.c[r * 1024 + 512 * kh + tid] : P.c_ctx[512 * kh + tid];
#pragma unroll
          for (int r = 0; r < 17; ++r) sl[r * 512 + tid] = cv[r] / (1.f + __expf(-cv[r])); }
        __syncthreads(); FK_STAMP_WG(16, 0);
        const int col = tid & 63, kg = wave, n = cg_ * 64 + col;
        float acc[17];
#pragma unroll
        for (int r = 0; r < 17; ++r) acc[r] = 0.f;
        { float w[64];
#pragma unroll
          for (int j = 0; j < 64; ++j) w[j] = __builtin_nontemporal_load(P.w_mod + (size_t)(512 * kh + 64 * kg + j) * 6144 + n);
#pragma unroll
          for (int j = 0; j < 64; ++j)
#pragma unroll
              for (int r = 0; r < 17; ++r) acc[r] += sl[r * 512 + 64 * kg + j] * w[j]; }
#pragma unroll
        for (int r = 0; r < 17; ++r) red[(kg * 17 + r) * 64 + col] = acc[r];
        __syncthreads(); FK_STAMP_WG(17, 0);
        for (int i = tid; i < 17 * 64; i += 512) { const int r = i >> 6, cc = i & 63; float sm = kh == 0 ? P.b_mod[cg_ * 64 + cc] : 0.f;
#pragma unroll
            for (int g = 0; g < 8; ++g) sm += red[(g * 17 + r) * 64 + cc];
            atomicAdd(mod + r * 6144 + cg_ * 64 + cc, sm); }
        __syncthreads(); FK_STAMP_WG(18, 0);
    } else if (wg == NMODWG) {
        float2* rope = (float2*)(P.ws + WS_ROPE);
        for (int i = tid; i < 64 * 16; i += 512) { const int pos = i >> 4, f = i & 15; const float ang = (float)pos * powf(10000.f, -(float)f / 16.f); rope[i] = make_float2(cosf(ang), sinf(ang)); }
    }
    constexpr int I_IN = 16 * 104;
    const int npure = (G - NMODWG) * 8;
    if (wg >= NMODWG) { for (int it = (wg - NMODWG) * 8 + wave; it < 2 * npure && it < I_IN; it += npure) conv_item(P, it, lane); }
    else { for (int it = 2 * npure + wg * 8 + wave; it < I_IN; it += NMODWG * 8) conv_item(P, it, lane); }
    __syncthreads(); FK_STAMP_WG(19, 0); FK_STAMP_WG(20, 200);
}

template <int NR>
__device__ __forceinline__ void norm1_rows(const Params& P, int row0, int lane) {
    const float* mod = (const float*)(P.ws + WS_MOD);
    bf16_t* HX = (bf16_t*)(P.ws + WS_HX);
    const float* xr; const float* mv;
    if (row0 < M) { xr = P.x + (size_t)row0 * D; mv = mod + (row0 >> 11) * 6144; } else { xr = P.ctx + (size_t)(row0 - M) * D; mv = mod + 16 * 6144; }
    f32x4 v[NR][4];
#pragma unroll
    for (int r = 0; r < NR; ++r)
#pragma unroll
        for (int j = 0; j < 2; ++j) { v[r][2 * j] = __builtin_nontemporal_load((const f32x4*)(xr + (size_t)r * D + 8 * lane + 512 * j)); v[r][2 * j + 1] = __builtin_nontemporal_load((const f32x4*)(xr + (size_t)r * D + 8 * lane + 512 * j + 4)); }
    float rs[NR];
#pragma unroll
    for (int r = 0; r < NR; ++r) { const float ss = (sq4(v[r][0]) + sq4(v[r][1])) + (sq4(v[r][2]) + sq4(v[r][3])); rs[r] = 1.0f / sqrtf(wave_sum(ss) * (1.f / D) + 1e-6f); }
#pragma unroll
    for (int j = 0; j < 2; ++j) { const int c0 = 8 * lane + 512 * j;
        const f32x4 g0 = *(const f32x4*)(P.norm1_g + c0) * (*(const f32x4*)(mv + 1024 + c0) + 1.0f), g1 = *(const f32x4*)(P.norm1_g + c0 + 4) * (*(const f32x4*)(mv + 1024 + c0 + 4) + 1.0f);
        const f32x4 sh0 = *(const f32x4*)(mv + c0), sh1 = *(const f32x4*)(mv + c0 + 4);
#pragma unroll
        for (int r = 0; r < NR; ++r) *(u32x4*)(HX + (size_t)(row0 + r) * D + c0) = f32_to_bf8(v[r][2 * j] * rs[r] * g0 + sh0, v[r][2 * j + 1] * rs[r] * g1 + sh1); }
}
enum { KD_Q = 0, KD_K = 1, KD_KC = 2, KD_VT = 3, KD_VTC = 4, KD_UC = 5, KD_BC = 6, KD_GG = 7 };
struct InprojSched {
    int G, c; const char *hx, *win, *wv;
    static constexpr int NMAIN = (M / 256) * NT_IN, NVT = M / 256, NC = MC / 256, NTOT = NMAIN + NVT;
    __device__ __forceinline__ bool next(int i, Unit& u) const {
        const int Lx = i * G + c; if (Lx >= NTOT) return false;
        constexpr size_t TS = (size_t)256 * 1024 * 2;
        if (Lx < NMAIN) {
            const int wgid = (Lx % 8) * (NMAIN / 8) + Lx / 8;
            constexpr int nig = 8 * NT_IN; const int gid = wgid / nig, w = wgid % nig;
            u.pm = gid * 8 + (w % 8); u.pn = w / 8;
            u.a = hx + (size_t)u.pm * TS; u.b = win + (size_t)u.pn * TS;
            u.kind = u.pn < 4 ? KD_Q : u.pn == 4 ? KD_K : u.pn < 13 ? KD_UC : u.pn < 17 ? KD_BC : KD_GG; u.aux = 0; u.rows = nullptr;
        } else {
            const int xq = Lx - NMAIN;
            u.kind = KD_VT; u.pm = 0; u.pn = xq; u.a = wv; u.b = hx + (size_t)xq * TS;
            u.aux = 0; u.rows = nullptr;
        }
        return true;
    }
};
struct CtxSched {
    int c; const char *hx, *win, *wv;
    __device__ __forceinline__ bool next(int i, Unit& u) const {
        if (i != 0) return false;
        constexpr size_t TS = (size_t)256 * 1024 * 2; constexpr int NC = MC / 256;
        if (c < NC) { u.kind = KD_KC; u.pm = M / 256 + c; u.pn = 4; u.a = hx + (size_t)u.pm * TS; u.b = win + (size_t)4 * TS; }
        else { u.kind = KD_VTC; u.pm = 0; u.pn = c - NC; u.a = wv; u.b = hx + (size_t)(M / 256 + u.pn) * TS; }
        u.aux = 0; u.rows = nullptr; return true;
    }
};
struct EpiInproj {
    bf16_t *q, *z, *bb, *rb, *sgc; unsigned char *kb, *kcb, *vb, *vcb; const float* rope;
    __device__ __forceinline__ void operator()(const f32x4 (&acc)[2][2][4][2], const Unit& u, int wr, int wc, int fr, int fq) const {
        const int kind = u.kind;
        if (kind == KD_Q || kind == KD_K) {
#pragma unroll
            for (int ai = 0; ai < 2; ++ai)
#pragma unroll
                for (int m = 0; m < 4; ++m) {
                    const int r = u.pm * 256 + 128 * ai + 64 * wr + 16 * m + fr, t = r & 2047, b = r >> 11;
                    const int pos = (wc & 1) ? (t & 63) : (t >> 6);
                    const float* tb = rope + (pos * 16 + 4 * fq) * 2;
                    const f32x4 t0 = *(const f32x4*)tb, t1 = *(const f32x4*)(tb + 4);
                    const f32x4 cs = {t0.x, t0.z, t1.x, t1.z}, sn = {t0.y, t0.w, t1.y, t1.w};
#pragma unroll
                    for (int bj = 0; bj < 2; ++bj) {
                        const f32x4 x0 = acc[ai][bj][m][0], x1 = acc[ai][bj][m][1];
                        f32x4 o0 = x0 * cs - x1 * sn, o1 = x1 * cs + x0 * sn;
                        if (kind == KD_Q) {
                            o0 = o0 * C2; o1 = o1 * C2;
                            bf16_t* dst = q + (size_t)r * 1024 + u.pn * 256 + 128 * bj + 32 * wc + 4 * fq;
                            u32x2 w0, w1; w0.x = cvt_pk_bf16(o0.x, o0.y); w0.y = cvt_pk_bf16(o0.z, o0.w); w1.x = cvt_pk_bf16(o1.x, o1.y); w1.y = cvt_pk_bf16(o1.z, o1.w);
                            *(u32x2*)dst = w0; *(u32x2*)(dst + 16) = w1;
                        } else {
                            const int hkv = 2 * bj + (wc >> 1), ch0 = 4 * (wc & 1) + (fq >> 1);
                            unsigned char* dst = kb + ((size_t)((b * 4 + hkv) * 32 + (t >> 6))) * 8192 + ch0 * 1024 + (t & 63) * 16 + 8 * (fq & 1);
                            u32x2 w0, w1; w0.x = cvt_pk_bf16(o0.x, o0.y); w0.y = cvt_pk_bf16(o0.z, o0.w); w1.x = cvt_pk_bf16(o1.x, o1.y); w1.y = cvt_pk_bf16(o1.z, o1.w);
                            *(u32x2*)dst = w0; *(u32x2*)(dst + 2048) = w1;
                        }
                    }
                }
        } else if (kind == KD_KC) {
#pragma unroll
            for (int ai = 0; ai < 2; ++ai)
#pragma unroll
                for (int m = 0; m < 4; ++m) {
                    const int r = (u.pm - M / 256) * 256 + 128 * ai + 64 * wr + 16 * m + fr, l = r & 255, b = r >> 8;
#pragma unroll
                    for (int bj = 0; bj < 2; ++bj) {
                        const int hkv = 2 * bj + (wc >> 1), ch0 = 4 * (wc & 1) + (fq >> 1);
                        unsigned char* dst = kcb + ((size_t)((b * 4 + hkv) * 4 + (l >> 6))) * 8192 + ch0 * 1024 + (l & 63) * 16 + 8 * (fq & 1);
#pragma unroll
                        for (int n = 0; n < 2; ++n) { const f32x4 v = acc[ai][bj][m][n]; u32x2 w; w.x = cvt_pk_bf16(v.x, v.y); w.y = cvt_pk_bf16(v.z, v.w); *(u32x2*)(dst + n * 2048) = w; }
                    }
                }
        } else if (kind == KD_VT || kind == KD_VTC) {
#pragma unroll
            for (int ai = 0; ai < 2; ++ai)
#pragma unroll
                for (int m = 0; m < 4; ++m) {
                    const int hkv = 2 * ai + wr, d = 16 * m + fr;
#pragma unroll
                    for (int bj = 0; bj < 2; ++bj) {
                        size_t blk;
                        if (kind == KD_VT) blk = (size_t)(((u.pn >> 3) * 4 + hkv) * 32 + 4 * (u.pn & 7) + 2 * bj + (wc >> 1));
                        else blk = (size_t)((u.pn * 4 + hkv) * 4 + 2 * bj + (wc >> 1));
                        unsigned char* base = (kind == KD_VT ? vb : vcb) + blk * 8192 + d * 16 + 8 * (fq >> 1);
#pragma unroll
                        for (int n = 0; n < 2; ++n) { const f32x4 v = acc[ai][bj][m][n]; u32x2 w; w.x = cvt_pk_bf16(v.x, v.y); w.y = cvt_pk_bf16(v.z, v.w);
                            *(u32x2*)(base + (2 * (2 * (wc & 1) + n) + (fq & 1)) * 1024) = w; }
                    }
                }
        } else if (kind == KD_UC) {
#pragma unroll
            for (int ai = 0; ai < 2; ++ai)
#pragma unroll
                for (int m = 0; m < 4; ++m) {
                    const int r = u.pm * 256 + 128 * ai + 64 * wr + 16 * m + fr;
                    const f32x4 v0 = acc[ai][0][m][0] * acc[ai][1][m][0], v1 = acc[ai][0][m][1] * acc[ai][1][m][1];
                    u32x4 w; w.x = cvt_pk_bf16(v0.x, v0.y); w.y = cvt_pk_bf16(v0.z, v0.w); w.z = cvt_pk_bf16(v1.x, v1.y); w.w = cvt_pk_bf16(v1.z, v1.w);
                    *(u32x4*)(z + (size_t)r * 1024 + (u.pn - 5) * 128 + 32 * wc + 8 * fq) = w;
                }
        } else if (kind == KD_BC) {
#pragma unroll
            for (int ai = 0; ai < 2; ++ai)
#pragma unroll
                for (int m = 0; m < 4; ++m) {
                    const int r = u.pm * 256 + 128 * ai + 64 * wr + 16 * m + fr;
#pragma unroll
                    for (int bj = 0; bj < 2; ++bj) { const f32x4 v0 = acc[ai][bj][m][0], v1 = acc[ai][bj][m][1];
                        u32x4 w; w.x = cvt_pk_bf16(v0.x, v0.y); w.y = cvt_pk_bf16(v0.z, v0.w); w.z = cvt_pk_bf16(v1.x, v1.y); w.w = cvt_pk_bf16(v1.z, v1.w);
                        *(u32x4*)(bb + (size_t)r * 1024 + (u.pn - 13) * 256 + 128 * bj + 32 * wc + 8 * fq) = w; }
                }
        } else {
#pragma unroll
            for (int ai = 0; ai < 2; ++ai)
#pragma unroll
                for (int m = 0; m < 4; ++m) {
                    const int r = u.pm * 256 + 128 * ai + 64 * wr + 16 * m + fr;
                    f32x4 rr[2], sg[2];
#pragma unroll
                    for (int n = 0; n < 2; ++n)
#pragma unroll
                        for (int j = 0; j < 4; ++j) { const float ea = __expf(-acc[ai][0][m][n][j]), ec = __expf(-acc[ai][1][m][n][j]);
                            rr[n][j] = (1.f + ec) * __builtin_amdgcn_rcpf(1.f + ea); sg[n][j] = __builtin_amdgcn_rcpf(1.f + ec); }
                    const size_t off = (size_t)r * 1024 + (u.pn - 17) * 128 + 32 * wc + 8 * fq;
                    u32x4 w; w.x = cvt_pk_bf16(rr[0].x, rr[0].y); w.y = cvt_pk_bf16(rr[0].z, rr[0].w); w.z = cvt_pk_bf16(rr[1].x, rr[1].y); w.w = cvt_pk_bf16(rr[1].z, rr[1].w);
                    *(u32x4*)(rb + off) = w;
                    w.x = cvt_pk_bf16(sg[0].x, sg[0].y); w.y = cvt_pk_bf16(sg[0].z, sg[0].w); w.z = cvt_pk_bf16(sg[1].x, sg[1].y); w.w = cvt_pk_bf16(sg[1].z, sg[1].w);
                    *(u32x4*)(sgc + off) = w;
                }
        }
    }
};
__device__ __forceinline__ void ph_inproj(const Params& P, LAS unsigned char* lds) {
    InprojSched S; S.G = gridDim.x; S.c = blockIdx.x; S.hx = (const char*)(P.ws + WS_HX); S.win = (const char*)(P.ws + WS_WIN); S.wv = (const char*)(P.ws + WS_WV);
    EpiInproj E; E.q = (bf16_t*)(P.ws + WS_Q); E.z = (bf16_t*)(P.ws + WS_Z); E.bb = (bf16_t*)(P.ws + WS_BB); E.rb = (bf16_t*)(P.ob + OB_RB); E.sgc = (bf16_t*)(P.ob + OB_SGC);
    E.kb = P.ws + WS_KB; E.kcb = P.ws + WS_KCB; E.vb = P.ws + WS_VB; E.vcb = P.ws + WS_VCB; E.rope = (const float*)(P.ws + WS_ROPE);
#ifdef FK_STAGGER_PROBE
    { const unsigned long long t0 = __builtin_amdgcn_s_memrealtime(); const unsigned long long dt = (unsigned long long)((blockIdx.x >> 3) & 31) * FK_STAGGER_PROBE;
      while (__builtin_amdgcn_s_memrealtime() - t0 < dt) __builtin_amdgcn_s_sleep(4); }
#endif
#if defined(FK_EPI2_PROBE)
    gemm_phase<EpiInproj, InprojSched, false, false, 3>(lds, 1024, S, E);
#elif defined(FK_KREP_INPROJ)
    gemm_phase<EpiInproj, InprojSched, false, false, 2>(lds, 1024, S, E);
#else
    gemm_phase<EpiInproj, InprojSched, false>(lds, 1024, S, E);
#endif
}

constexpr int CW_QUEUE = 3584;
__device__ __forceinline__ void ph_norm1(const Params& P, LAS unsigned char* lds) {
    const int tid = threadIdx.x, lane = tid & 63, wave = __builtin_amdgcn_readfirstlane(tid >> 6), wg = blockIdx.x, G = gridDim.x;
    constexpr int NC = MC / 256;
    if (wg < 2 * NC && G > 2 * NC) {
        const int tile = wg < NC ? wg : wg - NC;
        for (int r = wave * 4; r < 256; r += 32) norm1_rows<4>(P, M + tile * 256 + r, lane);
        asm volatile("s_waitcnt vmcnt(0)" ::: "memory");
        __syncthreads();
        CtxSched S; S.c = wg; S.hx = (const char*)(P.ws + WS_HX); S.win = (const char*)(P.ws + WS_WIN); S.wv = (const char*)(P.ws + WS_WV);
        EpiInproj E; E.q = nullptr; E.z = nullptr; E.bb = nullptr; E.rb = nullptr; E.sgc = nullptr;
        E.kb = P.ws + WS_KB; E.kcb = P.ws + WS_KCB; E.vb = P.ws + WS_VB; E.vcb = P.ws + WS_VCB; E.rope = (const float*)(P.ws + WS_ROPE);
        gemm_phase<EpiInproj, CtxSched, false>(lds, 1024, S, E);
        FK_STAMP_WG(14, 0);
    } else {
        const int nw = (G - 2 * NC) * 8, gw = (wg - 2 * NC) * 8 + wave;
        for (int row = gw * 4; row < M; row += nw * 4) norm1_rows<4>(P, row, lane);
        __syncthreads(); FK_STAMP_WG(12, 40);
    }
    unsigned* head = (unsigned*)(P.ws + WS_CTL) + CW_QUEUE;
    LAS unsigned* slot = (LAS unsigned*)(lds + LDS_MISC_Q);
    for (;;) {
        __syncthreads();
        if (tid == 0) slot[0] = __hip_atomic_fetch_add(head, 32u, __ATOMIC_RELAXED, __HIP_MEMORY_SCOPE_AGENT);
        __syncthreads();
        const int base = CV_IN + (int)slot[0];
        if (base >= CV_TOTAL) break;
#pragma unroll 1
        for (int k = 0; k < 4; ++k) { const int it = base + wave * 4 + k; if (it < CV_TOTAL) conv_item(P, it, lane); }
    }
    FK_STAMP_WG(13, 40); FK_STAMP_WG(15, 0);
}

__device__ __forceinline__ int crow(int r, int hi) { return (r & 3) + 8 * (r >> 2) + 4 * hi; }
#ifndef FK_ATT_THR
#define FK_ATT_THR 24.0f
#endif
constexpr float ATT_THR = FK_ATT_THR;
constexpr int ATT_NS = 5;
struct AttnUnitInfo { int b, hkv, qb, w_lo, nwin, ntile; };
__device__ __forceinline__ AttnUnitInfo attn_decode(int uidx) {
    AttnUnitInfo u; u.b = uidx >> 7; u.hkv = (uidx >> 5) & 3; u.qb = uidx & 31;
    u.w_lo = u.qb - 2 < 0 ? 0 : u.qb - 2; const int w_hi = u.qb + 2 > 31 ? 31 : u.qb + 2; u.nwin = w_hi - u.w_lo + 1; u.ntile = u.nwin + 4; return u;
}
__device__ __forceinline__ float max3f(float a, float b, float c) { float r; asm("v_max3_f32 %0, %1, %2, %3" : "=v"(r) : "v"(a), "v"(b), "v"(c)); return r; }
__device__ __forceinline__ void attn_finish(const Params& P, const f32x16& o0, const f32x16& o1, float lrun, int b, int hkv, int qb, int g, int wsub, int r32, int hi) {
    const float ltot = lrun + __shfl_xor(lrun, 32), inv = 1.f / ltot;
    bf16_t* AO = (bf16_t*)(P.ws + WS_AO) + (size_t)(b * T + qb * 64 + 32 * wsub + r32) * 2048 + (hkv * 4 + g) * 64 + 4 * hi;
#pragma unroll
    for (int g4 = 0; g4 < 4; ++g4) {
        u32x2 w; w.x = cvt_pk_bf16(o0[4 * g4] * inv, o0[4 * g4 + 1] * inv); w.y = cvt_pk_bf16(o0[4 * g4 + 2] * inv, o0[4 * g4 + 3] * inv); *(u32x2*)(AO + 8 * g4) = w;
        w.x = cvt_pk_bf16(o1[4 * g4] * inv, o1[4 * g4 + 1] * inv); w.y = cvt_pk_bf16(o1[4 * g4 + 2] * inv, o1[4 * g4 + 3] * inv); *(u32x2*)(AO + 32 + 8 * g4) = w;
    }
}
__device__ __forceinline__ void attn_drain(const Params& P, LAS unsigned char* lds, const f32x16& Pa, const f32x16& Pb, f32x16& o0, f32x16& o1, float lrun, int vslot,
                                           int cu, int nun, int ubase, int GY, int g, int wsub, int r32, int hi) {
    float sacc = 0.f;
#pragma unroll
    for (int r = 0; r < 16; ++r) sacc += Pa[r] + Pb[r];
    lrun += sacc;
    const LAS unsigned char* Vp = lds + vslot * 16384 + 8192 + hi * 1024 + r32 * 16;
#pragma unroll
    for (int ks = 0; ks < 4; ++ks) {
        const f32x16& S = ks < 2 ? Pa : Pb; const int o = 8 * (ks & 1);
        const u32x4 pw = (u32x4){cvt_pk_bf16(S[o], S[o + 1]), cvt_pk_bf16(S[o + 2], S[o + 3]), cvt_pk_bf16(S[o + 4], S[o + 5]), cvt_pk_bf16(S[o + 6], S[o + 7])};
        const bf16x8 v0 = *(const LAS bf16x8*)(Vp + (2 * ks) * 1024), v1 = *(const LAS bf16x8*)(Vp + (2 * ks) * 1024 + 512);
        const bf16x8 pb = __builtin_bit_cast(bf16x8, pw);
        o0 = __builtin_amdgcn_mfma_f32_32x32x16_bf16(v0, pb, o0, 0, 0, 0); o1 = __builtin_amdgcn_mfma_f32_32x32x16_bf16(v1, pb, o1, 0, 0, 0);
    }
    const AttnUnitInfo li = attn_decode(ubase + GY * (nun - 1));
    attn_finish(P, o0, o1, lrun, li.b, li.hkv, li.qb, g, wsub, r32, hi);
}
__device__ __forceinline__ void attn_phase(const Params& P, LAS unsigned char* lds) {
    const int tid = threadIdx.x, lane = tid & 63, wid = __builtin_amdgcn_readfirstlane(tid >> 6), r32 = lane & 31, hi = lane >> 5;
    constexpr int NU = NBF * 4 * 32;
    const int G = gridDim.x, xg = blockIdx.x & 7, yg = blockIdx.x >> 3, GY = G >> 3;
    const int nun = (NU / 8 - yg + GY - 1) / GY;
    if (nun <= 0) return;
    const int ubase = xg * (NU / 8) + yg;
    const bf16_t* Q = (const bf16_t*)(P.ws + WS_Q);
    const unsigned char* KB = P.ws + WS_KB; const unsigned char* VB = P.ws + WS_VB; const unsigned char* KCB = P.ws + WS_KCB; const unsigned char* VCB = P.ws + WS_VCB;
    const int g = wid >> 1, wsub = wid & 1;
#define AT_WAIT(n) asm volatile("s_waitcnt vmcnt(" #n ")" ::: "memory")
#define AT_SB() __builtin_amdgcn_sched_barrier(0)
    int pu = 0, pit = 0, pstep = 0, pslot = 0; AttnUnitInfo pinfo = attn_decode(ubase);
    auto issue = [&]() {
        const size_t bh = (size_t)(pinfo.b * 4 + pinfo.hkv);
        const unsigned char* ks = pit < pinfo.nwin ? KB + (bh * 32 + pinfo.w_lo + pit) * 8192 : KCB + (bh * 4 + (pit - pinfo.nwin)) * 8192;
        const unsigned char* vs = pit < pinfo.nwin ? VB + (bh * 32 + pinfo.w_lo + pit) * 8192 : VCB + (bh * 4 + (pit - pinfo.nwin)) * 8192;
        LAS unsigned char* dst = lds + pslot * 16384 + wid * 1024;
        __builtin_amdgcn_global_load_lds((const unsigned*)(ks + wid * 1024 + lane * 16), (LAS unsigned*)dst, 16, 0, 0);
        __builtin_amdgcn_global_load_lds((const unsigned*)(vs + wid * 1024 + lane * 16), (LAS unsigned*)(dst + 8192), 16, 0, 0);
        ++pstep; pslot = pslot == ATT_NS - 1 ? 0 : pslot + 1; ++pit;
        if (pit == pinfo.ntile) { pit = 0; ++pu; if (pu < nun) pinfo = attn_decode(ubase + GY * pu); }
    };
    int total = 0;
    for (int k = 0; k < nun; ++k) total += attn_decode(ubase + GY * k).ntile;
    *(LAS u32x4*)(lds + (ATT_NS - 1) * 16384 + 8192 + tid * 16) = (u32x4){0u, 0u, 0u, 0u};
    __syncthreads();
    int cu = 0, it = 0, step = 0, cslot = 0, vslot = ATT_NS - 1; AttnUnitInfo ci = attn_decode(ubase);
    int fb = 0, fhkv = 0, fqb = 0;
    constexpr int ATT_QOFF = ATT_NS * 16384;
    auto issueQ = [&](const AttnUnitInfo& ui) {
        const bf16_t* qp = Q + (size_t)(ui.b * T + ui.qb * 64 + 32 * wsub + r32) * 1024 + (ui.hkv * 4 + g) * 64 + hi * 8;
#pragma unroll
        for (int j = 0; j < 4; ++j)
            __builtin_amdgcn_global_load_lds((const unsigned*)(qp + 16 * j), (LAS unsigned*)(lds + ATT_QOFF + wid * 4096 + j * 1024), 16, 0, 0);
    };
    float sk0 = P.sink[0 * 4 + g] * LOG2E, sk1 = P.sink[1 * 4 + g] * LOG2E, sk2 = P.sink[2 * 4 + g] * LOG2E, sk3 = P.sink[3 * 4 + g] * LOG2E;
    asm volatile("s_waitcnt vmcnt(0)" : "+v"(sk0), "+v"(sk1), "+v"(sk2), "+v"(sk3) :: "memory");
    bf16x8 qf[4];
    float sink_c = 0.f;
    const f32x16 zero16 = {0.f, 0.f, 0.f, 0.f, 0.f, 0.f, 0.f, 0.f, 0.f, 0.f, 0.f, 0.f, 0.f, 0.f, 0.f, 0.f};
    f32x16 o0, o1, pA0, pA1, pB0, pB1;
    float mrun = 0.f, lrun = 0.f; bool slow = false;
#pragma unroll
    for (int r = 0; r < 16; ++r) { o0[r] = 0.f; o1[r] = 0.f; pA0[r] = 0.f; pA1[r] = 0.f; pB0[r] = 0.f; pB1[r] = 0.f; }
    bf16x8 fr[4]; u32x4 pw[4];
    issueQ(ci);
    issue(); if (total > 1) issue(); if (total > 2) issue();
    if (total > 2) AT_WAIT(2); else AT_WAIT(0);
    __builtin_amdgcn_s_barrier(); asm volatile("" ::: "memory");
    if (pstep < total) issue();
#define AT_FA(base, i) (*(const LAS bf16x8*)((base) + (((i) >> 1) * 2) * 1024 + ((i) & 1) * 512))
    { const LAS unsigned char* K0 = lds + hi * 1024 + r32 * 16; fr[0] = AT_FA(K0, 0); fr[1] = AT_FA(K0, 1); fr[2] = AT_FA(K0, 2); }

#define AT_PK(Pa, Pb, w) cvt_pk_bf16((w) < 8 ? Pa[2 * (w)] : Pb[2 * (w) - 16], (w) < 8 ? Pa[2 * (w) + 1] : Pb[2 * (w) - 15])
#define AT_PV(Pa, Pb, i) ((i) < 16 ? Pa[(i)] : Pb[(i) - 16])
#define AT_GAPA(gi, Cn, Pa, Pb) do { \
        Cn = __builtin_amdgcn_mfma_f32_32x32x16_bf16(fr[(gi) & 3], qf[(gi) >> 1], (gi) < 2 ? zero16 : Cn, 0, 0, 0); \
        if ((gi) + 3 < 8) fr[((gi) + 3) & 3] = AT_FA(Kc, (gi) + 3); else fr[((gi) + 3) & 3] = AT_FA(Vp, (gi) + 3 - 8); \
        sacc += AT_PV(Pa, Pb, 4 * (gi)) + AT_PV(Pa, Pb, 4 * (gi) + 1); sacc2 += AT_PV(Pa, Pb, 4 * (gi) + 2) + AT_PV(Pa, Pb, 4 * (gi) + 3); \
        pw[(gi) >> 1][2 * ((gi) & 1)] = AT_PK(Pa, Pb, 2 * (gi)); pw[(gi) >> 1][2 * ((gi) & 1) + 1] = AT_PK(Pa, Pb, 2 * (gi) + 1); AT_SB(); } while (0)
#define AT_GAPB(gi, Cx, cb) do { \
        if ((gi) & 1) o1 = __builtin_amdgcn_mfma_f32_32x32x16_bf16(fr[(gi) & 3], __builtin_bit_cast(bf16x8, pw[(gi) >> 1]), o1, 0, 0, 0); \
        else o0 = __builtin_amdgcn_mfma_f32_32x32x16_bf16(fr[(gi) & 3], __builtin_bit_cast(bf16x8, pw[(gi) >> 1]), o0, 0, 0, 0); \
        if ((gi) + 3 < 8) fr[((gi) + 3) & 3] = AT_FA(Vp, (gi) + 3); else fr[((gi) + 3) & 3] = AT_FA(Kn, (gi) + 3 - 8); \
        Cx[cb] = __builtin_amdgcn_exp2f(Cx[cb]); Cx[cb + 1] = __builtin_amdgcn_exp2f(Cx[cb + 1]); Cx[cb + 2] = __builtin_amdgcn_exp2f(Cx[cb + 2]); Cx[cb + 3] = __builtin_amdgcn_exp2f(Cx[cb + 3]); \
        AT_SB(); } while (0)
#define AT_STEP(C0, C1, Pa, Pb) do { \
        const bool first = (it == 0); \
        if (first) { fb = ci.b; fhkv = ci.hkv; fqb = ci.qb; if (step > 0) { const AttnUnitInfo pi = attn_decode(ubase + GY * (cu - 1)); fb = pi.b; fhkv = pi.hkv; fqb = pi.qb; } \
            sink_c = ci.hkv == 0 ? sk0 : ci.hkv == 1 ? sk1 : ci.hkv == 2 ? sk2 : sk3; mrun = 0.f; slow = false; \
            _Pragma("unroll") for (int ks = 0; ks < 4; ++ks) qf[ks] = *(const LAS bf16x8*)(lds + ATT_QOFF + wid * 4096 + (2 * ks + hi) * 512 + r32 * 16); \
            asm volatile("s_waitcnt lgkmcnt(0)" ::: "memory"); \
            if (cu + 1 < nun) issueQ(attn_decode(ubase + GY * (cu + 1))); } \
        const LAS unsigned char* Kc = lds + cslot * 16384 + hi * 1024 + r32 * 16; \
        const LAS unsigned char* Vp = lds + vslot * 16384 + 8192 + hi * 1024 + r32 * 16; \
        const int nslot = cslot == ATT_NS - 1 ? 0 : cslot + 1; \
        const LAS unsigned char* Kn = lds + nslot * 16384 + hi * 1024 + r32 * 16; \
        float sacc = 0.f, sacc2 = 0.f; AT_SB(); \
        AT_GAPA(0, C0, Pa, Pb); AT_GAPA(1, C1, Pa, Pb); AT_GAPA(2, C0, Pa, Pb); AT_GAPA(3, C1, Pa, Pb); AT_GAPA(4, C0, Pa, Pb); AT_GAPA(5, C1, Pa, Pb); AT_GAPA(6, C0, Pa, Pb); AT_GAPA(7, C1, Pa, Pb); \
        lrun += sacc + sacc2; \
        if (slow) { _Pragma("unroll") for (int r = 0; r < 16; ++r) { C0[r] -= mrun; C1[r] -= mrun; } } \
        if (it < ci.nwin) { const int wt = ci.w_lo + it, dq = wt - ci.qb; \
            if (dq == 2 || dq == -2) { const int base = ci.qb * 64 + 32 * wsub + r32 - 64 * wt; \
                _Pragma("unroll") for (int r = 0; r < 16; ++r) { const int d0 = base - crow(r, hi), d1 = d0 - 32; \
                    if (d0 > 128 || d0 < -128) C0[r] = -1e30f; if (d1 > 128 || d1 < -128) C1[r] = -1e30f; } } } \
        float mx; { float ma = max3f(C0[0], C0[1], C1[0]), mb = max3f(C0[2], C0[3], C1[1]); ma = max3f(ma, C1[2], C1[3]); \
            _Pragma("unroll") for (int r = 4; r < 16; r += 4) { ma = max3f(ma, C0[r], C0[r + 1]); mb = max3f(mb, C0[r + 2], C0[r + 3]); ma = max3f(ma, C1[r], C1[r + 1]); mb = max3f(mb, C1[r + 2], C1[r + 3]); } \
            mx = fmaxf(ma, mb); mx = fmaxf(mx, __shfl_xor(mx, 32)); } \
        float fres = 1.f; bool resc = false; \
        if (__any(mx > ATT_THR)) { const float dl = fmaxf(mx, 0.f); fres = __builtin_amdgcn_exp2f(-dl); mrun += dl; resc = true; slow = true; \
            _Pragma("unroll") for (int r = 0; r < 16; ++r) { C0[r] -= dl; C1[r] -= dl; } } \
        AT_SB(); \
        AT_GAPB(0, C0, 0); AT_GAPB(1, C0, 4); AT_GAPB(2, C0, 8); AT_GAPB(3, C0, 12); AT_GAPB(4, C1, 0); AT_GAPB(5, C1, 4); AT_GAPB(6, C1, 8); AT_GAPB(7, C1, 12); \
        if (first && step > 0) { attn_finish(P, o0, o1, lrun, fb, fhkv, fqb, g, wsub, r32, hi); \
            _Pragma("unroll") for (int r = 0; r < 16; ++r) { o0[r] = 0.f; o1[r] = 0.f; } lrun = (hi == 0 ? __builtin_amdgcn_exp2f(sink_c) : 0.f) * fres; } \
        else if (first) { lrun = (hi == 0 ? __builtin_amdgcn_exp2f(sink_c) : 0.f) * fres; } \
        else if (resc) { lrun *= fres; _Pragma("unroll") for (int r = 0; r < 16; ++r) { o0[r] *= fres; o1[r] *= fres; } } \
        ++it; ++step; vslot = cslot; cslot = nslot; \
        if (it == ci.ntile) { it = 0; ++cu; if (cu < nun) ci = attn_decode(ubase + GY * cu); } \
        if (step < total) { \
            const int ahead = pstep - step;        \
            if (ahead >= 3) AT_WAIT(2); else AT_WAIT(0); \
            __builtin_amdgcn_s_barrier(); asm volatile("" ::: "memory"); \
            if (pstep < total) issue(); \
        } } while (0)

    while (step < total) {
        AT_STEP(pB0, pB1, pA0, pA1);
        if (step >= total) {
            attn_drain(P, lds, pB0, pB1, o0, o1, lrun, vslot, cu, nun, ubase, GY, g, wsub, r32, hi);
            break; }
        AT_STEP(pA0, pA1, pB0, pB1);
        if (step >= total) { attn_drain(P, lds, pA0, pA1, o0, o1, lrun, vslot, cu, nun, ubase, GY, g, wsub, r32, hi); break; }
    }
    AT_WAIT(0);
    __syncthreads();
#undef AT_STEP
#undef AT_GAPA
#undef AT_GAPB
#undef AT_PK
#undef AT_PV
#undef AT_FA
#undef AT_WAIT
#undef AT_SB
}
__device__ __forceinline__ void ph_mix(const Params& P, LAS unsigned char* lds) {
    const int G = gridDim.x;
    attn_phase(P, lds);
#if (FK_DBL >> 11) & 1
    attn_phase(P, lds);
#endif
#if (FK_DBL >> 12) & 1
    for (int rep = 0; rep < 2; ++rep)
#endif
    const bf16_t* Z = (const bf16_t*)(P.ws + WS_Z); const bf16_t* BB = (const bf16_t*)(P.ws + WS_BB); bf16_t* AO = (bf16_t*)(P.ws + WS_AO);
    for (int it = blockIdx.x * 512 + threadIdx.x; it < (M / 16) * 128; it += G * 512) {
        const int cch = it & 127, tr = it >> 7, row0 = tr * 16, tl = row0 & 2047;
        const f32x4 wa = *(const f32x4*)(P.conv_w + cch * 8), wb = *(const f32x4*)(P.conv_w + cch * 8 + 4);
        const f32x4 wc0 = *(const f32x4*)(P.conv_w + 1024 + cch * 8), wc1 = *(const f32x4*)(P.conv_w + 1024 + cch * 8 + 4);
        const f32x4 we0 = *(const f32x4*)(P.conv_w + 2048 + cch * 8), we1 = *(const f32x4*)(P.conv_w + 2048 + cch * 8 + 4);
        const bf16_t* zp = Z + (size_t)row0 * 1024 + cch * 8;
        u32x4 zm = tl > 0 ? *(const u32x4*)(zp - 1024) : (u32x4){0u, 0u, 0u, 0u};
        u32x4 zc = *(const u32x4*)zp;
#pragma unroll 4
        for (int i = 0; i < 16; ++i) {
            const u32x4 zn = (tl + i + 1 < 2048) ? *(const u32x4*)(zp + (size_t)(i + 1) * 1024) : (u32x4){0u, 0u, 0u, 0u};
            const u32x4 bv = *(const u32x4*)(BB + (size_t)(row0 + i) * 1024 + cch * 8);
            float y[8];
#pragma unroll
            for (int k = 0; k < 4; ++k) {
                const float w0l = k < 2 ? wa[2 * k] : wb[2 * k - 4], w0h = k < 2 ? wa[2 * k + 1] : wb[2 * k - 3];
                const float w1l = k < 2 ? wc0[2 * k] : wc1[2 * k - 4], w1h = k < 2 ? wc0[2 * k + 1] : wc1[2 * k - 3];
                const float w2l = k < 2 ? we0[2 * k] : we1[2 * k - 4], w2h = k < 2 ? we0[2 * k + 1] : we1[2 * k - 3];
                y[2 * k] = bf_lo(bv[k]) * (w0l * bf_lo(zm[k]) + w1l * bf_lo(zc[k]) + w2l * bf_lo(zn[k]));
                y[2 * k + 1] = bf_hi(bv[k]) * (w0h * bf_hi(zm[k]) + w1h * bf_hi(zc[k]) + w2h * bf_hi(zn[k]));
            }
            u32x4 o; o.x = cvt_pk_bf16(y[0], y[1]); o.y = cvt_pk_bf16(y[2], y[3]); o.z = cvt_pk_bf16(y[4], y[5]); o.w = cvt_pk_bf16(y[6], y[7]);
            *(u32x4*)(AO + (size_t)(row0 + i) * 2048 + 1024 + cch * 8) = o;
            zm = zc; zc = zn;
        }
    }
}

struct RowColSched {
    int G, c, nM, nN; const char *A, *B; size_t ts;
    __device__ __forceinline__ bool next(int i, Unit& u) const {
        const int nwg = nM * nN, Lx = i * G + c; if (Lx >= nwg) return false;
        const int wgid = (Lx % 8) * (nwg / 8) + Lx / 8;
        const int nig = 8 * nN, gid = wgid / nig, w = wgid % nig;
        u.pm = gid * 8 + (w % 8); u.pn = w / 8; u.a = A + (size_t)u.pm * ts; u.b = B + (size_t)u.pn * ts; u.kind = 0; u.aux = 0; u.rows = nullptr; return true;
    }
};
struct EpiProj {
    const bf16_t *rb, *sgc; bf16_t* mb;
    __device__ __forceinline__ void mid(f32x4 (&acc)[2][2][4][2], const Unit& u, int wr, int wc, int fr, int fq) const {
#pragma unroll
        for (int ai = 0; ai < 2; ++ai)
#pragma unroll
            for (int m = 0; m < 4; ++m) { const int r = u.pm * 256 + 128 * ai + 64 * wr + 16 * m + fr;
#pragma unroll
                for (int bj = 0; bj < 2; ++bj) { const u32x4 w = *(const u32x4*)(rb + (size_t)r * 1024 + u.pn * 256 + 128 * bj + 32 * wc + 8 * fq);
                    acc[ai][bj][m][0] *= (f32x4){bf_lo(w.x), bf_hi(w.x), bf_lo(w.y), bf_hi(w.y)}; acc[ai][bj][m][1] *= (f32x4){bf_lo(w.z), bf_hi(w.z), bf_lo(w.w), bf_hi(w.w)}; } }
    }
    __device__ __forceinline__ void operator()(const f32x4 (&acc)[2][2][4][2], const Unit& u, int wr, int wc, int fr, int fq) const {
#pragma unroll
        for (int ai = 0; ai < 2; ++ai)
#pragma unroll
            for (int m = 0; m < 4; ++m) { const int r = u.pm * 256 + 128 * ai + 64 * wr + 16 * m + fr;
#pragma unroll
                for (int bj = 0; bj < 2; ++bj) { const size_t off = (size_t)r * 1024 + u.pn * 256 + 128 * bj + 32 * wc + 8 * fq; const u32x4 w = *(const u32x4*)(sgc + off);
                    const f32x4 v0 = acc[ai][bj][m][0] * (f32x4){bf_lo(w.x), bf_hi(w.x), bf_lo(w.y), bf_hi(w.y)}, v1 = acc[ai][bj][m][1] * (f32x4){bf_lo(w.z), bf_hi(w.z), bf_lo(w.w), bf_hi(w.w)};
                    u32x4 o; o.x = cvt_pk_bf16(v0.x, v0.y); o.y = cvt_pk_bf16(v0.z, v0.w); o.z = cvt_pk_bf16(v1.x, v1.y); o.w = cvt_pk_bf16(v1.z, v1.w);
                    *(u32x4*)(mb + off) = o; } }
    }
};
__device__ __forceinline__ void ph_proj(const Params& P, LAS unsigned char* lds) {
    RowColSched S; S.G = gridDim.x; S.c = blockIdx.x; S.nM = M / 256; S.nN = 4; S.A = (const char*)(P.ws + WS_AO); S.B = (const char*)(P.ws + WS_WP); S.ts = (size_t)256 * 2048 * 2;
    EpiProj E; E.rb = (const bf16_t*)(P.ob + OB_RB); E.sgc = (const bf16_t*)(P.ob + OB_SGC); E.mb = (bf16_t*)(P.ws + WS_MB);
    gemm_phase<EpiProj, RowColSched, true>(lds, 2048, S, E);
}
struct EpiOut {
    const float* mod; bf16_t* dl;
    __device__ __forceinline__ void operator()(const f32x4 (&acc)[2][2][4][2], const Unit& u, int wr, int wc, int fr, int fq) const {
        const int b = (u.pm * 256) >> 11;
#pragma unroll
        for (int bj = 0; bj < 2; ++bj) { const int col = u.pn * 256 + 128 * bj + 32 * wc + 8 * fq;
            const f32x4 g0 = *(const f32x4*)(mod + b * 6144 + 2048 + col), g1 = *(const f32x4*)(mod + b * 6144 + 2048 + col + 4);
#pragma unroll
            for (int ai = 0; ai < 2; ++ai)
#pragma unroll
                for (int m = 0; m < 4; ++m) { const size_t off = (size_t)(u.pm * 256 + 128 * ai + 64 * wr + 16 * m + fr) * 1024 + col;
                    const f32x4 v0 = g0 * acc[ai][bj][m][0], v1 = g1 * acc[ai][bj][m][1];
                    u32x4 w; w.x = cvt_pk_bf16(v0.x, v0.y); w.y = cvt_pk_bf16(v0.z, v0.w); w.z = cvt_pk_bf16(v1.x, v1.y); w.w = cvt_pk_bf16(v1.z, v1.w);
                    *(u32x4*)(dl + off) = w; } }
    }
};
__device__ __forceinline__ void ph_out(const Params& P, LAS unsigned char* lds) {
    RowColSched S; S.G = gridDim.x; S.c = blockIdx.x; S.nM = M / 256; S.nN = 4; S.A = (const char*)(P.ws + WS_MB); S.B = (const char*)(P.ws + WS_WO); S.ts = (size_t)256 * 1024 * 2;
    EpiOut E; E.mod = (const float*)(P.ws + WS_MOD); E.dl = (bf16_t*)(P.ws + WS_DL);
    gemm_phase<EpiOut, RowColSched, false>(lds, 1024, S, E);
}

__device__ __forceinline__ void ph_router(const Params& P, LAS unsigned char* lds) {
    const int tid = threadIdx.x, lane = tid & 63, wave = tid >> 6;
    LAS float* wt = (LAS float*)lds;
    for (int i = tid; i < 16384; i += 512) { const int k = i >> 4, e = i & 15; wt[e * 1024 + k] = P.w_router[i]; }
    __syncthreads();
    const bf16_t* DL = (const bf16_t*)(P.ws + WS_DL); const float* mod = (const float*)(P.ws + WS_MOD);
    bf16_t* HX2 = (bf16_t*)(P.ws + WS_HX2); float* AFF = (float*)(P.ws + WS_AFF);
    f32x4 nx0[4], nx1[4]; u32x4 nd0[2], nd1[2];
    const int rp0 = blockIdx.x * 8 + wave, rstep = gridDim.x * 8;
#define RT_LOAD(rpv) do { _Pragma("unroll") for (int j = 0; j < 2; ++j) { const size_t o0 = (size_t)((rpv) * 2) * D + 8 * lane + 512 * j; \
        nx0[2 * j] = *(const f32x4*)(P.x + o0); nx0[2 * j + 1] = *(const f32x4*)(P.x + o0 + 4); nx1[2 * j] = *(const f32x4*)(P.x + o0 + D); nx1[2 * j + 1] = *(const f32x4*)(P.x + o0 + D + 4); \
        nd0[j] = *(const u32x4*)(DL + o0); nd1[j] = *(const u32x4*)(DL + o0 + D); } } while (0)
    if (rp0 < M / 2) RT_LOAD(rp0);
    for (int rp = rp0; rp < M / 2; rp += rstep) {
        const int row = rp * 2, b = row >> 11; const float* mv = mod + b * 6144;
        f32x4 v0[4], v1[4]; float s0 = 0.f, s1 = 0.f;
#pragma unroll
        for (int j = 0; j < 2; ++j) { f32x4 a, c; bf8_to_f32(nd0[j], a, c); v0[2 * j] = nx0[2 * j] + a; v0[2 * j + 1] = nx0[2 * j + 1] + c; bf8_to_f32(nd1[j], a, c); v1[2 * j] = nx1[2 * j] + a; v1[2 * j + 1] = nx1[2 * j + 1] + c;
            s0 += sq4(v0[2 * j]) + sq4(v0[2 * j + 1]); s1 += sq4(v1[2 * j]) + sq4(v1[2 * j + 1]); }
        if (rp + rstep < M / 2) RT_LOAD(rp + rstep);
        const float r0 = 1.0f / sqrtf(wave_sum(s0) * (1.f / D) + 1e-6f), r1 = 1.0f / sqrtf(wave_sum(s1) * (1.f / D) + 1e-6f);
#pragma unroll
        for (int j = 0; j < 2; ++j) { const int c0 = 8 * lane + 512 * j;
            const f32x4 g0 = *(const f32x4*)(P.norm2_g + c0) * (*(const f32x4*)(mv + 4096 + c0) + 1.0f), g1 = *(const f32x4*)(P.norm2_g + c0 + 4) * (*(const f32x4*)(mv + 4096 + c0 + 4) + 1.0f);
            const f32x4 sh0 = *(const f32x4*)(mv + 3072 + c0), sh1 = *(const f32x4*)(mv + 3072 + c0 + 4);
            v0[2 * j] = v0[2 * j] * r0 * g0 + sh0; v0[2 * j + 1] = v0[2 * j + 1] * r0 * g1 + sh1; v1[2 * j] = v1[2 * j] * r1 * g0 + sh0; v1[2 * j + 1] = v1[2 * j + 1] * r1 * g1 + sh1;
            *(u32x4*)(HX2 + (size_t)row * D + c0) = f32_to_bf8(v0[2 * j], v0[2 * j + 1]); *(u32x4*)(HX2 + (size_t)(row + 1) * D + c0) = f32_to_bf8(v1[2 * j], v1[2 * j + 1]); }
        float pa[16], pc[16];
#pragma unroll
        for (int e = 0; e < 16; ++e) { float a = 0.f, c = 0.f;
#pragma unroll
            for (int j = 0; j < 4; ++j) { const f32x4 w = *(const LAS f32x4*)(wt + e * 1024 + 8 * lane + 512 * (j >> 1) + 4 * (j & 1));
                a += dot4(v0[j], w); c += dot4(v1[j], w); }
            pa[e] = a; pc[e] = c;
            if ((e & 1) == 1) __builtin_amdgcn_sched_barrier(0); }
#define RT_HALVE(H, DIST) do { const bool up = (lane & (DIST)) != 0; _Pragma("unroll") for (int i = 0; i < (H); ++i) { \
            const float ka = up ? pa[i + (H)] : pa[i], sa = up ? pa[i] : pa[i + (H)], kc = up ? pc[i + (H)] : pc[i], sc = up ? pc[i] : pc[i + (H)]; \
            pa[i] = ka + __shfl_xor(sa, (DIST)); pc[i] = kc + __shfl_xor(sc, (DIST)); } } while (0)
        RT_HALVE(8, 32); RT_HALVE(4, 16); RT_HALVE(2, 8); RT_HALVE(1, 4);
#undef RT_HALVE
        float l0 = pa[0], l1 = pc[0];
        l0 += __shfl_xor(l0, 2); l1 += __shfl_xor(l1, 2); l0 += __shfl_xor(l0, 1); l1 += __shfl_xor(l1, 1);
        float m0 = l0, m1 = l1;
#pragma unroll
        for (int o = 4; o < 64; o <<= 1) { m0 = fmaxf(m0, __shfl_xor(m0, o)); m1 = fmaxf(m1, __shfl_xor(m1, o)); }
        const float e0 = expf(l0 - m0), e1 = expf(l1 - m1);
        float z0 = e0, z1 = e1;
#pragma unroll
        for (int o = 4; o < 64; o <<= 1) { z0 += __shfl_xor(z0, o); z1 += __shfl_xor(z1, o); }
        if ((lane & 3) == 0) { const int ex = ((lane >> 5) & 1) * 8 + ((lane >> 4) & 1) * 4 + ((lane >> 3) & 1) * 2 + ((lane >> 2) & 1); const int t = row & 2047;
            AFF[(size_t)(b * 16 + ex) * T + t] = e0 / z0; AFF[(size_t)(b * 16 + ex) * T + t + 1] = e1 / z1; }
    }
}

__device__ __forceinline__ int block_count4(bool p0, bool p1, bool p2, bool p3, LAS int* red, int par, int wave, int lane) {
    const int c = __builtin_popcountll(__ballot(p0)) + __builtin_popcountll(__ballot(p1)) + __builtin_popcountll(__ballot(p2)) + __builtin_popcountll(__ballot(p3));
    if (lane == 0) red[par * 8 + wave] = c;
    __syncthreads();
    const LAS int* r = red + par * 8;
    return (r[0] + r[1]) + (r[2] + r[3]) + (r[4] + r[5]) + (r[6] + r[7]);
}
__device__ __forceinline__ int block_excl_prefix(int v, LAS int* red, int wave, int lane, int& total) {
    int inc = v;
#pragma unroll
    for (int o = 1; o < 64; o <<= 1) { const int n = __shfl_up(inc, o); if (lane >= o) inc += n; }
    __syncthreads();
    if (lane == 63) red[wave] = inc;
    __syncthreads();
    int base = 0, tot = 0;
#pragma unroll
    for (int w = 0; w < 8; ++w) { const int s = red[w]; if (w < wave) base += s; tot += s; }
    total = tot; return base + inc - v;
}
__device__ __forceinline__ void ph_topk(const Params& P, LAS unsigned char* lds) {
    const int tid = threadIdx.x, lane = tid & 63, wave = tid >> 6;
    LAS int* red = (LAS int*)lds;
    const float* AFF = (const float*)(P.ws + WS_AFF); int* IDX = (int*)(P.ws + WS_IDX); float* GATE = (float*)(P.ws + WS_GATE); int* SEL = (int*)(P.ws + WS_SEL);
    for (int be = blockIdx.x; be < NBF * 16; be += gridDim.x) {
        const int b = be >> 4, e = be & 15;
        const u32x4 kv = *(const u32x4*)(AFF + (size_t)be * T + tid * 4);
        unsigned thr = 0u;
        for (int bit = 31; bit >= 0; --bit) { const unsigned cand = thr | (1u << bit);
            const int cnt = block_count4(kv.x >= cand, kv.y >= cand, kv.z >= cand, kv.w >= cand, red, bit & 1, wave, lane);
            if (cnt >= CAP) thr = cand; }
        const int ngt = block_count4(kv.x > thr, kv.y > thr, kv.z > thr, kv.w > thr, red, 1, wave, lane);
        const int need = CAP - ngt;
        int tot;
        const int e0 = kv.x == thr, e1 = kv.y == thr, e2 = kv.z == thr, e3 = kv.w == thr;
        const int eqb = block_excl_prefix(e0 + e1 + e2 + e3, red + 32, wave, lane, tot);
        const int s0 = (kv.x > thr) || (e0 && eqb < need), s1 = (kv.y > thr) || (e1 && eqb + e0 < need), s2 = (kv.z > thr) || (e2 && eqb + e0 + e1 < need),
                  s3 = (kv.w > thr) || (e3 && eqb + e0 + e1 + e2 < need);
        const int sb = block_excl_prefix(s0 + s1 + s2 + s3, red + 32, wave, lane, tot);
        const int p0 = sb, p1 = sb + s0, p2 = p1 + s1, p3 = p2 + s2;
        const int t0 = 4 * tid;
        if (s0) { IDX[be * CAP + p0] = t0; GATE[be * CAP + p0] = __uint_as_float(kv.x); }
        if (s1) { IDX[be * CAP + p1] = t0 + 1; GATE[be * CAP + p1] = __uint_as_float(kv.y); }
        if (s2) { IDX[be * CAP + p2] = t0 + 2; GATE[be * CAP + p2] = __uint_as_float(kv.z); }
        if (s3) { IDX[be * CAP + p3] = t0 + 3; GATE[be * CAP + p3] = __uint_as_float(kv.w); }
        SEL[(size_t)(b * T + t0) * 16 + e] = s0 ? p0 : -1; SEL[(size_t)(b * T + t0 + 1) * 16 + e] = s1 ? p1 : -1;
        SEL[(size_t)(b * T + t0 + 2) * 16 + e] = s2 ? p2 : -1; SEL[(size_t)(b * T + t0 + 3) * 16 + e] = s3 ? p3 : -1;
        __syncthreads();
    }
}

struct MoeUpSched {
    int G, c; const char *hx2, *wgu; const int* idx;
    __device__ __forceinline__ bool next(int i, Unit& u) const {
        const int Lx = i * G + c; if (Lx >= NBF * 128) return false;
        const int x = Lx & 7, j = Lx >> 3, e = 2 * x + j / (NBF * 8), jj = j % (NBF * 8), rg = jj >> 5, w = jj & 31;
        const int smp = 8 * (rg >> 1) + (w & 7), pn = 4 * (rg & 1) + (w >> 3), be = smp * 16 + e;
        u.pm = be; u.pn = pn; u.kind = 0; u.aux = e; u.a = hx2 + (size_t)smp * ((size_t)T * 1024 * 2); u.rows = idx + be * CAP; u.b = wgu + ((size_t)e * 2048 + pn * 256) * 2048; return true;
    }
};
struct EpiUp {
    bf16_t* hb;
    __device__ __forceinline__ void operator()(const f32x4 (&acc)[2][2][4][2], const Unit& u, int wr, int wc, int fr, int fq) const {
#pragma unroll
        for (int ai = 0; ai < 2; ++ai)
#pragma unroll
            for (int m = 0; m < 4; ++m) { const int r = u.pm * 256 + 128 * ai + 64 * wr + 16 * m + fr;
                f32x4 h[2];
#pragma unroll
                for (int n = 0; n < 2; ++n)
#pragma unroll
                    for (int j = 0; j < 4; ++j) { const float a = acc[ai][0][m][n][j]; h[n][j] = a * __builtin_amdgcn_rcpf(1.f + __expf(-a)) * acc[ai][1][m][n][j]; }
                u32x4 w; w.x = cvt_pk_bf16(h[0].x, h[0].y); w.y = cvt_pk_bf16(h[0].z, h[0].w); w.z = cvt_pk_bf16(h[1].x, h[1].y); w.w = cvt_pk_bf16(h[1].z, h[1].w);
                *(u32x4*)(hb + (size_t)r * 1024 + u.pn * 128 + 32 * wc + 8 * fq) = w; }
    }
};
__device__ __forceinline__ void ph_moe_up(const Params& P, LAS unsigned char* lds) {
    MoeUpSched S; S.G = gridDim.x; S.c = blockIdx.x; S.hx2 = (const char*)(P.ws + WS_HX2); S.idx = (const int*)(P.ws + WS_IDX); S.wgu = (const char*)(P.ws + WS_WGU);
    EpiUp E; E.hb = (bf16_t*)(P.ob + OB_HB);
    gemm_phase<EpiUp, MoeUpSched, false, true>(lds, 1024, S, E);
}
struct MoeDownSched {
    int G, c; const char *hb, *wd;
    __device__ __forceinline__ bool next(int i, Unit& u) const {
        const int Lx = i * G + c; if (Lx >= NBF * 64) return false;
        const int x = Lx & 7, j = Lx >> 3, e = 2 * x + j / (NBF * 4), jj = j % (NBF * 4), rg = jj >> 5, w = jj & 31;
        const int smp = 8 * rg + (w & 7), pn = w >> 3, be = smp * 16 + e;
        u.pm = be; u.pn = pn; u.kind = 0; u.aux = e; u.rows = nullptr; u.a = hb + (size_t)be * (256 * 1024 * 2); u.b = wd + ((size_t)e * 1024 + pn * 256) * 2048; return true;
    }
};
struct EpiDown {
    const float* gate; bf16_t* ye;
    __device__ __forceinline__ void operator()(const f32x4 (&acc)[2][2][4][2], const Unit& u, int wr, int wc, int fr, int fq) const {
#pragma unroll
        for (int ai = 0; ai < 2; ++ai)
#pragma unroll
            for (int m = 0; m < 4; ++m) { const int r = u.pm * 256 + 128 * ai + 64 * wr + 16 * m + fr; const float gt = gate[r];
#pragma unroll
                for (int bj = 0; bj < 2; ++bj) { const f32x4 v0 = acc[ai][bj][m][0] * gt, v1 = acc[ai][bj][m][1] * gt;
                    u32x4 w; w.x = cvt_pk_bf16(v0.x, v0.y); w.y = cvt_pk_bf16(v0.z, v0.w); w.z = cvt_pk_bf16(v1.x, v1.y); w.w = cvt_pk_bf16(v1.z, v1.w);
                    *(u32x4*)(ye + (size_t)r * 1024 + u.pn * 256 + 128 * bj + 32 * wc + 8 * fq) = w; } }
    }
};
__device__ __forceinline__ void ph_moe_down(const Params& P, LAS unsigned char* lds) {
    MoeDownSched S; S.G = gridDim.x; S.c = blockIdx.x; S.hb = (const char*)(P.ob + OB_HB); S.wd = (const char*)(P.ws + WS_WD);
    EpiDown E; E.gate = (const float*)(P.ws + WS_GATE); E.ye = (bf16_t*)(P.ws + WS_YE);
    gemm_phase<EpiDown, MoeDownSched, false>(lds, 1024, S, E);
}

__device__ __forceinline__ void ph_final(const Params& P) {
    const int lane = threadIdx.x & 63, wave = threadIdx.x >> 6;
    const bf16_t* DL = (const bf16_t*)(P.ws + WS_DL); const float* mod = (const float*)(P.ws + WS_MOD); const int* SEL = (const int*)(P.ws + WS_SEL); const bf16_t* YE = (const bf16_t*)(P.ws + WS_YE);
    constexpr int NR = 2;
#ifdef FK_TS
    float ts_eps; { const unsigned long long* tsp = (const unsigned long long*)(P.ws + WS_CTL) + 1800;
        const unsigned long long t0 = __hip_atomic_load(tsp + FK_TS, __ATOMIC_RELAXED, __HIP_MEMORY_SCOPE_AGENT); unsigned long long t1 = 0ull;
        for (int sp = 0; sp < 100000 && (t1 = __hip_atomic_load(tsp + FK_TS2, __ATOMIC_RELAXED, __HIP_MEMORY_SCOPE_AGENT)) == 0ull; ++sp) __builtin_amdgcn_s_sleep(2);
        ts_eps = (float)(t1 - t0) * FK_TS_SCALE; }
#endif
    for (int row0 = (blockIdx.x * 8 + wave) * NR; row0 < M; row0 += gridDim.x * 8 * NR) {
        const int b = row0 >> 11;
        int sv[NR]; f32x4 xv[NR][4]; u32x4 dv[NR][2];
#pragma unroll
        for (int r = 0; r < NR; ++r) { sv[r] = SEL[(size_t)(row0 + r) * 16 + (lane & 15)];
#pragma unroll
            for (int j = 0; j < 2; ++j) { const size_t o = (size_t)(row0 + r) * D + 8 * lane + 512 * j; xv[r][2 * j] = *(const f32x4*)(P.x + o); xv[r][2 * j + 1] = *(const f32x4*)(P.x + o + 4); dv[r][j] = *(const u32x4*)(DL + o); } }
        f32x4 mo[NR][4];
#pragma unroll
        for (int r = 0; r < NR; ++r)
#pragma unroll
            for (int j = 0; j < 4; ++j) mo[r][j] = (f32x4){0.f, 0.f, 0.f, 0.f};
#pragma unroll
        for (int e = 0; e < 16; ++e) {
#pragma unroll
            for (int r = 0; r < NR; ++r) { const int sl = __builtin_amdgcn_readlane(sv[r], e);
                if (sl >= 0) { const bf16_t* yr = YE + ((size_t)(b * 16 + e) * CAP + sl) * D + 8 * lane;
#pragma unroll
                    for (int j = 0; j < 2; ++j) { f32x4 a, c; bf8_to_f32(*(const u32x4*)(yr + 512 * j), a, c); mo[r][2 * j] += a; mo[r][2 * j + 1] += c; } } } }
#pragma unroll
        for (int r = 0; r < NR; ++r) { float ss = 0.f; f32x4 v[4];
#pragma unroll
            for (int j = 0; j < 2; ++j) { const int c0 = 8 * lane + 512 * j; f32x4 a, c; bf8_to_f32(dv[r][j], a, c);
                v[2 * j] = xv[r][2 * j] + a + *(const f32x4*)(mod + b * 6144 + 5120 + c0) * mo[r][2 * j]; v[2 * j + 1] = xv[r][2 * j + 1] + c + *(const f32x4*)(mod + b * 6144 + 5120 + c0 + 4) * mo[r][2 * j + 1];
                ss += sq4(v[2 * j]) + sq4(v[2 * j + 1]); }
            const float rs = 1.0f / sqrtf(wave_sum(ss) * (1.f / D) + 1e-6f);
#pragma unroll
            for (int j = 0; j < 2; ++j) { const int c0 = 8 * lane + 512 * j;
#ifdef FK_TS
                { const f32x4 tsa = {1.f + ts_eps, 1.f - ts_eps, 1.f + ts_eps, 1.f - ts_eps};
                  *(f32x4*)(P.out + (size_t)(row0 + r) * D + c0) = v[2 * j] * rs * *(const f32x4*)(P.fg + c0) * tsa; *(f32x4*)(P.out + (size_t)(row0 + r) * D + c0 + 4) = v[2 * j + 1] * rs * *(const f32x4*)(P.fg + c0 + 4) * tsa; } } }
#else
                *(f32x4*)(P.out + (size_t)(row0 + r) * D + c0) = v[2 * j] * rs * *(const f32x4*)(P.fg + c0); *(f32x4*)(P.out + (size_t)(row0 + r) * D + c0 + 4) = v[2 * j + 1] * rs * *(const f32x4*)(P.fg + c0 + 4); } }
#endif
    }
}

#define XB_TMO      128
#define XB_XCNT(j)  (256  + 64 * (j))
#define XB_XSUB(j)  (1280 + 64 * (j))
#define XB_XGEN(j)  (2304 + 64 * (j))
#define XB_TOP      3328
#define XB_TOPGEN   3392
#define XCD_BAR_WORDS 3456
#define XB_SPIN_CAP (1u << 20)
__device__ __forceinline__ unsigned xb_ld(unsigned* p)              { return __hip_atomic_load(p, __ATOMIC_RELAXED, __HIP_MEMORY_SCOPE_AGENT); }
__device__ __forceinline__ unsigned xb_add(unsigned* p, unsigned v) { return __hip_atomic_fetch_add(p, v, __ATOMIC_RELAXED, __HIP_MEMORY_SCOPE_AGENT); }
__device__ __forceinline__ unsigned xb_xcc_id() { return (unsigned)__builtin_amdgcn_s_getreg((3 << 11) | 20) & 0xFu; }
#define XB_SPIN(cond, bar) do { unsigned _sp = 0; while (cond) { __builtin_amdgcn_s_sleep(1); \
    if ((++_sp & 255u) == 0u) { if (xb_ld(&(bar)[XB_TMO])) break; if (_sp > XB_SPIN_CAP) { atomicAdd(&(bar)[XB_TMO], 1u); break; } } } } while (0)
struct XcdBarrier { unsigned* bar; unsigned x; volatile LAS unsigned* st; };
__device__ __forceinline__ XcdBarrier xcd_barrier_post(unsigned* bar, volatile LAS unsigned* st) {
    XcdBarrier b; b.bar = bar; b.x = xb_xcc_id(); b.st = st;
    if (threadIdx.x == 0) (void)xb_add(&bar[XB_XCNT(b.x)], 1u);
    return b;
}
__device__ __forceinline__ void xcd_barrier_complete(unsigned* bar, unsigned x, unsigned& nloc, unsigned& nx) {
    const unsigned G = gridDim.x * gridDim.y * gridDim.z;
    unsigned sum, cnt, mine, sp = 0u;
    for (;;) {
        sum = 0u; cnt = 0u; mine = 0u;
#pragma unroll
        for (unsigned j = 0; j < 16; ++j) { const unsigned c = xb_ld(&bar[XB_XCNT(j)]); sum += c; cnt += (c > 0u) ? 1u : 0u; mine = (j == x) ? c : mine; }
        if (sum == G) break;
        __builtin_amdgcn_s_sleep(1);
        if ((++sp & 255u) == 0u) { if (xb_ld(&bar[XB_TMO])) break; if (sp > XB_SPIN_CAP) { atomicAdd(&bar[XB_TMO], 1u); break; } }
    }
    nloc = mine > 0u ? mine : 1u; nx = cnt > 0u ? cnt : 1u;
}
__device__ __forceinline__ void xcd_barrier(const XcdBarrier& b) {
    asm volatile("s_waitcnt vmcnt(0)" ::: "memory");
    __syncthreads();
    if (threadIdx.x == 0) {
        unsigned* bar = b.bar;
        __builtin_amdgcn_s_waitcnt(0);
        unsigned nloc = b.st[0], nx = b.st[1];
        if (nloc == 0u) { xcd_barrier_complete(bar, b.x, nloc, nx); b.st[0] = nloc; b.st[1] = nx; }
        const unsigned old = xb_add(&bar[XB_XSUB(b.x)], 1u);
        const unsigned gen = old / nloc;
        if (old + 1u == (gen + 1u) * nloc) {
            __builtin_amdgcn_fence(__ATOMIC_RELEASE, "agent");
            asm volatile("s_waitcnt vmcnt(0)" ::: "memory");
            const unsigned og = xb_add(&bar[XB_TOP], 1u);
            const unsigned tg = og / nx;
            if (og + 1u == (tg + 1u) * nx) xb_add(&bar[XB_TOPGEN], 1u);
            else XB_SPIN(xb_ld(&bar[XB_TOPGEN]) == tg, bar);
            __builtin_amdgcn_fence(__ATOMIC_ACQUIRE, "agent");
            xb_add(&bar[XB_XGEN(b.x)], 1u);
            asm volatile("s_waitcnt vmcnt(0)" ::: "memory");
        } else {
            XB_SPIN(xb_ld(&bar[XB_XGEN(b.x)]) == gen, bar);
            __builtin_amdgcn_fence(__ATOMIC_ACQUIRE, "agent");
            asm volatile("s_waitcnt vmcnt(0)" ::: "memory");
        }
    }
    __syncthreads();
}


#ifdef FK_COPYPROBE
#ifndef FK_COPYMODE
#define FK_COPYMODE 0
#endif
__device__ __forceinline__ void ph_copyprobe(const Params& P) {
    const int lane = threadIdx.x & 63, wave = threadIdx.x >> 6;
    const u32x4* src = (const u32x4*)P.wg; u32x4* dst = (u32x4*)(P.ws + WS_AO);
    const size_t nchunk = (size_t)16 * 1024 * 1024 * 4 / 4096;
    constexpr int CH = FK_COPYMODE == 1 ? 12 : 4;
    constexpr int NJ = (FK_COPYMODE == 2 || FK_COPYMODE == 3) ? 1 : 4;
    constexpr int CSTR = FK_COPYMODE == 3 ? 4 : 1;
#if FK_COPYMODE == 7
    return;
#endif
#if FK_COPYMODE == 5 || FK_COPYMODE == 6
    u32x4 acc4 = {0u, 0u, 0u, 0u};
    for (size_t c0 = (size_t)(blockIdx.x * 8 + wave) * CH; c0 < nchunk; c0 += (size_t)gridDim.x * 8 * CH) {
#pragma unroll
        for (int r = 0; r < CH; ++r)
#pragma unroll
            for (int j = 0; j < NJ; ++j) { const size_t c = c0 + r < nchunk ? c0 + r : nchunk - 1;
                if (FK_COPYMODE == 5) { const u32x4 t = src[c * 256 + lane + 64 * j]; acc4.x ^= t.x; acc4.y ^= t.y; acc4.z ^= t.z; acc4.w ^= t.w; }
                else dst[c * 256 + lane + 64 * j] = (u32x4){(unsigned)c, 1u, 2u, 3u}; }
    }
    if (FK_COPYMODE == 5) dst[(size_t)(blockIdx.x * 8 + wave) * 64 + lane] = acc4;
    return;
#endif
#if FK_COPYMODE == 4
    const size_t per = nchunk / ((size_t)gridDim.x * 8), cbeg = (size_t)(blockIdx.x * 8 + wave) * per;
    for (size_t c0 = cbeg; c0 < cbeg + per; c0 += CH) {
#else
    for (size_t c0 = (size_t)(blockIdx.x * 8 + wave) * CH; c0 < nchunk; c0 += (size_t)gridDim.x * 8 * CH) {
#endif
        u32x4 v[CH][NJ];
#pragma unroll
        for (int r = 0; r < CH; ++r)
#pragma unroll
            for (int j = 0; j < NJ; ++j) { const size_t c = c0 + r < nchunk ? c0 + r : nchunk - 1; v[r][j] = src[(c / CSTR * CSTR) * 256 + lane + 64 * j]; }
#pragma unroll
        for (int r = 0; r < CH; ++r)
#pragma unroll
            for (int j = 0; j < NJ; ++j) { const size_t c = c0 + r < nchunk ? c0 + r : nchunk - 1; dst[(c / CSTR * CSTR) * 256 + lane + 64 * j] = v[r][j]; }
    }
}
#endif
constexpr int NPHASE = 11;
constexpr size_t CTL_ZERO_BYTES = 16384;
#ifndef FK_MASK
#define FK_MASK 0x7ff
#endif
#ifndef FK_CGSYNC
#define FK_CGSYNC 0
#endif
__global__ void __launch_bounds__(512, 2) mega(Params P) {
    extern __shared__ __attribute__((aligned(16))) unsigned char lds_raw[];
    LAS unsigned char* lds = (LAS unsigned char*)lds_raw;
    cg::grid_group grid = cg::this_grid();
    volatile LAS unsigned* misc = (volatile LAS unsigned*)(lds + LDS_MISC);
    if (threadIdx.x < 2) misc[threadIdx.x] = 0u;
    __syncthreads();
    const XcdBarrier bar = xcd_barrier_post((unsigned*)(P.ws + WS_CTL), misc);
    const int lo = P.ph_lo, hi = P.ph_hi;
    if (lo < 0) grid.sync();
#define FK_SYNC(k) do { if ((k) < FK_CGSYNC) grid.sync(); else xcd_barrier(bar); } while (0)
    typedef const __attribute__((address_space(4))) Params* KArgPtr;
#if defined(__HIP_DEVICE_COMPILE__)
#define FK_ARGS(name) KArgPtr kp_##name = (KArgPtr)__builtin_amdgcn_kernarg_segment_ptr(); asm volatile("" : "+s"(kp_##name)); const Params name = *(const Params*)kp_##name
#else
#define FK_ARGS(name) const Params name = P
#endif
#define FK_PH(k, call) if (((FK_MASK >> (k)) & 1) && lo <= (k) && (k) < hi) { { FK_ARGS(L); call; } if ((FK_DBL >> (k)) & 1) { FK_SYNC(k); { FK_ARGS(L); call; } } if ((k) + 1 < hi) { FK_SYNC(k); FK_STAMP((k) + 1); } }
    FK_STAMP(0);
    FK_PH(0, ph_prep(L, lds))
#ifdef FK_COPYPROBE
    for (int rep = 0; rep < FK_COPYPROBE; ++rep) { { FK_ARGS(L); ph_copyprobe(L); } xcd_barrier(bar); }
#endif
    FK_PH(1, ph_norm1(L, lds))
    FK_PH(2, ph_inproj(L, lds))
    FK_PH(3, ph_mix(L, lds))
    FK_PH(4, ph_proj(L, lds))
    FK_PH(5, ph_out(L, lds))
    FK_PH(6, ph_router(L, lds))
    FK_PH(7, ph_topk(L, lds))
    FK_PH(8, ph_moe_up(L, lds))
    FK_PH(9, ph_moe_down(L, lds))
    FK_PH(10, ph_final(L))
#undef FK_ARGS
#undef FK_PH
#undef FK_SYNC
}
}
static void fk_launch(fk::Params p, int lo, int hi, hipStream_t stream);
#if HYB >= 0
#include <hip/hip_runtime.h>

namespace nv {
constexpr int D = 1024, T = 2048, L = 256, NB = 16, INW = 6656, NE = 16, CAP = 256;

__global__ void k_mod(const float* __restrict__ c, const float* __restrict__ c_ctx, const float* __restrict__ w_mod,
                      const float* __restrict__ b_mod, float* __restrict__ mod) {
    const int n = blockIdx.x * 256 + threadIdx.x, r = blockIdx.y;
    const float* cv = r < 16 ? c + r * 1024 : c_ctx;
    float acc = 0.f;
    for (int k = 0; k < 1024; ++k) { const float v = cv[k]; const float s = v / (1.f + expf(-v)); acc += s * w_mod[(size_t)k * 6144 + n]; }
    mod[r * 6144 + n] = acc + b_mod[n];
}

__device__ __forceinline__ float block_sum256(float v, float* red) {
#pragma unroll
    for (int o = 32; o > 0; o >>= 1) v += __shfl_xor(v, o);
    __syncthreads();
    if ((threadIdx.x & 63) == 0) red[threadIdx.x >> 6] = v;
    __syncthreads();
    return red[0] + red[1] + red[2] + red[3];
}

__global__ void k_norm_mod(const float* __restrict__ x, const float* __restrict__ g, const float* __restrict__ shift,
                           const float* __restrict__ scale, float* __restrict__ out) {
    __shared__ float red[4];
    const int row = blockIdx.x, t = threadIdx.x;
    const float* xr = x + (size_t)row * D;
    float v[4]; float ss = 0.f;
#pragma unroll
    for (int j = 0; j < 4; ++j) { v[j] = xr[t + 256 * j]; ss += v[j] * v[j]; }
    const float tot = block_sum256(ss, red);
    const float rs = 1.0f / sqrtf(tot * (1.f / D) + 1e-6f);
#pragma unroll
    for (int j = 0; j < 4; ++j) { const int cidx = t + 256 * j; out[(size_t)row * D + cidx] = v[j] * rs * g[cidx] * (1.f + scale[cidx]) + shift[cidx]; }
}

__global__ __launch_bounds__(256) void k_sgemm(const float* __restrict__ A, int lda, const int* __restrict__ rows, long sA, long sRows,
                                               const float* __restrict__ B, int ldb, long sB, float* __restrict__ C, int ldc, long sC, int K) {
    __shared__ float As[16][65];
    __shared__ float Bs[16][64];
    const int z = blockIdx.z;
    A += (size_t)z * sA; B += (size_t)z * sB; C += (size_t)z * sC; if (rows) rows += (size_t)z * sRows;
    const int tx = threadIdx.x & 15, ty = threadIdx.x >> 4;
    const int m0 = blockIdx.y * 64, n0 = blockIdx.x * 64;
    float acc[4][4];
#pragma unroll
    for (int i = 0; i < 4; ++i)
#pragma unroll
        for (int j = 0; j < 4; ++j) acc[i][j] = 0.f;
    for (int k0 = 0; k0 < K; k0 += 16) {
#pragma unroll
        for (int ii = 0; ii < 4; ++ii) { const int i = threadIdx.x + 256 * ii; const int r = i >> 4, kk = i & 15; const int row = m0 + r; const int src = rows ? rows[row] : row;
            As[kk][r] = A[(size_t)src * lda + k0 + kk]; }
#pragma unroll
        for (int ii = 0; ii < 4; ++ii) { const int i = threadIdx.x + 256 * ii; const int kk = i >> 6, cc = i & 63; Bs[kk][cc] = B[(size_t)(k0 + kk) * ldb + n0 + cc]; }
        __syncthreads();
#pragma unroll
        for (int kk = 0; kk < 16; ++kk) {
            float a[4], b[4];
#pragma unroll
            for (int i = 0; i < 4; ++i) a[i] = As[kk][ty * 4 + i];
#pragma unroll
            for (int j = 0; j < 4; ++j) b[j] = Bs[kk][tx * 4 + j];
#pragma unroll
            for (int i = 0; i < 4; ++i)
#pragma unroll
                for (int j = 0; j < 4; ++j) acc[i][j] += a[i] * b[j];
        }
        __syncthreads();
    }
#pragma unroll
    for (int i = 0; i < 4; ++i)
#pragma unroll
        for (int j = 0; j < 4; ++j) C[(size_t)(m0 + ty * 4 + i) * ldc + n0 + tx * 4 + j] = acc[i][j];
}

__global__ void k_rope(float* __restrict__ P) {
    const int gid = blockIdx.x * 256 + threadIdx.x;
    const int pr = gid & 31, hs = (gid >> 5) % 20, t = gid / (32 * 20);
    if (t >= T) return;
    const int half = pr >> 4, i = pr & 15;
    const float pos = half == 0 ? (float)(t / 64) : (float)(t % 64);
    const float inv_freq = powf(10000.f, -(float)i / 16.f);
    const float ang = pos * inv_freq;
    const float cs = cosf(ang), sn = sinf(ang);
    float* p = P + (size_t)t * INW + hs * 64 + half * 32 + i;
    const float x1 = p[0], x2 = p[16];
    p[0] = x1 * cs - x2 * sn;
    p[16] = x2 * cs + x1 * sn;
}

__global__ __launch_bounds__(64) void k_attn(const float* __restrict__ P, const float* __restrict__ kvc, const float* __restrict__ sink, float* __restrict__ o) {
    __shared__ float qs[64];
    __shared__ float sc[257 + 256];
    const int t = blockIdx.x, h = blockIdx.y, hkv = h >> 2, d = threadIdx.x;
    qs[d] = P[(size_t)t * INW + h * 64 + d];
    __syncthreads();
    const int lo = t - 128 < 0 ? 0 : t - 128, hi = t + 128 > T - 1 ? T - 1 : t + 128, nw = hi - lo + 1, ntot = nw + L;
    for (int j = d; j < ntot; j += 64) {
        const float* kp = j < nw ? P + (size_t)(lo + j) * INW + 1024 + hkv * 64 : kvc + (size_t)(j - nw) * 512 + hkv * 64;
        float s = 0.f;
        for (int dd = 0; dd < 64; ++dd) s += qs[dd] * kp[dd];
        sc[j] = s * 0.125f;
    }
    __syncthreads();
    const float sk = sink[h];
    float m = sk;
    for (int j = d; j < ntot; j += 64) m = fmaxf(m, sc[j]);
#pragma unroll
    for (int off = 32; off > 0; off >>= 1) m = fmaxf(m, __shfl_xor(m, off));
    float l = 0.f;
    for (int j = d; j < ntot; j += 64) { const float p = expf(sc[j] - m); sc[j] = p; l += p; }
#pragma unroll
    for (int off = 32; off > 0; off >>= 1) l += __shfl_xor(l, off);
    l += expf(sk - m);
    __syncthreads();
    float acc = 0.f;
    for (int j = 0; j < ntot; ++j) {
        const float* vp = j < nw ? P + (size_t)(lo + j) * INW + 1280 + hkv * 64 : kvc + (size_t)(j - nw) * 512 + 256 + hkv * 64;
        acc += sc[j] * vp[d];
    }
    o[(size_t)t * D + h * 64 + d] = acc / l;
}

__global__ void k_conv(const float* __restrict__ P, const float* __restrict__ cw, float* __restrict__ y) {
    const int gid = blockIdx.x * 256 + threadIdx.x; const int ch = gid & 1023, t = gid >> 10;
    const float* pr = P + (size_t)t * INW;
    const float z1 = pr[3584 + ch] * pr[1536 + ch];
    const float z0 = t > 0 ? pr[3584 + ch - INW] * pr[1536 + ch - INW] : 0.f;
    const float z2 = t < T - 1 ? pr[3584 + ch + INW] * pr[1536 + ch + INW] : 0.f;
    y[gid] = pr[2560 + ch] * (cw[ch] * z0 + cw[1024 + ch] * z1 + cw[2048 + ch] * z2);
}

__global__ void k_merge(const float* __restrict__ P, float* __restrict__ a, const float* __restrict__ s) {
    const int gid = blockIdx.x * 256 + threadIdx.x; const int ch = gid & 1023, t = gid >> 10;
    const float ga = P[(size_t)t * INW + 4608 + ch], gc = P[(size_t)t * INW + 5632 + ch];
    a[gid] = a[gid] / (1.f + expf(-ga)) + s[gid] / (1.f + expf(-gc));
}

__global__ void k_resid(const float* __restrict__ x, const float* __restrict__ g, const float* __restrict__ o, float* __restrict__ x1) {
    const int gid = blockIdx.x * 256 + threadIdx.x; const int ch = gid & 1023;
    x1[gid] = x[gid] + g[ch] * o[gid];
}

__global__ void k_router(const float* __restrict__ x1, const float* __restrict__ g, const float* __restrict__ shift, const float* __restrict__ scale,
                         const float* __restrict__ w_router, float* __restrict__ hx2, float* __restrict__ aff) {
    __shared__ float red[4];
    __shared__ float lg[16];
    const int row = blockIdx.x, t = threadIdx.x;
    const float* xr = x1 + (size_t)row * D;
    float v[4]; float ss = 0.f;
#pragma unroll
    for (int j = 0; j < 4; ++j) { v[j] = xr[t + 256 * j]; ss += v[j] * v[j]; }
    const float tot = block_sum256(ss, red);
    const float rs = 1.0f / sqrtf(tot * (1.f / D) + 1e-6f);
#pragma unroll
    for (int j = 0; j < 4; ++j) { const int cidx = t + 256 * j; v[j] = v[j] * rs * g[cidx] * (1.f + scale[cidx]) + shift[cidx]; hx2[(size_t)row * D + cidx] = v[j]; }
    for (int e = 0; e < 16; ++e) {
        float p = 0.f;
#pragma unroll
        for (int j = 0; j < 4; ++j) p += v[j] * w_router[(size_t)(t + 256 * j) * 16 + e];
        const float s = block_sum256(p, red);
        if (t == 0) lg[e] = s;
    }
    __syncthreads();
    if (t < 16) {
        float m = lg[0];
        for (int e = 1; e < 16; ++e) m = fmaxf(m, lg[e]);
        float sum = 0.f;
        for (int e = 0; e < 16; ++e) sum += expf(lg[e] - m);
        aff[(size_t)t * T + row] = expf(lg[t] - m) / sum;
    }
}

__global__ void k_topk(const float* __restrict__ aff, int* __restrict__ idx, float* __restrict__ gate, int* __restrict__ sel) {
    __shared__ float a[T];
    const int e = blockIdx.x;
    for (int i = threadIdx.x; i < T; i += 256) a[i] = aff[(size_t)e * T + i];
    __syncthreads();
    for (int i = threadIdx.x; i < T; i += 256) {
        const float v = a[i]; int rank = 0;
        for (int j = 0; j < T; ++j) { const float w = a[j]; rank += (w > v || (w == v && j < i)) ? 1 : 0; }
        if (rank < CAP) { idx[e * CAP + rank] = i; gate[e * CAP + rank] = v; sel[i * 16 + e] = rank; }
        else sel[i * 16 + e] = -1;
    }
}

__global__ void k_silu_mul(float* __restrict__ a, const float* __restrict__ u) {
    const size_t gid = (size_t)blockIdx.x * 256 + threadIdx.x;
    const float v = a[gid];
    a[gid] = v / (1.f + expf(-v)) * u[gid];
}

__global__ void k_combine(const float* __restrict__ x1, const float* __restrict__ g2, const float* __restrict__ ye, const float* __restrict__ gate,
                          const int* __restrict__ sel, const float* __restrict__ fg, float* __restrict__ out) {
    __shared__ float red[4];
    const int row = blockIdx.x, t = threadIdx.x;
    float m[4] = {0.f, 0.f, 0.f, 0.f};
    for (int e = 0; e < 16; ++e) {
        const int s = sel[row * 16 + e];
        if (s >= 0) { const float gt = gate[e * CAP + s]; const float* yr = ye + ((size_t)e * CAP + s) * D;
#pragma unroll
            for (int j = 0; j < 4; ++j) m[j] += gt * yr[t + 256 * j]; }
    }
    float v[4]; float ss = 0.f;
#pragma unroll
    for (int j = 0; j < 4; ++j) { const int cidx = t + 256 * j; v[j] = x1[(size_t)row * D + cidx] + g2[cidx] * m[j]; ss += v[j] * v[j]; }
    const float tot = block_sum256(ss, red);
    const float rs = 1.0f / sqrtf(tot * (1.f / D) + 1e-6f);
#pragma unroll
    for (int j = 0; j < 4; ++j) { const int cidx = t + 256 * j; out[(size_t)row * D + cidx] = v[j] * rs * fg[cidx]; }
}

struct Inputs {
    const float *x, *c, *ctx, *c_ctx, *w_mod, *b_mod, *norm1_g, *w_in, *sink, *conv_w, *wpa, *wpc, *wo, *norm2_g, *w_router, *wg, *wu, *wd, *fg;
};
struct Scratch {
    float *mod, *hx, *hc, *P, *kvc, *oat, *yc, *a, *s, *o1, *x1, *hx2, *aff, *gate, *ea, *eu, *ye; int *idx, *sel;
};
inline size_t carve(Scratch& S, char* base) {
    size_t off = 0;
    auto take = [&](size_t bytes) { char* p = base + off; off += (bytes + 255) & ~(size_t)255; return p; };
    S.mod = (float*)take(17 * 6144 * 4);
    S.hx = (float*)take((size_t)T * D * 4); S.hc = (float*)take((size_t)L * D * 4);
    S.P = (float*)take((size_t)T * INW * 4); S.kvc = (float*)take((size_t)L * 512 * 4);
    S.oat = (float*)take((size_t)T * D * 4); S.yc = (float*)take((size_t)T * D * 4);
    S.a = (float*)take((size_t)T * D * 4); S.s = (float*)take((size_t)T * D * 4); S.o1 = (float*)take((size_t)T * D * 4);
    S.x1 = (float*)take((size_t)T * D * 4); S.hx2 = (float*)take((size_t)T * D * 4);
    S.aff = (float*)take((size_t)NE * T * 4); S.gate = (float*)take(NE * CAP * 4); S.idx = (int*)take(NE * CAP * 4); S.sel = (int*)take((size_t)T * 16 * 4);
    S.ea = S.P; S.eu = S.P + (size_t)NE * CAP * D; S.ye = S.P + (size_t)2 * NE * CAP * D;
    return off;
}

inline void run_mod(const Inputs& I, const Scratch& S, hipStream_t st) { k_mod<<<dim3(24, 17), 256, 0, st>>>(I.c, I.c_ctx, I.w_mod, I.b_mod, S.mod); }
inline void s1a_norm(const Inputs& I, const Scratch& S, int b, hipStream_t st) {
    const float* mb = S.mod + b * 6144; const float* mc = S.mod + 16 * 6144;
    k_norm_mod<<<T, 256, 0, st>>>(I.x + (size_t)b * T * D, I.norm1_g, mb, mb + 1024, S.hx);
    k_norm_mod<<<L, 256, 0, st>>>(I.ctx + (size_t)b * L * D, I.norm1_g, mc, mc + 1024, S.hc);
}
inline void s1b_gemm(const Inputs& I, const Scratch& S, int b, hipStream_t st) {
    k_sgemm<<<dim3(INW / 64, T / 64, 1), 256, 0, st>>>(S.hx, D, nullptr, 0, 0, I.w_in, INW, 0, S.P, INW, 0, D);
    k_sgemm<<<dim3(512 / 64, L / 64, 1), 256, 0, st>>>(S.hc, D, nullptr, 0, 0, I.w_in + 1024, INW, 0, S.kvc, 512, 0, D);
    k_rope<<<T * 20 * 32 / 256, 256, 0, st>>>(S.P);
}
inline void s2_mix(const Inputs& I, const Scratch& S, int b, hipStream_t st) {
    k_attn<<<dim3(T, 16), 64, 0, st>>>(S.P, S.kvc, I.sink, S.oat);
    k_conv<<<T * D / 256, 256, 0, st>>>(S.P, I.conv_w, S.yc);
}
inline void s3_merge(const Inputs& I, const Scratch& S, int b, hipStream_t st) {
    k_sgemm<<<dim3(D / 64, T / 64, 1), 256, 0, st>>>(S.oat, D, nullptr, 0, 0, I.wpa, D, 0, S.a, D, 0, D);
    k_sgemm<<<dim3(D / 64, T / 64, 1), 256, 0, st>>>(S.yc, D, nullptr, 0, 0, I.wpc, D, 0, S.s, D, 0, D);
    k_merge<<<T * D / 256, 256, 0, st>>>(S.P, S.a, S.s);
}
inline void s4_out(const Inputs& I, const Scratch& S, int b, hipStream_t st) {
    k_sgemm<<<dim3(D / 64, T / 64, 1), 256, 0, st>>>(S.a, D, nullptr, 0, 0, I.wo, D, 0, S.o1, D, 0, D);
    k_resid<<<T * D / 256, 256, 0, st>>>(I.x + (size_t)b * T * D, S.mod + b * 6144 + 2048, S.o1, S.x1);
}
inline void s5_router(const Inputs& I, const Scratch& S, int b, hipStream_t st) {
    const float* mb = S.mod + b * 6144;
    k_router<<<T, 256, 0, st>>>(S.x1, I.norm2_g, mb + 3072, mb + 4096, I.w_router, S.hx2, S.aff);
}
inline void s6_topk(const Inputs& I, const Scratch& S, int b, hipStream_t st) { k_topk<<<NE, 256, 0, st>>>(S.aff, S.idx, S.gate, S.sel); }
inline void s7_up(const Inputs& I, const Scratch& S, int b, hipStream_t st) {
    k_sgemm<<<dim3(D / 64, CAP / 64, NE), 256, 0, st>>>(S.hx2, D, S.idx, 0, CAP, I.wg, D, (long)D * D, S.ea, D, (long)CAP * D, D);
    k_sgemm<<<dim3(D / 64, CAP / 64, NE), 256, 0, st>>>(S.hx2, D, S.idx, 0, CAP, I.wu, D, (long)D * D, S.eu, D, (long)CAP * D, D);
    k_silu_mul<<<NE * CAP * D / 256, 256, 0, st>>>(S.ea, S.eu);
}
inline void s8_down(const Inputs& I, const Scratch& S, int b, hipStream_t st) {
    k_sgemm<<<dim3(D / 64, CAP / 64, NE), 256, 0, st>>>(S.ea, D, nullptr, (long)CAP * D, 0, I.wd, D, (long)D * D, S.ye, D, (long)CAP * D, D);
}
inline void s9_final(const Inputs& I, const Scratch& S, int b, float* out, hipStream_t st) {
    k_combine<<<T, 256, 0, st>>>(S.x1, S.mod + b * 6144 + 5120, S.ye, S.gate, S.sel, I.fg, out + (size_t)b * T * D);
}
}
namespace hyb {
using fk::bf16_t;
__device__ __forceinline__ float bf2f(bf16_t v) { return __uint_as_float((unsigned)v << 16); }
__global__ void k_cv_bf16(const bf16_t* __restrict__ src, size_t spitch, float* __restrict__ dst, int cols, size_t n) {
    const size_t gid = (size_t)blockIdx.x * 256 + threadIdx.x; if (gid >= n) return;
    const size_t r = gid / cols; const int c = (int)(gid % cols);
    dst[gid] = bf2f(src[r * spitch + c]);
}
__global__ void k_copy_f32(const float* __restrict__ src, float* __restrict__ dst, size_t n) { const size_t gid = (size_t)blockIdx.x * 256 + threadIdx.x; if (gid < n) dst[gid] = src[gid]; }
__global__ void k_copy_i32(const int* __restrict__ src, int* __restrict__ dst, size_t n) { const size_t gid = (size_t)blockIdx.x * 256 + threadIdx.x; if (gid < n) dst[gid] = src[gid]; }
__global__ void k_fill_f32(float* __restrict__ dst, float v, size_t n) { const size_t gid = (size_t)blockIdx.x * 256 + threadIdx.x; if (gid < n) dst[gid] = v; }
__device__ __forceinline__ float logit_(float p) { return p >= 1.f ? 30.f : (p <= 0.f ? -30.f : logf(p / (1.f - p))); }
__global__ void k_cv_P(const unsigned char* __restrict__ ws, const unsigned char* __restrict__ ob, int b, float* __restrict__ Pn) {
    const size_t gid = (size_t)blockIdx.x * 256 + threadIdx.x; if (gid >= (size_t)2048 * 6656) return;
    const int t = (int)(gid / 6656), col = (int)(gid % 6656); const size_t row = (size_t)b * 2048 + t;
    float v;
    if (col < 1024) v = bf2f(((const bf16_t*)(ws + fk::WS_Q))[row * 1024 + col]) / fk::C2;
    else if (col < 1280) { const int hkv = (col - 1024) >> 6, d = col & 63; const size_t blk = (size_t)((b * 4 + hkv) * 32 + (t >> 6));
        v = bf2f(*(const bf16_t*)(ws + fk::WS_KB + blk * 8192 + (d >> 3) * 1024 + (t & 63) * 16 + (d & 7) * 2)); }
    else if (col < 1536) { const int hkv = (col - 1280) >> 6, d = col & 63; const size_t blk = (size_t)((b * 4 + hkv) * 32 + (t >> 6));
        const int kk = t & 63, s = kk >> 4, w = kk & 15, h = (w >> 2) & 1, e = w >> 3, jj = w & 3;
        v = bf2f(*(const bf16_t*)(ws + fk::WS_VB + blk * 8192 + (2 * s + h) * 1024 + d * 16 + 8 * e + 2 * jj)); }
    else if (col < 2560) v = bf2f(((const bf16_t*)(ws + fk::WS_Z))[row * 1024 + col - 1536]);
    else if (col < 3584) v = bf2f(((const bf16_t*)(ws + fk::WS_BB))[row * 1024 + col - 2560]);
    else if (col < 4608) v = 1.f;
    else { const int ch = col < 5632 ? col - 4608 : col - 5632;
        const float r = bf2f(((const bf16_t*)(ob + fk::OB_RB))[row * 1024 + ch]), sg = bf2f(((const bf16_t*)(ob + fk::OB_SGC))[row * 1024 + ch]);
        v = col < 5632 ? logit_(r * sg) : logit_(sg); }
    Pn[gid] = v;
}
__global__ void k_cv_kvc(const unsigned char* __restrict__ ws, int b, float* __restrict__ kvc) {
    const int gid = blockIdx.x * 256 + threadIdx.x; if (gid >= 256 * 512) return;
    const int l = gid >> 9, col = gid & 511;
    if (col < 256) { const int hkv = col >> 6, d = col & 63; const size_t blk = (size_t)((b * 4 + hkv) * 4 + (l >> 6));
        kvc[gid] = bf2f(*(const bf16_t*)(ws + fk::WS_KCB + blk * 8192 + (d >> 3) * 1024 + (l & 63) * 16 + (d & 7) * 2)); }
    else { const int hkv = (col - 256) >> 6, d = col & 63; const size_t blk = (size_t)((b * 4 + hkv) * 4 + (l >> 6));
        const int kk = l & 63, s = kk >> 4, w = kk & 15, h = (w >> 2) & 1, e = w >> 3, jj = w & 3;
        kvc[gid] = bf2f(*(const bf16_t*)(ws + fk::WS_VCB + blk * 8192 + (2 * s + h) * 1024 + d * 16 + 8 * e + 2 * jj)); }
}
inline unsigned nblk(size_t n) { return (unsigned)((n + 255) / 256); }

inline void run(fk::Params p, void* const* d_in, float* out, char* nbase, size_t nbytes, hipStream_t st) {
    nv::Inputs I; const float** ip = (const float**)&I; for (int i = 0; i < 19; ++i) ip[i] = (const float*)d_in[i];
    nv::Scratch S; const size_t need = nv::carve(S, nbase);
    if (need > nbytes) { fprintf(stderr, "hybrid: scratch too small %zu > %zu\n", need, nbytes); return; }
    constexpr int X = HYB;
    if (X >= 10) { fk_launch(p, 0, fk::NPHASE, st); }
    else { fk_launch(p, 0, X + 1, st); }
    nv::run_mod(I, S, st);
    const unsigned char* ws = p.ws; const unsigned char* ob = p.ob;
    constexpr size_t TD = (size_t)2048 * 1024;
    for (int b = 0; b < 16; ++b) {
        const bool fast = b < fk::NBF;
        if (b == fk::NBF && X == 0) nv::run_mod(I, S, st);
        int from = 0;
        if (fast) {
            const size_t r0 = (size_t)b * 2048;
            if (X == 0) { k_copy_f32<<<nblk(17 * 6144), 256, 0, st>>>((const float*)(ws + fk::WS_MOD), S.mod, 17 * 6144); from = 0; }
            else if (X == 1) { k_cv_bf16<<<nblk(TD), 256, 0, st>>>((const bf16_t*)(ws + fk::WS_HX) + r0 * 1024, 1024, S.hx, 1024, TD);
                k_cv_bf16<<<nblk(256 * 1024), 256, 0, st>>>((const bf16_t*)(ws + fk::WS_HX) + ((size_t)fk::M + (size_t)b * 256) * 1024, 1024, S.hc, 1024, (size_t)256 * 1024); from = 1; }
            else if (X == 2 || X == 3) { k_cv_P<<<nblk((size_t)2048 * 6656), 256, 0, st>>>(ws, ob, b, S.P); k_cv_kvc<<<512, 256, 0, st>>>(ws, b, S.kvc); from = 2;
                if (X == 3) { k_cv_bf16<<<nblk(TD), 256, 0, st>>>((const bf16_t*)(ws + fk::WS_AO) + r0 * 2048, 2048, S.oat, 1024, TD);
                    k_cv_bf16<<<nblk(TD), 256, 0, st>>>((const bf16_t*)(ws + fk::WS_AO) + r0 * 2048 + 1024, 2048, S.yc, 1024, TD); from = 3; } }
            else if (X == 4) { k_cv_bf16<<<nblk(TD), 256, 0, st>>>((const bf16_t*)(ws + fk::WS_MB) + r0 * 1024, 1024, S.a, 1024, TD); from = 4; }
            else {
                k_cv_bf16<<<nblk(TD), 256, 0, st>>>((const bf16_t*)(ws + fk::WS_DL) + r0 * 1024, 1024, S.o1, 1024, TD); nv::k_resid<<<nblk(TD), 256, 0, st>>>(I.x + r0 * 1024, S.one, S.o1, S.x1); from = 5;
                if (X >= 6) { k_cv_bf16<<<nblk(TD), 256, 0, st>>>((const bf16_t*)(ws + fk::WS_HX2) + r0 * 1024, 1024, S.hx2, 1024, TD);
                    k_copy_f32<<<nblk(16 * 2048), 256, 0, st>>>((const float*)(ws + fk::WS_AFF) + (size_t)b * 16 * 2048, S.aff, 16 * 2048); from = 6; }
                if (X >= 7) { k_copy_i32<<<nblk(16 * 256), 256, 0, st>>>((const int*)(ws + fk::WS_IDX) + b * 16 * 256, S.idx, 16 * 256);
                    k_copy_f32<<<nblk(16 * 256), 256, 0, st>>>((const float*)(ws + fk::WS_GATE) + b * 16 * 256, S.gate, 16 * 256);
                    k_copy_i32<<<nblk(2048 * 16), 256, 0, st>>>((const int*)(ws + fk::WS_SEL) + r0 * 16, S.sel, 2048 * 16); from = 7; }
                if (X >= 8) { k_cv_bf16<<<nblk((size_t)4096 * 1024), 256, 0, st>>>((const bf16_t*)(ob + fk::OB_HB) + (size_t)b * 4096 * 1024, 1024, S.ea, 1024, (size_t)4096 * 1024); from = 8; }
                if (X >= 9) { k_cv_bf16<<<nblk((size_t)4096 * 1024), 256, 0, st>>>((const bf16_t*)(ws + fk::WS_YE) + (size_t)b * 4096 * 1024, 1024, S.ye, 1024, (size_t)4096 * 1024);
                    k_fill_f32<<<nblk(16 * 256), 256, 0, st>>>(S.gate, 1.f, 16 * 256); from = 9; }
                if (X >= 10) from = 10;
            }
        }
        if (from <= 0) nv::s1a_norm(I, S, b, st);
        if (from <= 1) nv::s1b_gemm(I, S, b, st);
        if (from <= 2) nv::s2_mix(I, S, b, st);
        if (from <= 3) nv::s3_merge(I, S, b, st);
        if (from <= 4) nv::s4_out(I, S, b, st);
        if (from <= 5) nv::s5_router(I, S, b, st);
        if (from <= 6) nv::s6_topk(I, S, b, st);
        if (from <= 7) nv::s7_up(I, S, b, st);
        if (from <= 8) nv::s8_down(I, S, b, st);
        if (from <= 9) nv::s9_final(I, S, b, out, st);
    }
}
}
#endif

static int fk_grid = 0;
static bool fk_setup() {
    if (fk_grid) return fk_grid > 0;
    int dev = 0, cus = 0, per_cu = 0;
    if (hipGetDevice(&dev) != hipSuccess || hipDeviceGetAttribute(&cus, hipDeviceAttributeMultiprocessorCount, dev) != hipSuccess) { fk_grid = -1; return false; }
    if (hipFuncSetAttribute((const void*)fk::mega, hipFuncAttributeMaxDynamicSharedMemorySize, fk::LDS_BYTES) != hipSuccess) { fprintf(stderr, "kernel_launch: hipFuncSetAttribute failed\n"); fk_grid = -1; return false; }
    if (hipOccupancyMaxActiveBlocksPerMultiprocessor(&per_cu, (const void*)fk::mega, 512, fk::LDS_BYTES) != hipSuccess || per_cu < 1) { fprintf(stderr, "kernel_launch: occupancy query says %d\n", per_cu); fk_grid = -1; return false; }
    fk_grid = cus * per_cu;
    return true;
}
static void fk_launch(fk::Params p, int lo, int hi, hipStream_t stream) {
    p.ph_lo = lo; p.ph_hi = hi;
    if (hipMemsetAsync(p.ws + fk::WS_CTL, 0, fk::CTL_ZERO_BYTES, stream) != hipSuccess) { fprintf(stderr, "kernel_launch: memset failed\n"); return; }
    if (lo == 0 && hipMemsetAsync(p.ws + fk::WS_MOD, 0, 17 * 6144 * 4, stream) != hipSuccess) { fprintf(stderr, "kernel_launch: memset failed\n"); return; }
    void* args[] = {&p};
    hipError_t e = hipLaunchCooperativeKernel((const void*)fk::mega, dim3(fk_grid), dim3(512), args, fk::LDS_BYTES, stream);
    if (e != hipSuccess) fprintf(stderr, "kernel_launch: cooperative launch failed: %s (grid %d)\n", hipGetErrorString(e), fk_grid);
}

extern "C" void kernel_launch(void* const* d_in, const int* in_sizes, int n_in, void* d_out, int out_size, void* d_ws, size_t ws_size, hipStream_t stream) {
    if (n_in != 19 || !fk_setup()) { fprintf(stderr, "kernel_launch: bad setup (n_in %d)\n", n_in); return; }
    fk::Params p{};
    const float** ip = (const float**)&p;
    for (int i = 0; i < 19; ++i) ip[i] = (const float*)d_in[i];
    p.out = (float*)d_out; p.ws = (unsigned char*)d_ws;
#if HYB < 0
    if (ws_size < fk::R_END) { fprintf(stderr, "kernel_launch: workspace too small: %zu < %zu\n", ws_size, (size_t)fk::R_END); return; }
    p.ob = (unsigned char*)d_out;
    fk_launch(p, 0, fk::NPHASE, stream);
#else
    p.ob = (unsigned char*)d_ws + fk::R_END;
    hyb::run(p, d_in, (float*)d_out, (char*)d_ws + fk::R_END + fk::OB_BYTES, ws_size - fk::R_END - fk::OB_BYTES, stream);
#endif
}
```
